# Optimizing an MI355X kernel written in HIP

```python
import jax, jax.numpy as jnp
from jax import lax
import numpy as np

D_MODEL = 1024
BATCH = 4
SEQ = 8192
DEPTH = 1

D_LRU = D_MODEL // 2
D_RET = D_MODEL // 2
D_MIX = D_LRU + D_RET
LRU_HEADS = 8
LRU_HEAD_DIM = D_LRU // LRU_HEADS
CONV_WIDTH = 4
LRU_C = 8.0
RET_HEADS = 4
RET_HEAD_DIM = D_RET // RET_HEADS
RET_CHUNK = 128
ROPE_THETA = 10000.0
MAX_POS_OFFSET = 1024
D_IN = 2 * D_LRU + 4 * D_RET
N_EXPERTS = 32
TOP_K = 4
D_FF = D_MODEL
SWIGLU_ALPHA = 1.702
SWIGLU_LIMIT = 7.0
MOE_BLOCK = 128
NORM_EPS = 1e-5

kernel_name = "hymba_rglru_retention_moe"


def rmsnorm(x, g):
    xf = x.astype(jnp.float32)
    y = xf * lax.rsqrt(jnp.mean(xf * xf, axis=-1, keepdims=True) + NORM_EPS)
    return (y * g.astype(jnp.float32)).astype(x.dtype)


def causal_conv1d(x, w, b):
    c = x.shape[-1]
    y = lax.conv_general_dilated(x, w[:, None, :].astype(x.dtype), window_strides=(1,),
                                 padding=[(CONV_WIDTH - 1, 0)],
                                 dimension_numbers=('NWC', 'WIO', 'NWC'),
                                 feature_group_count=c)
    return y + b.astype(x.dtype)


def rg_lru(x, wa, ba, wx, bx, lam):
    bsz, seq, _ = x.shape
    xh = x.reshape(bsz, seq, LRU_HEADS, LRU_HEAD_DIM)
    r = jax.nn.sigmoid(jnp.einsum('bshi,hij->bshj', xh, wa).reshape(bsz, seq, D_LRU) + ba)
    i = jax.nn.sigmoid(jnp.einsum('bshi,hij->bshj', xh, wx).reshape(bsz, seq, D_LRU) + bx)
    log_a = -LRU_C * r.astype(jnp.float32) * jax.nn.softplus(-lam.astype(jnp.float32))
    a = jnp.exp(log_a)
    b_in = jnp.sqrt(-jnp.expm1(2.0 * log_a)) * (i * x).astype(jnp.float32)

    def combine(c1, c2):
        a1, b1 = c1
        a2, b2 = c2
        return a1 * a2, a2 * b1 + b2

    _, h = lax.associative_scan(combine, (a, b_in), axis=1)
    return h.astype(x.dtype)


def rotary(x, positions):
    half = RET_HEAD_DIM // 2
    inv_freq = ROPE_THETA ** (-jnp.arange(half, dtype=jnp.float32) / half)
    ang = positions.astype(jnp.float32)[..., None] * inv_freq
    cos = jnp.cos(ang)[:, :, None, :]
    sin = jnp.sin(ang)[:, :, None, :]
    xf = x.astype(jnp.float32)
    x1, x2 = xf[..., :half], xf[..., half:]
    return jnp.concatenate([x1 * cos - x2 * sin, x2 * cos + x1 * sin], axis=-1)


def chunkwise_retention(q, k, v):
    bsz, seq, _, _ = q.shape
    nc = seq // RET_CHUNK

    def to_chunks(t):
        return t.reshape(bsz, nc, RET_CHUNK, RET_HEADS, RET_HEAD_DIM).transpose(0, 3, 1, 2, 4)

    qc, kc, vc = to_chunks(q), to_chunks(k), to_chunks(v)
    log_gamma = jnp.log1p(-jnp.exp2(-5.0 - jnp.arange(RET_HEADS, dtype=jnp.float32)))
    pos = jnp.arange(RET_CHUNK, dtype=jnp.float32)
    rel = pos[:, None] - pos[None, :]
    causal = rel >= 0
    decay = jnp.where(causal, jnp.exp(log_gamma[:, None, None] * jnp.where(causal, rel, 0.0)), 0.0)
    scores = jnp.einsum('bhncd,bhnmd->bhncm', qc, kc) * decay[None, :, None]
    intra = jnp.einsum('bhncm,bhnmd->bhncd', scores, vc)
    zeta = jnp.exp(log_gamma[:, None] * (RET_CHUNK - 1.0 - pos))
    chunk_kv = jnp.einsum('bhnmd,bhnme->bhnde', kc * zeta[None, :, None, :, None], vc)
    chunk_decay = jnp.exp(log_gamma * RET_CHUNK)[None, :, None, None]

    def step(state, kv_n):
        return chunk_decay * state + kv_n, state

    init = jnp.zeros((bsz, RET_HEADS, RET_HEAD_DIM, RET_HEAD_DIM), jnp.float32)
    _, prev = lax.scan(step, init, jnp.moveaxis(chunk_kv, 2, 0))
    prev = jnp.moveaxis(prev, 0, 2)
    xi = jnp.exp(log_gamma[:, None] * (pos + 1.0))
    cross = jnp.einsum('bhncd,bhnde->bhnce', qc, prev) * xi[None, :, None, :, None]
    out = intra + cross
    return out.transpose(0, 2, 3, 1, 4).reshape(bsz, seq, RET_HEADS, RET_HEAD_DIM)


def head_groupnorm(o, g, b):
    mu = jnp.mean(o, axis=-1, keepdims=True)
    var = jnp.mean(jnp.square(o - mu), axis=-1, keepdims=True)
    on = (o - mu) * lax.rsqrt(var + NORM_EPS)
    bsz, seq = o.shape[:2]
    return on.reshape(bsz, seq, D_RET) * g.astype(jnp.float32) + b.astype(jnp.float32)


def hybrid_mixer(x, positions, norm_g, w_in, conv_w, conv_b, lru_wa, lru_ba, lru_wx, lru_bx,
                 lru_lambda, lru_norm_g, ret_norm_g, ret_norm_b, w_out):
    bsz, seq, _ = x.shape
    h = rmsnorm(x, norm_g)
    proj = h @ w_in
    lru_x, lru_gate, q, k, v, g = jnp.split(
        proj, [D_LRU, 2 * D_LRU, 2 * D_LRU + D_RET, 2 * D_LRU + 2 * D_RET, 2 * D_LRU + 3 * D_RET], axis=-1)
    hs = rg_lru(causal_conv1d(lru_x, conv_w, conv_b), lru_wa, lru_ba, lru_wx, lru_bx, lru_lambda)
    y_lru = rmsnorm(hs * jax.nn.gelu(lru_gate), lru_norm_g)
    qh = rotary(q.reshape(bsz, seq, RET_HEADS, RET_HEAD_DIM), positions)
    kh = rotary(k.reshape(bsz, seq, RET_HEADS, RET_HEAD_DIM), positions) * (RET_HEAD_DIM ** -0.5)
    vh = v.reshape(bsz, seq, RET_HEADS, RET_HEAD_DIM).astype(jnp.float32)
    o = head_groupnorm(chunkwise_retention(qh, kh, vh), ret_norm_g, ret_norm_b)
    y_ret = (jax.nn.silu(g.astype(jnp.float32)) * o).astype(x.dtype)
    y = jnp.concatenate([y_lru, y_ret], axis=-1) @ w_out
    return x + y.astype(x.dtype)


def moe_ffn(hf, top_idx, gates, w_gate, b_gate, w_up, b_up, w_down, b_down):
    n_tok, d = hf.shape
    n_assign = n_tok * TOP_K
    n_pad = n_assign + N_EXPERTS * MOE_BLOCK
    n_blocks = n_pad // MOE_BLOCK
    flat_e = top_idx.reshape(-1).astype(jnp.int32)
    flat_tok = jnp.arange(n_assign, dtype=jnp.int32) // TOP_K
    flat_w = gates.reshape(-1)
    order = jnp.argsort(flat_e)
    sorted_e = flat_e[order]
    counts = jnp.bincount(flat_e, length=N_EXPERTS)
    padded = (counts + MOE_BLOCK - 1) // MOE_BLOCK * MOE_BLOCK
    start = jnp.cumsum(counts) - counts
    pstart = jnp.cumsum(padded) - padded
    pend = pstart + padded
    dest = pstart[sorted_e] + jnp.arange(n_assign, dtype=jnp.int32) - start[sorted_e]
    row_tok = jnp.full((n_pad,), n_tok, jnp.int32).at[dest].set(flat_tok[order])
    row_w = jnp.zeros((n_pad,), flat_w.dtype).at[dest].set(flat_w[order])
    block_start = jnp.arange(n_blocks, dtype=jnp.int32) * MOE_BLOCK
    block_e = jnp.minimum(jnp.sum(block_start[:, None] >= pend[None, :], axis=1), N_EXPERTS - 1)
    x_pad = jnp.concatenate([hf, jnp.zeros((1, d), hf.dtype)], axis=0)
    xb = x_pad[row_tok].reshape(n_blocks, MOE_BLOCK, d)

    def expert_block(args):
        xblk, e = args
        gate = jnp.minimum(xblk @ w_gate[e] + b_gate[e], SWIGLU_LIMIT)
        up = jnp.clip(xblk @ w_up[e] + b_up[e], -SWIGLU_LIMIT, SWIGLU_LIMIT)
        act = gate * jax.nn.sigmoid(SWIGLU_ALPHA * gate) * (up + 1.0)
        return act @ w_down[e] + b_down[e]

    yb = lax.map(expert_block, (xb, block_e)).reshape(n_pad, d)
    y = jnp.zeros((n_tok + 1, d), yb.dtype).at[row_tok].add(yb * row_w[:, None].astype(yb.dtype))
    return y[:n_tok]


def moe_layer(x, norm_g, router_w, router_b, w_gate, b_gate, w_up, b_up, w_down, b_down):
    bsz, seq, d = x.shape
    hf = rmsnorm(x, norm_g).reshape(bsz * seq, d)
    logits = (hf @ router_w + router_b).astype(jnp.float32)
    top_vals, top_idx = lax.top_k(logits, TOP_K)
    gates = jax.nn.softmax(top_vals, axis=-1)
    y = moe_ffn(hf, top_idx, gates, w_gate, b_gate, w_up, b_up, w_down, b_down)
    return x + y.reshape(bsz, seq, d).astype(x.dtype)


def setup_inputs(seed: int = 0) -> dict:
    key = jax.random.key(seed)
    ks = jax.random.split(key, 24)
    f32 = jnp.float32
    L = DEPTH

    def nrm(k, shape, scale):
        return jax.random.normal(k, shape, f32) * scale

    x = nrm(ks[0], (BATCH, SEQ, D_MODEL), 1.0)
    positions = (jax.random.randint(ks[1], (BATCH, 1), 0, MAX_POS_OFFSET, dtype=jnp.int32)
                 + jnp.arange(SEQ, dtype=jnp.int32)[None, :])
    u = jax.random.uniform(ks[9], (L, D_LRU), f32, 0.9, 0.999)
    a0 = u ** (1.0 / LRU_C)
    return {
        'x': x,
        'positions': positions,
        'attn_norm_g': 1.0 + nrm(ks[2], (L, D_MODEL), 0.02),
        'w_in': nrm(ks[3], (L, D_MODEL, D_IN), D_MODEL ** -0.5),
        'conv_w': nrm(ks[4], (L, CONV_WIDTH, D_LRU), CONV_WIDTH ** -0.5),
        'conv_b': nrm(ks[5], (L, D_LRU), 0.01),
        'lru_wa': nrm(ks[6], (L, LRU_HEADS, LRU_HEAD_DIM, LRU_HEAD_DIM), LRU_HEAD_DIM ** -0.5),
        'lru_ba': nrm(ks[7], (L, D_LRU), 0.01),
        'lru_wx': nrm(ks[8], (L, LRU_HEADS, LRU_HEAD_DIM, LRU_HEAD_DIM), LRU_HEAD_DIM ** -0.5),
        'lru_bx': nrm(ks[10], (L, D_LRU), 0.01),
        'lru_lambda': jnp.log(a0) - jnp.log1p(-a0),
        'lru_norm_g': 1.0 + nrm(ks[11], (L, D_LRU), 0.02),
        'ret_norm_g': 1.0 + nrm(ks[12], (L, D_RET), 0.02),
        'ret_norm_b': nrm(ks[13], (L, D_RET), 0.01),
        'w_out': nrm(ks[14], (L, D_MIX, D_MODEL), D_MIX ** -0.5),
        'ffn_norm_g': 1.0 + nrm(ks[15], (L, D_MODEL), 0.02),
        'router_w': nrm(ks[16], (L, D_MODEL, N_EXPERTS), D_MODEL ** -0.5),
        'router_b': nrm(ks[17], (L, N_EXPERTS), 0.01),
        'moe_w_gate': nrm(ks[18], (L, N_EXPERTS, D_MODEL, D_FF), D_MODEL ** -0.5),
        'moe_b_gate': nrm(ks[19], (L, N_EXPERTS, D_FF), 0.01),
        'moe_w_up': nrm(ks[20], (L, N_EXPERTS, D_MODEL, D_FF), D_MODEL ** -0.5),
        'moe_b_up': nrm(ks[21], (L, N_EXPERTS, D_FF), 0.01),
        'moe_w_down': nrm(ks[22], (L, N_EXPERTS, D_FF, D_MODEL), D_FF ** -0.5),
        'moe_b_down': nrm(ks[23], (L, N_EXPERTS, D_MODEL), 0.01),
        'final_norm_g': 1.0 + nrm(jax.random.fold_in(key, 99), (D_MODEL,), 0.02),
    }


def reference(x, positions, attn_norm_g, w_in, conv_w, conv_b, lru_wa, lru_ba, lru_wx, lru_bx,
              lru_lambda, lru_norm_g, ret_norm_g, ret_norm_b, w_out, ffn_norm_g, router_w, router_b,
              moe_w_gate, moe_b_gate, moe_w_up, moe_b_up, moe_w_down, moe_b_down, final_norm_g):
    for l in range(DEPTH):
        x = hybrid_mixer(x, positions, attn_norm_g[l], w_in[l], conv_w[l], conv_b[l], lru_wa[l], lru_ba[l],
                         lru_wx[l], lru_bx[l], lru_lambda[l], lru_norm_g[l], ret_norm_g[l], ret_norm_b[l],
                         w_out[l])
        x = moe_layer(x, ffn_norm_g[l], router_w[l], router_b[l], moe_w_gate[l], moe_b_gate[l],
                      moe_w_up[l], moe_b_up[l], moe_w_down[l], moe_b_down[l])
    return rmsnorm(x, final_norm_g)
```

```cpp
#ifndef CPU_EMU
#include <hip/hip_runtime.h>
#include <cstdio>
#define LAS __attribute__((address_space(3)))
#define GAS __attribute__((address_space(1)))
#define ASM_VMCNT(n) asm volatile("s_waitcnt vmcnt(" #n ")" ::: "memory")
#define ASM_LGKMCNT(n) asm volatile("s_waitcnt lgkmcnt(" #n ")" ::: "memory")
#define WAVE_SYNC() do { asm volatile("s_waitcnt lgkmcnt(0)" ::: "memory"); __builtin_amdgcn_wave_barrier(); } while (0)
#define OPAQUE(x) asm volatile("" : "+v"(x))
__device__ __forceinline__ int lane_id_fresh() { int l; asm volatile("v_mbcnt_lo_u32_b32 %0, -1, 0\n\tv_mbcnt_hi_u32_b32 %0, -1, %0" : "=v"(l)); return l; }
#define LANE_ID() lane_id_fresh()
#define SHFLX_F(v, mask, lane) __builtin_bit_cast(float, __builtin_amdgcn_ds_bpermute((((lane) ^ (mask)) << 2), __builtin_bit_cast(int, (float)(v))))
#define SHFLX_I(v, mask, lane) __builtin_amdgcn_ds_bpermute((((lane) ^ (mask)) << 2), (int)(v))
#else
#define ASM_VMCNT(n) ((void)0)
#define ASM_LGKMCNT(n) ((void)0)
#define WAVE_SYNC() emu::wave_collective(nullptr, 0, nullptr, 0, [](emu::Wave&) {})
#define OPAQUE(x) ((void)0)
#define LANE_ID() ((int)emu::cur->lane)
#define SHFLX_F(v, mask, lane) __shfl_xor((float)(v), (mask))
#define SHFLX_I(v, mask, lane) __shfl_xor((int)(v), (mask))
#endif

typedef unsigned short bf16_t;
typedef float f32x4 __attribute__((ext_vector_type(4)));
typedef float f32x2 __attribute__((ext_vector_type(2)));
typedef unsigned u32x4 __attribute__((ext_vector_type(4)));
typedef unsigned u32x2 __attribute__((ext_vector_type(2)));
typedef short bf16x8 __attribute__((ext_vector_type(8)));
typedef short v4i16_t __attribute__((ext_vector_type(4)));
typedef int v8i32_t __attribute__((ext_vector_type(8)));

#ifdef CPU_EMU
constexpr int BATCH = CFG_BATCH, SEQ = CFG_SEQ, NEXP = CFG_NEXP;
#else
constexpr int BATCH = 4, SEQ = 8192, NEXP = 32;
#endif
constexpr int NWAVES = 8, NTHREADS = 512;
constexpr int T = BATCH * SEQ, D = 1024, DIN = 3072, NCH = SEQ / 128, NBH = BATCH * 4;
constexpr int TOPK = 4, NSLOT = T * TOPK;
constexpr float NORM_EPS = 1e-5f;
constexpr int MAXTILES = NSLOT / 256 + NEXP;

constexpr size_t MiB = 1u << 20;
constexpr size_t al256(size_t x) { return (x + 255) & ~(size_t)255; }
constexpr size_t WS_CTL = 0, CTL_ZERO_BYTES = 1 * MiB;
constexpr int CW_BAR = 4096, CW_CNT = 16384;
constexpr size_t WS_RS1 = 1 * MiB;
constexpr size_t WS_RS2 = WS_RS1 + al256((size_t)T * 4);
constexpr size_t WS_SSQ = WS_RS2 + al256((size_t)T * 4);
constexpr size_t WS_GW = WS_SSQ + al256((size_t)16 * T * 4);
constexpr size_t WS_LIST = WS_GW + al256((size_t)NEXP * T * 4);
constexpr size_t WS_RS2S = WS_LIST + al256((size_t)NEXP * T * 4);
constexpr size_t WS_LAP = WS_RS2S + al256((size_t)NEXP * T * 4);
constexpr size_t WS_LAH = WS_LAP + al256((size_t)BATCH * NCH * 512 * 4);
constexpr size_t WS_CARRY = WS_LAH + al256((size_t)BATCH * NCH * 512 * 4);
constexpr size_t WS_WR = WS_CARRY + al256((size_t)BATCH * NCH * 512 * 4);
constexpr size_t WS_WAF = WS_WR + al256((size_t)32 * D * 2);
constexpr size_t WS_RSL = WS_WAF + 2 * 65536;
constexpr size_t WS_WIN = (WS_RSL + al256((size_t)T * 4) + MiB - 1) / MiB * MiB;
constexpr size_t WS_WOUT = WS_WIN + (size_t)DIN * D * 2;
constexpr size_t WS_WGU = WS_WOUT + (size_t)D * D * 2;
constexpr size_t WS_WD = WS_WGU + (size_t)NEXP * 2048 * D;
constexpr size_t WS_X8 = WS_WD + (size_t)NEXP * D * D;
constexpr size_t WS_R1 = WS_X8 + (size_t)T * D;
constexpr size_t WS_PROJ = WS_R1;
constexpr size_t WS_XB = WS_R1 + (size_t)T * DIN * 2;
constexpr size_t WS_ACT = WS_R1;
constexpr size_t WS_YB23 = WS_ACT + (size_t)(NSLOT + 256) * D;
constexpr size_t WS_END = WS_YB23 + (size_t)T * 2 * D * 2;
static_assert(WS_XB + (size_t)T * D * 2 <= WS_END, "map");
constexpr size_t DO_KVT = 0, DO_PREVT = (size_t)T * 1024;
static_assert(2 * (size_t)T * 1024 <= (size_t)T * D * 4, "d_out scratch");

constexpr int RING_BYTES = 131072, MISC_OFF = RING_BYTES + 320, TAB_OFF = RING_BYTES + 1024, LDS_BYTES = 147456;
constexpr int TAB_CNT = TAB_OFF, TAB_EOFF = TAB_CNT + 4 * 64, TAB_TBASE = TAB_EOFF + 4 * 64, TAB_TILEE = TAB_TBASE + 4 * 80;
constexpr int META_OFF = RING_BYTES + 8192;
static_assert(NEXP <= 64 && TAB_TILEE + 2 * MAXTILES + 16 <= META_OFF && META_OFF + 8192 <= LDS_BYTES, "LDS tables");

__device__ __forceinline__ unsigned f2bf(float f) { unsigned u = __builtin_bit_cast(unsigned, f); return (u + 0x7fffu + ((u >> 16) & 1u)) >> 16; }
__device__ __forceinline__ unsigned pk2(float lo, float hi) {
#ifdef CPU_EMU
    return f2bf(lo) | (f2bf(hi) << 16);
#else
    unsigned r; asm volatile("v_cvt_pk_bf16_f32 %0, %1, %2" : "=v"(r) : "v"(lo), "v"(hi)); return r;
#endif
}
__device__ __forceinline__ unsigned pk2v(float lo, float hi) {
#ifdef CPU_EMU
    return f2bf(lo) | (f2bf(hi) << 16);
#else
    unsigned r; asm volatile("s_nop 7\n\ts_nop 7\n\tv_cvt_pk_bf16_f32 %0, %1, %2" : "=v"(r) : "v"(lo), "v"(hi)); return r;
#endif
}
#define unpk2_fp8(w, hi) __builtin_amdgcn_cvt_pk_f32_fp8((int)(w), hi)
__device__ __forceinline__ unsigned pk4_fp8(float a, float b, float c, float d) {
    int r = __builtin_amdgcn_cvt_pk_fp8_f32(a, b, 0, false); r = __builtin_amdgcn_cvt_pk_fp8_f32(c, d, r, true); return (unsigned)r;
}
__device__ __forceinline__ float bf2f(unsigned h) { return __builtin_bit_cast(float, h << 16); }
__device__ __forceinline__ float bflo(unsigned w) { return __builtin_bit_cast(float, w << 16); }
__device__ __forceinline__ float bfhi(unsigned w) { return __builtin_bit_cast(float, w & 0xffff0000u); }
__device__ __forceinline__ float fexp2(float x) { return __builtin_amdgcn_exp2f(x); }
__device__ __forceinline__ float frcp(float x) { return __builtin_amdgcn_rcpf(x); }
__device__ __forceinline__ float sigmoid_f(float x) { return frcp(1.0f + fexp2(-1.4426950408889634f * x)); }
__device__ __forceinline__ float gelu_tanh(float x) { const float u = 0.7978845608028654f * (x + 0.044715f * x * x * x); return x * frcp(1.0f + fexp2(-2.8853900817779268f * u)); }
__device__ __forceinline__ float silu_f(float x) { return x * sigmoid_f(x); }
__device__ __forceinline__ float wave_sum(float v, int lane) {
#pragma unroll
    for (int o = 1; o < 64; o <<= 1) v += SHFLX_F(v, o, lane);
    return v;
}

#define XB_TMO      128
#define XB_XCNT(j)  (256  + 64 * (j))
#define XB_XSUB(j)  (1280 + 64 * (j))
#define XB_XGEN(j)  (2304 + 64 * (j))
#define XB_TOP      3328
#define XB_TOPGEN   3392
#define XCD_BAR_WORDS 3456
#define XB_SPIN_CAP (1u << 20)
__device__ __forceinline__ unsigned xb_ld(unsigned* p)              { return __hip_atomic_load(p, __ATOMIC_RELAXED, __HIP_MEMORY_SCOPE_AGENT); }
__device__ __forceinline__ unsigned xb_add(unsigned* p, unsigned v) { return __hip_atomic_fetch_add(p, v, __ATOMIC_RELAXED, __HIP_MEMORY_SCOPE_AGENT); }
__device__ __forceinline__ unsigned xb_xcc_id() { return (unsigned)__builtin_amdgcn_s_getreg((3 << 11) | 20) & 0xFu; }
#define XB_SPIN(cond, bar) do { unsigned _sp = 0; while (cond) { __builtin_amdgcn_s_sleep(1); \
    if ((++_sp & 255u) == 0u) { if (xb_ld(&(bar)[XB_TMO])) break; if (_sp > XB_SPIN_CAP) { atomicAdd(&(bar)[XB_TMO], 1u); break; } } } } while (0)
struct XcdBarrier { unsigned* bar; unsigned x; volatile LAS unsigned* st; };
__device__ __forceinline__ XcdBarrier xcd_barrier_post(unsigned* bar, volatile LAS unsigned* st, int wv) {
    XcdBarrier b; b.bar = bar; b.x = xb_xcc_id(); b.st = st;
    if (wv == 0 && LANE_ID() == 0) (void)xb_add(&bar[XB_XCNT(b.x)], 1u);
    return b;
}
__device__ __forceinline__ void xcd_barrier_complete(unsigned* bar, unsigned x, unsigned& nloc, unsigned& nx) {
    const unsigned G = gridDim.x;
    unsigned sum, cnt, mine, sp = 0u;
    for (;;) {
        sum = 0u; cnt = 0u; mine = 0u;
#pragma unroll
        for (unsigned j = 0; j < 16; ++j) { const unsigned c = xb_ld(&bar[XB_XCNT(j)]); sum += c; cnt += (c > 0u) ? 1u : 0u; mine = (j == x) ? c : mine; }
        if (sum == G) break;
        __builtin_amdgcn_s_sleep(1);
        if ((++sp & 255u) == 0u) { if (xb_ld(&bar[XB_TMO])) break; if (sp > XB_SPIN_CAP) { atomicAdd(&bar[XB_TMO], 1u); break; } }
    }
    nloc = mine > 0u ? mine : 1u; nx = cnt > 0u ? cnt : 1u;
}
__device__ __forceinline__ void xcd_barrier(const XcdBarrier& b, int wv) {
    ASM_VMCNT(0);
    __syncthreads();
    if (wv == 0 && LANE_ID() == 0) {
        unsigned* bar = b.bar;
        __builtin_amdgcn_s_waitcnt(0);
        unsigned nloc = b.st[0], nx = b.st[1];
        if (nloc == 0u) { xcd_barrier_complete(bar, b.x, nloc, nx); b.st[0] = nloc; b.st[1] = nx; }
        const unsigned old = xb_add(&bar[XB_XSUB(b.x)], 1u);
        const unsigned gen = old / nloc;
        if (old + 1u == (gen + 1u) * nloc) {
            __builtin_amdgcn_fence(__ATOMIC_RELEASE, "agent");
            ASM_VMCNT(0);
            const unsigned og = xb_add(&bar[XB_TOP], 1u);
            const unsigned tg = og / nx;
            if (og + 1u == (tg + 1u) * nx) xb_add(&bar[XB_TOPGEN], 1u);
            else XB_SPIN(xb_ld(&bar[XB_TOPGEN]) == tg, bar);
            __builtin_amdgcn_fence(__ATOMIC_ACQUIRE, "agent");
            xb_add(&bar[XB_XGEN(b.x)], 1u);
            ASM_VMCNT(0);
        } else {
            XB_SPIN(xb_ld(&bar[XB_XGEN(b.x)]) == gen, bar);
            __builtin_amdgcn_fence(__ATOMIC_ACQUIRE, "agent");
            ASM_VMCNT(0);
        }
    }
    __syncthreads();
}

namespace pg8 {
constexpr int BM = 256, BK = 64, HALF = 128, HTB = HALF * BK * 2, STAGE_BYTES = 8 * HTB, NXCD = 8, WGM = 8;
__device__ __forceinline__ int lds_byte(int r, int c) { const int st = (r >> 4) * 2 + (c >> 5), rr = r & 15, cc = c & 31, ob = rr * 64 + cc * 2; return st * 1024 + (ob ^ (((ob >> 9) & 1) << 5)); }
__device__ __forceinline__ void stage_rc(int b, int& R, int& C) { const int st = b / 1024, sb = b % 1024, swz = sb ^ (((sb >> 9) & 1) << 5); R = (st >> 1) * 16 + swz / 64; C = (st & 1) * 32 + (swz % 64) / 2; }
__device__ __forceinline__ int lds_byte8(int r, int fq) { const int st = (r >> 4) * 2 + (fq >> 1), rr = r & 15, ob = rr * 64 + 32 * (fq & 1); return st * 1024 + (ob ^ (((ob >> 9) & 1) << 5)); }
__device__ __forceinline__ int perm32(int rho) { const int n = rho >> 4, i = rho & 15; return 8 * (i >> 2) + 4 * n + (i & 3); }
struct Unit { int pm, pn, e, pos0, nvalid, eoff; };
__device__ __forceinline__ f32x4 mma_fp8(u32x4 a0, u32x4 a1, u32x4 b0, u32x4 b1, f32x4 c) {
    typedef int i32x4 __attribute__((ext_vector_type(4)));
    const v8i32_t a = __builtin_shufflevector(__builtin_bit_cast(i32x4, a0), __builtin_bit_cast(i32x4, a1), 0, 1, 2, 3, 4, 5, 6, 7);
    const v8i32_t b = __builtin_shufflevector(__builtin_bit_cast(i32x4, b0), __builtin_bit_cast(i32x4, b1), 0, 1, 2, 3, 4, 5, 6, 7);
#ifdef CPU_EMU
    return __builtin_amdgcn_mfma_scale_f32_16x16x128_f8f6f4(a, b, c, 0, 0, 0, 0x7F7F7F7F, 0, 0x7F7F7F7F);
#else
    const int one = 0x7F7F7F7F;
    asm volatile("v_mfma_scale_f32_16x16x128_f8f6f4 %0, %1, %2, %0, %3, %3 op_sel_hi:[0,0,0]" : "+v"(c) : "v"(a), "v"(b), "v"(one));
    return c;
#endif
}
__device__ __forceinline__ bool static_order(int i, int G, int c, int nM, int nN, int& pm, int& pn) {
    const int nwg = nM * nN; const long L = (long)i * G + c; if (L >= nwg) return false;
    int wgid = (int)L; { const int q = nwg / NXCD, r = nwg % NXCD, xcd = wgid % NXCD, off = wgid / NXCD; wgid = (xcd < r ? xcd * (q + 1) : r * (q + 1) + (xcd - r) * q) + off; }
    const int nig = WGM * nN, gid = wgid / nig, fm = gid * WGM, gsz = (nM - fm) < WGM ? (nM - fm) : WGM;
    pm = fm + ((wgid % nig) % gsz); pn = (wgid % nig) / gsz; return true;
}

template <class P>
__device__ __forceinline__ void gemm_phase(LAS unsigned char* lds, const P& prob, int wv) {
    int tid_ = wv * 64 + LANE_ID(); OPAQUE(tid_);
    const int tid = tid_, wid = __builtin_amdgcn_readfirstlane(tid >> 6), lane = tid & 63, wr = wid >> 2, wc = wid & 3, fr = lane & 15, fq = lane >> 4;
    constexpr int ROWB = P::FP8 ? 1024 : 2048, NT = ROWB / 128, CH = P::FP8 ? 16 : 1024;
    unsigned voffA[2][2], nvoffA[2][2], voffB[2];
#pragma unroll
    for (int i = 0; i < 2; ++i) { int R, C; stage_rc(tid * 16 + i * 8192, R, C); const int Rb = (R & ~31) + perm32(R & 31);
        voffA[0][i] = (unsigned)(R * ROWB + C * 2); voffA[1][i] = voffA[0][i] + (unsigned)(HALF * ROWB); voffB[i] = (unsigned)(Rb * ROWB + C * 2);
        nvoffA[0][i] = voffA[0][i]; nvoffA[1][i] = voffA[1][i]; }
    const size_t kstep = (size_t)(BK * 2);
    const size_t hstep = (size_t)HALF * ROWB;
    const unsigned ldsw = (unsigned)wid * 1024u;
    const int aoff = P::FP8 ? lds_byte8(wr * 64 + fr, fq) : lds_byte(wr * 64 + fr, fq * 8), boff = P::FP8 ? lds_byte8(wc * 32 + fr, fq) : lds_byte(wc * 32 + fr, fq * 8);
#define PG8_SA(b, h) (((b) * 2 + (h)) * HTB)
#define PG8_SB(b, h) ((4 + (b) * 2 + (h)) * HTB)
#define PG8_STAGE(bufoff, gbase, voff) do { _Pragma("unroll") for (int _i = 0; _i < 2; ++_i) \
        __builtin_amdgcn_global_load_lds((const unsigned*)((const char*)(gbase) + (voff)[_i]), (LAS unsigned*)(lds + (bufoff) + ldsw + _i * 8192), 16, 0, 0); } while (0)
#define PG8_LDA(dst, b, h) do { _Pragma("unroll") for (int m = 0; m < 4; ++m) _Pragma("unroll") for (int k = 0; k < 2; ++k) dst[m][k] = *(const LAS u32x4*)(lds + PG8_SA(b, h) + aoff + m * 2048 + k * CH); } while (0)
#define PG8_LDB(dst, b, h) do { _Pragma("unroll") for (int n = 0; n < 2; ++n) _Pragma("unroll") for (int k = 0; k < 2; ++k) dst[n][k] = *(const LAS u32x4*)(lds + PG8_SB(b, h) + boff + n * 2048 + k * CH); } while (0)
#define PG8_MMA(ai, bj, At, Bt) do { __builtin_amdgcn_s_setprio(1); _Pragma("unroll") for (int m = 0; m < 4; ++m) _Pragma("unroll") for (int n = 0; n < 2; ++n) { \
        if constexpr (P::FP8) acc[ai][bj][m][n] = mma_fp8(Bt[n][0], Bt[n][1], At[m][0], At[m][1], acc[ai][bj][m][n]); \
        else { _Pragma("unroll") for (int k = 0; k < 2; ++k) acc[ai][bj][m][n] = __builtin_amdgcn_mfma_f32_16x16x32_bf16(__builtin_bit_cast(bf16x8, Bt[n][k]), __builtin_bit_cast(bf16x8, At[m][k]), acc[ai][bj][m][n], 0, 0, 0); } } \
        __builtin_amdgcn_s_setprio(0); } while (0)
#define PG8_BAR __builtin_amdgcn_s_barrier()
#define PG8_SCHED __builtin_amdgcn_sched_barrier(0)
    Unit cur, nxt; int ui = 0;
    if (!prob.next(0, cur)) return;
    f32x4 acc[2][2][4][2];
#pragma unroll
    for (int a = 0; a < 2; ++a)
#pragma unroll
        for (int b = 0; b < 2; ++b)
#pragma unroll
            for (int m = 0; m < 4; ++m)
#pragma unroll
                for (int n = 0; n < 2; ++n) acc[a][b][m][n] = (f32x4){0.f, 0.f, 0.f, 0.f};
    u32x4 At[4][2], B0[2][2], B1[2][2];
    const char* cA = prob.a_base(cur); const char* cB = prob.b_base(cur);
    if constexpr (P::GATHER) prob.a_offsets(cur, tid, voffA);
#define PG8_META(u, par) do { _Pragma("unroll") for (int _j = 0; _j < 2; ++_j) { const int _a = (wid >> 2) + 2 * _j; if (_a < P::NMETA) \
        __builtin_amdgcn_global_load_lds(prob.meta_ptr(u, _a, (wid & 3) * 64 + lane), (LAS unsigned*)(lds + META_OFF + (par) * 4096 + _a * 1024 + (wid & 3) * 256), 4, 0, 0); } } while (0)
    if constexpr (P::NMETA > 0) PG8_META(cur, 0);
    PG8_STAGE(PG8_SB(0, 0), cB, voffB); PG8_STAGE(PG8_SA(0, 0), cA, voffA[0]); PG8_STAGE(PG8_SB(0, 1), cB + hstep, voffB); PG8_STAGE(PG8_SA(0, 1), cA, voffA[1]);
    if (wr == 1) PG8_BAR;
    ASM_VMCNT(4); PG8_BAR;
    PG8_STAGE(PG8_SB(1, 0), cB + kstep, voffB); PG8_STAGE(PG8_SA(1, 0), cA + kstep, voffA[0]); PG8_STAGE(PG8_SB(1, 1), cB + hstep + kstep, voffB);
    ASM_VMCNT(6); PG8_BAR;
    for (;;) {
        const bool has_next = prob.next(ui + 1, nxt);
        const char* nA = has_next ? prob.a_base(nxt) : cA; const char* nB = has_next ? prob.b_base(nxt) : cB;
        for (int t = 0; t < NT; t += 2) {
            const bool last = (t == NT - 2);
            const char* a1 = cA + (size_t)(t + 1) * kstep;
            const char* a2 = last ? nA : cA + (size_t)(t + 2) * kstep; const char* b2 = last ? nB : cB + (size_t)(t + 2) * kstep;
            const char* a3 = a2 + kstep; const char* b3 = b2 + kstep;
            if constexpr (P::GATHER) { if (last && has_next) prob.a_offsets(nxt, tid, nvoffA); }
            unsigned va0[2], va1[2];
#pragma unroll
            for (int i = 0; i < 2; ++i) { va0[i] = (P::GATHER && last) ? nvoffA[0][i] : voffA[0][i]; va1[i] = (P::GATHER && last) ? nvoffA[1][i] : voffA[1][i]; }
            if constexpr (P::MIDK) { if (t == NT / 2) prob.midk(acc, cur, wr, fr, lds + META_OFF + (ui & 1) * 4096); }
            PG8_LDB(B0, 0, 0); PG8_SCHED; PG8_LDA(At, 0, 0); PG8_STAGE(PG8_SA(1, 1), a1, voffA[1]);
            ASM_LGKMCNT(8); PG8_BAR; ASM_LGKMCNT(0); PG8_MMA(0, 0, At, B0); PG8_BAR; PG8_SCHED;
            PG8_LDB(B1, 0, 1); PG8_STAGE(PG8_SB(0, 0), b2, voffB);
            PG8_BAR; ASM_LGKMCNT(0); PG8_MMA(0, 1, At, B1); PG8_BAR;
            PG8_LDA(At, 0, 1); PG8_STAGE(PG8_SA(0, 0), a2, va0);
            PG8_BAR; ASM_LGKMCNT(0); PG8_MMA(1, 0, At, B0); PG8_BAR; PG8_SCHED;
            PG8_STAGE(PG8_SB(0, 1), b2 + hstep, voffB);
            ASM_VMCNT(6); PG8_BAR; PG8_MMA(1, 1, At, B1); PG8_BAR;
            if constexpr (P::NMETA > 0) { if (t == 2 && has_next) PG8_META(nxt, (ui + 1) & 1); }
            PG8_LDB(B0, 1, 0); PG8_SCHED; PG8_LDA(At, 1, 0); PG8_STAGE(PG8_SA(0, 1), a2, va1);
            ASM_LGKMCNT(8); PG8_BAR; ASM_LGKMCNT(0); PG8_MMA(0, 0, At, B0); PG8_BAR; PG8_SCHED;
            PG8_LDB(B1, 1, 1); PG8_STAGE(PG8_SB(1, 0), b3, voffB);
            PG8_BAR; ASM_LGKMCNT(0); PG8_MMA(0, 1, At, B1); PG8_BAR;
            PG8_LDA(At, 1, 1); PG8_STAGE(PG8_SA(1, 0), a3, va0);
            PG8_BAR; ASM_LGKMCNT(0); PG8_MMA(1, 0, At, B0); PG8_BAR; PG8_SCHED;
            PG8_STAGE(PG8_SB(1, 1), b3 + hstep, voffB);
            ASM_VMCNT(6); PG8_BAR; PG8_MMA(1, 1, At, B1); PG8_BAR;
        }
        if (wr == 0) PG8_BAR;
        prob.epi(acc, cur, wr, wc, fr, fq, lds + META_OFF + (ui & 1) * 4096);
        if (!has_next) break;
#pragma unroll
        for (int a = 0; a < 2; ++a)
#pragma unroll
            for (int b = 0; b < 2; ++b)
#pragma unroll
                for (int m = 0; m < 4; ++m)
#pragma unroll
                    for (int n = 0; n < 2; ++n) acc[a][b][m][n] = (f32x4){0.f, 0.f, 0.f, 0.f};
        cur = nxt; cA = nA; cB = nB; ++ui;
        if constexpr (P::GATHER) {
#pragma unroll
            for (int h = 0; h < 2; ++h)
#pragma unroll
                for (int i = 0; i < 2; ++i) voffA[h][i] = nvoffA[h][i];
        }
        if (wr == 1) PG8_BAR;
    }
    ASM_VMCNT(0);
    PG8_BAR;
#undef PG8_META
#undef PG8_SA
#undef PG8_SB
#undef PG8_STAGE
#undef PG8_LDA
#undef PG8_LDB
#undef PG8_MMA
#undef PG8_BAR
#undef PG8_SCHED
}
}
using pg8::Unit;

constexpr float Y8_SCALE = 16.0f;
constexpr float LOG2_THETA_64 = 13.287712379549449f / 64.0f;
__device__ __forceinline__ float log2_gamma(int h) { return __builtin_log2f(1.0f - __builtin_exp2f(-5.0f - (float)h)); }

struct ProbIn {
    static constexpr bool GATHER = false, MIDK = false, FP8 = false; static constexpr int NMETA = 2;
    const bf16_t* xb; const bf16_t* wt; const float* rs1; const int* pos; bf16_t* proj; int G, c;
    __device__ __forceinline__ bool next(int i, Unit& u) const { u.e = 0; u.pos0 = 0; u.nvalid = 256; u.eoff = 0; return pg8::static_order(i, G, c, T / 256, DIN / 256, u.pm, u.pn); }
    __device__ __forceinline__ const char* a_base(const Unit& u) const { return (const char*)xb + (size_t)u.pm * 256 * D * 2; }
    __device__ __forceinline__ const char* b_base(const Unit& u) const { return (const char*)wt + (size_t)u.pn * 256 * D * 2; }
    __device__ __forceinline__ void a_offsets(const Unit&, int, unsigned (&)[2][2]) const {}
    __device__ __forceinline__ const unsigned* meta_ptr(const Unit& u, int a, int idx) const { return (a == 0 ? (const unsigned*)rs1 : (const unsigned*)pos) + u.pm * 256 + idx; }
    __device__ __forceinline__ void epi(const f32x4 (&acc)[2][2][4][2], const Unit& u, int wr, int wc, int fr, int fq, const LAS unsigned char* mbuf) const {
        const int seg = u.pn >> 1;
        float invf[4];
#pragma unroll
        for (int q = 0; q < 4; ++q) invf[q] = exp2f(-(float)(16 * wc + 4 * fq + q) * LOG2_THETA_64) * 0.15915494309189535f;
#pragma unroll
        for (int ai = 0; ai < 2; ++ai)
#pragma unroll
            for (int m = 0; m < 4; ++m) {
                const int rl = ai * 128 + wr * 64 + m * 16 + fr, row = u.pm * 256 + rl;
                const float rs = *(const LAS float*)(mbuf + rl * 4);
                float cs[4], sn[4];
                if (seg == 2 || seg == 3) {
                    const float p = (float)*(const LAS int*)(mbuf + 1024 + rl * 4);
#pragma unroll
                    for (int q = 0; q < 4; ++q) { float rev = p * invf[q]; rev = rev - floorf(rev); cs[q] = __builtin_amdgcn_cosf(rev); sn[q] = __builtin_amdgcn_sinf(rev); }
                }
#pragma unroll
                for (int bj = 0; bj < 2; ++bj) {
                    f32x4 v0 = acc[ai][bj][m][0] * rs, v1 = acc[ai][bj][m][1] * rs;
                    if (seg == 1) {
#pragma unroll
                        for (int j = 0; j < 4; ++j) { v0[j] = gelu_tanh(v0[j]); v1[j] = gelu_tanh(v1[j]); }
                    } else if (seg == 5) {
#pragma unroll
                        for (int j = 0; j < 4; ++j) { v0[j] = silu_f(v0[j]); v1[j] = silu_f(v1[j]); }
                    } else if (seg == 2 || seg == 3) {
                        const int head = 2 * (u.pn & 1) + bj;
                        const float e1 = (float)((row & 127) + 1) * log2_gamma(head);
                        const float f = (seg == 2) ? exp2f(e1) : exp2f(-e1) * 0.08838834764831845f;
                        f32x4 o0, o1;
                        o0[0] = (v0[0] * cs[0] - v0[1] * sn[0]) * f; o0[1] = (v0[1] * cs[0] + v0[0] * sn[0]) * f;
                        o0[2] = (v0[2] * cs[1] - v0[3] * sn[1]) * f; o0[3] = (v0[3] * cs[1] + v0[2] * sn[1]) * f;
                        o1[0] = (v1[0] * cs[2] - v1[1] * sn[2]) * f; o1[1] = (v1[1] * cs[2] + v1[0] * sn[2]) * f;
                        o1[2] = (v1[2] * cs[3] - v1[3] * sn[3]) * f; o1[3] = (v1[3] * cs[3] + v1[2] * sn[3]) * f;
                        v0 = o0; v1 = o1;
                    }
                    u32x4 w; w.x = pk2(v0[0], v0[1]); w.y = pk2(v0[2], v0[3]); w.z = pk2(v1[0], v1[1]); w.w = pk2(v1[2], v1[3]);
                    *(u32x4*)(proj + (size_t)row * DIN + u.pn * 256 + bj * 128 + wc * 32 + 8 * fq) = w;
                }
            }
    }
};

struct ProbOut {
    static constexpr bool GATHER = false, MIDK = true, FP8 = false; static constexpr int NMETA = 1;
    const bf16_t* ycat; const bf16_t* wt; const float* x; const float* rsl; bf16_t* yb01; unsigned char* x8; float* ssq; int G, c;
    __device__ __forceinline__ void midk(f32x4 (&acc)[2][2][4][2], const Unit&, int wr, int fr, const LAS unsigned char* mbuf) const {
#pragma unroll
        for (int ai = 0; ai < 2; ++ai)
#pragma unroll
            for (int m = 0; m < 4; ++m) { const float sc = *(const LAS float*)(mbuf + (ai * 128 + wr * 64 + m * 16 + fr) * 4);
#pragma unroll
                for (int bj = 0; bj < 2; ++bj)
#pragma unroll
                    for (int n = 0; n < 2; ++n) acc[ai][bj][m][n] *= sc; }
    }
    __device__ __forceinline__ bool next(int i, Unit& u) const { u.e = 0; u.pos0 = 0; u.nvalid = 256; u.eoff = 0; return pg8::static_order(i, G, c, T / 256, D / 256, u.pm, u.pn); }
    __device__ __forceinline__ const char* a_base(const Unit& u) const { return (const char*)ycat + (size_t)u.pm * 256 * D * 2; }
    __device__ __forceinline__ const char* b_base(const Unit& u) const { return (const char*)wt + (size_t)u.pn * 256 * D * 2; }
    __device__ __forceinline__ void a_offsets(const Unit&, int, unsigned (&)[2][2]) const {}
    __device__ __forceinline__ const unsigned* meta_ptr(const Unit& u, int, int idx) const { return (const unsigned*)rsl + u.pm * 256 + idx; }
    __device__ __forceinline__ void epi(const f32x4 (&acc)[2][2][4][2], const Unit& u, int wr, int wc, int fr, int fq, const LAS unsigned char*) const {
#pragma unroll
        for (int ai = 0; ai < 2; ++ai)
#pragma unroll
            for (int m = 0; m < 4; ++m) {
                const int row = u.pm * 256 + ai * 128 + wr * 64 + m * 16 + fr;
                float ss = 0.f;
#pragma unroll
                for (int bj = 0; bj < 2; ++bj) {
                    const int col = u.pn * 256 + bj * 128 + wc * 32 + 8 * fq;
                    const f32x4 x0 = *(const f32x4*)(x + (size_t)row * D + col), x1 = *(const f32x4*)(x + (size_t)row * D + col + 4);
                    const f32x4 v0 = acc[ai][bj][m][0] + x0, v1 = acc[ai][bj][m][1] + x1;
                    ss += (v0[0] * v0[0] + v0[1] * v0[1]) + (v0[2] * v0[2] + v0[3] * v0[3]) + (v1[0] * v1[0] + v1[1] * v1[1]) + (v1[2] * v1[2] + v1[3] * v1[3]);
                    u32x4 w; w.x = pk2(v0[0], v0[1]); w.y = pk2(v0[2], v0[3]); w.z = pk2(v1[0], v1[1]); w.w = pk2(v1[2], v1[3]);
                    *(u32x4*)(yb01 + (size_t)row * 2048 + col) = w;
                    u32x2 w8; w8.x = pk4_fp8(v0[0], v0[1], v0[2], v0[3]); w8.y = pk4_fp8(v1[0], v1[1], v1[2], v1[3]);
                    *(u32x2*)(x8 + (size_t)row * D + col) = w8;
                }
                ss += SHFLX_F(ss, 16, fr + 16 * fq); ss += SHFLX_F(ss, 32, fr + 16 * fq);
                if (fq == 0) ssq[(size_t)(u.pn * 4 + wc) * T + row] = ss;
            }
    }
};

struct MoeTabs {
    const LAS unsigned* cnt; const LAS unsigned* eoff; const LAS unsigned* tbase; const LAS unsigned short* tile_e; int ntiles;
    __device__ __forceinline__ bool next(int i, int G, int c, int nN, Unit& u) const {
        int pm, pn; if (!pg8::static_order(i, G, c, ntiles, nN, pm, pn)) return false;
        const int e = __builtin_amdgcn_readfirstlane((int)tile_e[pm]);
        const int tb = __builtin_amdgcn_readfirstlane((int)tbase[e]), ce = __builtin_amdgcn_readfirstlane((int)cnt[e]), eo = __builtin_amdgcn_readfirstlane((int)eoff[e]);
        u.pm = pm; u.pn = pn; u.e = e; u.pos0 = (pm - tb) * 256; u.nvalid = (ce - u.pos0) < 256 ? (ce - u.pos0) : 256; u.eoff = eo; return true;
    }
};
__device__ __forceinline__ MoeTabs moe_build_tabs(LAS unsigned char* lds, const unsigned* ctl, int wv) {
    LAS unsigned* cnt = (LAS unsigned*)(lds + TAB_CNT); LAS unsigned* eoff = (LAS unsigned*)(lds + TAB_EOFF); LAS unsigned* tbase = (LAS unsigned*)(lds + TAB_TBASE);
    LAS unsigned short* tile_e = (LAS unsigned short*)(lds + TAB_TILEE);
    __syncthreads();
    if (wv == 0 && LANE_ID() == 0) {
        unsigned eo = 0, tb = 0;
        for (int e = 0; e < NEXP; ++e) { const unsigned c = ctl[CW_CNT + 64 * e]; cnt[e] = c; eoff[e] = eo; tbase[e] = tb; const unsigned nt = (c + 255u) >> 8;
            for (unsigned t = 0; t < nt; ++t) tile_e[tb + t] = (unsigned short)e; eo += c; tb += nt; }
        tbase[NEXP] = tb;
    }
    __syncthreads();
    MoeTabs mt; mt.cnt = cnt; mt.eoff = eoff; mt.tbase = tbase; mt.tile_e = tile_e; mt.ntiles = __builtin_amdgcn_readfirstlane((int)tbase[NEXP]); return mt;
}

struct ProbUp {
    static constexpr bool GATHER = true, MIDK = false, FP8 = true; static constexpr int NMETA = 2;
    int probe_mode; MoeTabs tabs; const unsigned char* x8; const unsigned char* wgu; const unsigned* list; const float* rs2s; const float* bg; const float* bu; unsigned char* act; int G, c;
    __device__ __forceinline__ bool next(int i, Unit& u) const { return tabs.next(i, G, c, 8, u); }
    __device__ __forceinline__ const char* a_base(const Unit&) const { return (const char*)x8; }
    __device__ __forceinline__ const char* b_base(const Unit& u) const { return (const char*)wgu + ((size_t)u.e * 2048 + (size_t)u.pn * 256) * D; }
    __device__ __forceinline__ void a_offsets(const Unit& u, int tid, unsigned (&vo)[2][2]) const {
        int R[2], C[2];
#pragma unroll
        for (int i = 0; i < 2; ++i) pg8::stage_rc(tid * 16 + i * 8192, R[i], C[i]);
#pragma unroll
        for (int h = 0; h < 2; ++h)
#pragma unroll
            for (int i = 0; i < 2; ++i) { const int rl = h * 128 + R[i]; const int pos = u.pos0 + (rl < u.nvalid ? rl : 0);
                const unsigned slot = list[(size_t)u.e * T + pos]; vo[h][i] = (slot >> 2) * 1024u + (unsigned)C[i] * 2u; }
    }
    __device__ __forceinline__ const unsigned* meta_ptr(const Unit& u, int a, int idx) const {
        if (a == 0) return (const unsigned*)rs2s + (size_t)u.e * T + u.pos0 + idx;
        return (const unsigned*)(idx < 128 ? bg : bu) + (size_t)u.e * D + u.pn * 128 + (idx & 127);
    }
    __device__ __forceinline__ void epi(const f32x4 (&acc)[2][2][4][2], const Unit& u, int wr, int wc, int fr, int fq, const LAS unsigned char* mbuf) const {
        const int col8 = u.pn * 128 + wc * 32 + 8 * fq;
        f32x4 bgv[2], buv[2];
#pragma unroll
        for (int n = 0; n < 2; ++n) { bgv[n] = *(const LAS f32x4*)(mbuf + 1024 + (wc * 32 + 8 * fq + 4 * n) * 4); buv[n] = *(const LAS f32x4*)(mbuf + 1536 + (wc * 32 + 8 * fq + 4 * n) * 4); }
        float rsv[2][4];
#pragma unroll
        for (int ai = 0; ai < 2; ++ai)
#pragma unroll
            for (int m = 0; m < 4; ++m) { const int rl = ai * 128 + wr * 64 + m * 16 + fr; rsv[ai][m] = *(const LAS float*)(mbuf + rl * 4) * (1.0f / 64.0f);
            }
#pragma unroll
        for (int ai = 0; ai < 2; ++ai)
#pragma unroll
            for (int m = 0; m < 4; ++m) {
                const int rl = ai * 128 + wr * 64 + m * 16 + fr;
                const float rs = rsv[ai][m];
                float o[8];
#pragma unroll
                for (int n = 0; n < 2; ++n)
#pragma unroll
                    for (int jp = 0; jp < 2; ++jp) {
                        const f32x2 ag = {acc[ai][0][m][n][2 * jp], acc[ai][0][m][n][2 * jp + 1]}, au = {acc[ai][1][m][n][2 * jp], acc[ai][1][m][n][2 * jp + 1]};
                        const f32x2 bg2 = {bgv[n][2 * jp], bgv[n][2 * jp + 1]}, bu2 = {buv[n][2 * jp], buv[n][2 * jp + 1]};
                        f32x2 g = ag * rs + bg2, up = au * rs + bu2;
                        g.x = fminf(g.x, 7.0f); g.y = fminf(g.y, 7.0f);
                        up.x = fminf(fmaxf(up.x, -7.0f), 7.0f); up.y = fminf(fmaxf(up.y, -7.0f), 7.0f);
                        const f32x2 z = g * (-1.702f * 1.4426950408889634f);
                        f32x2 e; e.x = fexp2(z.x); e.y = fexp2(z.y);
                        const f32x2 den = e + 1.0f;
                        f32x2 r; r.x = frcp(den.x); r.y = frcp(den.y);
                        const f32x2 res = (g * r) * (up + 1.0f);
                        o[4 * n + 2 * jp] = res.x; o[4 * n + 2 * jp + 1] = res.y;
                    }
                u32x2 w; w.x = pk4_fp8(o[0], o[1], o[2], o[3]); w.y = pk4_fp8(o[4], o[5], o[6], o[7]);
                if (rl < u.nvalid) *(u32x2*)(act + (size_t)(u.eoff + u.pos0 + rl) * D + col8) = w;
            }
    }
};

struct ProbDown {
    static constexpr bool GATHER = false, MIDK = false, FP8 = true; static constexpr int NMETA = 3;
    MoeTabs tabs; const unsigned char* act; const unsigned char* wd; const unsigned* list; const float* gw; const float* bd; unsigned char* y8; int G, c;
    __device__ __forceinline__ bool next(int i, Unit& u) const { return tabs.next(i, G, c, 4, u); }
    __device__ __forceinline__ const char* a_base(const Unit& u) const { return (const char*)act + (size_t)(u.eoff + u.pos0) * D; }
    __device__ __forceinline__ const char* b_base(const Unit& u) const { return (const char*)wd + ((size_t)u.e * D + (size_t)u.pn * 256) * D; }
    __device__ __forceinline__ void a_offsets(const Unit&, int, unsigned (&)[2][2]) const {}
    __device__ __forceinline__ const unsigned* meta_ptr(const Unit& u, int a, int idx) const {
        if (a == 2) return (const unsigned*)bd + (size_t)u.e * D + u.pn * 256 + idx;
        return (a == 0 ? list : (const unsigned*)gw) + (size_t)u.e * T + u.pos0 + idx;
    }
    __device__ __forceinline__ void epi(const f32x4 (&acc)[2][2][4][2], const Unit& u, int wr, int wc, int fr, int fq, const LAS unsigned char* mbuf) const {
        const int cofs = u.pn * 256 + wc * 32 + 8 * fq;
        f32x4 bdv[2][2];
#pragma unroll
        for (int bj = 0; bj < 2; ++bj) { bdv[bj][0] = *(const LAS f32x4*)(mbuf + 2048 + (bj * 128 + wc * 32 + 8 * fq) * 4); bdv[bj][1] = *(const LAS f32x4*)(mbuf + 2048 + (bj * 128 + wc * 32 + 8 * fq + 4) * 4); }
#pragma unroll
        for (int ai = 0; ai < 2; ++ai)
#pragma unroll
            for (int m = 0; m < 4; ++m) {
                const int rl = ai * 128 + wr * 64 + m * 16 + fr;
                const unsigned sl = *(const LAS unsigned*)(mbuf + rl * 4);
                const float g = *(const LAS float*)(mbuf + 1024 + rl * 4), s1 = g * (Y8_SCALE / 64.0f), s2 = g * Y8_SCALE;
                unsigned char* dst = y8 + (size_t)sl * D + cofs;
#pragma unroll
                for (int bj = 0; bj < 2; ++bj) {
                    const f32x4 v0 = acc[ai][bj][m][0] * s1 + bdv[bj][0] * s2, v1 = acc[ai][bj][m][1] * s1 + bdv[bj][1] * s2;
                    u32x2 w; w.x = pk4_fp8(v0[0], v0[1], v0[2], v0[3]); w.y = pk4_fp8(v1[0], v1[1], v1[2], v1[3]);
                    if (rl < u.nvalid) *(u32x2*)(dst + bj * 128) = w;
                }
            }
    }
};

struct P0Item { const float* W; const float* scale; void* WT; int N, mode, off, k0, n0, fp8; };
__device__ __forceinline__ int p0_dest(const P0Item& d, int n) {
    if (d.mode == 1) { const int seg = n >> 9; if (seg == 2 || seg == 3) { const int w = n & 511, head = w >> 7, dd = w & 127; return (seg << 9) + (head << 7) + 2 * (dd & 63) + (dd >> 6); } return n; }
    if (d.mode == 2) return d.off + 256 * (n >> 7) + (n & 127);
    return d.off + n;
}
constexpr int P0_I_IN = 16 * (DIN / 64), P0_I_OUT = 16 * (D / 64), P0_I_E = 16 * (D / 64), P0_NITEMS_ALL = P0_I_IN + P0_I_OUT + 3 * NEXP * P0_I_E;
__device__ __forceinline__ void p0_load(const P0Item& d, int lane, f32x4 (&v)[16], float& sc) {
#pragma unroll
    for (int i = 0; i < 16; ++i) v[i] = *(const f32x4*)(d.W + (size_t)(d.k0 + (lane >> 4) + 4 * i) * d.N + d.n0 + 4 * (lane & 15));
    sc = d.scale ? d.scale[d.k0 + lane] : 1.0f;
    if (d.fp8) sc *= 64.0f;
}
__device__ __forceinline__ void p0_process(const P0Item& d, int lane, const f32x4 (&v)[16], float sc, LAS unsigned char* scr) {
    LAS float* ssc = (LAS float*)(scr + 64 * 136);
    ssc[lane] = sc;
    WAVE_SYNC();
#pragma unroll
    for (int i = 0; i < 16; ++i) { const int kk = (lane >> 4) + 4 * i; const float f = ssc[kk];
        u32x2 o; o.x = pk2(v[i].x * f, v[i].y * f); o.y = pk2(v[i].z * f, v[i].w * f);
        *(LAS u32x2*)(scr + kk * 136 + 8 * (lane & 15)) = o; }
    WAVE_SYNC();
    const int q = (lane & 15) >> 2, p = lane & 3;
    if (d.fp8) {
#pragma unroll
        for (int st = 0; st < 4; ++st) {
            const int n16 = 16 * st; unsigned o[4];
#pragma unroll
            for (int hf = 0; hf < 2; ++hf) {
                const int kb8 = 2 * (lane >> 4) + hf;
                const v4i16_t lo = __builtin_amdgcn_ds_read_tr16_b64_v4i16((LAS v4i16_t*)(scr + (8 * kb8 + q) * 136 + (n16 + 4 * p) * 2));
                const v4i16_t hi = __builtin_amdgcn_ds_read_tr16_b64_v4i16((LAS v4i16_t*)(scr + (8 * kb8 + 4 + q) * 136 + (n16 + 4 * p) * 2));
                o[2 * hf] = pk4_fp8(bf2f((unsigned short)lo[0]), bf2f((unsigned short)lo[1]), bf2f((unsigned short)lo[2]), bf2f((unsigned short)lo[3]));
                o[2 * hf + 1] = pk4_fp8(bf2f((unsigned short)hi[0]), bf2f((unsigned short)hi[1]), bf2f((unsigned short)hi[2]), bf2f((unsigned short)hi[3]));
            }
            *(u32x4*)((unsigned char*)d.WT + (size_t)p0_dest(d, d.n0 + n16 + (lane & 15)) * D + d.k0 + 16 * (lane >> 4)) = (u32x4){o[0], o[1], o[2], o[3]};
        }
    } else {
#pragma unroll
    for (int st = 0; st < 8; ++st) {
        const int n16 = 16 * (st & 3), kb8 = (st >> 2) * 4 + (lane >> 4);
        const v4i16_t lo = __builtin_amdgcn_ds_read_tr16_b64_v4i16((LAS v4i16_t*)(scr + (8 * kb8 + q) * 136 + (n16 + 4 * p) * 2));
        const v4i16_t hi = __builtin_amdgcn_ds_read_tr16_b64_v4i16((LAS v4i16_t*)(scr + (8 * kb8 + 4 + q) * 136 + (n16 + 4 * p) * 2));
        u32x4 o; o.x = (unsigned)(unsigned short)lo[0] | ((unsigned)(unsigned short)lo[1] << 16); o.y = (unsigned)(unsigned short)lo[2] | ((unsigned)(unsigned short)lo[3] << 16);
        o.z = (unsigned)(unsigned short)hi[0] | ((unsigned)(unsigned short)hi[1] << 16); o.w = (unsigned)(unsigned short)hi[2] | ((unsigned)(unsigned short)hi[3] << 16);
        *(u32x4*)((bf16_t*)d.WT + (size_t)p0_dest(d, d.n0 + n16 + (lane & 15)) * D + d.k0 + 8 * kb8) = o;
    }
    }
    WAVE_SYNC();
}

#ifndef STREAM_FINAL
#define STREAM_FINAL 1
#endif
#define STREAM_IN_PASS(fin) ((fin) ? (STREAM_FINAL != 0) : true)
struct MoeConv { const float *wg, *wu, *wd, *ffn_g; unsigned char *wgu8, *wd8; };
constexpr int MOE_ITEMS = 3 * NEXP * P0_I_E, NLRU = BATCH * NCH;
constexpr int MOE_PER_WU = (MOE_ITEMS + NLRU * 8 - 1) / (NLRU * 8);
constexpr int MOE_K0 = MOE_PER_WU >= 12 ? 8 : (MOE_PER_WU * 2 + 2) / 3, MOE_K1_RAW = MOE_PER_WU - MOE_K0, MOE_K1 = MOE_K1_RAW < 0 ? 0 : (MOE_K1_RAW > 8 ? 8 : MOE_K1_RAW);
constexpr int MOE_PASS0_ITEMS = NLRU * 8 * MOE_K0, MOE_CAP = NLRU * 8 * (MOE_K0 + MOE_K1), MOE_STREAMED = MOE_ITEMS < MOE_CAP ? MOE_ITEMS : MOE_CAP;
constexpr int P0_NITEMS = P0_NITEMS_ALL - MOE_STREAMED;
__device__ __forceinline__ P0Item moe_item(const MoeConv& M, int it) {
    P0Item d; d.scale = nullptr; d.off = 0; d.mode = 0; d.fp8 = 1; d.N = D;
    const int e = it / (3 * P0_I_E), q = (it / P0_I_E) % 3, r = it % P0_I_E;
    if (q == 0) { d.W = M.wg + (size_t)e * D * D; d.scale = M.ffn_g; d.WT = M.wgu8; d.mode = 2; d.off = e * 2048; }
    else if (q == 1) { d.W = M.wu + (size_t)e * D * D; d.scale = M.ffn_g; d.WT = M.wgu8; d.mode = 2; d.off = e * 2048 + 128; }
    else { d.W = M.wd + (size_t)e * D * D; d.WT = M.wd8; d.off = e * D; }
    d.k0 = 64 * (r / (D / 64)); d.n0 = 64 * (r % (D / 64)); return d;
}

constexpr int RT_STRIDE = 272;
constexpr int LDS_VT = 0, LDS_KT = 128 * RT_STRIDE;
constexpr int XA_STRIDE = 144, XA_WAVE = 16 * XA_STRIDE;
constexpr int AG_STRIDE = 520, AG_WAVE = 16 * AG_STRIDE;
constexpr int LRU_WAVE = XA_WAVE + AG_WAVE;
constexpr int LDS_XA = 0, LDS_SS = 8 * LRU_WAVE, LDS_RSL = LDS_SS + 8 * 128 * 4;
static_assert(LRU_WAVE % 16 == 0 && LRU_WAVE >= 64 * 136 + 256, "LRU per-wave LDS block must hold one weight item");
static_assert(LDS_RSL + 512 <= RING_BYTES && LDS_KT + 128 * RT_STRIDE <= RING_BYTES, "LDS seq map");

__device__ __forceinline__ bf16x8 tr_frag(const LAS unsigned char* tile, int row0, int col0, int fr) {
    const int q = fr >> 2, p = fr & 3;
    const v4i16_t lo = __builtin_amdgcn_ds_read_tr16_b64_v4i16((LAS v4i16_t*)(tile + (row0 + q) * RT_STRIDE + (col0 + 4 * p) * 2));
    const v4i16_t hi = __builtin_amdgcn_ds_read_tr16_b64_v4i16((LAS v4i16_t*)(tile + (row0 + 4 + q) * RT_STRIDE + (col0 + 4 * p) * 2));
    bf16x8 r; r[0] = lo[0]; r[1] = lo[1]; r[2] = lo[2]; r[3] = lo[3]; r[4] = hi[0]; r[5] = hi[1]; r[6] = hi[2]; r[7] = hi[3]; return r;
}
__device__ __forceinline__ void stage_tile(LAS unsigned char* dst, const bf16_t* src, int tid) {
#pragma unroll
    for (int i = 0; i < 4; ++i) { const int p = tid + 512 * i, r = p >> 4, c = p & 15;
        const u32x4 v = *(const u32x4*)(src + (size_t)r * DIN + c * 8); *(LAS u32x4*)(dst + r * RT_STRIDE + c * 16) = v; }
}

template <bool FINAL>
__device__ __forceinline__ void lru_unit(LAS unsigned char* lds, int b, int n, const bf16_t* __restrict__ proj, const float* __restrict__ conv_w, const float* __restrict__ conv_b, const bf16_t* __restrict__ waf,
                                         const float* __restrict__ ba, const float* __restrict__ bx, const float* __restrict__ lam, const float* __restrict__ lru_ng,
                                         float* __restrict__ lap, float* __restrict__ lah, const float* __restrict__ carry, bf16_t* __restrict__ ycat, float* __restrict__ rsl_out, const MoeConv& MC, int item0, int wv) {
    int tid_ = wv * 64 + LANE_ID(); OPAQUE(tid_);
    const int tid = tid_, lane = tid & 63, w = __builtin_amdgcn_readfirstlane(tid >> 6), fr = lane & 15, fq = lane >> 4, c = tid;
    LAS unsigned char* xa = lds + LDS_XA + w * LRU_WAVE; LAS unsigned char* ag = xa + XA_WAVE;
    LAS float* ss = (LAS float*)(lds + LDS_SS);
    bf16x8 Ba[2][4], Bx[2][4];
#pragma unroll
    for (int ks = 0; ks < 2; ++ks)
#pragma unroll
        for (int nt = 0; nt < 4; ++nt) { const size_t fi = ((size_t)(w * 2 + ks) * 4 + nt) * 64 + lane; Ba[ks][nt] = *(const bf16x8*)(waf + fi * 8); Bx[ks][nt] = *(const bf16x8*)(waf + (fi + 4096) * 8); }
    float bav[4], bxv[4], spl[4];
#pragma unroll
    for (int nt = 0; nt < 4; ++nt) { const int co = w * 64 + 16 * nt + fr; bav[nt] = ba[co]; bxv[nt] = bx[co]; const float l = lam[co];
        spl[nt] = -8.0f * 1.4426950408889634f * (fmaxf(-l, 0.f) + log1pf(expf(-fabsf(l)))); }
    const float w0 = conv_w[c], w1 = conv_w[512 + c], w2 = conv_w[1024 + c], w3 = conv_w[1536 + c], cb = conv_b[c];
    const float gn = FINAL ? lru_ng[c] : 0.f;
    const size_t t0 = (size_t)b * SEQ + (size_t)n * 128;
    float xm3 = 0.f, xm2 = 0.f, xm1 = 0.f;
    if (n > 0) { xm3 = bf2f(proj[(t0 - 3) * DIN + c]); xm2 = bf2f(proj[(t0 - 2) * DIN + c]); xm1 = bf2f(proj[(t0 - 1) * DIN + c]); }
    float h = FINAL ? carry[((size_t)b * NCH + n) * 512 + c] : 0.f, P = 1.f;
    unsigned xr[16];
#pragma unroll
    for (int i = 0; i < 16; ++i) xr[i] = proj[(t0 + i) * DIN + c];
    for (int tt = 0; tt < 8; ++tt) {
        float xcv[16]; unsigned gr[16];
#pragma unroll
        for (int i = 0; i < 16; ++i) { xcv[i] = bf2f(xr[i]); gr[i] = FINAL ? (unsigned)proj[(t0 + tt * 16 + i) * DIN + 512 + c] : 0u; }
        if (tt < 7) {
#pragma unroll
            for (int i = 0; i < 16; ++i) xr[i] = proj[(t0 + (tt + 1) * 16 + i) * DIN + c];
        }
        constexpr int KP = FINAL ? MOE_K1 : MOE_K0;
        const int cit = item0 + (w * KP + tt);
        const bool chas = (tt < KP) && (cit < MOE_STREAMED);
        P0Item cd; f32x4 cv[16]; float csc = 1.f;
        if (chas) { cd = moe_item(MC, cit); p0_load(cd, lane, cv, csc); }
#pragma unroll
        for (int i = 0; i < 16; ++i) {
            const float x0 = xcv[i];
            const float xc = w0 * xm3 + w1 * xm2 + w2 * xm1 + w3 * x0 + cb;
            xm3 = xm2; xm2 = xm1; xm1 = x0; xcv[i] = xc;
            *(LAS bf16_t*)(xa + i * XA_STRIDE + lane * 2) = (bf16_t)f2bf(xc);
        }
        WAVE_SYNC();
        bf16x8 af[2];
#pragma unroll
        for (int ks = 0; ks < 2; ++ks) af[ks] = *(const LAS bf16x8*)(xa + fr * XA_STRIDE + (32 * ks + 8 * fq) * 2);
#pragma unroll
        for (int nt = 0; nt < 4; ++nt) {
            f32x4 ar = {0.f, 0.f, 0.f, 0.f}, ai = {0.f, 0.f, 0.f, 0.f};
#pragma unroll
            for (int ks = 0; ks < 2; ++ks) { ar = __builtin_amdgcn_mfma_f32_16x16x32_bf16(af[ks], Ba[ks][nt], ar, 0, 0, 0); ai = __builtin_amdgcn_mfma_f32_16x16x32_bf16(af[ks], Bx[ks][nt], ai, 0, 0, 0); }
#pragma unroll
            for (int r = 0; r < 4; ++r) {
                const float rr = sigmoid_f(ar[r] + bav[nt]), ii = sigmoid_f(ai[r] + bxv[nt]);
                const float a = fexp2(rr * spl[nt]);
                const float g = sqrtf(fmaxf(1.0f - a * a, 0.f)) * ii;
                *(LAS f32x2*)(ag + (4 * fq + r) * AG_STRIDE + (16 * nt + fr) * 8) = (f32x2){a, g};
            }
        }
        WAVE_SYNC();
        unsigned upk[8];
#pragma unroll
        for (int i = 0; i < 16; ++i) {
            const f32x2 v = *(const LAS f32x2*)(ag + i * AG_STRIDE + lane * 8);
            h = v.x * h + v.y * xcv[i];
            if (!FINAL) P *= v.x;
            if (FINAL) {
                const float u = h * bf2f(gr[i]);
                const unsigned ub = f2bf(u * gn);
                if (i & 1) upk[i >> 1] |= ub << 16; else upk[i >> 1] = ub;
                *(LAS float*)(ag + i * AG_STRIDE + lane * 8) = u;
            }
        }
        if (FINAL) {
            WAVE_SYNC();
            const int tk = lane & 15, qd = lane >> 4; float s = 0.f;
#pragma unroll
            for (int i = 0; i < 16; ++i) { const float u = *(const LAS float*)(ag + tk * AG_STRIDE + (16 * qd + i) * 8); s += u * u; }
            s += SHFLX_F(s, 16, lane); s += SHFLX_F(s, 32, lane);
            if (qd == 0) ss[w * 128 + tt * 16 + tk] = s;
        }
        WAVE_SYNC();
        if (chas) p0_process(cd, lane, cv, csc, xa);
        if (FINAL) {
#pragma unroll
            for (int i = 0; i < 16; ++i) ycat[(t0 + tt * 16 + i) * D + c] = (bf16_t)((i & 1) ? (upk[i >> 1] >> 16) : (upk[i >> 1] & 0xffffu));
        }
    }
    if (!FINAL) { lap[((size_t)b * NCH + n) * 512 + c] = P; lah[((size_t)b * NCH + n) * 512 + c] = h; }
    else {
        __syncthreads();
        if (tid < 128) { float tot = 0.f;
#pragma unroll
            for (int q = 0; q < 8; ++q) tot += ss[q * 128 + tid];
            rsl_out[t0 + tid] = 1.0f / sqrtf(tot * (1.0f / 512.0f) + NORM_EPS); }
    }
    __syncthreads();
}

__device__ __forceinline__ void ret_kv_load(u32x4 (&tk)[4], u32x4 (&tv)[4], int unit, const bf16_t* __restrict__ proj, int tid) {
    const int bh = unit / NCH, n = unit % NCH, b = bh >> 2, hh = bh & 3;
    const size_t t0 = (size_t)b * SEQ + (size_t)n * 128;
#pragma unroll
    for (int i = 0; i < 4; ++i) { const int p = tid + 512 * i, r = p >> 4, c = p & 15;
        tk[i] = *(const u32x4*)(proj + (t0 + r) * DIN + 1536 + hh * 128 + c * 8); tv[i] = *(const u32x4*)(proj + (t0 + r) * DIN + 2048 + hh * 128 + c * 8); }
}
__device__ __forceinline__ void ret_kv_stage(LAS unsigned char* lds, const u32x4 (&tk)[4], const u32x4 (&tv)[4], int tid) {
#pragma unroll
    for (int i = 0; i < 4; ++i) { const int p = tid + 512 * i, r = p >> 4, c = p & 15;
        *(LAS u32x4*)(lds + LDS_KT + r * RT_STRIDE + c * 16) = tk[i]; *(LAS u32x4*)(lds + LDS_VT + r * RT_STRIDE + c * 16) = tv[i]; }
}
__device__ __forceinline__ void ret_kv_phase(LAS unsigned char* lds, const bf16_t* __restrict__ proj, bf16_t* __restrict__ kvt, int G, int bx, int wv) {
    int tid_ = wv * 64 + LANE_ID(); OPAQUE(tid_);
    const int tid = tid_, lane = tid & 63, w = wv, fr = lane & 15, fq = lane >> 4;
    u32x4 tk[4], tv[4];
    int unit = bx;
    if (unit < NBH * NCH) { ret_kv_load(tk, tv, unit, proj, tid); ret_kv_stage(lds, tk, tv, tid); __syncthreads(); if (unit + G < NBH * NCH) ret_kv_load(tk, tv, unit + G, proj, tid); }
    for (; unit < NBH * NCH; unit += G) {
        f32x4 acc[8];
#pragma unroll
        for (int et = 0; et < 8; ++et) acc[et] = (f32x4){0.f, 0.f, 0.f, 0.f};
#pragma unroll
        for (int ks = 0; ks < 4; ++ks) {
            const bf16x8 af = tr_frag(lds + LDS_KT, 32 * ks + 8 * fq, 16 * w, fr);
#pragma unroll
            for (int et = 0; et < 8; ++et) { const bf16x8 bfv = tr_frag(lds + LDS_VT, 32 * ks + 8 * fq, 16 * et, fr);
                acc[et] = __builtin_amdgcn_mfma_f32_16x16x32_bf16(af, bfv, acc[et], 0, 0, 0); }
        }
        u32x2 o[8];
#pragma unroll
        for (int et = 0; et < 8; ++et) { o[et].x = pk2v(acc[et][0], acc[et][1]); o[et].y = pk2v(acc[et][2], acc[et][3]); }
        __syncthreads();
        if (unit + G < NBH * NCH) ret_kv_stage(lds, tk, tv, tid);
        bf16_t* out = kvt + (size_t)unit * 16384;
#pragma unroll
        for (int et = 0; et < 8; ++et) *(u32x2*)(out + (size_t)(16 * et + fr) * 128 + 16 * w + 4 * fq) = o[et];
        __syncthreads();
        if (unit + 2 * G < NBH * NCH) ret_kv_load(tk, tv, unit + 2 * G, proj, tid);
    }
}

__device__ __forceinline__ int swz_off(int row, int chunk) { return row * 256 + ((chunk ^ (row & 15)) << 4); }
constexpr int LDS_RV = 0, LDS_RK = 32768, LDS_RP = 65536, LDS_RPT = 98304;
__device__ __forceinline__ bf16x8 tr_frag_swz(const LAS unsigned char* tile, int row0, int col0, int fr) {
    const int q = fr >> 2, p = fr & 3, ch = (col0 >> 3) + (p >> 1), bo = (p & 1) * 8;
    const v4i16_t lo = __builtin_amdgcn_ds_read_tr16_b64_v4i16((LAS v4i16_t*)(tile + swz_off(row0 + q, ch) + bo));
    const v4i16_t hi = __builtin_amdgcn_ds_read_tr16_b64_v4i16((LAS v4i16_t*)(tile + swz_off(row0 + 4 + q, ch) + bo));
    bf16x8 r; r[0] = lo[0]; r[1] = lo[1]; r[2] = lo[2]; r[3] = lo[3]; r[4] = hi[0]; r[5] = hi[1]; r[6] = hi[2]; r[7] = hi[3]; return r;
}
struct RetRegs { u32x4 tv[4], tk[4], tp[4]; bf16x8 bq[4]; u32x2 sg[8]; };
__device__ __forceinline__ void ret_out_load(RetRegs& R, int unit, const bf16_t* __restrict__ proj, const bf16_t* __restrict__ prevt, int tid, int w, int fr, int fq) {
    const int bh = unit / NCH, n = unit % NCH, b = bh >> 2, hh = bh & 3;
    const size_t t0 = (size_t)b * SEQ + (size_t)n * 128;
#pragma unroll
    for (int i = 0; i < 4; ++i) { const int p = tid + 512 * i, r = p >> 4, c = p & 15;
        R.tv[i] = *(const u32x4*)(proj + (t0 + r) * DIN + 2048 + hh * 128 + c * 8);
        R.tk[i] = *(const u32x4*)(proj + (t0 + r) * DIN + 1536 + hh * 128 + c * 8);
        R.tp[i] = *(const u32x4*)(prevt + (size_t)unit * 16384 + r * 128 + c * 8); }
#pragma unroll
    for (int ks = 0; ks < 4; ++ks) R.bq[ks] = *(const bf16x8*)(proj + (t0 + 16 * w + fr) * DIN + 1024 + hh * 128 + 32 * ks + 8 * fq);
#pragma unroll
    for (int et = 0; et < 8; ++et) R.sg[et] = *(const u32x2*)(proj + (t0 + 16 * w + fr) * DIN + 2560 + hh * 128 + 16 * et + 4 * fq);
}
__device__ __forceinline__ void ret_out_phase(LAS unsigned char* lds, const bf16_t* __restrict__ proj, const bf16_t* __restrict__ prevt, const float* __restrict__ gng, const float* __restrict__ gnb, bf16_t* __restrict__ ycat, int G, int bx, int wv) {
    int tid_ = wv * 64 + LANE_ID(); OPAQUE(tid_);
    const int tid = tid_, lane = tid & 63, w = __builtin_amdgcn_readfirstlane(tid >> 6), fr = lane & 15, fq = lane >> 4;
    RetRegs R;
    int unit = bx;
    bf16x8 bq[4]; u32x2 sg[8];
    if (unit < NBH * NCH) {
        ret_out_load(R, unit, proj, prevt, tid, w, fr, fq);
#pragma unroll
        for (int i = 0; i < 4; ++i) { const int p = tid + 512 * i, r = p >> 4, c = p & 15, o = swz_off(r, c);
            *(LAS u32x4*)(lds + LDS_RV + o) = R.tv[i]; *(LAS u32x4*)(lds + LDS_RK + o) = R.tk[i]; *(LAS u32x4*)(lds + LDS_RP + o) = R.tp[i]; }
#pragma unroll
        for (int ks = 0; ks < 4; ++ks) bq[ks] = R.bq[ks];
#pragma unroll
        for (int et = 0; et < 8; ++et) sg[et] = R.sg[et];
        __syncthreads();
        if (unit + G < NBH * NCH) ret_out_load(R, unit + G, proj, prevt, tid, w, fr, fq);
    }
    for (; unit < NBH * NCH; unit += G) {
        const int bh = unit / NCH, n = unit % NCH, b = bh >> 2, hh = bh & 3;
        const size_t t0 = (size_t)b * SEQ + (size_t)n * 128;
        const int crow = 16 * w + fr;
#pragma unroll
        for (int mt = 0; mt < 8; ++mt) {
            if (mt <= w) {
                f32x4 sacc = {0.f, 0.f, 0.f, 0.f};
#pragma unroll
                for (int ks = 0; ks < 4; ++ks) { const bf16x8 ak = *(const LAS bf16x8*)(lds + LDS_RK + swz_off(16 * mt + fr, 4 * ks + fq));
                    sacc = __builtin_amdgcn_mfma_f32_16x16x32_bf16(ak, bq[ks], sacc, 0, 0, 0); }
                if (mt == w) {
#pragma unroll
                    for (int r = 0; r < 4; ++r) if (4 * fq + r > fr) sacc[r] = 0.f;
                }
                u32x2 o; o.x = pk2v(sacc[0], sacc[1]); o.y = pk2v(sacc[2], sacc[3]);
                *(LAS u32x2*)(lds + LDS_RPT + swz_off(crow, 2 * mt + (fq >> 1)) + (fq & 1) * 8) = o;
            } else if (mt == w + 1 && (mt & 1)) {
                *(LAS u32x2*)(lds + LDS_RPT + swz_off(crow, 2 * mt + (fq >> 1)) + (fq & 1) * 8) = (u32x2){0u, 0u};
            }
        }
        WAVE_SYNC();
        f32x4 acc[8];
#pragma unroll
        for (int et = 0; et < 8; ++et) acc[et] = (f32x4){0.f, 0.f, 0.f, 0.f};
        const int nks = (w + 2) >> 1;
#pragma unroll
        for (int ksm = 0; ksm < 4; ++ksm) {
            if (ksm < nks) {
                const bf16x8 bp = *(const LAS bf16x8*)(lds + LDS_RPT + swz_off(crow, 4 * ksm + fq));
#pragma unroll
                for (int et = 0; et < 8; ++et) { const bf16x8 av = tr_frag_swz(lds + LDS_RV, 32 * ksm + 8 * fq, 16 * et, fr);
                    acc[et] = __builtin_amdgcn_mfma_f32_16x16x32_bf16(av, bp, acc[et], 0, 0, 0); }
            }
        }
#pragma unroll
        for (int et = 0; et < 8; ++et)
#pragma unroll
            for (int ks = 0; ks < 4; ++ks) { const bf16x8 ap = *(const LAS bf16x8*)(lds + LDS_RP + swz_off(16 * et + fr, 4 * ks + fq));
                acc[et] = __builtin_amdgcn_mfma_f32_16x16x32_bf16(ap, bq[ks], acc[et], 0, 0, 0); }
        float s1 = 0.f;
#pragma unroll
        for (int et = 0; et < 8; ++et) s1 += (acc[et][0] + acc[et][1]) + (acc[et][2] + acc[et][3]);
        s1 += SHFLX_F(s1, 16, lane); s1 += SHFLX_F(s1, 32, lane);
        const float mu = s1 * (1.0f / 128.0f);
        float s2 = 0.f;
#pragma unroll
        for (int et = 0; et < 8; ++et)
#pragma unroll
            for (int r = 0; r < 4; ++r) { const float dlt = acc[et][r] - mu; s2 += dlt * dlt; }
        s2 += SHFLX_F(s2, 16, lane); s2 += SHFLX_F(s2, 32, lane);
        const float rstd = 1.0f / sqrtf(s2 * (1.0f / 128.0f) + NORM_EPS);
        const size_t t = t0 + 16 * w + fr;
        u32x2 yo[8];
#pragma unroll
        for (int et = 0; et < 8; ++et) {
            const int e0 = hh * 128 + 16 * et + 4 * fq;
            const f32x4 gv = *(const f32x4*)(gng + e0), bv = *(const f32x4*)(gnb + e0);
            const float y0 = ((acc[et][0] - mu) * rstd * gv[0] + bv[0]) * bflo(sg[et].x), y1 = ((acc[et][1] - mu) * rstd * gv[1] + bv[1]) * bfhi(sg[et].x);
            const float y2 = ((acc[et][2] - mu) * rstd * gv[2] + bv[2]) * bflo(sg[et].y), y3 = ((acc[et][3] - mu) * rstd * gv[3] + bv[3]) * bfhi(sg[et].y);
            yo[et].x = pk2v(y0, y1); yo[et].y = pk2v(y2, y3);
        }
        __syncthreads();
        const bool has_next = unit + G < NBH * NCH;
        if (has_next) {
#pragma unroll
            for (int i = 0; i < 4; ++i) { const int p = tid + 512 * i, r = p >> 4, c = p & 15, o = swz_off(r, c);
                *(LAS u32x4*)(lds + LDS_RV + o) = R.tv[i]; *(LAS u32x4*)(lds + LDS_RK + o) = R.tk[i]; *(LAS u32x4*)(lds + LDS_RP + o) = R.tp[i]; }
#pragma unroll
            for (int ks = 0; ks < 4; ++ks) bq[ks] = R.bq[ks];
#pragma unroll
            for (int et = 0; et < 8; ++et) sg[et] = R.sg[et];
        }
#pragma unroll
        for (int et = 0; et < 8; ++et) *(u32x2*)(ycat + t * D + 512 + hh * 128 + 16 * et + 4 * fq) = yo[et];
        __syncthreads();
        if (unit + 2 * G < NBH * NCH) ret_out_load(R, unit + 2 * G, proj, prevt, tid, w, fr, fq);
    }
}

struct Ptrs {
    const float *x, *attn_g, *w_in, *conv_w, *conv_b, *lru_wa, *lru_ba, *lru_wx, *lru_bx, *lru_lam, *lru_ng, *ret_ng, *ret_nb, *w_out, *ffn_g, *router_w, *router_b;
    const float *moe_wg, *moe_bg, *moe_wu, *moe_bu, *moe_wd, *moe_bd, *final_g; const int* positions;
    float *RS1, *RS2S, *SSQ, *GW, *LAP, *LAH, *CARRY, *out; unsigned *LIST, *ctl;
    bf16_t *WR_T, *WIN_T, *WOUT_T, *PROJ, *XB, *YCAT, *YB23, *KVT, *PREVT, *YB01, *WAF; float* RSL; unsigned char *WGU8, *WD8, *X8, *ACT; int wv;
};
__device__ __forceinline__ MoeConv moe_conv(const Ptrs& P) { MoeConv M; M.wg = P.moe_wg; M.wu = P.moe_wu; M.wd = P.moe_wd; M.ffn_g = P.ffn_g; M.wgu8 = P.WGU8; M.wd8 = P.WD8; return M; }
#define PHASE_IDS() int tid = P.wv * 64 + LANE_ID(); OPAQUE(tid); const int lane = tid & 63, wave = P.wv; const int gw = bx * NWAVES + wave, NGW = G * NWAVES; (void)lane; (void)gw; (void)NGW

__device__ __forceinline__ P0Item p0_decode(const Ptrs& P, int it) {
    P0Item d; d.scale = nullptr; d.off = 0; d.mode = 0; d.fp8 = 0; int r = it, nblk;
    if (r < P0_I_IN) { d.W = P.w_in; d.N = DIN; d.WT = P.WIN_T; d.mode = 1; }
    else if ((r -= P0_I_IN) < P0_I_OUT) { d.W = P.w_out; d.N = D; d.WT = P.WOUT_T; }
    else { r -= P0_I_OUT; r += MOE_STREAMED;
        const int e = r / (3 * P0_I_E), q = (r / P0_I_E) % 3; r = r % P0_I_E; d.N = D;
        d.fp8 = 1;
        if (q == 0) { d.W = P.moe_wg + (size_t)e * D * D; d.scale = P.ffn_g; d.WT = P.WGU8; d.mode = 2; d.off = e * 2048; }
        else if (q == 1) { d.W = P.moe_wu + (size_t)e * D * D; d.scale = P.ffn_g; d.WT = P.WGU8; d.mode = 2; d.off = e * 2048 + 128; }
        else { d.W = P.moe_wd + (size_t)e * D * D; d.WT = P.WD8; d.off = e * D; } }
    nblk = d.N / 64; d.k0 = 64 * (r / nblk); d.n0 = 64 * (r % nblk); return d;
}
__device__ __forceinline__ void p0_prologue(LAS unsigned char* lds, const Ptrs& P, int G, int bx) {
    PHASE_IDS();
    {
        f32x4 gv[4];
#pragma unroll
        for (int j = 0; j < 4; ++j) gv[j] = ((const f32x4*)P.attn_g)[lane + 64 * j];
        f32x4 v[4], nv[4];
        int m = gw;
        if (m < T) {
#pragma unroll
            for (int j = 0; j < 4; ++j) v[j] = ((const f32x4*)(P.x + (size_t)m * D))[lane + 64 * j];
        }
        for (; m < T; m += NGW) {
            const int mn = m + NGW;
            if (mn < T) {
#pragma unroll
                for (int j = 0; j < 4; ++j) nv[j] = ((const f32x4*)(P.x + (size_t)mn * D))[lane + 64 * j];
            }
            float s = 0.f;
#pragma unroll
            for (int j = 0; j < 4; ++j) s += (v[j].x * v[j].x + v[j].y * v[j].y) + (v[j].z * v[j].z + v[j].w * v[j].w);
            s = wave_sum(s, lane);
            if (lane == 0) P.RS1[m] = 1.0f / sqrtf(s * (1.0f / D) + NORM_EPS);
            u32x2* o8 = (u32x2*)(P.XB + (size_t)m * D) + lane;
#pragma unroll
            for (int j = 0; j < 4; ++j) { u32x2 o; o.x = pk2(v[j].x * gv[j].x, v[j].y * gv[j].y); o.y = pk2(v[j].z * gv[j].z, v[j].w * gv[j].w); o8[64 * j] = o; }
#pragma unroll
            for (int j = 0; j < 4; ++j) v[j] = nv[j];
        }
    }
    {
        LAS unsigned char* scr = lds + wave * 16384;
        f32x4 v[16], nv[16]; float sc = 1.f, nsc = 1.f;
        int it = gw;
        P0Item d, nd;
        if (it < P0_NITEMS) { d = p0_decode(P, it); p0_load(d, lane, v, sc); }
        for (; it < P0_NITEMS; it += NGW) {
            const int nit = it + NGW;
            if (nit < P0_NITEMS) { nd = p0_decode(P, nit); p0_load(nd, lane, nv, nsc); }
            p0_process(d, lane, v, sc, scr);
            d = nd; sc = nsc;
#pragma unroll
            for (int i = 0; i < 16; ++i) v[i] = nv[i];
        }
    }
    for (int i = bx * NTHREADS + tid; i < 32 * D; i += G * NTHREADS) { const int e = i / D, k = i % D; P.WR_T[i] = (bf16_t)((e < NEXP) ? f2bf(P.router_w[(size_t)k * NEXP + e] * P.ffn_g[k]) : 0u); }
    for (int i = bx * NTHREADS + tid; i < 2 * 8 * 2 * 4 * 64; i += G * NTHREADS) {
        const int ln = i & 63, nt = (i >> 6) & 3, ks = (i >> 8) & 1, h = (i >> 9) & 7, mat = i >> 12, fr = ln & 15, fq = ln >> 4;
        const float* w = mat ? P.lru_wx : P.lru_wa; unsigned pk[4];
#pragma unroll
        for (int j = 0; j < 4; ++j) { const size_t i0 = ((size_t)h * 64 + 32 * ks + 8 * fq + 2 * j) * 64 + 16 * nt + fr; pk[j] = pk2(w[i0], w[i0 + 64]); }
        *(u32x4*)(P.WAF + (size_t)i * 8) = (u32x4){pk[0], pk[1], pk[2], pk[3]};
    }
}

__device__ __forceinline__ void p3_scans(const Ptrs& P, int G, int bx) {
    PHASE_IDS();
    for (int i = bx * NTHREADS + tid; i < BATCH * 512; i += G * NTHREADS) { const int b = i / 512, c = i % 512; float st = 0.f;
        for (int n = 0; n < NCH; ++n) { const size_t o = ((size_t)b * NCH + n) * 512 + c; P.CARRY[o] = st; st = P.LAP[o] * st + P.LAH[o]; } }
    for (int i = bx * NTHREADS + tid; i < NBH * 8192; i += G * NTHREADS) {
        const int bh = i / 8192, rem = i % 8192, hh = bh & 3;
        const float lamb = exp2f(128.0f * log2_gamma(hh));
        float s0 = 0.f, s1 = 0.f;
        const unsigned* src = (const unsigned*)(P.KVT + (size_t)bh * NCH * 16384) + rem; unsigned* dst = (unsigned*)(P.PREVT + (size_t)bh * NCH * 16384) + rem;
        for (int n0 = 0; n0 < NCH; n0 += 64) {
            unsigned kv[64];
#pragma unroll
            for (int j = 0; j < 64; ++j) kv[j] = (n0 + j < NCH) ? src[(size_t)(n0 + j) * 8192] : 0u;
#pragma unroll
            for (int j = 0; j < 64; ++j) { if (n0 + j < NCH) { dst[(size_t)(n0 + j) * 8192] = pk2(s0, s1); s0 = lamb * (s0 + bflo(kv[j])); s1 = lamb * (s1 + bfhi(kv[j])); } }
        }
    }
}

constexpr int CW_HIST = 32768;
__device__ __forceinline__ void p6_router(LAS unsigned char* lds, const Ptrs& P, int G, int bx, const XcdBarrier& bar) {
    PHASE_IDS();
    LAS unsigned* hist = (LAS unsigned*)(lds + 0); LAS unsigned* base = (LAS unsigned*)(lds + 256); LAS unsigned* part = (LAS unsigned*)(lds + 512);
    const int fr = lane & 15, fq = lane >> 4;
    const bool act = bx < T / 128;
    if (tid < 64) hist[tid] = 0u;
    __syncthreads();
    const int tok = (act ? bx : 0) * 128 + wave * 16 + fr;
    f32x4 lg[2] = {{0.f, 0.f, 0.f, 0.f}, {0.f, 0.f, 0.f, 0.f}};
    for (int ks = 0; ks < 32; ++ks) {
        const bf16x8 bt = *(const bf16x8*)(P.YB01 + (size_t)tok * 2048 + 32 * ks + 8 * fq);
#pragma unroll
        for (int tt = 0; tt < 2; ++tt) { const bf16x8 aw = *(const bf16x8*)(P.WR_T + (size_t)(16 * tt + fr) * D + 32 * ks + 8 * fq);
            lg[tt] = __builtin_amdgcn_mfma_f32_16x16x32_bf16(aw, bt, lg[tt], 0, 0, 0); }
    }
    float tot = 0.f;
#pragma unroll
    for (int p = 0; p < 16; ++p) tot += P.SSQ[(size_t)p * T + tok];
    const float rs = 1.0f / sqrtf(tot * (1.0f / D) + NORM_EPS);
    float val[8];
#pragma unroll
    for (int tt = 0; tt < 2; ++tt)
#pragma unroll
        for (int r = 0; r < 4; ++r) { const int e = 16 * tt + 4 * fq + r; val[4 * tt + r] = (e < NEXP) ? (lg[tt][r] * rs + P.router_b[e < NEXP ? e : 0]) : -3.0e38f; }
    float tv[4]; int ti[4];
#pragma unroll
    for (int k = 0; k < 4; ++k) {
        float bv = -3.4e38f; int bi = 1 << 20;
#pragma unroll
        for (int q = 0; q < 8; ++q) { const int e = 16 * (q >> 2) + 4 * fq + (q & 3); if (val[q] > bv || (val[q] == bv && e < bi)) { bv = val[q]; bi = e; } }
#pragma unroll
        for (int o = 16; o <= 32; o <<= 1) { const float ov = SHFLX_F(bv, o, lane); const int oi = SHFLX_I(bi, o, lane); if (ov > bv || (ov == bv && oi < bi)) { bv = ov; bi = oi; } }
        tv[k] = bv; ti[k] = bi;
#pragma unroll
        for (int q = 0; q < 8; ++q) { const int e = 16 * (q >> 2) + 4 * fq + (q & 3); if (e == bi) val[q] = -3.4e38f; }
    }
    float ex[4], den = 0.f;
#pragma unroll
    for (int k = 0; k < 4; ++k) { ex[k] = expf(tv[k] - tv[0]); den += ex[k]; }
    unsigned lp[4] = {0u, 0u, 0u, 0u};
    if (act && fq == 0) {
#pragma unroll
        for (int k = 0; k < 4; ++k) lp[k] = __hip_atomic_fetch_add(&hist[ti[k]], 1u, __ATOMIC_RELAXED, __HIP_MEMORY_SCOPE_WORKGROUP);
    }
    __syncthreads();
    if (tid < 32) P.ctl[CW_HIST + bx * 32 + tid] = hist[tid];
    xcd_barrier(bar, P.wv);
    {
        const int e = tid & 31, pt = tid >> 5; unsigned sum = 0u;
#pragma unroll
        for (int i = 0; i < 16; ++i) { const int w = pt * 16 + i; const unsigned c = P.ctl[CW_HIST + (w < G ? w : 0) * 32 + e]; sum += (w < bx) ? c : 0u; }
        part[pt * 32 + e] = sum;
    }
    __syncthreads();
    if (tid < 32) { unsigned sum = 0u;
#pragma unroll
        for (int i = 0; i < 16; ++i) sum += part[i * 32 + tid];
        base[tid] = sum;
        if (bx == G - 1 && tid < NEXP) P.ctl[CW_CNT + 64 * tid] = sum + hist[tid]; }
    __syncthreads();
    if (act && fq == 0) {
#pragma unroll
        for (int k = 0; k < 4; ++k) { const size_t o = (size_t)ti[k] * T + base[ti[k]] + lp[k]; P.LIST[o] = (unsigned)tok * 4u + (unsigned)k; P.GW[o] = ex[k] / den; P.RS2S[o] = rs; }
    }
    __syncthreads();
}

__device__ __forceinline__ void p9_final(const Ptrs& P, int G, int bx) {
    PHASE_IDS();
    const unsigned char* Y8 = (const unsigned char*)P.YB23;
    u32x4 q[2], nq[2], nnq[2]; u32x2 e[8], ne[8], nne[8];
    int m = gw;
#define P9_LOAD(dq, de, row) do { _Pragma("unroll") for (int j = 0; j < 2; ++j) { const int col = (j * 64 + lane) * 8; \
        dq[j] = *(const u32x4*)(P.YB01 + (size_t)(row) * 2048 + col); \
        _Pragma("unroll") for (int k = 0; k < 4; ++k) de[4 * j + k] = *(const u32x2*)(Y8 + (size_t)(row) * 4096 + k * 1024 + col); } } while (0)
    if (m < T) P9_LOAD(q, e, m);
    if (m + NGW < T) P9_LOAD(nq, ne, m + NGW);
    f32x4 g0[2], g1[2];
#pragma unroll
    for (int j = 0; j < 2; ++j) { const int col = (j * 64 + lane) * 8; g0[j] = *(const f32x4*)(P.final_g + col); g1[j] = *(const f32x4*)(P.final_g + col + 4); }
    for (; m < T; m += NGW) {
        const int mn = m + 2 * NGW;
        if (mn < T) P9_LOAD(nnq, nne, mn);
        float v[2][8]; float s = 0.f;
#pragma unroll
        for (int j = 0; j < 2; ++j) {
            f32x2 t[4] = {{0.f, 0.f}, {0.f, 0.f}, {0.f, 0.f}, {0.f, 0.f}};
#pragma unroll
            for (int k = 0; k < 4; ++k) { const u32x2 w = e[4 * j + k]; t[0] += unpk2_fp8(w.x, false); t[1] += unpk2_fp8(w.x, true); t[2] += unpk2_fp8(w.y, false); t[3] += unpk2_fp8(w.y, true); }
            const u32x4 a = q[j];
            v[j][0] = bflo(a.x) + t[0].x * (1.0f / Y8_SCALE); v[j][1] = bfhi(a.x) + t[0].y * (1.0f / Y8_SCALE); v[j][2] = bflo(a.y) + t[1].x * (1.0f / Y8_SCALE); v[j][3] = bfhi(a.y) + t[1].y * (1.0f / Y8_SCALE);
            v[j][4] = bflo(a.z) + t[2].x * (1.0f / Y8_SCALE); v[j][5] = bfhi(a.z) + t[2].y * (1.0f / Y8_SCALE); v[j][6] = bflo(a.w) + t[3].x * (1.0f / Y8_SCALE); v[j][7] = bfhi(a.w) + t[3].y * (1.0f / Y8_SCALE);
#pragma unroll
            for (int k = 0; k < 8; ++k) s += v[j][k] * v[j][k];
        }
        s = wave_sum(s, lane);
        const float rs = 1.0f / sqrtf(s * (1.0f / D) + NORM_EPS);
#pragma unroll
        for (int j = 0; j < 2; ++j) {
            const int col = (j * 64 + lane) * 8;
            f32x4 o0, o1;
#pragma unroll
            for (int k = 0; k < 4; ++k) { o0[k] = v[j][k] * rs * g0[j][k]; o1[k] = v[j][4 + k] * rs * g1[j][k]; }
            *(f32x4*)(P.out + (size_t)m * D + col) = o0; *(f32x4*)(P.out + (size_t)m * D + col + 4) = o1;
        }
#pragma unroll
        for (int k = 0; k < 2; ++k) { q[k] = nq[k]; nq[k] = nnq[k]; }
#pragma unroll
        for (int k = 0; k < 8; ++k) { e[k] = ne[k]; ne[k] = nne[k]; }
    }
#undef P9_LOAD
}

#ifndef REPEAT_PHASE
#define REPEAT_PHASE -1
#define REPEAT_N 0
#endif
#define RUN_PHASE(k, call) do { call; xcd_barrier(bar, P.wv); \
    if (REPEAT_PHASE == (k) && REPEAT_N >= 1) { call; xcd_barrier(bar, P.wv); } \
    if (REPEAT_PHASE == (k) && REPEAT_N >= 2) { call; xcd_barrier(bar, P.wv); } \
    if (REPEAT_PHASE == (k) && REPEAT_N >= 3) { call; xcd_barrier(bar, P.wv); } } while (0)

struct Args { const void* in[25]; float* out; unsigned char* ws; };

__device__ __forceinline__ void p1_gemm(LAS unsigned char* lds, const Ptrs& P, int G, int bx) { ProbIn pr; pr.xb = P.XB; pr.wt = P.WIN_T; pr.rs1 = P.RS1; pr.pos = P.positions; pr.proj = P.PROJ; pr.G = G; pr.c = bx; pg8::gemm_phase(lds, pr, P.wv); }
__device__ __forceinline__ void p2_seq(LAS unsigned char* lds, const Ptrs& P, int G, int bx) {
    for (int u = bx; u < BATCH * NCH; u += G) lru_unit<false>(lds, u / NCH, u % NCH, P.PROJ, P.conv_w, P.conv_b, P.WAF, P.lru_ba, P.lru_bx, P.lru_lam, P.lru_ng, P.LAP, P.LAH, nullptr, nullptr, nullptr, moe_conv(P), u * 8 * MOE_K0, P.wv);
    ret_kv_phase(lds, P.PROJ, P.KVT, G, bx, P.wv);
}
__device__ __forceinline__ void p4_lru(LAS unsigned char* lds, const Ptrs& P, int G, int bx) {
    for (int u = bx; u < BATCH * NCH; u += G) lru_unit<true>(lds, u / NCH, u % NCH, P.PROJ, P.conv_w, P.conv_b, P.WAF, P.lru_ba, P.lru_bx, P.lru_lam, P.lru_ng, nullptr, nullptr, P.CARRY, P.YCAT, P.RSL, moe_conv(P), MOE_PASS0_ITEMS + u * 8 * MOE_K1, P.wv);
}
__device__ __forceinline__ void p4_ret(LAS unsigned char* lds, const Ptrs& P, int G, int bx) {
    ret_out_phase(lds, P.PROJ, P.PREVT, P.ret_ng, P.ret_nb, P.YCAT, G, bx, P.wv);
}
__device__ __forceinline__ void p4_seq(LAS unsigned char* lds, const Ptrs& P, int G, int bx) {
    for (int u = bx; u < BATCH * NCH; u += G) lru_unit<true>(lds, u / NCH, u % NCH, P.PROJ, P.conv_w, P.conv_b, P.WAF, P.lru_ba, P.lru_bx, P.lru_lam, P.lru_ng, nullptr, nullptr, P.CARRY, P.YCAT, P.RSL, moe_conv(P), MOE_PASS0_ITEMS + u * 8 * MOE_K1, P.wv);
    ret_out_phase(lds, P.PROJ, P.PREVT, P.ret_ng, P.ret_nb, P.YCAT, G, bx, P.wv);
}
__device__ __forceinline__ void p5_gemm(LAS unsigned char* lds, const Ptrs& P, int G, int bx) { ProbOut pr; pr.ycat = P.YCAT; pr.wt = P.WOUT_T; pr.x = P.x; pr.rsl = P.RSL; pr.yb01 = P.YB01; pr.x8 = P.X8; pr.ssq = P.SSQ; pr.G = G; pr.c = bx; pg8::gemm_phase(lds, pr, P.wv); }
__device__ __forceinline__ void p7_gemm(LAS unsigned char* lds, const Ptrs& P, int G, int bx, int probe_mode = 0) {
    const MoeTabs tabs = moe_build_tabs(lds, P.ctl, P.wv);
    ProbUp pr; pr.probe_mode = probe_mode; pr.tabs = tabs; pr.x8 = P.X8; pr.wgu = P.WGU8; pr.list = P.LIST; pr.rs2s = P.RS2S; pr.bg = P.moe_bg; pr.bu = P.moe_bu; pr.act = P.ACT; pr.G = G; pr.c = bx;
    pg8::gemm_phase(lds, pr, P.wv);
}
__device__ __forceinline__ void p8_gemm(LAS unsigned char* lds, const Ptrs& P, int G, int bx) {
    const MoeTabs tabs = moe_build_tabs(lds, P.ctl, P.wv);
    ProbDown pr; pr.tabs = tabs; pr.act = P.ACT; pr.wd = P.WD8; pr.list = P.LIST; pr.gw = P.GW; pr.bd = P.moe_bd; pr.y8 = (unsigned char*)P.YB23; pr.G = G; pr.c = bx;
    pg8::gemm_phase(lds, pr, P.wv);
}

__global__ void __launch_bounds__(NTHREADS, 2) mega_fwd(Args args) {
#ifdef CPU_EMU
    unsigned char* lds_raw = emu::cur->blk->lds;
#else
    extern __shared__ __attribute__((aligned(16))) unsigned char lds_raw[];
#endif
    LAS unsigned char* lds = (LAS unsigned char*)lds_raw;
    volatile LAS unsigned* MISC = (volatile LAS unsigned*)(lds + MISC_OFF);
    const int G = gridDim.x, bx = blockIdx.x;
    unsigned char* ws = args.ws;
    Ptrs P;
    P.wv = __builtin_amdgcn_readfirstlane((int)(threadIdx.x >> 6));
    P.x = (const float*)args.in[0]; P.positions = (const int*)args.in[1]; P.attn_g = (const float*)args.in[2];
    P.w_in = (const float*)args.in[3]; P.conv_w = (const float*)args.in[4]; P.conv_b = (const float*)args.in[5];
    P.lru_wa = (const float*)args.in[6]; P.lru_ba = (const float*)args.in[7]; P.lru_wx = (const float*)args.in[8]; P.lru_bx = (const float*)args.in[9];
    P.lru_lam = (const float*)args.in[10]; P.lru_ng = (const float*)args.in[11]; P.ret_ng = (const float*)args.in[12]; P.ret_nb = (const float*)args.in[13];
    P.w_out = (const float*)args.in[14]; P.ffn_g = (const float*)args.in[15]; P.router_w = (const float*)args.in[16]; P.router_b = (const float*)args.in[17];
    P.moe_wg = (const float*)args.in[18]; P.moe_bg = (const float*)args.in[19]; P.moe_wu = (const float*)args.in[20]; P.moe_bu = (const float*)args.in[21];
    P.moe_wd = (const float*)args.in[22]; P.moe_bd = (const float*)args.in[23]; P.final_g = (const float*)args.in[24];
    P.ctl = (unsigned*)(ws + WS_CTL);
    P.RS1 = (float*)(ws + WS_RS1); P.RS2S = (float*)(ws + WS_RS2S); P.SSQ = (float*)(ws + WS_SSQ); P.GW = (float*)(ws + WS_GW);
    P.LIST = (unsigned*)(ws + WS_LIST); P.LAP = (float*)(ws + WS_LAP); P.LAH = (float*)(ws + WS_LAH); P.CARRY = (float*)(ws + WS_CARRY);
    P.WAF = (bf16_t*)(ws + WS_WAF); P.RSL = (float*)(ws + WS_RSL);
    P.WR_T = (bf16_t*)(ws + WS_WR); P.WIN_T = (bf16_t*)(ws + WS_WIN); P.WOUT_T = (bf16_t*)(ws + WS_WOUT); P.WGU8 = ws + WS_WGU; P.WD8 = ws + WS_WD; P.X8 = ws + WS_X8;
    P.PROJ = (bf16_t*)(ws + WS_PROJ); P.XB = (bf16_t*)(ws + WS_XB); P.YCAT = P.XB; P.ACT = ws + WS_ACT; P.YB23 = (bf16_t*)(ws + WS_YB23);
    P.KVT = (bf16_t*)((unsigned char*)args.out + DO_KVT); P.PREVT = (bf16_t*)((unsigned char*)args.out + DO_PREVT); P.YB01 = (bf16_t*)args.out; P.out = args.out;

    for (int u = (int)threadIdx.x; u < (LDS_BYTES - RING_BYTES) / 4; u += NTHREADS) ((LAS unsigned*)(lds + RING_BYTES))[u] = 0u;
    __syncthreads();
    const XcdBarrier bar = xcd_barrier_post(P.ctl + CW_BAR, MISC + 8, P.wv);

    if (REPEAT_PHASE == 100) { xcd_barrier(bar, P.wv); xcd_barrier(bar, P.wv); xcd_barrier(bar, P.wv); xcd_barrier(bar, P.wv); xcd_barrier(bar, P.wv); xcd_barrier(bar, P.wv); xcd_barrier(bar, P.wv); xcd_barrier(bar, P.wv); }
    RUN_PHASE(0, p0_prologue(lds, P, G, bx));
    RUN_PHASE(1, p1_gemm(lds, P, G, bx));
    RUN_PHASE(2, p2_seq(lds, P, G, bx));
    RUN_PHASE(3, p3_scans(P, G, bx));
    RUN_PHASE(4, p4_seq(lds, P, G, bx));
    if (REPEAT_PHASE == 41) { p4_lru(lds, P, G, bx); xcd_barrier(bar, P.wv); p4_lru(lds, P, G, bx); xcd_barrier(bar, P.wv); }
    if (REPEAT_PHASE == 42) { p4_ret(lds, P, G, bx); xcd_barrier(bar, P.wv); p4_ret(lds, P, G, bx); xcd_barrier(bar, P.wv); }
    RUN_PHASE(5, p5_gemm(lds, P, G, bx));
    RUN_PHASE(6, p6_router(lds, P, G, bx, bar));
    if (REPEAT_PHASE == 71) { p7_gemm(lds, P, G, bx, 1); xcd_barrier(bar, P.wv); }
    if (REPEAT_PHASE == 72) { p7_gemm(lds, P, G, bx, 2); xcd_barrier(bar, P.wv); }
    RUN_PHASE(7, p7_gemm(lds, P, G, bx));
    RUN_PHASE(8, p8_gemm(lds, P, G, bx));
    if (REPEAT_PHASE == 9) { Ptrs Q = P; Q.out = (float*)P.ACT; p9_final(Q, G, bx); xcd_barrier(bar, P.wv); }
    p9_final(P, G, bx);
}

extern "C" void kernel_launch(void* const* d_in, const int* in_sizes, int n_in, void* d_out, int out_size, void* d_ws, size_t ws_size, hipStream_t stream) {
    static int grid = 0;
    if (grid == 0) {
        if (n_in != 25 || out_size != T * D || ws_size < WS_END) { fprintf(stderr, "kernel_launch: unexpected shapes (n_in %d, out %d, ws %zu, need %zu)\n", n_in, out_size, ws_size, (size_t)WS_END); grid = -1; return; }
        int dev = 0, cus = 0;
        if (hipGetDevice(&dev) != hipSuccess || hipDeviceGetAttribute(&cus, hipDeviceAttributeMultiprocessorCount, dev) != hipSuccess) { fprintf(stderr, "kernel_launch: device query failed\n"); grid = -1; return; }
        if (hipFuncSetAttribute((const void*)mega_fwd, hipFuncAttributeMaxDynamicSharedMemorySize, LDS_BYTES) != hipSuccess) { fprintf(stderr, "kernel_launch: hipFuncSetAttribute failed\n"); grid = -1; return; }
        (void)hipGetLastError();
        if (cus < T / 128 || cus > 256) { fprintf(stderr, "kernel_launch: the router phase needs T/128 <= CUs <= 256 (have %d)\n", cus); grid = -1; return; }
        grid = cus;
    }
    if (grid < 0) return;
    (void)in_sizes;
    (void)hipMemsetAsync((char*)d_ws + WS_CTL, 0, CTL_ZERO_BYTES, stream);
    Args a{};
    for (int i = 0; i < 25; ++i) a.in[i] = d_in[i];
    a.out = (float*)d_out; a.ws = (unsigned char*)d_ws;
    hipLaunchKernelGGL(mega_fwd, dim3(grid), dim3(NTHREADS), LDS_BYTES, stream, a);
}
```

```cpp
#ifndef CPU_EMU
#include <hip/hip_runtime.h>
#include <cstdio>
#define LAS __attribute__((address_space(3)))
#define GAS __attribute__((address_space(1)))
#define ASM_VMCNT(n) asm volatile("s_waitcnt vmcnt(" #n ")" ::: "memory")
#define ASM_LGKMCNT(n) asm volatile("s_waitcnt lgkmcnt(" #n ")" ::: "memory")
#define WAVE_SYNC() do { asm volatile("s_waitcnt lgkmcnt(0)" ::: "memory"); __builtin_amdgcn_wave_barrier(); } while (0)
#define OPAQUE(x) asm volatile("" : "+v"(x))
__device__ __forceinline__ int lane_id_fresh() { int l; asm volatile("v_mbcnt_lo_u32_b32 %0, -1, 0\n\tv_mbcnt_hi_u32_b32 %0, -1, %0" : "=v"(l)); return l; }
#define LANE_ID() lane_id_fresh()
#define SHFLX_F(v, mask, lane) __builtin_bit_cast(float, __builtin_amdgcn_ds_bpermute((((lane) ^ (mask)) << 2), __builtin_bit_cast(int, (float)(v))))
#define SHFLX_I(v, mask, lane) __builtin_amdgcn_ds_bpermute((((lane) ^ (mask)) << 2), (int)(v))
#else
#define ASM_VMCNT(n) ((void)0)
#define ASM_LGKMCNT(n) ((void)0)
#define WAVE_SYNC() emu::wave_collective(nullptr, 0, nullptr, 0, [](emu::Wave&) {})
#define OPAQUE(x) ((void)0)
#define LANE_ID() ((int)emu::cur->lane)
#define SHFLX_F(v, mask, lane) __shfl_xor((float)(v), (mask))
#define SHFLX_I(v, mask, lane) __shfl_xor((int)(v), (mask))
#endif

typedef unsigned short bf16_t;
typedef float f32x4 __attribute__((ext_vector_type(4)));
typedef float f32x2 __attribute__((ext_vector_type(2)));
typedef unsigned u32x4 __attribute__((ext_vector_type(4)));
typedef unsigned u32x2 __attribute__((ext_vector_type(2)));
typedef short bf16x8 __attribute__((ext_vector_type(8)));
typedef short v4i16_t __attribute__((ext_vector_type(4)));
typedef int v8i32_t __attribute__((ext_vector_type(8)));

#ifdef CPU_EMU
constexpr int BATCH = CFG_BATCH, SEQ = CFG_SEQ, NEXP = CFG_NEXP;
#else
constexpr int BATCH = 4, SEQ = 8192, NEXP = 32;
#endif
constexpr int NWAVES = 8, NTHREADS = 512;
constexpr int T = BATCH * SEQ, D = 1024, DIN = 3072, NCH = SEQ / 128, NBH = BATCH * 4;
constexpr int TOPK = 4, NSLOT = T * TOPK;
constexpr float NORM_EPS = 1e-5f;
constexpr int MAXTILES = NSLOT / 256 + NEXP;

constexpr size_t MiB = 1u << 20;
constexpr size_t al256(size_t x) { return (x + 255) & ~(size_t)255; }
constexpr size_t WS_CTL = 0, CTL_ZERO_BYTES = 1 * MiB;
constexpr int CW_BAR = 4096, CW_CNT = 16384;
constexpr size_t WS_RS1 = 1 * MiB;
constexpr size_t WS_RS2 = WS_RS1 + al256((size_t)T * 4);
constexpr size_t WS_SSQ = WS_RS2 + al256((size_t)T * 4);
constexpr size_t WS_GW = WS_SSQ + al256((size_t)16 * T * 4);
constexpr size_t WS_LIST = WS_GW + al256((size_t)NEXP * T * 4);
constexpr size_t WS_RS2S = WS_LIST + al256((size_t)NEXP * T * 4);
constexpr size_t WS_LAP = WS_RS2S + al256((size_t)NEXP * T * 4);
constexpr size_t WS_LAH = WS_LAP + al256((size_t)BATCH * NCH * 512 * 4);
constexpr size_t WS_CARRY = WS_LAH + al256((size_t)BATCH * NCH * 512 * 4);
constexpr size_t WS_WR = WS_CARRY + al256((size_t)BATCH * NCH * 512 * 4);
constexpr size_t WS_WAF = WS_WR + al256((size_t)32 * D * 2);
constexpr size_t WS_RSL = WS_WAF + 2 * 65536;
constexpr size_t WS_WIN = (WS_RSL + al256((size_t)T * 4) + MiB - 1) / MiB * MiB;
constexpr size_t WS_WOUT = WS_WIN + (size_t)DIN * D * 2;
constexpr size_t WS_WGU = WS_WOUT + (size_t)D * D * 2;
constexpr size_t WS_WD = WS_WGU + (size_t)NEXP * 2048 * D;
constexpr size_t WS_X8 = WS_WD + (size_t)NEXP * D * D;
constexpr size_t WS_R1 = WS_X8 + (size_t)T * D;
constexpr size_t WS_PROJ = WS_R1;
constexpr size_t WS_XB = WS_R1 + (size_t)T * DIN * 2;
constexpr size_t WS_ACT = WS_R1;
constexpr size_t WS_YB23 = WS_ACT + (size_t)(NSLOT + 256) * D;
constexpr size_t WS_END = WS_YB23 + (size_t)T * 2 * D * 2;
static_assert(WS_XB + (size_t)T * D * 2 <= WS_END, "map");
constexpr size_t DO_KVT = 0, DO_PREVT = (size_t)T * 1024;
static_assert(2 * (size_t)T * 1024 <= (size_t)T * D * 4, "d_out scratch");

constexpr int RING_BYTES = 131072, MISC_OFF = RING_BYTES + 320, TAB_OFF = RING_BYTES + 1024, LDS_BYTES = 147456;
constexpr int TAB_CNT = TAB_OFF, TAB_EOFF = TAB_CNT + 4 * 64, TAB_TBASE = TAB_EOFF + 4 * 64, TAB_TILEE = TAB_TBASE + 4 * 80;
constexpr int META_OFF = RING_BYTES + 8192;
static_assert(NEXP <= 64 && TAB_TILEE + 2 * MAXTILES + 16 <= META_OFF && META_OFF + 8192 <= LDS_BYTES, "LDS tables");

__device__ __forceinline__ unsigned f2bf(float f) { unsigned u = __builtin_bit_cast(unsigned, f); return (u + 0x7fffu + ((u >> 16) & 1u)) >> 16; }
__device__ __forceinline__ unsigned pk2(float lo, float hi) {
#ifdef CPU_EMU
    return f2bf(lo) | (f2bf(hi) << 16);
#else
    unsigned r; asm volatile("v_cvt_pk_bf16_f32 %0, %1, %2" : "=v"(r) : "v"(lo), "v"(hi)); return r;
#endif
}
__device__ __forceinline__ unsigned pk2v(float lo, float hi) {
#ifdef CPU_EMU
    return f2bf(lo) | (f2bf(hi) << 16);
#else
    unsigned r; asm volatile("s_nop 7\n\ts_nop 7\n\tv_cvt_pk_bf16_f32 %0, %1, %2" : "=v"(r) : "v"(lo), "v"(hi)); return r;
#endif
}
#define unpk2_fp8(w, hi) __builtin_amdgcn_cvt_pk_f32_fp8((int)(w), hi)
__device__ __forceinline__ unsigned pk4_fp8(float a, float b, float c, float d) {
    int r = __builtin_amdgcn_cvt_pk_fp8_f32(a, b, 0, false); r = __builtin_amdgcn_cvt_pk_fp8_f32(c, d, r, true); return (unsigned)r;
}
__device__ __forceinline__ float bf2f(unsigned h) { return __builtin_bit_cast(float, h << 16); }
__device__ __forceinline__ float bflo(unsigned w) { return __builtin_bit_cast(float, w << 16); }
__device__ __forceinline__ float bfhi(unsigned w) { return __builtin_bit_cast(float, w & 0xffff0000u); }
__device__ __forceinline__ float fexp2(float x) { return __builtin_amdgcn_exp2f(x); }
__device__ __forceinline__ float frcp(float x) { return __builtin_amdgcn_rcpf(x); }
__device__ __forceinline__ float sigmoid_f(float x) { return frcp(1.0f + fexp2(-1.4426950408889634f * x)); }
__device__ __forceinline__ float gelu_tanh(float x) { const float u = 0.7978845608028654f * (x + 0.044715f * x * x * x); return x * frcp(1.0f + fexp2(-2.8853900817779268f * u)); }
__device__ __forceinline__ float silu_f(float x) { return x * sigmoid_f(x); }
__device__ __forceinline__ float wave_sum(float v, int lane) {
#pragma unroll
    for (int o = 1; o < 64; o <<= 1) v += SHFLX_F(v, o, lane);
    return v;
}

#define XB_TMO      128
#define XB_XCNT(j)  (256  + 64 * (j))
#define XB_XSUB(j)  (1280 + 64 * (j))
#define XB_XGEN(j)  (2304 + 64 * (j))
#define XB_TOP      3328
#define XB_TOPGEN   3392
#define XCD_BAR_WORDS 3456
#define XB_SPIN_CAP (1u << 20)
__device__ __forceinline__ unsigned xb_ld(unsigned* p)              { return __hip_atomic_load(p, __ATOMIC_RELAXED, __HIP_MEMORY_SCOPE_AGENT); }
__device__ __forceinline__ unsigned xb_add(unsigned* p, unsigned v) { return __hip_atomic_fetch_add(p, v, __ATOMIC_RELAXED, __HIP_MEMORY_SCOPE_AGENT); }
__device__ __forceinline__ unsigned xb_xcc_id() { return (unsigned)__builtin_amdgcn_s_getreg((3 << 11) | 20) & 0xFu; }
#define XB_SPIN(cond, bar) do { unsigned _sp = 0; while (cond) { __builtin_amdgcn_s_sleep(1); \
    if ((++_sp & 255u) == 0u) { if (xb_ld(&(bar)[XB_TMO])) break; if (_sp > XB_SPIN_CAP) { atomicAdd(&(bar)[XB_TMO], 1u); break; } } } } while (0)
struct XcdBarrier { unsigned* bar; unsigned x; volatile LAS unsigned* st; };
__device__ __forceinline__ XcdBarrier xcd_barrier_post(unsigned* bar, volatile LAS unsigned* st, int wv) {
    XcdBarrier b; b.bar = bar; b.x = xb_xcc_id(); b.st = st;
    if (wv == 0 && LANE_ID() == 0) (void)xb_add(&bar[XB_XCNT(b.x)], 1u);
    return b;
}
__device__ __forceinline__ void xcd_barrier_complete(unsigned* bar, unsigned x, unsigned& nloc, unsigned& nx) {
    const unsigned G = gridDim.x;
    unsigned sum, cnt, mine, sp = 0u;
    for (;;) {
        sum = 0u; cnt = 0u; mine = 0u;
#pragma unroll
        for (unsigned j = 0; j < 16; ++j) { const unsigned c = xb_ld(&bar[XB_XCNT(j)]); sum += c; cnt += (c > 0u) ? 1u : 0u; mine = (j == x) ? c : mine; }
        if (sum == G) break;
        __builtin_amdgcn_s_sleep(1);
        if ((++sp & 255u) == 0u) { if (xb_ld(&bar[XB_TMO])) break; if (sp > XB_SPIN_CAP) { atomicAdd(&bar[XB_TMO], 1u); break; } }
    }
    nloc = mine > 0u ? mine : 1u; nx = cnt > 0u ? cnt : 1u;
}
__device__ __forceinline__ void xcd_barrier(const XcdBarrier& b, int wv) {
    ASM_VMCNT(0);
    __syncthreads();
    if (wv == 0 && LANE_ID() == 0) {
        unsigned* bar = b.bar;
        __builtin_amdgcn_s_waitcnt(0);
        unsigned nloc = b.st[0], nx = b.st[1];
        if (nloc == 0u) { xcd_barrier_complete(bar, b.x, nloc, nx); b.st[0] = nloc; b.st[1] = nx; }
        const unsigned old = xb_add(&bar[XB_XSUB(b.x)], 1u);
        const unsigned gen = old / nloc;
        if (old + 1u == (gen + 1u) * nloc) {
            __builtin_amdgcn_fence(__ATOMIC_RELEASE, "agent");
            ASM_VMCNT(0);
            const unsigned og = xb_add(&bar[XB_TOP], 1u);
            const unsigned tg = og / nx;
            if (og + 1u == (tg + 1u) * nx) xb_add(&bar[XB_TOPGEN], 1u);
            else XB_SPIN(xb_ld(&bar[XB_TOPGEN]) == tg, bar);
            __builtin_amdgcn_fence(__ATOMIC_ACQUIRE, "agent");
            xb_add(&bar[XB_XGEN(b.x)], 1u);
            ASM_VMCNT(0);
        } else {
            XB_SPIN(xb_ld(&bar[XB_XGEN(b.x)]) == gen, bar);
            __builtin_amdgcn_fence(__ATOMIC_ACQUIRE, "agent");
            ASM_VMCNT(0);
        }
    }
    __syncthreads();
}

namespace pg8 {
constexpr int BM = 256, BK = 64, HALF = 128, HTB = HALF * BK * 2, STAGE_BYTES = 8 * HTB, NXCD = 8, WGM = 8;
__device__ __forceinline__ int lds_byte(int r, int c) { const int st = (r >> 4) * 2 + (c >> 5), rr = r & 15, cc = c & 31, ob = rr * 64 + cc * 2; return st * 1024 + (ob ^ (((ob >> 9) & 1) << 5)); }
__device__ __forceinline__ void stage_rc(int b, int& R, int& C) { const int st = b / 1024, sb = b % 1024, swz = sb ^ (((sb >> 9) & 1) << 5); R = (st >> 1) * 16 + swz / 64; C = (st & 1) * 32 + (swz % 64) / 2; }
__device__ __forceinline__ int lds_byte8(int r, int fq) { const int st = (r >> 4) * 2 + (fq >> 1), rr = r & 15, ob = rr * 64 + 32 * (fq & 1); return st * 1024 + (ob ^ (((ob >> 9) & 1) << 5)); }
__device__ __forceinline__ int perm32(int rho) { const int n = rho >> 4, i = rho & 15; return 8 * (i >> 2) + 4 * n + (i & 3); }
struct Unit { int pm, pn, e, pos0, nvalid, eoff; };
__device__ __forceinline__ f32x4 mma_fp8(u32x4 a0, u32x4 a1, u32x4 b0, u32x4 b1, f32x4 c) {
    typedef int i32x4 __attribute__((ext_vector_type(4)));
    const v8i32_t a = __builtin_shufflevector(__builtin_bit_cast(i32x4, a0), __builtin_bit_cast(i32x4, a1), 0, 1, 2, 3, 4, 5, 6, 7);
    const v8i32_t b = __builtin_shufflevector(__builtin_bit_cast(i32x4, b0), __builtin_bit_cast(i32x4, b1), 0, 1, 2, 3, 4, 5, 6, 7);
#ifdef CPU_EMU
    return __builtin_amdgcn_mfma_scale_f32_16x16x128_f8f6f4(a, b, c, 0, 0, 0, 0x7F7F7F7F, 0, 0x7F7F7F7F);
#else
    const int one = 0x7F7F7F7F;
    asm volatile("v_mfma_scale_f32_16x16x128_f8f6f4 %0, %1, %2, %0, %3, %3 op_sel_hi:[0,0,0]" : "+v"(c) : "v"(a), "v"(b), "v"(one));
    return c;
#endif
}
__device__ __forceinline__ bool static_order(int i, int G, int c, int nM, int nN, int& pm, int& pn) {
    const int nwg = nM * nN; const long L = (long)i * G + c; if (L >= nwg) return false;
    int wgid = (int)L; { const int q = nwg / NXCD, r = nwg % NXCD, xcd = wgid % NXCD, off = wgid / NXCD; wgid = (xcd < r ? xcd * (q + 1) : r * (q + 1) + (xcd - r) * q) + off; }
    const int nig = WGM * nN, gid = wgid / nig, fm = gid * WGM, gsz = (nM - fm) < WGM ? (nM - fm) : WGM;
    pm = fm + ((wgid % nig) % gsz); pn = (wgid % nig) / gsz; return true;
}

template <class P>
__device__ __forceinline__ void gemm_phase(LAS unsigned char* lds, const P& prob, int wv) {
    int tid_ = wv * 64 + LANE_ID(); OPAQUE(tid_);
    const int tid = tid_, wid = __builtin_amdgcn_readfirstlane(tid >> 6), lane = tid & 63, wr = wid >> 2, wc = wid & 3, fr = lane & 15, fq = lane >> 4;
    constexpr int ROWB = P::FP8 ? 1024 : 2048, NT = ROWB / 128, CH = 1024;
    unsigned voffA[2][2], nvoffA[2][2], voffB[2];
#pragma unroll
    for (int i = 0; i < 2; ++i) { int R, C; stage_rc(tid * 16 + i * 8192, R, C); const int Rb = (R & ~31) + perm32(R & 31);
        voffA[0][i] = (unsigned)(R * ROWB + C * 2); voffA[1][i] = voffA[0][i] + (unsigned)(HALF * ROWB); voffB[i] = (unsigned)(Rb * ROWB + C * 2);
        nvoffA[0][i] = voffA[0][i]; nvoffA[1][i] = voffA[1][i]; }
    const size_t kstep = (size_t)(BK * 2);
    const size_t hstep = (size_t)HALF * ROWB;
    const unsigned ldsw = (unsigned)wid * 1024u;
    const int aoff = lds_byte(wr * 64 + fr, fq * 8), boff = lds_byte(wc * 32 + fr, fq * 8);
#define PG8_SA(b, h) (((b) * 2 + (h)) * HTB)
#define PG8_SB(b, h) ((4 + (b) * 2 + (h)) * HTB)
#define PG8_STAGE(bufoff, gbase, voff) do { _Pragma("unroll") for (int _i = 0; _i < 2; ++_i) \
        __builtin_amdgcn_global_load_lds((const unsigned*)((const char*)(gbase) + (voff)[_i]), (LAS unsigned*)(lds + (bufoff) + ldsw + _i * 8192), 16, 0, 0); } while (0)
#define PG8_LDA(dst, b, h) do { _Pragma("unroll") for (int m = 0; m < 4; ++m) _Pragma("unroll") for (int k = 0; k < 2; ++k) dst[m][k] = *(const LAS u32x4*)(lds + PG8_SA(b, h) + aoff + m * 2048 + k * CH); } while (0)
#define PG8_LDB(dst, b, h) do { _Pragma("unroll") for (int n = 0; n < 2; ++n) _Pragma("unroll") for (int k = 0; k < 2; ++k) dst[n][k] = *(const LAS u32x4*)(lds + PG8_SB(b, h) + boff + n * 2048 + k * CH); } while (0)
#define PG8_MMA(ai, bj, At, Bt) do { __builtin_amdgcn_s_setprio(1); _Pragma("unroll") for (int m = 0; m < 4; ++m) _Pragma("unroll") for (int n = 0; n < 2; ++n) { \
        if constexpr (P::FP8) acc[ai][bj][m][n] = mma_fp8(Bt[n][0], Bt[n][1], At[m][0], At[m][1], acc[ai][bj][m][n]); \
        else { _Pragma("unroll") for (int k = 0; k < 2; ++k) acc[ai][bj][m][n] = __builtin_amdgcn_mfma_f32_16x16x32_bf16(__builtin_bit_cast(bf16x8, Bt[n][k]), __builtin_bit_cast(bf16x8, At[m][k]), acc[ai][bj][m][n], 0, 0, 0); } } \
        __builtin_amdgcn_s_setprio(0); } while (0)
#define PG8_BAR __builtin_amdgcn_s_barrier()
#define PG8_SCHED __builtin_amdgcn_sched_barrier(0)
    Unit cur, nxt; int ui = 0;
    if (!prob.next(0, cur)) return;
    f32x4 acc[2][2][4][2];
#pragma unroll
    for (int a = 0; a < 2; ++a)
#pragma unroll
        for (int b = 0; b < 2; ++b)
#pragma unroll
            for (int m = 0; m < 4; ++m)
#pragma unroll
                for (int n = 0; n < 2; ++n) acc[a][b][m][n] = (f32x4){0.f, 0.f, 0.f, 0.f};
    u32x4 At[4][2], B0[2][2], B1[2][2];
    const char* cA = prob.a_base(cur); const char* cB = prob.b_base(cur);
    if constexpr (P::GATHER) prob.a_offsets(cur, tid, voffA);
#define PG8_META(u, par) do { _Pragma("unroll") for (int _j = 0; _j < 2; ++_j) { const int _a = (wid >> 2) + 2 * _j; if (_a < P::NMETA) \
        __builtin_amdgcn_global_load_lds(prob.meta_ptr(u, _a, (wid & 3) * 64 + lane), (LAS unsigned*)(lds + META_OFF + (par) * 4096 + _a * 1024 + (wid & 3) * 256), 4, 0, 0); } } while (0)
    if constexpr (P::NMETA > 0) PG8_META(cur, 0);
    PG8_STAGE(PG8_SB(0, 0), cB, voffB); PG8_STAGE(PG8_SA(0, 0), cA, voffA[0]); PG8_STAGE(PG8_SB(0, 1), cB + hstep, voffB); PG8_STAGE(PG8_SA(0, 1), cA, voffA[1]);
    if (wr == 1) PG8_BAR;
    ASM_VMCNT(4); PG8_BAR;
    PG8_STAGE(PG8_SB(1, 0), cB + kstep, voffB); PG8_STAGE(PG8_SA(1, 0), cA + kstep, voffA[0]); PG8_STAGE(PG8_SB(1, 1), cB + hstep + kstep, voffB);
    ASM_VMCNT(6); PG8_BAR;
    for (;;) {
        const bool has_next = prob.next(ui + 1, nxt);
        const char* nA = has_next ? prob.a_base(nxt) : cA; const char* nB = has_next ? prob.b_base(nxt) : cB;
        for (int t = 0; t < NT; t += 2) {
            const bool last = (t == NT - 2);
            const char* a1 = cA + (size_t)(t + 1) * kstep;
            const char* a2 = last ? nA : cA + (size_t)(t + 2) * kstep; const char* b2 = last ? nB : cB + (size_t)(t + 2) * kstep;
            const char* a3 = a2 + kstep; const char* b3 = b2 + kstep;
            if constexpr (P::GATHER) { if (last && has_next) prob.a_offsets(nxt, tid, nvoffA); }
            unsigned va0[2], va1[2];
#pragma unroll
            for (int i = 0; i < 2; ++i) { va0[i] = (P::GATHER && last) ? nvoffA[0][i] : voffA[0][i]; va1[i] = (P::GATHER && last) ? nvoffA[1][i] : voffA[1][i]; }
            if constexpr (P::MIDK) { if (t == NT / 2) prob.midk(acc, cur, wr, fr, lds + META_OFF + (ui & 1) * 4096); }
            PG8_LDB(B0, 0, 0); PG8_SCHED; PG8_LDA(At, 0, 0); PG8_STAGE(PG8_SA(1, 1), a1, voffA[1]);
            ASM_LGKMCNT(8); ASM_VMCNT(10); PG8_BAR; ASM_LGKMCNT(0); PG8_MMA(0, 0, At, B0); PG8_BAR; PG8_SCHED;
            PG8_LDB(B1, 0, 1); PG8_STAGE(PG8_SB(0, 0), b2, voffB);
            ASM_VMCNT(10); PG8_BAR; ASM_LGKMCNT(0); PG8_MMA(0, 1, At, B1); PG8_BAR;
            PG8_LDA(At, 0, 1); PG8_STAGE(PG8_SA(0, 0), a2, va0);
            PG8_BAR; ASM_LGKMCNT(0); PG8_MMA(1, 0, At, B0); PG8_BAR; PG8_SCHED;
            PG8_STAGE(PG8_SB(0, 1), b2 + hstep, voffB);
            ASM_VMCNT(10); PG8_BAR; PG8_MMA(1, 1, At, B1); PG8_BAR;
            if constexpr (P::NMETA > 0) { if (t == 2 && has_next) PG8_META(nxt, (ui + 1) & 1); }
            PG8_LDB(B0, 1, 0); PG8_SCHED; PG8_LDA(At, 1, 0); PG8_STAGE(PG8_SA(0, 1), a2, va1);
            ASM_LGKMCNT(8); ASM_VMCNT(10); PG8_BAR; ASM_LGKMCNT(0); PG8_MMA(0, 0, At, B0); PG8_BAR; PG8_SCHED;
            PG8_LDB(B1, 1, 1); PG8_STAGE(PG8_SB(1, 0), b3, voffB);
            ASM_VMCNT(10); PG8_BAR; ASM_LGKMCNT(0); PG8_MMA(0, 1, At, B1); PG8_BAR;
            PG8_LDA(At, 1, 1); PG8_STAGE(PG8_SA(1, 0), a3, va0);
            PG8_BAR; ASM_LGKMCNT(0); PG8_MMA(1, 0, At, B0); PG8_BAR; PG8_SCHED;
            PG8_STAGE(PG8_SB(1, 1), b3 + hstep, voffB);
            ASM_VMCNT(10); PG8_BAR; PG8_MMA(1, 1, At, B1); PG8_BAR;
        }
        if (wr == 0) PG8_BAR;
        prob.epi(acc, cur, wr, wc, fr, fq, lds + META_OFF + (ui & 1) * 4096);
        if (!has_next) break;
#pragma unroll
        for (int a = 0; a < 2; ++a)
#pragma unroll
            for (int b = 0; b < 2; ++b)
#pragma unroll
                for (int m = 0; m < 4; ++m)
#pragma unroll
                    for (int n = 0; n < 2; ++n) acc[a][b][m][n] = (f32x4){0.f, 0.f, 0.f, 0.f};
        cur = nxt; cA = nA; cB = nB; ++ui;
        if constexpr (P::GATHER) {
#pragma unroll
            for (int h = 0; h < 2; ++h)
#pragma unroll
                for (int i = 0; i < 2; ++i) voffA[h][i] = nvoffA[h][i];
        }
        if (wr == 1) PG8_BAR;
    }
    ASM_VMCNT(0);
    PG8_BAR;
#undef PG8_META
#undef PG8_SA
#undef PG8_SB
#undef PG8_STAGE
#undef PG8_LDA
#undef PG8_LDB
#undef PG8_MMA
#undef PG8_BAR
#undef PG8_SCHED
}
}
using pg8::Unit;

constexpr float Y8_SCALE = 16.0f;
constexpr float LOG2_THETA_64 = 13.287712379549449f / 64.0f;
__device__ __forceinline__ float log2_gamma(int h) { return __builtin_log2f(1.0f - __builtin_exp2f(-5.0f - (float)h)); }

struct ProbIn {
    static constexpr bool GATHER = false, MIDK = false, FP8 = false; static constexpr int NMETA = 2;
    const bf16_t* xb; const bf16_t* wt; const float* rs1; const int* pos; bf16_t* proj; int G, c;
    __device__ __forceinline__ bool next(int i, Unit& u) const { u.e = 0; u.pos0 = 0; u.nvalid = 256; u.eoff = 0; return pg8::static_order(i, G, c, T / 256, DIN / 256, u.pm, u.pn); }
    __device__ __forceinline__ const char* a_base(const Unit& u) const { return (const char*)xb + (size_t)u.pm * 256 * D * 2; }
    __device__ __forceinline__ const char* b_base(const Unit& u) const { return (const char*)wt + (size_t)u.pn * 256 * D * 2; }
    __device__ __forceinline__ void a_offsets(const Unit&, int, unsigned (&)[2][2]) const {}
    __device__ __forceinline__ const unsigned* meta_ptr(const Unit& u, int a, int idx) const { return (a == 0 ? (const unsigned*)rs1 : (const unsigned*)pos) + u.pm * 256 + idx; }
    __device__ __forceinline__ void epi(const f32x4 (&acc)[2][2][4][2], const Unit& u, int wr, int wc, int fr, int fq, const LAS unsigned char* mbuf) const {
        const int seg = u.pn >> 1;
        float invf[4];
#pragma unroll
        for (int q = 0; q < 4; ++q) invf[q] = exp2f(-(float)(16 * wc + 4 * fq + q) * LOG2_THETA_64) * 0.15915494309189535f;
#pragma unroll
        for (int ai = 0; ai < 2; ++ai)
#pragma unroll
            for (int m = 0; m < 4; ++m) {
                const int rl = ai * 128 + wr * 64 + m * 16 + fr, row = u.pm * 256 + rl;
                const float rs = *(const LAS float*)(mbuf + rl * 4);
                float cs[4], sn[4];
                if (seg == 2 || seg == 3) {
                    const float p = (float)*(const LAS int*)(mbuf + 1024 + rl * 4);
#pragma unroll
                    for (int q = 0; q < 4; ++q) { float rev = p * invf[q]; rev = rev - floorf(rev); cs[q] = __builtin_amdgcn_cosf(rev); sn[q] = __builtin_amdgcn_sinf(rev); }
                }
#pragma unroll
                for (int bj = 0; bj < 2; ++bj) {
                    f32x4 v0 = acc[ai][bj][m][0] * rs, v1 = acc[ai][bj][m][1] * rs;
                    if (seg == 1) {
#pragma unroll
                        for (int j = 0; j < 4; ++j) { v0[j] = gelu_tanh(v0[j]); v1[j] = gelu_tanh(v1[j]); }
                    } else if (seg == 5) {
#pragma unroll
                        for (int j = 0; j < 4; ++j) { v0[j] = silu_f(v0[j]); v1[j] = silu_f(v1[j]); }
                    } else if (seg == 2 || seg == 3) {
                        const int head = 2 * (u.pn & 1) + bj;
                        const float e1 = (float)((row & 127) + 1) * log2_gamma(head);
                        const float f = (seg == 2) ? exp2f(e1) : exp2f(-e1) * 0.08838834764831845f;
                        f32x4 o0, o1;
                        o0[0] = (v0[0] * cs[0] - v0[1] * sn[0]) * f; o0[1] = (v0[1] * cs[0] + v0[0] * sn[0]) * f;
                        o0[2] = (v0[2] * cs[1] - v0[3] * sn[1]) * f; o0[3] = (v0[3] * cs[1] + v0[2] * sn[1]) * f;
                        o1[0] = (v1[0] * cs[2] - v1[1] * sn[2]) * f; o1[1] = (v1[1] * cs[2] + v1[0] * sn[2]) * f;
                        o1[2] = (v1[2] * cs[3] - v1[3] * sn[3]) * f; o1[3] = (v1[3] * cs[3] + v1[2] * sn[3]) * f;
                        v0 = o0; v1 = o1;
                    }
                    u32x4 w; w.x = pk2(v0[0], v0[1]); w.y = pk2(v0[2], v0[3]); w.z = pk2(v1[0], v1[1]); w.w = pk2(v1[2], v1[3]);
                    *(u32x4*)(proj + (size_t)row * DIN + u.pn * 256 + bj * 128 + wc * 32 + 8 * fq) = w;
                }
            }
    }
};

struct ProbOut {
    static constexpr bool GATHER = false, MIDK = true, FP8 = false; static constexpr int NMETA = 1;
    const bf16_t* ycat; const bf16_t* wt; const float* x; const float* rsl; bf16_t* yb01; unsigned char* x8; float* ssq; int G, c;
    __device__ __forceinline__ void midk(f32x4 (&acc)[2][2][4][2], const Unit&, int wr, int fr, const LAS unsigned char* mbuf) const {
#pragma unroll
        for (int ai = 0; ai < 2; ++ai)
#pragma unroll
            for (int m = 0; m < 4; ++m) { const float sc = *(const LAS float*)(mbuf + (ai * 128 + wr * 64 + m * 16 + fr) * 4);
#pragma unroll
                for (int bj = 0; bj < 2; ++bj)
#pragma unroll
                    for (int n = 0; n < 2; ++n) acc[ai][bj][m][n] *= sc; }
    }
    __device__ __forceinline__ bool next(int i, Unit& u) const { u.e = 0; u.pos0 = 0; u.nvalid = 256; u.eoff = 0; return pg8::static_order(i, G, c, T / 256, D / 256, u.pm, u.pn); }
    __device__ __forceinline__ const char* a_base(const Unit& u) const { return (const char*)ycat + (size_t)u.pm * 256 * D * 2; }
    __device__ __forceinline__ const char* b_base(const Unit& u) const { return (const char*)wt + (size_t)u.pn * 256 * D * 2; }
    __device__ __forceinline__ void a_offsets(const Unit&, int, unsigned (&)[2][2]) const {}
    __device__ __forceinline__ const unsigned* meta_ptr(const Unit& u, int, int idx) const { return (const unsigned*)rsl + u.pm * 256 + idx; }
    __device__ __forceinline__ void epi(const f32x4 (&acc)[2][2][4][2], const Unit& u, int wr, int wc, int fr, int fq, const LAS unsigned char*) const {
#pragma unroll
        for (int ai = 0; ai < 2; ++ai)
#pragma unroll
            for (int m = 0; m < 4; ++m) {
                const int row = u.pm * 256 + ai * 128 + wr * 64 + m * 16 + fr;
                float ss = 0.f;
#pragma unroll
                for (int bj = 0; bj < 2; ++bj) {
                    const int col = u.pn * 256 + bj * 128 + wc * 32 + 8 * fq;
                    const f32x4 x0 = *(const f32x4*)(x + (size_t)row * D + col), x1 = *(const f32x4*)(x + (size_t)row * D + col + 4);
                    const f32x4 v0 = acc[ai][bj][m][0] + x0, v1 = acc[ai][bj][m][1] + x1;
                    ss += (v0[0] * v0[0] + v0[1] * v0[1]) + (v0[2] * v0[2] + v0[3] * v0[3]) + (v1[0] * v1[0] + v1[1] * v1[1]) + (v1[2] * v1[2] + v1[3] * v1[3]);
                    u32x4 w; w.x = pk2(v0[0], v0[1]); w.y = pk2(v0[2], v0[3]); w.z = pk2(v1[0], v1[1]); w.w = pk2(v1[2], v1[3]);
                    *(u32x4*)(yb01 + (size_t)row * 2048 + col) = w;
                    u32x2 w8; w8.x = pk4_fp8(v0[0], v0[1], v0[2], v0[3]); w8.y = pk4_fp8(v1[0], v1[1], v1[2], v1[3]);
                    *(u32x2*)(x8 + (size_t)row * D + col) = w8;
                }
                ss += SHFLX_F(ss, 16, fr + 16 * fq); ss += SHFLX_F(ss, 32, fr + 16 * fq);
                if (fq == 0) ssq[(size_t)(u.pn * 4 + wc) * T + row] = ss;
            }
    }
};

struct MoeTabs {
    const LAS unsigned* cnt; const LAS unsigned* eoff; const LAS unsigned* tbase; const LAS unsigned short* tile_e; int ntiles;
    __device__ __forceinline__ bool next(int i, int G, int c, int nN, Unit& u) const {
        int pm, pn; if (!pg8::static_order(i, G, c, ntiles, nN, pm, pn)) return false;
        const int e = __builtin_amdgcn_readfirstlane((int)tile_e[pm]);
        const int tb = __builtin_amdgcn_readfirstlane((int)tbase[e]), ce = __builtin_amdgcn_readfirstlane((int)cnt[e]), eo = __builtin_amdgcn_readfirstlane((int)eoff[e]);
        u.pm = pm; u.pn = pn; u.e = e; u.pos0 = (pm - tb) * 256; u.nvalid = (ce - u.pos0) < 256 ? (ce - u.pos0) : 256; u.eoff = eo; return true;
    }
};
__device__ __forceinline__ MoeTabs moe_build_tabs(LAS unsigned char* lds, const unsigned* ctl, int wv) {
    LAS unsigned* cnt = (LAS unsigned*)(lds + TAB_CNT); LAS unsigned* eoff = (LAS unsigned*)(lds + TAB_EOFF); LAS unsigned* tbase = (LAS unsigned*)(lds + TAB_TBASE);
    LAS unsigned short* tile_e = (LAS unsigned short*)(lds + TAB_TILEE);
    __syncthreads();
    if (wv == 0 && LANE_ID() == 0) {
        unsigned eo = 0, tb = 0;
        for (int e = 0; e < NEXP; ++e) { const unsigned c = ctl[CW_CNT + 64 * e]; cnt[e] = c; eoff[e] = eo; tbase[e] = tb; const unsigned nt = (c + 255u) >> 8;
            for (unsigned t = 0; t < nt; ++t) tile_e[tb + t] = (unsigned short)e; eo += c; tb += nt; }
        tbase[NEXP] = tb;
    }
    __syncthreads();
    MoeTabs mt; mt.cnt = cnt; mt.eoff = eoff; mt.tbase = tbase; mt.tile_e = tile_e; mt.ntiles = __builtin_amdgcn_readfirstlane((int)tbase[NEXP]); return mt;
}

struct ProbUp {
    static constexpr bool GATHER = true, MIDK = false, FP8 = true; static constexpr int NMETA = 2;
    int probe_mode; MoeTabs tabs; const unsigned char* x8; const unsigned char* wgu; const unsigned* list; const float* rs2s; const float* bg; const float* bu; unsigned char* act; int G, c;
    __device__ __forceinline__ bool next(int i, Unit& u) const { return tabs.next(i, G, c, 8, u); }
    __device__ __forceinline__ const char* a_base(const Unit&) const { return (const char*)x8; }
    __device__ __forceinline__ const char* b_base(const Unit& u) const { return (const char*)wgu + ((size_t)u.e * 2048 + (size_t)u.pn * 256) * D; }
    __device__ __forceinline__ void a_offsets(const Unit& u, int tid, unsigned (&vo)[2][2]) const {
        int R[2], C[2];
#pragma unroll
        for (int i = 0; i < 2; ++i) pg8::stage_rc(tid * 16 + i * 8192, R[i], C[i]);
#pragma unroll
        for (int h = 0; h < 2; ++h)
#pragma unroll
            for (int i = 0; i < 2; ++i) { const int rl = h * 128 + R[i]; const int pos = u.pos0 + (rl < u.nvalid ? rl : 0);
                const unsigned slot = list[(size_t)u.e * T + pos]; vo[h][i] = (slot >> 2) * 1024u + (unsigned)C[i] * 2u; }
    }
    __device__ __forceinline__ const unsigned* meta_ptr(const Unit& u, int a, int idx) const {
        if (a == 0) return (const unsigned*)rs2s + (size_t)u.e * T + u.pos0 + idx;
        return (const unsigned*)(idx < 128 ? bg : bu) + (size_t)u.e * D + u.pn * 128 + (idx & 127);
    }
    __device__ __forceinline__ void epi(const f32x4 (&acc)[2][2][4][2], const Unit& u, int wr, int wc, int fr, int fq, const LAS unsigned char* mbuf) const {
        if (probe_mode == 1) return;
        const int col8 = u.pn * 128 + wc * 32 + 8 * fq;
        f32x4 bgv[2], buv[2];
#pragma unroll
        for (int n = 0; n < 2; ++n) { bgv[n] = *(const LAS f32x4*)(mbuf + 1024 + (wc * 32 + 8 * fq + 4 * n) * 4); buv[n] = *(const LAS f32x4*)(mbuf + 1536 + (wc * 32 + 8 * fq + 4 * n) * 4); }
        float rsv[2][4];
#pragma unroll
        for (int ai = 0; ai < 2; ++ai)
#pragma unroll
            for (int m = 0; m < 4; ++m) { const int rl = ai * 128 + wr * 64 + m * 16 + fr; rsv[ai][m] = *(const LAS float*)(mbuf + rl * 4) * (1.0f / 64.0f);
            }
#pragma unroll
        for (int ai = 0; ai < 2; ++ai)
#pragma unroll
            for (int m = 0; m < 4; ++m) {
                const int rl = ai * 128 + wr * 64 + m * 16 + fr;
                const float rs = rsv[ai][m];
                float o[8];
#pragma unroll
                for (int n = 0; n < 2; ++n)
#pragma unroll
                    for (int jp = 0; jp < 2; ++jp) {
                        const f32x2 ag = {acc[ai][0][m][n][2 * jp], acc[ai][0][m][n][2 * jp + 1]}, au = {acc[ai][1][m][n][2 * jp], acc[ai][1][m][n][2 * jp + 1]};
                        const f32x2 bg2 = {bgv[n][2 * jp], bgv[n][2 * jp + 1]}, bu2 = {buv[n][2 * jp], buv[n][2 * jp + 1]};
                        f32x2 g = ag * rs + bg2, up = au * rs + bu2;
                        g.x = fminf(g.x, 7.0f); g.y = fminf(g.y, 7.0f);
                        up.x = fminf(fmaxf(up.x, -7.0f), 7.0f); up.y = fminf(fmaxf(up.y, -7.0f), 7.0f);
                        const f32x2 z = g * (-1.702f * 1.4426950408889634f);
                        f32x2 e; e.x = fexp2(z.x); e.y = fexp2(z.y);
                        const f32x2 den = e + 1.0f;
                        f32x2 r; r.x = frcp(den.x); r.y = frcp(den.y);
                        const f32x2 res = (g * r) * (up + 1.0f);
                        o[4 * n + 2 * jp] = res.x; o[4 * n + 2 * jp + 1] = res.y;
                    }
                u32x2 w; w.x = pk4_fp8(o[0], o[1], o[2], o[3]); w.y = pk4_fp8(o[4], o[5], o[6], o[7]);
                if (rl < u.nvalid) *(u32x2*)(act + (size_t)(u.eoff + u.pos0 + rl) * D + col8) = w;
            }
    }
};

struct ProbDown {
    static constexpr bool GATHER = false, MIDK = false, FP8 = true; static constexpr int NMETA = 3;
    int probe_mode; MoeTabs tabs; const unsigned char* act; const unsigned char* wd; const unsigned* list; const float* gw; const float* bd; unsigned char* y8; int G, c;
    __device__ __forceinline__ bool next(int i, Unit& u) const { return tabs.next(i, G, c, 4, u); }
    __device__ __forceinline__ const char* a_base(const Unit& u) const { return (const char*)act + (size_t)(u.eoff + u.pos0) * D; }
    __device__ __forceinline__ const char* b_base(const Unit& u) const { return (const char*)wd + ((size_t)u.e * D + (size_t)u.pn * 256) * D; }
    __device__ __forceinline__ void a_offsets(const Unit&, int, unsigned (&)[2][2]) const {}
    __device__ __forceinline__ const unsigned* meta_ptr(const Unit& u, int a, int idx) const {
        if (a == 2) return (const unsigned*)bd + (size_t)u.e * D + u.pn * 256 + idx;
        return (a == 0 ? list : (const unsigned*)gw) + (size_t)u.e * T + u.pos0 + idx;
    }
    __device__ __forceinline__ void epi(const f32x4 (&acc)[2][2][4][2], const Unit& u, int wr, int wc, int fr, int fq, const LAS unsigned char* mbuf) const {
        if (probe_mode == 1) return;
        const int cofs = u.pn * 256 + wc * 32 + 8 * fq;
        f32x4 bdv[2][2];
#pragma unroll
        for (int bj = 0; bj < 2; ++bj) { bdv[bj][0] = *(const LAS f32x4*)(mbuf + 2048 + (bj * 128 + wc * 32 + 8 * fq) * 4); bdv[bj][1] = *(const LAS f32x4*)(mbuf + 2048 + (bj * 128 + wc * 32 + 8 * fq + 4) * 4); }
#pragma unroll
        for (int ai = 0; ai < 2; ++ai)
#pragma unroll
            for (int m = 0; m < 4; ++m) {
                const int rl = ai * 128 + wr * 64 + m * 16 + fr;
                const unsigned sl = *(const LAS unsigned*)(mbuf + rl * 4);
                const float g = *(const LAS float*)(mbuf + 1024 + rl * 4), s1 = g * (Y8_SCALE / 64.0f), s2 = g * Y8_SCALE;
                unsigned char* dst = y8 + (size_t)sl * D + cofs;
#pragma unroll
                for (int bj = 0; bj < 2; ++bj) {
                    const f32x4 v0 = acc[ai][bj][m][0] * s1 + bdv[bj][0] * s2, v1 = acc[ai][bj][m][1] * s1 + bdv[bj][1] * s2;
                    u32x2 w; w.x = pk4_fp8(v0[0], v0[1], v0[2], v0[3]); w.y = pk4_fp8(v1[0], v1[1], v1[2], v1[3]);
                    if (rl < u.nvalid) *(u32x2*)(dst + bj * 128) = w;
                }
            }
    }
};

struct P0Item { const float* W; const float* scale; void* WT; int N, mode, off, k0, n0, fp8; };
__device__ __forceinline__ int p0_dest(const P0Item& d, int n) {
    if (d.mode == 1) { const int seg = n >> 9; if (seg == 2 || seg == 3) { const int w = n & 511, head = w >> 7, dd = w & 127; return (seg << 9) + (head << 7) + 2 * (dd & 63) + (dd >> 6); } return n; }
    if (d.mode == 2) return d.off + 256 * (n >> 7) + (n & 127);
    return d.off + n;
}
constexpr int P0_I_IN = 16 * (DIN / 64), P0_I_OUT = 16 * (D / 64), P0_I_E = 16 * (D / 64), P0_NITEMS_ALL = P0_I_IN + P0_I_OUT + 3 * NEXP * P0_I_E;
__device__ __forceinline__ void p0_load(const P0Item& d, int lane, f32x4 (&v)[16], float& sc) {
#pragma unroll
    for (int i = 0; i < 16; ++i) v[i] = *(const f32x4*)(d.W + (size_t)(d.k0 + (lane >> 4) + 4 * i) * d.N + d.n0 + 4 * (lane & 15));
    sc = d.scale ? d.scale[d.k0 + lane] : 1.0f;
    if (d.fp8) sc *= 64.0f;
}
__device__ __forceinline__ void p0_process(const P0Item& d, int lane, const f32x4 (&v)[16], float sc, LAS unsigned char* scr) {
    LAS float* ssc = (LAS float*)(scr + 64 * 136);
    ssc[lane] = sc;
    WAVE_SYNC();
#pragma unroll
    for (int i = 0; i < 16; ++i) { const int kk = (lane >> 4) + 4 * i; const float f = ssc[kk];
        u32x2 o; o.x = pk2(v[i].x * f, v[i].y * f); o.y = pk2(v[i].z * f, v[i].w * f);
        *(LAS u32x2*)(scr + kk * 136 + 8 * (lane & 15)) = o; }
    WAVE_SYNC();
    const int q = (lane & 15) >> 2, p = lane & 3;
    if (d.fp8) {
#pragma unroll
        for (int st = 0; st < 4; ++st) {
            const int n16 = 16 * st; unsigned o[4];
#pragma unroll
            for (int hf = 0; hf < 2; ++hf) {
                const int kb8 = 2 * (lane >> 4) + hf;
                const v4i16_t lo = __builtin_amdgcn_ds_read_tr16_b64_v4i16((LAS v4i16_t*)(scr + (8 * kb8 + q) * 136 + (n16 + 4 * p) * 2));
                const v4i16_t hi = __builtin_amdgcn_ds_read_tr16_b64_v4i16((LAS v4i16_t*)(scr + (8 * kb8 + 4 + q) * 136 + (n16 + 4 * p) * 2));
                o[2 * hf] = pk4_fp8(bf2f((unsigned short)lo[0]), bf2f((unsigned short)lo[1]), bf2f((unsigned short)lo[2]), bf2f((unsigned short)lo[3]));
                o[2 * hf + 1] = pk4_fp8(bf2f((unsigned short)hi[0]), bf2f((unsigned short)hi[1]), bf2f((unsigned short)hi[2]), bf2f((unsigned short)hi[3]));
            }
            *(u32x4*)((unsigned char*)d.WT + (size_t)p0_dest(d, d.n0 + n16 + (lane & 15)) * D + d.k0 + 16 * (lane >> 4)) = (u32x4){o[0], o[1], o[2], o[3]};
        }
    } else {
#pragma unroll
    for (int st = 0; st < 8; ++st) {
        const int n16 = 16 * (st & 3), kb8 = (st >> 2) * 4 + (lane >> 4);
        const v4i16_t lo = __builtin_amdgcn_ds_read_tr16_b64_v4i16((LAS v4i16_t*)(scr + (8 * kb8 + q) * 136 + (n16 + 4 * p) * 2));
        const v4i16_t hi = __builtin_amdgcn_ds_read_tr16_b64_v4i16((LAS v4i16_t*)(scr + (8 * kb8 + 4 + q) * 136 + (n16 + 4 * p) * 2));
        u32x4 o; o.x = (unsigned)(unsigned short)lo[0] | ((unsigned)(unsigned short)lo[1] << 16); o.y = (unsigned)(unsigned short)lo[2] | ((unsigned)(unsigned short)lo[3] << 16);
        o.z = (unsigned)(unsigned short)hi[0] | ((unsigned)(unsigned short)hi[1] << 16); o.w = (unsigned)(unsigned short)hi[2] | ((unsigned)(unsigned short)hi[3] << 16);
        *(u32x4*)((bf16_t*)d.WT + (size_t)p0_dest(d, d.n0 + n16 + (lane & 15)) * D + d.k0 + 8 * kb8) = o;
    }
    }
    WAVE_SYNC();
}

#ifndef STREAM_FINAL
#define STREAM_FINAL 1
#endif
#define STREAM_IN_PASS(fin) ((fin) ? (STREAM_FINAL != 0) : true)
struct MoeConv { const float *wg, *wu, *wd, *ffn_g; unsigned char *wgu8, *wd8; };
constexpr int MOE_ITEMS = 3 * NEXP * P0_I_E, NLRU = BATCH * NCH;
constexpr int MOE_PER_WU = (MOE_ITEMS + NLRU * 8 - 1) / (NLRU * 8);
constexpr int MOE_K0 = MOE_PER_WU >= 12 ? 8 : (MOE_PER_WU * 2 + 2) / 3, MOE_K1_RAW = MOE_PER_WU - MOE_K0, MOE_K1 = MOE_K1_RAW < 0 ? 0 : (MOE_K1_RAW > 8 ? 8 : MOE_K1_RAW);
constexpr int MOE_PASS0_ITEMS = NLRU * 8 * MOE_K0, MOE_CAP = NLRU * 8 * (MOE_K0 + MOE_K1), MOE_STREAMED = MOE_ITEMS < MOE_CAP ? MOE_ITEMS : MOE_CAP;
constexpr int P0_NITEMS = P0_NITEMS_ALL - MOE_STREAMED;
__device__ __forceinline__ P0Item moe_item(const MoeConv& M, int it) {
    P0Item d; d.scale = nullptr; d.off = 0; d.mode = 0; d.fp8 = 1; d.N = D;
    const int e = it / (3 * P0_I_E), q = (it / P0_I_E) % 3, r = it % P0_I_E;
    if (q == 0) { d.W = M.wg + (size_t)e * D * D; d.scale = M.ffn_g; d.WT = M.wgu8; d.mode = 2; d.off = e * 2048; }
    else if (q == 1) { d.W = M.wu + (size_t)e * D * D; d.scale = M.ffn_g; d.WT = M.wgu8; d.mode = 2; d.off = e * 2048 + 128; }
    else { d.W = M.wd + (size_t)e * D * D; d.WT = M.wd8; d.off = e * D; }
    d.k0 = 64 * (r / (D / 64)); d.n0 = 64 * (r % (D / 64)); return d;
}

constexpr int RT_STRIDE = 272;
constexpr int LDS_VT = 0, LDS_KT = 128 * RT_STRIDE;
constexpr int XA_STRIDE = 144, XA_WAVE = 16 * XA_STRIDE;
constexpr int AG_STRIDE = 520, AG_WAVE = 16 * AG_STRIDE;
constexpr int LRU_WAVE = XA_WAVE + AG_WAVE;
constexpr int LDS_XA = 0, LDS_SS = 8 * LRU_WAVE, LDS_RSL = LDS_SS + 8 * 128 * 4;
static_assert(LRU_WAVE % 16 == 0 && LRU_WAVE >= 64 * 136 + 256, "LRU per-wave LDS block must hold one weight item");
static_assert(LDS_RSL + 512 <= RING_BYTES && LDS_KT + 128 * RT_STRIDE <= RING_BYTES, "LDS seq map");

__device__ __forceinline__ bf16x8 tr_frag(const LAS unsigned char* tile, int row0, int col0, int fr) {
    const int q = fr >> 2, p = fr & 3;
    const v4i16_t lo = __builtin_amdgcn_ds_read_tr16_b64_v4i16((LAS v4i16_t*)(tile + (row0 + q) * RT_STRIDE + (col0 + 4 * p) * 2));
    const v4i16_t hi = __builtin_amdgcn_ds_read_tr16_b64_v4i16((LAS v4i16_t*)(tile + (row0 + 4 + q) * RT_STRIDE + (col0 + 4 * p) * 2));
    bf16x8 r; r[0] = lo[0]; r[1] = lo[1]; r[2] = lo[2]; r[3] = lo[3]; r[4] = hi[0]; r[5] = hi[1]; r[6] = hi[2]; r[7] = hi[3]; return r;
}
__device__ __forceinline__ void stage_tile(LAS unsigned char* dst, const bf16_t* src, int tid) {
#pragma unroll
    for (int i = 0; i < 4; ++i) { const int p = tid + 512 * i, r = p >> 4, c = p & 15;
        const u32x4 v = *(const u32x4*)(src + (size_t)r * DIN + c * 8); *(LAS u32x4*)(dst + r * RT_STRIDE + c * 16) = v; }
}

template <bool FINAL>
__device__ __forceinline__ void lru_unit(LAS unsigned char* lds, int b, int n, const bf16_t* __restrict__ proj, const float* __restrict__ conv_w, const float* __restrict__ conv_b, const bf16_t* __restrict__ waf,
                                         const float* __restrict__ ba, const float* __restrict__ bx, const float* __restrict__ lam, const float* __restrict__ lru_ng,
                                         float* __restrict__ lap, float* __restrict__ lah, const float* __restrict__ carry, bf16_t* __restrict__ ycat, float* __restrict__ rsl_out, const MoeConv& MC, int item0, int wv) {
    int tid_ = wv * 64 + LANE_ID(); OPAQUE(tid_);
    const int tid = tid_, lane = tid & 63, w = __builtin_amdgcn_readfirstlane(tid >> 6), fr = lane & 15, fq = lane >> 4, c = tid;
    LAS unsigned char* xa = lds + LDS_XA + w * LRU_WAVE; LAS unsigned char* ag = xa + XA_WAVE;
    LAS float* ss = (LAS float*)(lds + LDS_SS);
    bf16x8 Ba[2][4], Bx[2][4];
#pragma unroll
    for (int ks = 0; ks < 2; ++ks)
#pragma unroll
        for (int nt = 0; nt < 4; ++nt) { const size_t fi = ((size_t)(w * 2 + ks) * 4 + nt) * 64 + lane; Ba[ks][nt] = *(const bf16x8*)(waf + fi * 8); Bx[ks][nt] = *(const bf16x8*)(waf + (fi + 4096) * 8); }
    float bav[4], bxv[4], spl[4];
#pragma unroll
    for (int nt = 0; nt < 4; ++nt) { const int co = w * 64 + 16 * nt + fr; bav[nt] = ba[co]; bxv[nt] = bx[co]; const float l = lam[co];
        spl[nt] = -8.0f * 1.4426950408889634f * (fmaxf(-l, 0.f) + log1pf(expf(-fabsf(l)))); }
    const float w0 = conv_w[c], w1 = conv_w[512 + c], w2 = conv_w[1024 + c], w3 = conv_w[1536 + c], cb = conv_b[c];
    const float gn = FINAL ? lru_ng[c] : 0.f;
    const size_t t0 = (size_t)b * SEQ + (size_t)n * 128;
    float xm3 = 0.f, xm2 = 0.f, xm1 = 0.f;
    if (n > 0) { xm3 = bf2f(proj[(t0 - 3) * DIN + c]); xm2 = bf2f(proj[(t0 - 2) * DIN + c]); xm1 = bf2f(proj[(t0 - 1) * DIN + c]); }
    float h = FINAL ? carry[((size_t)b * NCH + n) * 512 + c] : 0.f, P = 1.f;
    unsigned xr[16];
#pragma unroll
    for (int i = 0; i < 16; ++i) xr[i] = proj[(t0 + i) * DIN + c];
    for (int tt = 0; tt < 8; ++tt) {
        float xcv[16]; unsigned gr[16];
#pragma unroll
        for (int i = 0; i < 16; ++i) { xcv[i] = bf2f(xr[i]); gr[i] = FINAL ? (unsigned)proj[(t0 + tt * 16 + i) * DIN + 512 + c] : 0u; }
        if (tt < 7) {
#pragma unroll
            for (int i = 0; i < 16; ++i) xr[i] = proj[(t0 + (tt + 1) * 16 + i) * DIN + c];
        }
        constexpr int KP = FINAL ? MOE_K1 : MOE_K0;
        const int cit = item0 + (w * KP + tt);
        const bool chas = (tt < KP) && (cit < MOE_STREAMED);
        P0Item cd; f32x4 cv[16]; float csc = 1.f;
        if (chas) { cd = moe_item(MC, cit); p0_load(cd, lane, cv, csc); }
#pragma unroll
        for (int i = 0; i < 16; ++i) {
            const float x0 = xcv[i];
            const float xc = w0 * xm3 + w1 * xm2 + w2 * xm1 + w3 * x0 + cb;
            xm3 = xm2; xm2 = xm1; xm1 = x0; xcv[i] = xc;
            *(LAS bf16_t*)(xa + i * XA_STRIDE + lane * 2) = (bf16_t)f2bf(xc);
        }
        WAVE_SYNC();
        bf16x8 af[2];
#pragma unroll
        for (int ks = 0; ks < 2; ++ks) af[ks] = *(const LAS bf16x8*)(xa + fr * XA_STRIDE + (32 * ks + 8 * fq) * 2);
#pragma unroll
        for (int nt = 0; nt < 4; ++nt) {
            f32x4 ar = {0.f, 0.f, 0.f, 0.f}, ai = {0.f, 0.f, 0.f, 0.f};
#pragma unroll
            for (int ks = 0; ks < 2; ++ks) { ar = __builtin_amdgcn_mfma_f32_16x16x32_bf16(af[ks], Ba[ks][nt], ar, 0, 0, 0); ai = __builtin_amdgcn_mfma_f32_16x16x32_bf16(af[ks], Bx[ks][nt], ai, 0, 0, 0); }
#pragma unroll
            for (int r = 0; r < 4; ++r) {
                const float rr = sigmoid_f(ar[r] + bav[nt]), ii = sigmoid_f(ai[r] + bxv[nt]);
                const float a = fexp2(rr * spl[nt]);
                const float g = sqrtf(fmaxf(1.0f - a * a, 0.f)) * ii;
                *(LAS f32x2*)(ag + (4 * fq + r) * AG_STRIDE + (16 * nt + fr) * 8) = (f32x2){a, g};
            }
        }
        WAVE_SYNC();
        unsigned upk[8];
#pragma unroll
        for (int i = 0; i < 16; ++i) {
            const f32x2 v = *(const LAS f32x2*)(ag + i * AG_STRIDE + lane * 8);
            h = v.x * h + v.y * xcv[i];
            if (!FINAL) P *= v.x;
            if (FINAL) {
                const float u = h * bf2f(gr[i]);
                const unsigned ub = f2bf(u * gn);
                if (i & 1) upk[i >> 1] |= ub << 16; else upk[i >> 1] = ub;
                *(LAS float*)(ag + i * AG_STRIDE + lane * 8) = u;
            }
        }
        if (FINAL) {
            WAVE_SYNC();
            const int tk = lane & 15, qd = lane >> 4; float s = 0.f;
#pragma unroll
            for (int i = 0; i < 16; ++i) { const float u = *(const LAS float*)(ag + tk * AG_STRIDE + (16 * qd + i) * 8); s += u * u; }
            s += SHFLX_F(s, 16, lane); s += SHFLX_F(s, 32, lane);
            if (qd == 0) ss[w * 128 + tt * 16 + tk] = s;
        }
        WAVE_SYNC();
        if (chas) p0_process(cd, lane, cv, csc, xa);
        if (FINAL) {
#pragma unroll
            for (int i = 0; i < 16; ++i) ycat[(t0 + tt * 16 + i) * D + c] = (bf16_t)((i & 1) ? (upk[i >> 1] >> 16) : (upk[i >> 1] & 0xffffu));
        }
    }
    if (!FINAL) { lap[((size_t)b * NCH + n) * 512 + c] = P; lah[((size_t)b * NCH + n) * 512 + c] = h; }
    else {
        __syncthreads();
        if (tid < 128) { float tot = 0.f;
#pragma unroll
            for (int q = 0; q < 8; ++q) tot += ss[q * 128 + tid];
            rsl_out[t0 + tid] = 1.0f / sqrtf(tot * (1.0f / 512.0f) + NORM_EPS); }
    }
    __syncthreads();
}

__device__ __forceinline__ void ret_kv_load(u32x4 (&tk)[4], u32x4 (&tv)[4], int unit, const bf16_t* __restrict__ proj, int tid) {
    const int bh = unit / NCH, n = unit % NCH, b = bh >> 2, hh = bh & 3;
    const size_t t0 = (size_t)b * SEQ + (size_t)n * 128;
#pragma unroll
    for (int i = 0; i < 4; ++i) { const int p = tid + 512 * i, r = p >> 4, c = p & 15;
        tk[i] = *(const u32x4*)(proj + (t0 + r) * DIN + 1536 + hh * 128 + c * 8); tv[i] = *(const u32x4*)(proj + (t0 + r) * DIN + 2048 + hh * 128 + c * 8); }
}
__device__ __forceinline__ void ret_kv_stage(LAS unsigned char* lds, const u32x4 (&tk)[4], const u32x4 (&tv)[4], int tid) {
#pragma unroll
    for (int i = 0; i < 4; ++i) { const int p = tid + 512 * i, r = p >> 4, c = p & 15;
        *(LAS u32x4*)(lds + LDS_KT + r * RT_STRIDE + c * 16) = tk[i]; *(LAS u32x4*)(lds + LDS_VT + r * RT_STRIDE + c * 16) = tv[i]; }
}
__device__ __forceinline__ void ret_kv_phase(LAS unsigned char* lds, const bf16_t* __restrict__ proj, bf16_t* __restrict__ kvt, int G, int bx, int wv) {
    int tid_ = wv * 64 + LANE_ID(); OPAQUE(tid_);
    const int tid = tid_, lane = tid & 63, w = wv, fr = lane & 15, fq = lane >> 4;
    u32x4 tk[4], tv[4];
    int unit = bx;
    if (unit < NBH * NCH) { ret_kv_load(tk, tv, unit, proj, tid); ret_kv_stage(lds, tk, tv, tid); __syncthreads(); if (unit + G < NBH * NCH) ret_kv_load(tk, tv, unit + G, proj, tid); }
    for (; unit < NBH * NCH; unit += G) {
        f32x4 acc[8];
#pragma unroll
        for (int et = 0; et < 8; ++et) acc[et] = (f32x4){0.f, 0.f, 0.f, 0.f};
#pragma unroll
        for (int ks = 0; ks < 4; ++ks) {
            const bf16x8 af = tr_frag(lds + LDS_KT, 32 * ks + 8 * fq, 16 * w, fr);
#pragma unroll
            for (int et = 0; et < 8; ++et) { const bf16x8 bfv = tr_frag(lds + LDS_VT, 32 * ks + 8 * fq, 16 * et, fr);
                acc[et] = __builtin_amdgcn_mfma_f32_16x16x32_bf16(af, bfv, acc[et], 0, 0, 0); }
        }
        u32x2 o[8];
#pragma unroll
        for (int et = 0; et < 8; ++et) { o[et].x = pk2v(acc[et][0], acc[et][1]); o[et].y = pk2v(acc[et][2], acc[et][3]); }
        __syncthreads();
        if (unit + G < NBH * NCH) ret_kv_stage(lds, tk, tv, tid);
        bf16_t* out = kvt + (size_t)unit * 16384;
#pragma unroll
        for (int et = 0; et < 8; ++et) *(u32x2*)(out + (size_t)(16 * et + fr) * 128 + 16 * w + 4 * fq) = o[et];
        __syncthreads();
        if (unit + 2 * G < NBH * NCH) ret_kv_load(tk, tv, unit + 2 * G, proj, tid);
    }
}

__device__ __forceinline__ int swz_off(int row, int chunk) { return row * 256 + ((chunk ^ (row & 15)) << 4); }
constexpr int LDS_RV = 0, LDS_RK = 32768, LDS_RP = 65536, LDS_RPT = 98304;
__device__ __forceinline__ bf16x8 tr_frag_swz(const LAS unsigned char* tile, int row0, int col0, int fr) {
    const int q = fr >> 2, p = fr & 3, ch = (col0 >> 3) + (p >> 1), bo = (p & 1) * 8;
    const v4i16_t lo = __builtin_amdgcn_ds_read_tr16_b64_v4i16((LAS v4i16_t*)(tile + swz_off(row0 + q, ch) + bo));
    const v4i16_t hi = __builtin_amdgcn_ds_read_tr16_b64_v4i16((LAS v4i16_t*)(tile + swz_off(row0 + 4 + q, ch) + bo));
    bf16x8 r; r[0] = lo[0]; r[1] = lo[1]; r[2] = lo[2]; r[3] = lo[3]; r[4] = hi[0]; r[5] = hi[1]; r[6] = hi[2]; r[7] = hi[3]; return r;
}
struct RetRegs { u32x4 tv[4], tk[4], tp[4]; bf16x8 bq[4]; u32x2 sg[8]; };
__device__ __forceinline__ void ret_out_load(RetRegs& R, int unit, const bf16_t* __restrict__ proj, const bf16_t* __restrict__ prevt, int tid, int w, int fr, int fq) {
    const int bh = unit / NCH, n = unit % NCH, b = bh >> 2, hh = bh & 3;
    const size_t t0 = (size_t)b * SEQ + (size_t)n * 128;
#pragma unroll
    for (int i = 0; i < 4; ++i) { const int p = tid + 512 * i, r = p >> 4, c = p & 15;
        R.tv[i] = *(const u32x4*)(proj + (t0 + r) * DIN + 2048 + hh * 128 + c * 8);
        R.tk[i] = *(const u32x4*)(proj + (t0 + r) * DIN + 1536 + hh * 128 + c * 8);
        R.tp[i] = *(const u32x4*)(prevt + (size_t)unit * 16384 + r * 128 + c * 8); }
#pragma unroll
    for (int ks = 0; ks < 4; ++ks) R.bq[ks] = *(const bf16x8*)(proj + (t0 + 16 * w + fr) * DIN + 1024 + hh * 128 + 32 * ks + 8 * fq);
#pragma unroll
    for (int et = 0; et < 8; ++et) R.sg[et] = *(const u32x2*)(proj + (t0 + 16 * w + fr) * DIN + 2560 + hh * 128 + 16 * et + 4 * fq);
}
__device__ __forceinline__ void ret_out_phase(LAS unsigned char* lds, const bf16_t* __restrict__ proj, const bf16_t* __restrict__ prevt, const float* __restrict__ gng, const float* __restrict__ gnb, bf16_t* __restrict__ ycat, int G, int bx, int wv) {
    int tid_ = wv * 64 + LANE_ID(); OPAQUE(tid_);
    const int tid = tid_, lane = tid & 63, w = __builtin_amdgcn_readfirstlane(tid >> 6), fr = lane & 15, fq = lane >> 4;
    RetRegs R;
    int unit = bx;
    bf16x8 bq[4]; u32x2 sg[8];
    if (unit < NBH * NCH) {
        ret_out_load(R, unit, proj, prevt, tid, w, fr, fq);
#pragma unroll
        for (int i = 0; i < 4; ++i) { const int p = tid + 512 * i, r = p >> 4, c = p & 15, o = swz_off(r, c);
            *(LAS u32x4*)(lds + LDS_RV + o) = R.tv[i]; *(LAS u32x4*)(lds + LDS_RK + o) = R.tk[i]; *(LAS u32x4*)(lds + LDS_RP + o) = R.tp[i]; }
#pragma unroll
        for (int ks = 0; ks < 4; ++ks) bq[ks] = R.bq[ks];
#pragma unroll
        for (int et = 0; et < 8; ++et) sg[et] = R.sg[et];
        __syncthreads();
        if (unit + G < NBH * NCH) ret_out_load(R, unit + G, proj, prevt, tid, w, fr, fq);
    }
    for (; unit < NBH * NCH; unit += G) {
        const int bh = unit / NCH, n = unit % NCH, b = bh >> 2, hh = bh & 3;
        const size_t t0 = (size_t)b * SEQ + (size_t)n * 128;
        const int crow = 16 * w + fr;
#pragma unroll
        for (int mt = 0; mt < 8; ++mt) {
            if (mt <= w) {
                f32x4 sacc = {0.f, 0.f, 0.f, 0.f};
#pragma unroll
                for (int ks = 0; ks < 4; ++ks) { const bf16x8 ak = *(const LAS bf16x8*)(lds + LDS_RK + swz_off(16 * mt + fr, 4 * ks + fq));
                    sacc = __builtin_amdgcn_mfma_f32_16x16x32_bf16(ak, bq[ks], sacc, 0, 0, 0); }
                if (mt == w) {
#pragma unroll
                    for (int r = 0; r < 4; ++r) if (4 * fq + r > fr) sacc[r] = 0.f;
                }
                u32x2 o; o.x = pk2v(sacc[0], sacc[1]); o.y = pk2v(sacc[2], sacc[3]);
                *(LAS u32x2*)(lds + LDS_RPT + swz_off(crow, 2 * mt + (fq >> 1)) + (fq & 1) * 8) = o;
            } else if (mt == w + 1 && (mt & 1)) {
                *(LAS u32x2*)(lds + LDS_RPT + swz_off(crow, 2 * mt + (fq >> 1)) + (fq & 1) * 8) = (u32x2){0u, 0u};
            }
        }
        WAVE_SYNC();
        f32x4 acc[8];
#pragma unroll
        for (int et = 0; et < 8; ++et) acc[et] = (f32x4){0.f, 0.f, 0.f, 0.f};
        const int nks = (w + 2) >> 1;
#pragma unroll
        for (int ksm = 0; ksm < 4; ++ksm) {
            if (ksm < nks) {
                const bf16x8 bp = *(const LAS bf16x8*)(lds + LDS_RPT + swz_off(crow, 4 * ksm + fq));
#pragma unroll
                for (int et = 0; et < 8; ++et) { const bf16x8 av = tr_frag_swz(lds + LDS_RV, 32 * ksm + 8 * fq, 16 * et, fr);
                    acc[et] = __builtin_amdgcn_mfma_f32_16x16x32_bf16(av, bp, acc[et], 0, 0, 0); }
            }
        }
#pragma unroll
        for (int et = 0; et < 8; ++et)
#pragma unroll
            for (int ks = 0; ks < 4; ++ks) { const bf16x8 ap = *(const LAS bf16x8*)(lds + LDS_RP + swz_off(16 * et + fr, 4 * ks + fq));
                acc[et] = __builtin_amdgcn_mfma_f32_16x16x32_bf16(ap, bq[ks], acc[et], 0, 0, 0); }
        float s1 = 0.f;
#pragma unroll
        for (int et = 0; et < 8; ++et) s1 += (acc[et][0] + acc[et][1]) + (acc[et][2] + acc[et][3]);
        s1 += SHFLX_F(s1, 16, lane); s1 += SHFLX_F(s1, 32, lane);
        const float mu = s1 * (1.0f / 128.0f);
        float s2 = 0.f;
#pragma unroll
        for (int et = 0; et < 8; ++et)
#pragma unroll
            for (int r = 0; r < 4; ++r) { const float dlt = acc[et][r] - mu; s2 += dlt * dlt; }
        s2 += SHFLX_F(s2, 16, lane); s2 += SHFLX_F(s2, 32, lane);
        const float rstd = 1.0f / sqrtf(s2 * (1.0f / 128.0f) + NORM_EPS);
        const size_t t = t0 + 16 * w + fr;
        u32x2 yo[8];
#pragma unroll
        for (int et = 0; et < 8; ++et) {
            const int e0 = hh * 128 + 16 * et + 4 * fq;
            const f32x4 gv = *(const f32x4*)(gng + e0), bv = *(const f32x4*)(gnb + e0);
            const float y0 = ((acc[et][0] - mu) * rstd * gv[0] + bv[0]) * bflo(sg[et].x), y1 = ((acc[et][1] - mu) * rstd * gv[1] + bv[1]) * bfhi(sg[et].x);
            const float y2 = ((acc[et][2] - mu) * rstd * gv[2] + bv[2]) * bflo(sg[et].y), y3 = ((acc[et][3] - mu) * rstd * gv[3] + bv[3]) * bfhi(sg[et].y);
            yo[et].x = pk2v(y0, y1); yo[et].y = pk2v(y2, y3);
        }
        __syncthreads();
        const bool has_next = unit + G < NBH * NCH;
        if (has_next) {
#pragma unroll
            for (int i = 0; i < 4; ++i) { const int p = tid + 512 * i, r = p >> 4, c = p & 15, o = swz_off(r, c);
                *(LAS u32x4*)(lds + LDS_RV + o) = R.tv[i]; *(LAS u32x4*)(lds + LDS_RK + o) = R.tk[i]; *(LAS u32x4*)(lds + LDS_RP + o) = R.tp[i]; }
#pragma unroll
            for (int ks = 0; ks < 4; ++ks) bq[ks] = R.bq[ks];
#pragma unroll
            for (int et = 0; et < 8; ++et) sg[et] = R.sg[et];
        }
#pragma unroll
        for (int et = 0; et < 8; ++et) *(u32x2*)(ycat + t * D + 512 + hh * 128 + 16 * et + 4 * fq) = yo[et];
        __syncthreads();
        if (unit + 2 * G < NBH * NCH) ret_out_load(R, unit + 2 * G, proj, prevt, tid, w, fr, fq);
    }
}

struct Ptrs {
    const float *x, *attn_g, *w_in, *conv_w, *conv_b, *lru_wa, *lru_ba, *lru_wx, *lru_bx, *lru_lam, *lru_ng, *ret_ng, *ret_nb, *w_out, *ffn_g, *router_w, *router_b;
    const float *moe_wg, *moe_bg, *moe_wu, *moe_bu, *moe_wd, *moe_bd, *final_g; const int* positions;
    float *RS1, *RS2S, *SSQ, *GW, *LAP, *LAH, *CARRY, *out; unsigned *LIST, *ctl;
    bf16_t *WR_T, *WIN_T, *WOUT_T, *PROJ, *XB, *YCAT, *YB23, *KVT, *PREVT, *YB01, *WAF; float* RSL; unsigned char *WGU8, *WD8, *X8, *ACT; int wv;
};
__device__ __forceinline__ MoeConv moe_conv(const Ptrs& P) { MoeConv M; M.wg = P.moe_wg; M.wu = P.moe_wu; M.wd = P.moe_wd; M.ffn_g = P.ffn_g; M.wgu8 = P.WGU8; M.wd8 = P.WD8; return M; }
#define PHASE_IDS() int tid = P.wv * 64 + LANE_ID(); OPAQUE(tid); const int lane = tid & 63, wave = P.wv; const int gw = bx * NWAVES + wave, NGW = G * NWAVES; (void)lane; (void)gw; (void)NGW

__device__ __forceinline__ P0Item p0_decode(const Ptrs& P, int it) {
    P0Item d; d.scale = nullptr; d.off = 0; d.mode = 0; d.fp8 = 0; int r = it, nblk;
    if (r < P0_I_IN) { d.W = P.w_in; d.N = DIN; d.WT = P.WIN_T; d.mode = 1; }
    else if ((r -= P0_I_IN) < P0_I_OUT) { d.W = P.w_out; d.N = D; d.WT = P.WOUT_T; }
    else { r -= P0_I_OUT; r += MOE_STREAMED;
        const int e = r / (3 * P0_I_E), q = (r / P0_I_E) % 3; r = r % P0_I_E; d.N = D;
        d.fp8 = 1;
        if (q == 0) { d.W = P.moe_wg + (size_t)e * D * D; d.scale = P.ffn_g; d.WT = P.WGU8; d.mode = 2; d.off = e * 2048; }
        else if (q == 1) { d.W = P.moe_wu + (size_t)e * D * D; d.scale = P.ffn_g; d.WT = P.WGU8; d.mode = 2; d.off = e * 2048 + 128; }
        else { d.W = P.moe_wd + (size_t)e * D * D; d.WT = P.WD8; d.off = e * D; } }
    nblk = d.N / 64; d.k0 = 64 * (r / nblk); d.n0 = 64 * (r % nblk); return d;
}
__device__ __forceinline__ void p0_prologue(LAS unsigned char* lds, const Ptrs& P, int G, int bx) {
    PHASE_IDS();
    {
        f32x4 gv[4];
#pragma unroll
        for (int j = 0; j < 4; ++j) gv[j] = ((const f32x4*)P.attn_g)[lane + 64 * j];
        f32x4 v[4], nv[4];
        int m = gw;
        if (m < T) {
#pragma unroll
            for (int j = 0; j < 4; ++j) v[j] = ((const f32x4*)(P.x + (size_t)m * D))[lane + 64 * j];
        }
        for (; m < T; m += NGW) {
            const int mn = m + NGW;
            if (mn < T) {
#pragma unroll
                for (int j = 0; j < 4; ++j) nv[j] = ((const f32x4*)(P.x + (size_t)mn * D))[lane + 64 * j];
            }
            float s = 0.f;
#pragma unroll
            for (int j = 0; j < 4; ++j) s += (v[j].x * v[j].x + v[j].y * v[j].y) + (v[j].z * v[j].z + v[j].w * v[j].w);
            s = wave_sum(s, lane);
            if (lane == 0) P.RS1[m] = 1.0f / sqrtf(s * (1.0f / D) + NORM_EPS);
            u32x2* o8 = (u32x2*)(P.XB + (size_t)m * D) + lane;
#pragma unroll
            for (int j = 0; j < 4; ++j) { u32x2 o; o.x = pk2(v[j].x * gv[j].x, v[j].y * gv[j].y); o.y = pk2(v[j].z * gv[j].z, v[j].w * gv[j].w); o8[64 * j] = o; }
#pragma unroll
            for (int j = 0; j < 4; ++j) v[j] = nv[j];
        }
    }
    {
        LAS unsigned char* scr = lds + wave * 16384;
        f32x4 v[16], nv[16]; float sc = 1.f, nsc = 1.f;
        int it = gw;
        P0Item d, nd;
        if (it < P0_NITEMS) { d = p0_decode(P, it); p0_load(d, lane, v, sc); }
        for (; it < P0_NITEMS; it += NGW) {
            const int nit = it + NGW;
            if (nit < P0_NITEMS) { nd = p0_decode(P, nit); p0_load(nd, lane, nv, nsc); }
            p0_process(d, lane, v, sc, scr);
            d = nd; sc = nsc;
#pragma unroll
            for (int i = 0; i < 16; ++i) v[i] = nv[i];
        }
    }
    for (int i = bx * NTHREADS + tid; i < 32 * D; i += G * NTHREADS) { const int e = i / D, k = i % D; P.WR_T[i] = (bf16_t)((e < NEXP) ? f2bf(P.router_w[(size_t)k * NEXP + e] * P.ffn_g[k]) : 0u); }
    for (int i = bx * NTHREADS + tid; i < 2 * 8 * 2 * 4 * 64; i += G * NTHREADS) {
        const int ln = i & 63, nt = (i >> 6) & 3, ks = (i >> 8) & 1, h = (i >> 9) & 7, mat = i >> 12, fr = ln & 15, fq = ln >> 4;
        const float* w = mat ? P.lru_wx : P.lru_wa; unsigned pk[4];
#pragma unroll
        for (int j = 0; j < 4; ++j) { const size_t i0 = ((size_t)h * 64 + 32 * ks + 8 * fq + 2 * j) * 64 + 16 * nt + fr; pk[j] = pk2(w[i0], w[i0 + 64]); }
        *(u32x4*)(P.WAF + (size_t)i * 8) = (u32x4){pk[0], pk[1], pk[2], pk[3]};
    }
}

__device__ __forceinline__ void p3_scans(const Ptrs& P, int G, int bx) {
    PHASE_IDS();
    for (int i = bx * NTHREADS + tid; i < BATCH * 512; i += G * NTHREADS) { const int b = i / 512, c = i % 512; float st = 0.f;
        for (int n = 0; n < NCH; ++n) { const size_t o = ((size_t)b * NCH + n) * 512 + c; P.CARRY[o] = st; st = P.LAP[o] * st + P.LAH[o]; } }
    for (int i = bx * NTHREADS + tid; i < NBH * 8192; i += G * NTHREADS) {
        const int bh = i / 8192, rem = i % 8192, hh = bh & 3;
        const float lamb = exp2f(128.0f * log2_gamma(hh));
        float s0 = 0.f, s1 = 0.f;
        const unsigned* src = (const unsigned*)(P.KVT + (size_t)bh * NCH * 16384) + rem; unsigned* dst = (unsigned*)(P.PREVT + (size_t)bh * NCH * 16384) + rem;
        for (int n0 = 0; n0 < NCH; n0 += 64) {
            unsigned kv[64];
#pragma unroll
            for (int j = 0; j < 64; ++j) kv[j] = (n0 + j < NCH) ? src[(size_t)(n0 + j) * 8192] : 0u;
#pragma unroll
            for (int j = 0; j < 64; ++j) { if (n0 + j < NCH) { dst[(size_t)(n0 + j) * 8192] = pk2(s0, s1); s0 = lamb * (s0 + bflo(kv[j])); s1 = lamb * (s1 + bfhi(kv[j])); } }
        }
    }
}

constexpr int CW_HIST = 32768;
__device__ __forceinline__ void p6_router(LAS unsigned char* lds, const Ptrs& P, int G, int bx, const XcdBarrier& bar) {
    PHASE_IDS();
    LAS unsigned* hist = (LAS unsigned*)(lds + 0); LAS unsigned* base = (LAS unsigned*)(lds + 256); LAS unsigned* part = (LAS unsigned*)(lds + 512);
    const int fr = lane & 15, fq = lane >> 4;
    const bool act = bx < T / 128;
    if (tid < 64) hist[tid] = 0u;
    __syncthreads();
    const int tok = (act ? bx : 0) * 128 + wave * 16 + fr;
    f32x4 lg[2] = {{0.f, 0.f, 0.f, 0.f}, {0.f, 0.f, 0.f, 0.f}};
    for (int ks = 0; ks < 32; ++ks) {
        const bf16x8 bt = *(const bf16x8*)(P.YB01 + (size_t)tok * 2048 + 32 * ks + 8 * fq);
#pragma unroll
        for (int tt = 0; tt < 2; ++tt) { const bf16x8 aw = *(const bf16x8*)(P.WR_T + (size_t)(16 * tt + fr) * D + 32 * ks + 8 * fq);
            lg[tt] = __builtin_amdgcn_mfma_f32_16x16x32_bf16(aw, bt, lg[tt], 0, 0, 0); }
    }
    float tot = 0.f;
#pragma unroll
    for (int p = 0; p < 16; ++p) tot += P.SSQ[(size_t)p * T + tok];
    const float rs = 1.0f / sqrtf(tot * (1.0f / D) + NORM_EPS);
    float val[8];
#pragma unroll
    for (int tt = 0; tt < 2; ++tt)
#pragma unroll
        for (int r = 0; r < 4; ++r) { const int e = 16 * tt + 4 * fq + r; val[4 * tt + r] = (e < NEXP) ? (lg[tt][r] * rs + P.router_b[e < NEXP ? e : 0]) : -3.0e38f; }
    float tv[4]; int ti[4];
#pragma unroll
    for (int k = 0; k < 4; ++k) {
        float bv = -3.4e38f; int bi = 1 << 20;
#pragma unroll
        for (int q = 0; q < 8; ++q) { const int e = 16 * (q >> 2) + 4 * fq + (q & 3); if (val[q] > bv || (val[q] == bv && e < bi)) { bv = val[q]; bi = e; } }
#pragma unroll
        for (int o = 16; o <= 32; o <<= 1) { const float ov = SHFLX_F(bv, o, lane); const int oi = SHFLX_I(bi, o, lane); if (ov > bv || (ov == bv && oi < bi)) { bv = ov; bi = oi; } }
        tv[k] = bv; ti[k] = bi;
#pragma unroll
        for (int q = 0; q < 8; ++q) { const int e = 16 * (q >> 2) + 4 * fq + (q & 3); if (e == bi) val[q] = -3.4e38f; }
    }
    float ex[4], den = 0.f;
#pragma unroll
    for (int k = 0; k < 4; ++k) { ex[k] = expf(tv[k] - tv[0]); den += ex[k]; }
    unsigned lp[4] = {0u, 0u, 0u, 0u};
    if (act && fq == 0) {
#pragma unroll
        for (int k = 0; k < 4; ++k) lp[k] = __hip_atomic_fetch_add(&hist[ti[k]], 1u, __ATOMIC_RELAXED, __HIP_MEMORY_SCOPE_WORKGROUP);
    }
    __syncthreads();
    if (tid < 32) P.ctl[CW_HIST + bx * 32 + tid] = hist[tid];
    xcd_barrier(bar, P.wv);
    {
        const int e = tid & 31, pt = tid >> 5; unsigned sum = 0u;
#pragma unroll
        for (int i = 0; i < 16; ++i) { const int w = pt * 16 + i; const unsigned c = P.ctl[CW_HIST + (w < G ? w : 0) * 32 + e]; sum += (w < bx) ? c : 0u; }
        part[pt * 32 + e] = sum;
    }
    __syncthreads();
    if (tid < 32) { unsigned sum = 0u;
#pragma unroll
        for (int i = 0; i < 16; ++i) sum += part[i * 32 + tid];
        base[tid] = sum;
        if (bx == G - 1 && tid < NEXP) P.ctl[CW_CNT + 64 * tid] = sum + hist[tid]; }
    __syncthreads();
    if (act && fq == 0) {
#pragma unroll
        for (int k = 0; k < 4; ++k) { const size_t o = (size_t)ti[k] * T + base[ti[k]] + lp[k]; P.LIST[o] = (unsigned)tok * 4u + (unsigned)k; P.GW[o] = ex[k] / den; P.RS2S[o] = rs; }
    }
    __syncthreads();
}

__device__ __forceinline__ void p9_final(const Ptrs& P, int G, int bx) {
    PHASE_IDS();
    const unsigned char* Y8 = (const unsigned char*)P.YB23;
    u32x4 q[2], nq[2], nnq[2]; u32x2 e[8], ne[8], nne[8];
    int m = gw;
#define P9_LOAD(dq, de, row) do { _Pragma("unroll") for (int j = 0; j < 2; ++j) { const int col = (j * 64 + lane) * 8; \
        dq[j] = *(const u32x4*)(P.YB01 + (size_t)(row) * 2048 + col); \
        _Pragma("unroll") for (int k = 0; k < 4; ++k) de[4 * j + k] = *(const u32x2*)(Y8 + (size_t)(row) * 4096 + k * 1024 + col); } } while (0)
    if (m < T) P9_LOAD(q, e, m);
    if (m + NGW < T) P9_LOAD(nq, ne, m + NGW);
    f32x4 g0[2], g1[2];
#pragma unroll
    for (int j = 0; j < 2; ++j) { const int col = (j * 64 + lane) * 8; g0[j] = *(const f32x4*)(P.final_g + col); g1[j] = *(const f32x4*)(P.final_g + col + 4); }
    for (; m < T; m += NGW) {
        const int mn = m + 2 * NGW;
        if (mn < T) P9_LOAD(nnq, nne, mn);
        float v[2][8]; float s = 0.f;
#pragma unroll
        for (int j = 0; j < 2; ++j) {
            f32x2 t[4] = {{0.f, 0.f}, {0.f, 0.f}, {0.f, 0.f}, {0.f, 0.f}};
#pragma unroll
            for (int k = 0; k < 4; ++k) { const u32x2 w = e[4 * j + k]; t[0] += unpk2_fp8(w.x, false); t[1] += unpk2_fp8(w.x, true); t[2] += unpk2_fp8(w.y, false); t[3] += unpk2_fp8(w.y, true); }
            const u32x4 a = q[j];
            v[j][0] = bflo(a.x) + t[0].x * (1.0f / Y8_SCALE); v[j][1] = bfhi(a.x) + t[0].y * (1.0f / Y8_SCALE); v[j][2] = bflo(a.y) + t[1].x * (1.0f / Y8_SCALE); v[j][3] = bfhi(a.y) + t[1].y * (1.0f / Y8_SCALE);
            v[j][4] = bflo(a.z) + t[2].x * (1.0f / Y8_SCALE); v[j][5] = bfhi(a.z) + t[2].y * (1.0f / Y8_SCALE); v[j][6] = bflo(a.w) + t[3].x * (1.0f / Y8_SCALE); v[j][7] = bfhi(a.w) + t[3].y * (1.0f / Y8_SCALE);
#pragma unroll
            for (int k = 0; k < 8; ++k) s += v[j][k] * v[j][k];
        }
        s = wave_sum(s, lane);
        const float rs = 1.0f / sqrtf(s * (1.0f / D) + NORM_EPS);
#pragma unroll
        for (int j = 0; j < 2; ++j) {
            const int col = (j * 64 + lane) * 8;
            f32x4 o0, o1;
#pragma unroll
            for (int k = 0; k < 4; ++k) { o0[k] = v[j][k] * rs * g0[j][k]; o1[k] = v[j][4 + k] * rs * g1[j][k]; }
            *(f32x4*)(P.out + (size_t)m * D + col) = o0; *(f32x4*)(P.out + (size_t)m * D + col + 4) = o1;
        }
#pragma unroll
        for (int k = 0; k < 2; ++k) { q[k] = nq[k]; nq[k] = nnq[k]; }
#pragma unroll
        for (int k = 0; k < 8; ++k) { e[k] = ne[k]; ne[k] = nne[k]; }
    }
#undef P9_LOAD
}

#ifndef REPEAT_PHASE
#define REPEAT_PHASE -1
#define REPEAT_N 0
#endif
#define RUN_PHASE(k, call) do { call; xcd_barrier(bar, P.wv); \
    if (REPEAT_PHASE == (k) && REPEAT_N >= 1) { call; xcd_barrier(bar, P.wv); } \
    if (REPEAT_PHASE == (k) && REPEAT_N >= 2) { call; xcd_barrier(bar, P.wv); } \
    if (REPEAT_PHASE == (k) && REPEAT_N >= 3) { call; xcd_barrier(bar, P.wv); } } while (0)

struct Args { const void* in[25]; float* out; unsigned char* ws; };

__device__ __forceinline__ void p1_gemm(LAS unsigned char* lds, const Ptrs& P, int G, int bx) { ProbIn pr; pr.xb = P.XB; pr.wt = P.WIN_T; pr.rs1 = P.RS1; pr.pos = P.positions; pr.proj = P.PROJ; pr.G = G; pr.c = bx; pg8::gemm_phase(lds, pr, P.wv); }
__device__ __forceinline__ void p2_seq(LAS unsigned char* lds, const Ptrs& P, int G, int bx) {
    for (int u = bx; u < BATCH * NCH; u += G) lru_unit<false>(lds, u / NCH, u % NCH, P.PROJ, P.conv_w, P.conv_b, P.WAF, P.lru_ba, P.lru_bx, P.lru_lam, P.lru_ng, P.LAP, P.LAH, nullptr, nullptr, nullptr, moe_conv(P), u * 8 * MOE_K0, P.wv);
    ret_kv_phase(lds, P.PROJ, P.KVT, G, bx, P.wv);
}
__device__ __forceinline__ void p4_lru(LAS unsigned char* lds, const Ptrs& P, int G, int bx) {
    for (int u = bx; u < BATCH * NCH; u += G) lru_unit<true>(lds, u / NCH, u % NCH, P.PROJ, P.conv_w, P.conv_b, P.WAF, P.lru_ba, P.lru_bx, P.lru_lam, P.lru_ng, nullptr, nullptr, P.CARRY, P.YCAT, P.RSL, moe_conv(P), MOE_PASS0_ITEMS + u * 8 * MOE_K1, P.wv);
}
__device__ __forceinline__ void p4_ret(LAS unsigned char* lds, const Ptrs& P, int G, int bx) {
    ret_out_phase(lds, P.PROJ, P.PREVT, P.ret_ng, P.ret_nb, P.YCAT, G, bx, P.wv);
}
__device__ __forceinline__ void p4_seq(LAS unsigned char* lds, const Ptrs& P, int G, int bx) {
    for (int u = bx; u < BATCH * NCH; u += G) lru_unit<true>(lds, u / NCH, u % NCH, P.PROJ, P.conv_w, P.conv_b, P.WAF, P.lru_ba, P.lru_bx, P.lru_lam, P.lru_ng, nullptr, nullptr, P.CARRY, P.YCAT, P.RSL, moe_conv(P), MOE_PASS0_ITEMS + u * 8 * MOE_K1, P.wv);
    ret_out_phase(lds, P.PROJ, P.PREVT, P.ret_ng, P.ret_nb, P.YCAT, G, bx, P.wv);
}
__device__ __forceinline__ void p5_gemm(LAS unsigned char* lds, const Ptrs& P, int G, int bx) { ProbOut pr; pr.ycat = P.YCAT; pr.wt = P.WOUT_T; pr.x = P.x; pr.rsl = P.RSL; pr.yb01 = P.YB01; pr.x8 = P.X8; pr.ssq = P.SSQ; pr.G = G; pr.c = bx; pg8::gemm_phase(lds, pr, P.wv); }
__device__ __forceinline__ void p7_gemm(LAS unsigned char* lds, const Ptrs& P, int G, int bx, int probe_mode = 0) {
    const MoeTabs tabs = moe_build_tabs(lds, P.ctl, P.wv);
    ProbUp pr; pr.probe_mode = probe_mode; pr.tabs = tabs; pr.x8 = P.X8; pr.wgu = P.WGU8; pr.list = P.LIST; pr.rs2s = P.RS2S; pr.bg = P.moe_bg; pr.bu = P.moe_bu; pr.act = P.ACT; pr.G = G; pr.c = bx;
    pg8::gemm_phase(lds, pr, P.wv);
}
__device__ __forceinline__ void p8_gemm(LAS unsigned char* lds, const Ptrs& P, int G, int bx, int probe_mode = 0) {
    const MoeTabs tabs = moe_build_tabs(lds, P.ctl, P.wv);
    ProbDown pr; pr.probe_mode = probe_mode; pr.tabs = tabs; pr.act = P.ACT; pr.wd = P.WD8; pr.list = P.LIST; pr.gw = P.GW; pr.bd = P.moe_bd; pr.y8 = (unsigned char*)P.YB23; pr.G = G; pr.c = bx;
    pg8::gemm_phase(lds, pr, P.wv);
}

__global__ void __launch_bounds__(NTHREADS, 2) mega_fwd(Args args) {
#ifdef CPU_EMU
    unsigned char* lds_raw = emu::cur->blk->lds;
#else
    extern __shared__ __attribute__((aligned(16))) unsigned char lds_raw[];
#endif
    LAS unsigned char* lds = (LAS unsigned char*)lds_raw;
    volatile LAS unsigned* MISC = (volatile LAS unsigned*)(lds + MISC_OFF);
    const int G = gridDim.x, bx = blockIdx.x;
    unsigned char* ws = args.ws;
    Ptrs P;
    P.wv = __builtin_amdgcn_readfirstlane((int)(threadIdx.x >> 6));
    P.x = (const float*)args.in[0]; P.positions = (const int*)args.in[1]; P.attn_g = (const float*)args.in[2];
    P.w_in = (const float*)args.in[3]; P.conv_w = (const float*)args.in[4]; P.conv_b = (const float*)args.in[5];
    P.lru_wa = (const float*)args.in[6]; P.lru_ba = (const float*)args.in[7]; P.lru_wx = (const float*)args.in[8]; P.lru_bx = (const float*)args.in[9];
    P.lru_lam = (const float*)args.in[10]; P.lru_ng = (const float*)args.in[11]; P.ret_ng = (const float*)args.in[12]; P.ret_nb = (const float*)args.in[13];
    P.w_out = (const float*)args.in[14]; P.ffn_g = (const float*)args.in[15]; P.router_w = (const float*)args.in[16]; P.router_b = (const float*)args.in[17];
    P.moe_wg = (const float*)args.in[18]; P.moe_bg = (const float*)args.in[19]; P.moe_wu = (const float*)args.in[20]; P.moe_bu = (const float*)args.in[21];
    P.moe_wd = (const float*)args.in[22]; P.moe_bd = (const float*)args.in[23]; P.final_g = (const float*)args.in[24];
    P.ctl = (unsigned*)(ws + WS_CTL);
    P.RS1 = (float*)(ws + WS_RS1); P.RS2S = (float*)(ws + WS_RS2S); P.SSQ = (float*)(ws + WS_SSQ); P.GW = (float*)(ws + WS_GW);
    P.LIST = (unsigned*)(ws + WS_LIST); P.LAP = (float*)(ws + WS_LAP); P.LAH = (float*)(ws + WS_LAH); P.CARRY = (float*)(ws + WS_CARRY);
    P.WAF = (bf16_t*)(ws + WS_WAF); P.RSL = (float*)(ws + WS_RSL);
    P.WR_T = (bf16_t*)(ws + WS_WR); P.WIN_T = (bf16_t*)(ws + WS_WIN); P.WOUT_T = (bf16_t*)(ws + WS_WOUT); P.WGU8 = ws + WS_WGU; P.WD8 = ws + WS_WD; P.X8 = ws + WS_X8;
    P.PROJ = (bf16_t*)(ws + WS_PROJ); P.XB = (bf16_t*)(ws + WS_XB); P.YCAT = P.XB; P.ACT = ws + WS_ACT; P.YB23 = (bf16_t*)(ws + WS_YB23);
    P.KVT = (bf16_t*)((unsigned char*)args.out + DO_KVT); P.PREVT = (bf16_t*)((unsigned char*)args.out + DO_PREVT); P.YB01 = (bf16_t*)args.out; P.out = args.out;

    for (int u = (int)threadIdx.x; u < (LDS_BYTES - RING_BYTES) / 4; u += NTHREADS) ((LAS unsigned*)(lds + RING_BYTES))[u] = 0u;
    __syncthreads();
    const XcdBarrier bar = xcd_barrier_post(P.ctl + CW_BAR, MISC + 8, P.wv);

    if (REPEAT_PHASE == 100) { xcd_barrier(bar, P.wv); xcd_barrier(bar, P.wv); xcd_barrier(bar, P.wv); xcd_barrier(bar, P.wv); xcd_barrier(bar, P.wv); xcd_barrier(bar, P.wv); xcd_barrier(bar, P.wv); xcd_barrier(bar, P.wv); }
    RUN_PHASE(0, p0_prologue(lds, P, G, bx));
    RUN_PHASE(1, p1_gemm(lds, P, G, bx));
    RUN_PHASE(2, p2_seq(lds, P, G, bx));
    RUN_PHASE(3, p3_scans(P, G, bx));
    RUN_PHASE(4, p4_seq(lds, P, G, bx));
    if (REPEAT_PHASE == 41) { p4_lru(lds, P, G, bx); xcd_barrier(bar, P.wv); p4_lru(lds, P, G, bx); xcd_barrier(bar, P.wv); }
    if (REPEAT_PHASE == 42) { p4_ret(lds, P, G, bx); xcd_barrier(bar, P.wv); p4_ret(lds, P, G, bx); xcd_barrier(bar, P.wv); }
    RUN_PHASE(5, p5_gemm(lds, P, G, bx));
    RUN_PHASE(6, p6_router(lds, P, G, bx, bar));
    if (REPEAT_PHASE == 71) { p7_gemm(lds, P, G, bx, 1); xcd_barrier(bar, P.wv); p7_gemm(lds, P, G, bx, 1); xcd_barrier(bar, P.wv); }
    if (REPEAT_PHASE == 72) { p7_gemm(lds, P, G, bx, 2); xcd_barrier(bar, P.wv); }
#if REPEAT_PHASE == 200 || REPEAT_PHASE == 201
    {
        const unsigned long long t0 = __builtin_amdgcn_s_memtime(), r0 = __builtin_amdgcn_s_memrealtime();
        if (REPEAT_PHASE == 200) p7_gemm(lds, P, G, bx, 1); else p1_gemm(lds, P, G, bx);
        const unsigned long long t1 = __builtin_amdgcn_s_memtime(), r1 = __builtin_amdgcn_s_memrealtime();
        if (bx == 0) { const unsigned long long mhz = (t1 - t0) * 100ull / (r1 - r0); while (__builtin_amdgcn_s_memrealtime() - r1 < mhz * 10ull) __builtin_amdgcn_s_sleep(8); }
        xcd_barrier(bar, P.wv);
    }
#endif
    RUN_PHASE(7, p7_gemm(lds, P, G, bx));
    if (REPEAT_PHASE == 81) { p8_gemm(lds, P, G, bx, 1); xcd_barrier(bar, P.wv); p8_gemm(lds, P, G, bx, 1); xcd_barrier(bar, P.wv); }
    RUN_PHASE(8, p8_gemm(lds, P, G, bx));
    if (REPEAT_PHASE == 9) { Ptrs Q = P; Q.out = (float*)P.ACT; p9_final(Q, G, bx); xcd_barrier(bar, P.wv); }
    p9_final(P, G, bx);
}

extern "C" void kernel_launch(void* const* d_in, const int* in_sizes, int n_in, void* d_out, int out_size, void* d_ws, size_t ws_size, hipStream_t stream) {
    static int grid = 0;
    if (grid == 0) {
        if (n_in != 25 || out_size != T * D || ws_size < WS_END) { fprintf(stderr, "kernel_launch: unexpected shapes (n_in %d, out %d, ws %zu, need %zu)\n", n_in, out_size, ws_size, (size_t)WS_END); grid = -1; return; }
        int dev = 0, cus = 0;
        if (hipGetDevice(&dev) != hipSuccess || hipDeviceGetAttribute(&cus, hipDeviceAttributeMultiprocessorCount, dev) != hipSuccess) { fprintf(stderr, "kernel_launch: device query failed\n"); grid = -1; return; }
        if (hipFuncSetAttribute((const void*)mega_fwd, hipFuncAttributeMaxDynamicSharedMemorySize, LDS_BYTES) != hipSuccess) { fprintf(stderr, "kernel_launch: hipFuncSetAttribute failed\n"); grid = -1; return; }
        (void)hipGetLastError();
        if (cus < T / 128 || cus > 256) { fprintf(stderr, "kernel_launch: the router phase needs T/128 <= CUs <= 256 (have %d)\n", cus); grid = -1; return; }
        grid = cus;
    }
    if (grid < 0) return;
    (void)in_sizes;
    (void)hipMemsetAsync((char*)d_ws + WS_CTL, 0, CTL_ZERO_BYTES, stream);
    Args a{};
    for (int i = 0; i < 25; ++i) a.in[i] = d_in[i];
    a.out = (float*)d_out; a.ws = (unsigned char*)d_ws;
    hipLaunchKernelGGL(mega_fwd, dim3(grid), dim3(NTHREADS), LDS_BYTES, stream, a);
}
```

```cpp
#ifndef CPU_EMU
#include <hip/hip_runtime.h>
#include <cstdio>
#define LAS __attribute__((address_space(3)))
#define GAS __attribute__((address_space(1)))
#define ASM_VMCNT(n) asm volatile("s_waitcnt vmcnt(" #n ")" ::: "memory")
#define ASM_LGKMCNT(n) asm volatile("s_waitcnt lgkmcnt(" #n ")" ::: "memory")
#define WAVE_SYNC() do { asm volatile("s_waitcnt lgkmcnt(0)" ::: "memory"); __builtin_amdgcn_wave_barrier(); } while (0)
#define OPAQUE(x) asm volatile("" : "+v"(x))
__device__ __forceinline__ int lane_id_fresh() { int l; asm volatile("v_mbcnt_lo_u32_b32 %0, -1, 0\n\tv_mbcnt_hi_u32_b32 %0, -1, %0" : "=v"(l)); return l; }
#define LANE_ID() lane_id_fresh()
#define SHFLX_F(v, mask, lane) __builtin_bit_cast(float, __builtin_amdgcn_ds_bpermute((((lane) ^ (mask)) << 2), __builtin_bit_cast(int, (float)(v))))
#define SHFLX_I(v, mask, lane) __builtin_amdgcn_ds_bpermute((((lane) ^ (mask)) << 2), (int)(v))
#else
#define ASM_VMCNT(n) ((void)0)
#define ASM_LGKMCNT(n) ((void)0)
#define WAVE_SYNC() emu::wave_collective(nullptr, 0, nullptr, 0, [](emu::Wave&) {})
#define OPAQUE(x) ((void)0)
#define LANE_ID() ((int)emu::cur->lane)
#define SHFLX_F(v, mask, lane) __shfl_xor((float)(v), (mask))
#define SHFLX_I(v, mask, lane) __shfl_xor((int)(v), (mask))
#endif

typedef unsigned short bf16_t;
typedef float f32x4 __attribute__((ext_vector_type(4)));
typedef float f32x2 __attribute__((ext_vector_type(2)));
typedef unsigned u32x4 __attribute__((ext_vector_type(4)));
typedef unsigned u32x2 __attribute__((ext_vector_type(2)));
typedef short bf16x8 __attribute__((ext_vector_type(8)));
typedef short v4i16_t __attribute__((ext_vector_type(4)));
typedef int v8i32_t __attribute__((ext_vector_type(8)));

#ifdef CPU_EMU
constexpr int BATCH = CFG_BATCH, SEQ = CFG_SEQ, NEXP = CFG_NEXP;
#else
constexpr int BATCH = 4, SEQ = 8192, NEXP = 32;
#endif
constexpr int NWAVES = 8, NTHREADS = 512;
constexpr int T = BATCH * SEQ, D = 1024, DIN = 3072, NCH = SEQ / 128, NBH = BATCH * 4;
constexpr int TOPK = 4, NSLOT = T * TOPK;
constexpr float NORM_EPS = 1e-5f;
constexpr int MAXTILES = NSLOT / 256 + NEXP;

constexpr size_t MiB = 1u << 20;
constexpr size_t al256(size_t x) { return (x + 255) & ~(size_t)255; }
constexpr size_t WS_CTL = 0, CTL_ZERO_BYTES = 1 * MiB;
constexpr int CW_BAR = 4096, CW_CNT = 16384;
constexpr size_t WS_RS1 = 1 * MiB;
constexpr size_t WS_RS2 = WS_RS1 + al256((size_t)T * 4);
constexpr size_t WS_SSQ = WS_RS2 + al256((size_t)T * 4);
constexpr size_t WS_GW = WS_SSQ + al256((size_t)16 * T * 4);
constexpr size_t WS_LIST = WS_GW + al256((size_t)NEXP * T * 4);
constexpr size_t WS_RS2S = WS_LIST + al256((size_t)NEXP * T * 4);
constexpr size_t WS_LAP = WS_RS2S + al256((size_t)NEXP * T * 4);
constexpr size_t WS_LAH = WS_LAP + al256((size_t)BATCH * NCH * 512 * 4);
constexpr size_t WS_CARRY = WS_LAH + al256((size_t)BATCH * NCH * 512 * 4);
constexpr size_t WS_WR = WS_CARRY + al256((size_t)BATCH * NCH * 512 * 4);
constexpr size_t WS_WAF = WS_WR + al256((size_t)32 * D * 2);
constexpr size_t WS_RSL = WS_WAF + 2 * 65536;
constexpr size_t WS_WIN = (WS_RSL + al256((size_t)T * 4) + MiB - 1) / MiB * MiB;
constexpr size_t WS_WOUT = WS_WIN + (size_t)DIN * D * 2;
constexpr size_t WS_WGU = WS_WOUT + (size_t)D * D * 2;
constexpr size_t WS_WD = WS_WGU + (size_t)NEXP * 2048 * D;
constexpr size_t WS_X8 = WS_WD + (size_t)NEXP * D * D;
constexpr size_t WS_R1 = WS_X8 + (size_t)T * D;
constexpr size_t WS_PROJ = WS_R1;
constexpr size_t WS_XB = WS_R1 + (size_t)T * DIN * 2;
constexpr size_t WS_ACT = WS_R1;
constexpr size_t WS_YB23 = WS_ACT + (size_t)(NSLOT + 256) * D;
constexpr size_t WS_YCAT = WS_YB23 + (size_t)T * 2 * D * 2;
constexpr size_t WS_END = WS_YCAT + (size_t)T * D * 2;
static_assert(WS_XB + (size_t)T * D * 2 <= WS_END, "map");
constexpr size_t DO_KVT = 0, DO_PREVT = (size_t)T * 1024;
static_assert(2 * (size_t)T * 1024 <= (size_t)T * D * 4, "d_out scratch");

constexpr int RING_BYTES = 131072, MISC_OFF = RING_BYTES + 320, TAB_OFF = RING_BYTES + 1024, LDS_BYTES = 147456;
constexpr int TAB_CNT = TAB_OFF, TAB_EOFF = TAB_CNT + 4 * 64, TAB_TBASE = TAB_EOFF + 4 * 64, TAB_TILEE = TAB_TBASE + 4 * 80;
constexpr int META_OFF = RING_BYTES + 8192;
static_assert(NEXP <= 64 && TAB_TILEE + 2 * MAXTILES + 16 <= META_OFF && META_OFF + 8192 <= LDS_BYTES, "LDS tables");

__device__ __forceinline__ unsigned f2bf(float f) { unsigned u = __builtin_bit_cast(unsigned, f); return (u + 0x7fffu + ((u >> 16) & 1u)) >> 16; }
__device__ __forceinline__ unsigned pk2(float lo, float hi) {
#ifdef CPU_EMU
    return f2bf(lo) | (f2bf(hi) << 16);
#else
    unsigned r; asm volatile("v_cvt_pk_bf16_f32 %0, %1, %2" : "=v"(r) : "v"(lo), "v"(hi)); return r;
#endif
}
__device__ __forceinline__ unsigned pk2v(float lo, float hi) {
#ifdef CPU_EMU
    return f2bf(lo) | (f2bf(hi) << 16);
#else
    unsigned r; asm volatile("s_nop 7\n\ts_nop 7\n\tv_cvt_pk_bf16_f32 %0, %1, %2" : "=v"(r) : "v"(lo), "v"(hi)); return r;
#endif
}
#define unpk2_fp8(w, hi) __builtin_amdgcn_cvt_pk_f32_fp8((int)(w), hi)
__device__ __forceinline__ unsigned pk4_fp8(float a, float b, float c, float d) {
    int r = __builtin_amdgcn_cvt_pk_fp8_f32(a, b, 0, false); r = __builtin_amdgcn_cvt_pk_fp8_f32(c, d, r, true); return (unsigned)r;
}
__device__ __forceinline__ float bf2f(unsigned h) { return __builtin_bit_cast(float, h << 16); }
__device__ __forceinline__ float bflo(unsigned w) { return __builtin_bit_cast(float, w << 16); }
__device__ __forceinline__ float bfhi(unsigned w) { return __builtin_bit_cast(float, w & 0xffff0000u); }
__device__ __forceinline__ float fexp2(float x) { return __builtin_amdgcn_exp2f(x); }
__device__ __forceinline__ float frcp(float x) { return __builtin_amdgcn_rcpf(x); }
__device__ __forceinline__ float sigmoid_f(float x) { return frcp(1.0f + fexp2(-1.4426950408889634f * x)); }
__device__ __forceinline__ float gelu_tanh(float x) { const float u = 0.7978845608028654f * (x + 0.044715f * x * x * x); return x * frcp(1.0f + fexp2(-2.8853900817779268f * u)); }
__device__ __forceinline__ float silu_f(float x) { return x * sigmoid_f(x); }
__device__ __forceinline__ float wave_sum(float v, int lane) {
#pragma unroll
    for (int o = 1; o < 64; o <<= 1) v += SHFLX_F(v, o, lane);
    return v;
}

#define XB_TMO      128
#define XB_XCNT(j)  (256  + 64 * (j))
#define XB_XSUB(j)  (1280 + 64 * (j))
#define XB_XGEN(j)  (2304 + 64 * (j))
#define XB_TOP      3328
#define XB_TOPGEN   3392
#define XCD_BAR_WORDS 3456
#define XB_SPIN_CAP (1u << 20)
__device__ __forceinline__ unsigned xb_ld(unsigned* p)              { return __hip_atomic_load(p, __ATOMIC_RELAXED, __HIP_MEMORY_SCOPE_AGENT); }
__device__ __forceinline__ unsigned xb_add(unsigned* p, unsigned v) { return __hip_atomic_fetch_add(p, v, __ATOMIC_RELAXED, __HIP_MEMORY_SCOPE_AGENT); }
__device__ __forceinline__ unsigned xb_xcc_id() { return (unsigned)__builtin_amdgcn_s_getreg((3 << 11) | 20) & 0xFu; }
#define XB_SPIN(cond, bar) do { unsigned _sp = 0; while (cond) { __builtin_amdgcn_s_sleep(1); \
    if ((++_sp & 255u) == 0u) { if (xb_ld(&(bar)[XB_TMO])) break; if (_sp > XB_SPIN_CAP) { atomicAdd(&(bar)[XB_TMO], 1u); break; } } } } while (0)
struct XcdBarrier { unsigned* bar; unsigned x; volatile LAS unsigned* st; };
__device__ __forceinline__ XcdBarrier xcd_barrier_post(unsigned* bar, volatile LAS unsigned* st, int wv) {
    XcdBarrier b; b.bar = bar; b.x = xb_xcc_id(); b.st = st;
    if (wv == 0 && LANE_ID() == 0) (void)xb_add(&bar[XB_XCNT(b.x)], 1u);
    return b;
}
__device__ __forceinline__ void xcd_barrier_complete(unsigned* bar, unsigned x, unsigned& nloc, unsigned& nx) {
    const unsigned G = gridDim.x;
    unsigned sum, cnt, mine, sp = 0u;
    for (;;) {
        sum = 0u; cnt = 0u; mine = 0u;
#pragma unroll
        for (unsigned j = 0; j < 16; ++j) { const unsigned c = xb_ld(&bar[XB_XCNT(j)]); sum += c; cnt += (c > 0u) ? 1u : 0u; mine = (j == x) ? c : mine; }
        if (sum == G) break;
        __builtin_amdgcn_s_sleep(1);
        if ((++sp & 255u) == 0u) { if (xb_ld(&bar[XB_TMO])) break; if (sp > XB_SPIN_CAP) { atomicAdd(&bar[XB_TMO], 1u); break; } }
    }
    nloc = mine > 0u ? mine : 1u; nx = cnt > 0u ? cnt : 1u;
}
__device__ __forceinline__ void xcd_barrier(const XcdBarrier& b, int wv) {
    ASM_VMCNT(0);
    __syncthreads();
    if (wv == 0 && LANE_ID() == 0) {
        unsigned* bar = b.bar;
        __builtin_amdgcn_s_waitcnt(0);
        unsigned nloc = b.st[0], nx = b.st[1];
        if (nloc == 0u) { xcd_barrier_complete(bar, b.x, nloc, nx); b.st[0] = nloc; b.st[1] = nx; }
        const unsigned old = xb_add(&bar[XB_XSUB(b.x)], 1u);
        const unsigned gen = old / nloc;
        if (old + 1u == (gen + 1u) * nloc) {
            __builtin_amdgcn_fence(__ATOMIC_RELEASE, "agent");
            ASM_VMCNT(0);
            const unsigned og = xb_add(&bar[XB_TOP], 1u);
            const unsigned tg = og / nx;
            if (og + 1u == (tg + 1u) * nx) xb_add(&bar[XB_TOPGEN], 1u);
            else XB_SPIN(xb_ld(&bar[XB_TOPGEN]) == tg, bar);
            __builtin_amdgcn_fence(__ATOMIC_ACQUIRE, "agent");
            xb_add(&bar[XB_XGEN(b.x)], 1u);
            ASM_VMCNT(0);
        } else {
            XB_SPIN(xb_ld(&bar[XB_XGEN(b.x)]) == gen, bar);
            __builtin_amdgcn_fence(__ATOMIC_ACQUIRE, "agent");
            ASM_VMCNT(0);
        }
    }
    __syncthreads();
}

namespace pg8 {
constexpr int BM = 256, BK = 64, HALF = 128, HTB = HALF * BK * 2, STAGE_BYTES = 8 * HTB, NXCD = 8, WGM = 8;
__device__ __forceinline__ int lds_byte(int r, int c) { const int st = (r >> 4) * 2 + (c >> 5), rr = r & 15, cc = c & 31, ob = rr * 64 + cc * 2; return st * 1024 + (ob ^ (((ob >> 9) & 1) << 5)); }
__device__ __forceinline__ void stage_rc(int b, int& R, int& C) { const int st = b / 1024, sb = b % 1024, swz = sb ^ (((sb >> 9) & 1) << 5); R = (st >> 1) * 16 + swz / 64; C = (st & 1) * 32 + (swz % 64) / 2; }
__device__ __forceinline__ int lds_byte8(int r, int fq) { const int st = (r >> 4) * 2 + (fq >> 1), rr = r & 15, ob = rr * 64 + 32 * (fq & 1); return st * 1024 + (ob ^ (((ob >> 9) & 1) << 5)); }
__device__ __forceinline__ int perm32(int rho) { const int n = rho >> 4, i = rho & 15; return 8 * (i >> 2) + 4 * n + (i & 3); }
struct Unit { int pm, pn, e, pos0, nvalid, eoff; };
__device__ __forceinline__ f32x4 mma_fp8(u32x4 a0, u32x4 a1, u32x4 b0, u32x4 b1, f32x4 c) {
    typedef int i32x4 __attribute__((ext_vector_type(4)));
    const v8i32_t a = __builtin_shufflevector(__builtin_bit_cast(i32x4, a0), __builtin_bit_cast(i32x4, a1), 0, 1, 2, 3, 4, 5, 6, 7);
    const v8i32_t b = __builtin_shufflevector(__builtin_bit_cast(i32x4, b0), __builtin_bit_cast(i32x4, b1), 0, 1, 2, 3, 4, 5, 6, 7);
#ifdef CPU_EMU
    return __builtin_amdgcn_mfma_scale_f32_16x16x128_f8f6f4(a, b, c, 0, 0, 0, 0x7F7F7F7F, 0, 0x7F7F7F7F);
#else
    const int one = 0x7F7F7F7F;
    asm volatile("v_mfma_scale_f32_16x16x128_f8f6f4 %0, %1, %2, %0, %3, %3 op_sel_hi:[0,0,0]" : "+v"(c) : "v"(a), "v"(b), "v"(one));
    return c;
#endif
}
__device__ __forceinline__ bool static_order(int i, int G, int c, int nM, int nN, int& pm, int& pn) {
    const int nwg = nM * nN; const long L = (long)i * G + c; if (L >= nwg) return false;
    int wgid = (int)L; { const int q = nwg / NXCD, r = nwg % NXCD, xcd = wgid % NXCD, off = wgid / NXCD; wgid = (xcd < r ? xcd * (q + 1) : r * (q + 1) + (xcd - r) * q) + off; }
    const int nig = WGM * nN, gid = wgid / nig, fm = gid * WGM, gsz = (nM - fm) < WGM ? (nM - fm) : WGM;
    pm = fm + ((wgid % nig) % gsz); pn = (wgid % nig) / gsz; return true;
}

template <class P>
__device__ __forceinline__ void gemm_phase(LAS unsigned char* lds, const P& prob, int wv) {
    int tid_ = wv * 64 + LANE_ID(); OPAQUE(tid_);
    const int tid = tid_, wid = __builtin_amdgcn_readfirstlane(tid >> 6), lane = tid & 63, wr = wid >> 2, wc = wid & 3, fr = lane & 15, fq = lane >> 4;
    constexpr int ROWB = P::FP8 ? 1024 : 2048, NT = ROWB / 128, CH = 1024;
    unsigned voffA[2][2], nvoffA[2][2], voffB[2];
#pragma unroll
    for (int i = 0; i < 2; ++i) { int R, C; stage_rc(tid * 16 + i * 8192, R, C); const int Rb = (R & ~31) + perm32(R & 31);
        voffA[0][i] = (unsigned)(R * ROWB + C * 2); voffA[1][i] = voffA[0][i] + (unsigned)(HALF * ROWB); voffB[i] = (unsigned)(Rb * ROWB + C * 2);
        nvoffA[0][i] = voffA[0][i]; nvoffA[1][i] = voffA[1][i]; }
    const size_t kstep = (size_t)(BK * 2);
    const size_t hstep = (size_t)HALF * ROWB;
    const unsigned ldsw = (unsigned)wid * 1024u;
    const int aoff = lds_byte(wr * 64 + fr, fq * 8), boff = lds_byte(wc * 32 + fr, fq * 8);
#define PG8_SA(b, h) (((b) * 2 + (h)) * HTB)
#define PG8_SB(b, h) ((4 + (b) * 2 + (h)) * HTB)
#define PG8_STAGE(bufoff, gbase, voff) do { if constexpr (!(P::DIAG & 2)) _Pragma("unroll") for (int _i = 0; _i < 2; ++_i) \
        __builtin_amdgcn_global_load_lds((const unsigned*)((const char*)(gbase) + (voff)[_i]), (LAS unsigned*)(lds + (bufoff) + ldsw + _i * 8192), 16, 0, 0); } while (0)
#define PG8_LDA(dst, b, h) do { if constexpr (!(P::DIAG & 1)) _Pragma("unroll") for (int m = 0; m < 4; ++m) _Pragma("unroll") for (int k = 0; k < 2; ++k) dst[m][k] = *(const LAS u32x4*)(lds + PG8_SA(b, h) + aoff + m * 2048 + k * CH); } while (0)
#define PG8_LDB(dst, b, h) do { if constexpr (!(P::DIAG & 1)) _Pragma("unroll") for (int n = 0; n < 2; ++n) _Pragma("unroll") for (int k = 0; k < 2; ++k) dst[n][k] = *(const LAS u32x4*)(lds + PG8_SB(b, h) + boff + n * 2048 + k * CH); } while (0)
#define PG8_MMA(ai, bj, At, Bt) do { if constexpr (!(P::DIAG & 8)) { __builtin_amdgcn_s_setprio(1); _Pragma("unroll") for (int m = 0; m < 4; ++m) _Pragma("unroll") for (int n = 0; n < 2; ++n) { \
        if constexpr (P::FP8) acc[ai][bj][m][n] = mma_fp8(Bt[n][0], Bt[n][1], At[m][0], At[m][1], acc[ai][bj][m][n]); \
        else { _Pragma("unroll") for (int k = 0; k < 2; ++k) acc[ai][bj][m][n] = __builtin_amdgcn_mfma_f32_16x16x32_bf16(__builtin_bit_cast(bf16x8, Bt[n][k]), __builtin_bit_cast(bf16x8, At[m][k]), acc[ai][bj][m][n], 0, 0, 0); } } \
        __builtin_amdgcn_s_setprio(0); } } while (0)
#define PG8_BAR do { if constexpr (!(P::DIAG & 4)) __builtin_amdgcn_s_barrier(); } while (0)
#define PG8_SCHED __builtin_amdgcn_sched_barrier(0)
    Unit cur, nxt; int ui = 0;
    if (!prob.next(0, cur)) return;
    f32x4 acc[2][2][4][2];
#pragma unroll
    for (int a = 0; a < 2; ++a)
#pragma unroll
        for (int b = 0; b < 2; ++b)
#pragma unroll
            for (int m = 0; m < 4; ++m)
#pragma unroll
                for (int n = 0; n < 2; ++n) acc[a][b][m][n] = (f32x4){0.f, 0.f, 0.f, 0.f};
    u32x4 At[4][2] = {}, B0[2][2] = {}, B1[2][2] = {};
    const char* cA = prob.a_base(cur); const char* cB = prob.b_base(cur);
    if constexpr (P::GATHER) prob.a_offsets(cur, tid, voffA);
#define PG8_META(u, par) do { _Pragma("unroll") for (int _j = 0; _j < 2; ++_j) { const int _a = (wid >> 2) + 2 * _j; if (_a < P::NMETA) \
        __builtin_amdgcn_global_load_lds(prob.meta_ptr(u, _a, (wid & 3) * 64 + lane), (LAS unsigned*)(lds + META_OFF + (par) * 4096 + _a * 1024 + (wid & 3) * 256), 4, 0, 0); } } while (0)
    if constexpr (P::NMETA > 0) PG8_META(cur, 0);
    PG8_STAGE(PG8_SB(0, 0), cB, voffB); PG8_STAGE(PG8_SA(0, 0), cA, voffA[0]); PG8_STAGE(PG8_SB(0, 1), cB + hstep, voffB); PG8_STAGE(PG8_SA(0, 1), cA, voffA[1]);
    if (wr == 1) PG8_BAR;
    ASM_VMCNT(4); PG8_BAR;
    PG8_STAGE(PG8_SB(1, 0), cB + kstep, voffB); PG8_STAGE(PG8_SA(1, 0), cA + kstep, voffA[0]); PG8_STAGE(PG8_SB(1, 1), cB + hstep + kstep, voffB);
    ASM_VMCNT(6); PG8_BAR;
    for (;;) {
        const bool has_next = prob.next(ui + 1, nxt);
        const char* nA = has_next ? prob.a_base(nxt) : cA; const char* nB = has_next ? prob.b_base(nxt) : cB;
        for (int t = 0; t < NT; t += 2) {
            const bool last = (t == NT - 2);
            const char* a1 = cA + (size_t)(t + 1) * kstep;
            const char* a2 = last ? nA : cA + (size_t)(t + 2) * kstep; const char* b2 = last ? nB : cB + (size_t)(t + 2) * kstep;
            const char* a3 = a2 + kstep; const char* b3 = b2 + kstep;
            if constexpr (P::GATHER) { if (last && has_next) prob.a_offsets(nxt, tid, nvoffA); }
            unsigned va0[2], va1[2];
#pragma unroll
            for (int i = 0; i < 2; ++i) { va0[i] = (P::GATHER && last) ? nvoffA[0][i] : voffA[0][i]; va1[i] = (P::GATHER && last) ? nvoffA[1][i] : voffA[1][i]; }
            if constexpr (P::MIDK) { if (t == NT / 2) prob.midk(acc, cur, wr, fr, lds + META_OFF + (ui & 1) * 4096); }
            PG8_LDB(B0, 0, 0); PG8_SCHED; PG8_LDA(At, 0, 0); PG8_STAGE(PG8_SA(1, 1), a1, voffA[1]);
            ASM_LGKMCNT(8); ASM_VMCNT(10); PG8_BAR; ASM_LGKMCNT(0); PG8_MMA(0, 0, At, B0); PG8_BAR; PG8_SCHED;
            PG8_LDB(B1, 0, 1); PG8_STAGE(PG8_SB(0, 0), b2, voffB);
            ASM_VMCNT(10); PG8_BAR; ASM_LGKMCNT(0); PG8_MMA(0, 1, At, B1); PG8_BAR;
            PG8_LDA(At, 0, 1); PG8_STAGE(PG8_SA(0, 0), a2, va0);
            PG8_BAR; ASM_LGKMCNT(0); PG8_MMA(1, 0, At, B0); PG8_BAR; PG8_SCHED;
            PG8_STAGE(PG8_SB(0, 1), b2 + hstep, voffB);
            ASM_VMCNT(10); PG8_BAR; PG8_MMA(1, 1, At, B1); PG8_BAR;
            if constexpr (P::NMETA > 0) { if (t == 2 && has_next) PG8_META(nxt, (ui + 1) & 1); }
            PG8_LDB(B0, 1, 0); PG8_SCHED; PG8_LDA(At, 1, 0); PG8_STAGE(PG8_SA(0, 1), a2, va1);
            ASM_LGKMCNT(8); ASM_VMCNT(10); PG8_BAR; ASM_LGKMCNT(0); PG8_MMA(0, 0, At, B0); PG8_BAR; PG8_SCHED;
            PG8_LDB(B1, 1, 1); PG8_STAGE(PG8_SB(1, 0), b3, voffB);
            ASM_VMCNT(10); PG8_BAR; ASM_LGKMCNT(0); PG8_MMA(0, 1, At, B1); PG8_BAR;
            PG8_LDA(At, 1, 1); PG8_STAGE(PG8_SA(1, 0), a3, va0);
            PG8_BAR; ASM_LGKMCNT(0); PG8_MMA(1, 0, At, B0); PG8_BAR; PG8_SCHED;
            PG8_STAGE(PG8_SB(1, 1), b3 + hstep, voffB);
            ASM_VMCNT(10); PG8_BAR; PG8_MMA(1, 1, At, B1); PG8_BAR;
        }
        if (wr == 0) PG8_BAR;
        prob.epi(acc, cur, wr, wc, fr, fq, lds + META_OFF + (ui & 1) * 4096);
        if (!has_next) break;
#pragma unroll
        for (int a = 0; a < 2; ++a)
#pragma unroll
            for (int b = 0; b < 2; ++b)
#pragma unroll
                for (int m = 0; m < 4; ++m)
#pragma unroll
                    for (int n = 0; n < 2; ++n) acc[a][b][m][n] = (f32x4){0.f, 0.f, 0.f, 0.f};
        cur = nxt; cA = nA; cB = nB; ++ui;
        if constexpr (P::GATHER) {
#pragma unroll
            for (int h = 0; h < 2; ++h)
#pragma unroll
                for (int i = 0; i < 2; ++i) voffA[h][i] = nvoffA[h][i];
        }
        if (wr == 1) PG8_BAR;
    }
    ASM_VMCNT(0);
    PG8_BAR;
#undef PG8_META
#undef PG8_SA
#undef PG8_SB
#undef PG8_STAGE
#undef PG8_LDA
#undef PG8_LDB
#undef PG8_MMA
#undef PG8_BAR
#undef PG8_SCHED
}
}
using pg8::Unit;

constexpr float Y8_SCALE = 16.0f;
constexpr float LOG2_THETA_64 = 13.287712379549449f / 64.0f;
__device__ __forceinline__ float log2_gamma(int h) { return __builtin_log2f(1.0f - __builtin_exp2f(-5.0f - (float)h)); }

struct ProbIn {
    static constexpr int DIAG = 0;
    static constexpr bool GATHER = false, MIDK = false, FP8 = false; static constexpr int NMETA = 2;
    const bf16_t* xb; const bf16_t* wt; const float* rs1; const int* pos; bf16_t* proj; int G, c;
    __device__ __forceinline__ bool next(int i, Unit& u) const { u.e = 0; u.pos0 = 0; u.nvalid = 256; u.eoff = 0; return pg8::static_order(i, G, c, T / 256, DIN / 256, u.pm, u.pn); }
    __device__ __forceinline__ const char* a_base(const Unit& u) const { return (const char*)xb + (size_t)u.pm * 256 * D * 2; }
    __device__ __forceinline__ const char* b_base(const Unit& u) const { return (const char*)wt + (size_t)u.pn * 256 * D * 2; }
    __device__ __forceinline__ void a_offsets(const Unit&, int, unsigned (&)[2][2]) const {}
    __device__ __forceinline__ const unsigned* meta_ptr(const Unit& u, int a, int idx) const { return (a == 0 ? (const unsigned*)rs1 : (const unsigned*)pos) + u.pm * 256 + idx; }
    __device__ __forceinline__ void epi(const f32x4 (&acc)[2][2][4][2], const Unit& u, int wr, int wc, int fr, int fq, const LAS unsigned char* mbuf) const {
        const int seg = u.pn >> 1;
        float invf[4];
#pragma unroll
        for (int q = 0; q < 4; ++q) invf[q] = exp2f(-(float)(16 * wc + 4 * fq + q) * LOG2_THETA_64) * 0.15915494309189535f;
#pragma unroll
        for (int ai = 0; ai < 2; ++ai)
#pragma unroll
            for (int m = 0; m < 4; ++m) {
                const int rl = ai * 128 + wr * 64 + m * 16 + fr, row = u.pm * 256 + rl;
                const float rs = *(const LAS float*)(mbuf + rl * 4);
                float cs[4], sn[4];
                if (seg == 2 || seg == 3) {
                    const float p = (float)*(const LAS int*)(mbuf + 1024 + rl * 4);
#pragma unroll
                    for (int q = 0; q < 4; ++q) { float rev = p * invf[q]; rev = rev - floorf(rev); cs[q] = __builtin_amdgcn_cosf(rev); sn[q] = __builtin_amdgcn_sinf(rev); }
                }
#pragma unroll
                for (int bj = 0; bj < 2; ++bj) {
                    f32x4 v0 = acc[ai][bj][m][0] * rs, v1 = acc[ai][bj][m][1] * rs;
                    if (seg == 1) {
#pragma unroll
                        for (int j = 0; j < 4; ++j) { v0[j] = gelu_tanh(v0[j]); v1[j] = gelu_tanh(v1[j]); }
                    } else if (seg == 5) {
#pragma unroll
                        for (int j = 0; j < 4; ++j) { v0[j] = silu_f(v0[j]); v1[j] = silu_f(v1[j]); }
                    } else if (seg == 2 || seg == 3) {
                        const int head = 2 * (u.pn & 1) + bj;
                        const float e1 = (float)((row & 127) + 1) * log2_gamma(head);
                        const float f = (seg == 2) ? exp2f(e1) : exp2f(-e1) * 0.08838834764831845f;
                        f32x4 o0, o1;
                        o0[0] = (v0[0] * cs[0] - v0[1] * sn[0]) * f; o0[1] = (v0[1] * cs[0] + v0[0] * sn[0]) * f;
                        o0[2] = (v0[2] * cs[1] - v0[3] * sn[1]) * f; o0[3] = (v0[3] * cs[1] + v0[2] * sn[1]) * f;
                        o1[0] = (v1[0] * cs[2] - v1[1] * sn[2]) * f; o1[1] = (v1[1] * cs[2] + v1[0] * sn[2]) * f;
                        o1[2] = (v1[2] * cs[3] - v1[3] * sn[3]) * f; o1[3] = (v1[3] * cs[3] + v1[2] * sn[3]) * f;
                        v0 = o0; v1 = o1;
                    }
                    u32x4 w; w.x = pk2(v0[0], v0[1]); w.y = pk2(v0[2], v0[3]); w.z = pk2(v1[0], v1[1]); w.w = pk2(v1[2], v1[3]);
                    *(u32x4*)(proj + (size_t)row * DIN + u.pn * 256 + bj * 128 + wc * 32 + 8 * fq) = w;
                }
            }
    }
};

struct ProbOut {
    static constexpr int DIAG = 0;
    static constexpr bool GATHER = false, MIDK = true, FP8 = false; static constexpr int NMETA = 1;
    const bf16_t* ycat; const bf16_t* wt; const bf16_t* xb; const float* rsl; bf16_t* yb01; unsigned char* x8; float* ssq; int G, c;
    __device__ __forceinline__ void midk(f32x4 (&acc)[2][2][4][2], const Unit&, int wr, int fr, const LAS unsigned char* mbuf) const {
#pragma unroll
        for (int ai = 0; ai < 2; ++ai)
#pragma unroll
            for (int m = 0; m < 4; ++m) { const float sc = *(const LAS float*)(mbuf + (ai * 128 + wr * 64 + m * 16 + fr) * 4);
#pragma unroll
                for (int bj = 0; bj < 2; ++bj)
#pragma unroll
                    for (int n = 0; n < 2; ++n) acc[ai][bj][m][n] *= sc; }
    }
    __device__ __forceinline__ bool next(int i, Unit& u) const { u.e = 0; u.pos0 = 0; u.nvalid = 256; u.eoff = 0; return pg8::static_order(i, G, c, T / 256, D / 256, u.pm, u.pn); }
    __device__ __forceinline__ const char* a_base(const Unit& u) const { return (const char*)ycat + (size_t)u.pm * 256 * D * 2; }
    __device__ __forceinline__ const char* b_base(const Unit& u) const { return (const char*)wt + (size_t)u.pn * 256 * D * 2; }
    __device__ __forceinline__ void a_offsets(const Unit&, int, unsigned (&)[2][2]) const {}
    __device__ __forceinline__ const unsigned* meta_ptr(const Unit& u, int, int idx) const { return (const unsigned*)rsl + u.pm * 256 + idx; }
    __device__ __forceinline__ void epi(const f32x4 (&acc)[2][2][4][2], const Unit& u, int wr, int wc, int fr, int fq, const LAS unsigned char*) const {
#pragma unroll
        for (int ai = 0; ai < 2; ++ai)
#pragma unroll
            for (int m = 0; m < 4; ++m) {
                const int row = u.pm * 256 + ai * 128 + wr * 64 + m * 16 + fr;
                float ss = 0.f;
#pragma unroll
                for (int bj = 0; bj < 2; ++bj) {
                    const int col = u.pn * 256 + bj * 128 + wc * 32 + 8 * fq;
                    const u32x4 xv = *(const u32x4*)(xb + (size_t)row * D + col);
                    const f32x4 x0 = {bflo(xv.x), bfhi(xv.x), bflo(xv.y), bfhi(xv.y)}, x1 = {bflo(xv.z), bfhi(xv.z), bflo(xv.w), bfhi(xv.w)};
                    const f32x4 v0 = acc[ai][bj][m][0] + x0, v1 = acc[ai][bj][m][1] + x1;
                    ss += (v0[0] * v0[0] + v0[1] * v0[1]) + (v0[2] * v0[2] + v0[3] * v0[3]) + (v1[0] * v1[0] + v1[1] * v1[1]) + (v1[2] * v1[2] + v1[3] * v1[3]);
                    u32x4 w; w.x = pk2(v0[0], v0[1]); w.y = pk2(v0[2], v0[3]); w.z = pk2(v1[0], v1[1]); w.w = pk2(v1[2], v1[3]);
                    *(u32x4*)(yb01 + (size_t)row * 2048 + col) = w;
                    u32x2 w8; w8.x = pk4_fp8(v0[0], v0[1], v0[2], v0[3]); w8.y = pk4_fp8(v1[0], v1[1], v1[2], v1[3]);
                    *(u32x2*)(x8 + (size_t)row * D + col) = w8;
                }
                ss += SHFLX_F(ss, 16, fr + 16 * fq); ss += SHFLX_F(ss, 32, fr + 16 * fq);
                if (fq == 0) ssq[(size_t)(u.pn * 4 + wc) * T + row] = ss;
            }
    }
};

struct MoeTabs {
    const LAS unsigned* cnt; const LAS unsigned* eoff; const LAS unsigned* tbase; const LAS unsigned short* tile_e; int ntiles;
    __device__ __forceinline__ bool next(int i, int G, int c, int nN, Unit& u) const {
        int pm, pn; if (!pg8::static_order(i, G, c, ntiles, nN, pm, pn)) return false;
        const int e = __builtin_amdgcn_readfirstlane((int)tile_e[pm]);
        const int tb = __builtin_amdgcn_readfirstlane((int)tbase[e]), ce = __builtin_amdgcn_readfirstlane((int)cnt[e]), eo = __builtin_amdgcn_readfirstlane((int)eoff[e]);
        u.pm = pm; u.pn = pn; u.e = e; u.pos0 = (pm - tb) * 256; u.nvalid = (ce - u.pos0) < 256 ? (ce - u.pos0) : 256; u.eoff = eo; return true;
    }
};
__device__ __forceinline__ MoeTabs moe_build_tabs(LAS unsigned char* lds, const unsigned* ctl, int wv) {
    LAS unsigned* cnt = (LAS unsigned*)(lds + TAB_CNT); LAS unsigned* eoff = (LAS unsigned*)(lds + TAB_EOFF); LAS unsigned* tbase = (LAS unsigned*)(lds + TAB_TBASE);
    LAS unsigned short* tile_e = (LAS unsigned short*)(lds + TAB_TILEE);
    __syncthreads();
    if (wv == 0 && LANE_ID() == 0) {
        unsigned eo = 0, tb = 0;
        for (int e = 0; e < NEXP; ++e) { const unsigned c = ctl[CW_CNT + 64 * e]; cnt[e] = c; eoff[e] = eo; tbase[e] = tb; const unsigned nt = (c + 255u) >> 8;
            for (unsigned t = 0; t < nt; ++t) tile_e[tb + t] = (unsigned short)e; eo += c; tb += nt; }
        tbase[NEXP] = tb;
    }
    __syncthreads();
    MoeTabs mt; mt.cnt = cnt; mt.eoff = eoff; mt.tbase = tbase; mt.tile_e = tile_e; mt.ntiles = __builtin_amdgcn_readfirstlane((int)tbase[NEXP]); return mt;
}

struct ProbUp {
    static constexpr int DIAG = 0;
    static constexpr bool GATHER = true, MIDK = false, FP8 = true; static constexpr int NMETA = 2;
    int probe_mode; MoeTabs tabs; const unsigned char* x8; const unsigned char* wgu; const unsigned* list; const float* rs2s; const float* bg; const float* bu; unsigned char* act; int G, c;
    __device__ __forceinline__ bool next(int i, Unit& u) const { return tabs.next(i, G, c, 8, u); }
    __device__ __forceinline__ const char* a_base(const Unit&) const { return (const char*)x8; }
    __device__ __forceinline__ const char* b_base(const Unit& u) const { return (const char*)wgu + ((size_t)u.e * 2048 + (size_t)u.pn * 256) * D; }
    __device__ __forceinline__ void a_offsets(const Unit& u, int tid, unsigned (&vo)[2][2]) const {
        int R[2], C[2];
#pragma unroll
        for (int i = 0; i < 2; ++i) pg8::stage_rc(tid * 16 + i * 8192, R[i], C[i]);
#pragma unroll
        for (int h = 0; h < 2; ++h)
#pragma unroll
            for (int i = 0; i < 2; ++i) { const int rl = h * 128 + R[i]; const int pos = u.pos0 + (rl < u.nvalid ? rl : 0);
                const unsigned slot = list[(size_t)u.e * T + pos]; vo[h][i] = (slot >> 2) * 1024u + (unsigned)C[i] * 2u; }
    }
    __device__ __forceinline__ const unsigned* meta_ptr(const Unit& u, int a, int idx) const {
        if (a == 0) return (const unsigned*)rs2s + (size_t)u.e * T + u.pos0 + idx;
        return (const unsigned*)(idx < 128 ? bg : bu) + (size_t)u.e * D + u.pn * 128 + (idx & 127);
    }
    __device__ __forceinline__ void epi(const f32x4 (&acc)[2][2][4][2], const Unit& u, int wr, int wc, int fr, int fq, const LAS unsigned char* mbuf) const {
        if (probe_mode == 1) return;
        const int col8 = u.pn * 128 + wc * 32 + 8 * fq;
        f32x4 bgv[2], buv[2];
#pragma unroll
        for (int n = 0; n < 2; ++n) { bgv[n] = *(const LAS f32x4*)(mbuf + 1024 + (wc * 32 + 8 * fq + 4 * n) * 4); buv[n] = *(const LAS f32x4*)(mbuf + 1536 + (wc * 32 + 8 * fq + 4 * n) * 4); }
        float rsv[2][4];
#pragma unroll
        for (int ai = 0; ai < 2; ++ai)
#pragma unroll
            for (int m = 0; m < 4; ++m) { const int rl = ai * 128 + wr * 64 + m * 16 + fr; rsv[ai][m] = *(const LAS float*)(mbuf + rl * 4) * (1.0f / 64.0f);
            }
#pragma unroll
        for (int ai = 0; ai < 2; ++ai)
#pragma unroll
            for (int m = 0; m < 4; ++m) {
                const int rl = ai * 128 + wr * 64 + m * 16 + fr;
                const float rs = rsv[ai][m];
                float o[8];
#pragma unroll
                for (int n = 0; n < 2; ++n)
#pragma unroll
                    for (int jp = 0; jp < 2; ++jp) {
                        const f32x2 ag = {acc[ai][0][m][n][2 * jp], acc[ai][0][m][n][2 * jp + 1]}, au = {acc[ai][1][m][n][2 * jp], acc[ai][1][m][n][2 * jp + 1]};
                        const f32x2 bg2 = {bgv[n][2 * jp], bgv[n][2 * jp + 1]}, bu2 = {buv[n][2 * jp], buv[n][2 * jp + 1]};
                        f32x2 g = ag * rs + bg2, up = au * rs + bu2;
                        g.x = fminf(g.x, 7.0f); g.y = fminf(g.y, 7.0f);
                        up.x = fminf(fmaxf(up.x, -7.0f), 7.0f); up.y = fminf(fmaxf(up.y, -7.0f), 7.0f);
                        const f32x2 z = g * (-1.702f * 1.4426950408889634f);
                        f32x2 e; e.x = fexp2(z.x); e.y = fexp2(z.y);
                        const f32x2 den = e + 1.0f;
                        f32x2 r; r.x = frcp(den.x); r.y = frcp(den.y);
                        const f32x2 res = (g * r) * (up + 1.0f);
                        o[4 * n + 2 * jp] = res.x; o[4 * n + 2 * jp + 1] = res.y;
                    }
                u32x2 w; w.x = pk4_fp8(o[0], o[1], o[2], o[3]); w.y = pk4_fp8(o[4], o[5], o[6], o[7]);
                if (rl < u.nvalid) *(u32x2*)(act + (size_t)(u.eoff + u.pos0 + rl) * D + col8) = w;
            }
    }
};

template <int DG> struct ProbUpDiag : ProbUp { static constexpr int DIAG = DG; };
struct ProbDown {
    static constexpr int DIAG = 0;
    static constexpr bool GATHER = false, MIDK = false, FP8 = true; static constexpr int NMETA = 3;
    int probe_mode; MoeTabs tabs; const unsigned char* act; const unsigned char* wd; const unsigned* list; const float* gw; const float* bd; unsigned char* y8; int G, c;
    __device__ __forceinline__ bool next(int i, Unit& u) const { return tabs.next(i, G, c, 4, u); }
    __device__ __forceinline__ const char* a_base(const Unit& u) const { return (const char*)act + (size_t)(u.eoff + u.pos0) * D; }
    __device__ __forceinline__ const char* b_base(const Unit& u) const { return (const char*)wd + ((size_t)u.e * D + (size_t)u.pn * 256) * D; }
    __device__ __forceinline__ void a_offsets(const Unit&, int, unsigned (&)[2][2]) const {}
    __device__ __forceinline__ const unsigned* meta_ptr(const Unit& u, int a, int idx) const {
        if (a == 2) return (const unsigned*)bd + (size_t)u.e * D + u.pn * 256 + idx;
        return (a == 0 ? list : (const unsigned*)gw) + (size_t)u.e * T + u.pos0 + idx;
    }
    __device__ __forceinline__ void epi(const f32x4 (&acc)[2][2][4][2], const Unit& u, int wr, int wc, int fr, int fq, const LAS unsigned char* mbuf) const {
        if (probe_mode == 1) return;
        const int cofs = u.pn * 256 + wc * 32 + 8 * fq;
        f32x4 bdv[2][2];
#pragma unroll
        for (int bj = 0; bj < 2; ++bj) { bdv[bj][0] = *(const LAS f32x4*)(mbuf + 2048 + (bj * 128 + wc * 32 + 8 * fq) * 4); bdv[bj][1] = *(const LAS f32x4*)(mbuf + 2048 + (bj * 128 + wc * 32 + 8 * fq + 4) * 4); }
#pragma unroll
        for (int ai = 0; ai < 2; ++ai)
#pragma unroll
            for (int m = 0; m < 4; ++m) {
                const int rl = ai * 128 + wr * 64 + m * 16 + fr;
                const unsigned sl = *(const LAS unsigned*)(mbuf + rl * 4);
                const float g = *(const LAS float*)(mbuf + 1024 + rl * 4), s1 = g * (Y8_SCALE / 64.0f), s2 = g * Y8_SCALE;
                unsigned char* dst = y8 + (size_t)sl * D + cofs;
#pragma unroll
                for (int bj = 0; bj < 2; ++bj) {
                    const f32x4 v0 = acc[ai][bj][m][0] * s1 + bdv[bj][0] * s2, v1 = acc[ai][bj][m][1] * s1 + bdv[bj][1] * s2;
                    u32x2 w; w.x = pk4_fp8(v0[0], v0[1], v0[2], v0[3]); w.y = pk4_fp8(v1[0], v1[1], v1[2], v1[3]);
                    if (rl < u.nvalid) *(u32x2*)(dst + bj * 128) = w;
                }
            }
    }
};

struct P0Item { const float* W; const float* scale; void* WT; int N, mode, off, k0, n0, fp8; };
__device__ __forceinline__ int p0_dest(const P0Item& d, int n) {
    if (d.mode == 1) { const int seg = n >> 9; if (seg == 2 || seg == 3) { const int w = n & 511, head = w >> 7, dd = w & 127; return (seg << 9) + (head << 7) + 2 * (dd & 63) + (dd >> 6); } return n; }
    if (d.mode == 2) return d.off + 256 * (n >> 7) + (n & 127);
    return d.off + n;
}
constexpr int P0_I_IN = 16 * (DIN / 64), P0_I_OUT = 16 * (D / 64), P0_I_E = 16 * (D / 64), P0_NITEMS_ALL = P0_I_IN + P0_I_OUT + 3 * NEXP * P0_I_E;
__device__ __forceinline__ void p0_load(const P0Item& d, int lane, f32x4 (&v)[16], float& sc) {
#pragma unroll
    for (int i = 0; i < 16; ++i) v[i] = *(const f32x4*)(d.W + (size_t)(d.k0 + (lane >> 4) + 4 * i) * d.N + d.n0 + 4 * (lane & 15));
    sc = d.scale ? d.scale[d.k0 + lane] : 1.0f;
    if (d.fp8) sc *= 64.0f;
}
__device__ __forceinline__ void p0_process(const P0Item& d, int lane, const f32x4 (&v)[16], float sc, LAS unsigned char* scr) {
    LAS float* ssc = (LAS float*)(scr + 64 * 136);
    ssc[lane] = sc;
    WAVE_SYNC();
#pragma unroll
    for (int i = 0; i < 16; ++i) { const int kk = (lane >> 4) + 4 * i; const float f = ssc[kk];
        u32x2 o; o.x = pk2(v[i].x * f, v[i].y * f); o.y = pk2(v[i].z * f, v[i].w * f);
        *(LAS u32x2*)(scr + kk * 136 + 8 * (lane & 15)) = o; }
    WAVE_SYNC();
    const int q = (lane & 15) >> 2, p = lane & 3;
    if (d.fp8) {
#pragma unroll
        for (int st = 0; st < 4; ++st) {
            const int n16 = 16 * st; unsigned o[4];
#pragma unroll
            for (int hf = 0; hf < 2; ++hf) {
                const int kb8 = 2 * (lane >> 4) + hf;
                const v4i16_t lo = __builtin_amdgcn_ds_read_tr16_b64_v4i16((LAS v4i16_t*)(scr + (8 * kb8 + q) * 136 + (n16 + 4 * p) * 2));
                const v4i16_t hi = __builtin_amdgcn_ds_read_tr16_b64_v4i16((LAS v4i16_t*)(scr + (8 * kb8 + 4 + q) * 136 + (n16 + 4 * p) * 2));
                o[2 * hf] = pk4_fp8(bf2f((unsigned short)lo[0]), bf2f((unsigned short)lo[1]), bf2f((unsigned short)lo[2]), bf2f((unsigned short)lo[3]));
                o[2 * hf + 1] = pk4_fp8(bf2f((unsigned short)hi[0]), bf2f((unsigned short)hi[1]), bf2f((unsigned short)hi[2]), bf2f((unsigned short)hi[3]));
            }
            *(u32x4*)((unsigned char*)d.WT + (size_t)p0_dest(d, d.n0 + n16 + (lane & 15)) * D + d.k0 + 16 * (lane >> 4)) = (u32x4){o[0], o[1], o[2], o[3]};
        }
    } else {
#pragma unroll
    for (int st = 0; st < 8; ++st) {
        const int n16 = 16 * (st & 3), kb8 = (st >> 2) * 4 + (lane >> 4);
        const v4i16_t lo = __builtin_amdgcn_ds_read_tr16_b64_v4i16((LAS v4i16_t*)(scr + (8 * kb8 + q) * 136 + (n16 + 4 * p) * 2));
        const v4i16_t hi = __builtin_amdgcn_ds_read_tr16_b64_v4i16((LAS v4i16_t*)(scr + (8 * kb8 + 4 + q) * 136 + (n16 + 4 * p) * 2));
        u32x4 o; o.x = (unsigned)(unsigned short)lo[0] | ((unsigned)(unsigned short)lo[1] << 16); o.y = (unsigned)(unsigned short)lo[2] | ((unsigned)(unsigned short)lo[3] << 16);
        o.z = (unsigned)(unsigned short)hi[0] | ((unsigned)(unsigned short)hi[1] << 16); o.w = (unsigned)(unsigned short)hi[2] | ((unsigned)(unsigned short)hi[3] << 16);
        *(u32x4*)((bf16_t*)d.WT + (size_t)p0_dest(d, d.n0 + n16 + (lane & 15)) * D + d.k0 + 8 * kb8) = o;
    }
    }
    WAVE_SYNC();
}

#ifndef STREAM_FINAL
#define STREAM_FINAL 1
#endif
#define STREAM_IN_PASS(fin) ((fin) ? (STREAM_FINAL != 0) : true)
struct MoeConv { const float *wg, *wu, *wd, *ffn_g; unsigned char *wgu8, *wd8; };
constexpr int MOE_ITEMS = 3 * NEXP * P0_I_E, NLRU = BATCH * NCH;
constexpr int MOE_PER_WU = (MOE_ITEMS + NLRU * 8 - 1) / (NLRU * 8);
constexpr int MOE_K0 = MOE_PER_WU >= 12 ? 8 : (MOE_PER_WU * 2 + 2) / 3, MOE_K1_RAW = MOE_PER_WU - MOE_K0, MOE_K1 = MOE_K1_RAW < 0 ? 0 : (MOE_K1_RAW > 8 ? 8 : MOE_K1_RAW);
constexpr int MOE_PASS0_ITEMS = NLRU * 8 * MOE_K0, MOE_CAP = NLRU * 8 * (MOE_K0 + MOE_K1), MOE_STREAMED = MOE_ITEMS < MOE_CAP ? MOE_ITEMS : MOE_CAP;
constexpr int P0_NITEMS = P0_NITEMS_ALL - MOE_STREAMED;
__device__ __forceinline__ P0Item moe_item(const MoeConv& M, int it) {
    P0Item d; d.scale = nullptr; d.off = 0; d.mode = 0; d.fp8 = 1; d.N = D;
    const int e = it / (3 * P0_I_E), q = (it / P0_I_E) % 3, r = it % P0_I_E;
    if (q == 0) { d.W = M.wg + (size_t)e * D * D; d.scale = M.ffn_g; d.WT = M.wgu8; d.mode = 2; d.off = e * 2048; }
    else if (q == 1) { d.W = M.wu + (size_t)e * D * D; d.scale = M.ffn_g; d.WT = M.wgu8; d.mode = 2; d.off = e * 2048 + 128; }
    else { d.W = M.wd + (size_t)e * D * D; d.WT = M.wd8; d.off = e * D; }
    d.k0 = 64 * (r / (D / 64)); d.n0 = 64 * (r % (D / 64)); return d;
}

constexpr int RT_STRIDE = 272;
constexpr int LDS_VT = 0, LDS_KT = 128 * RT_STRIDE;
constexpr int XA_STRIDE = 144, XA_WAVE = 16 * XA_STRIDE;
constexpr int AG_STRIDE = 520, AG_WAVE = 16 * AG_STRIDE;
constexpr int LRU_WAVE = XA_WAVE + AG_WAVE;
constexpr int LDS_XA = 0, LDS_SS = 8 * LRU_WAVE, LDS_RSL = LDS_SS + 8 * 128 * 4;
static_assert(LRU_WAVE % 16 == 0 && LRU_WAVE >= 64 * 136 + 256, "LRU per-wave LDS block must hold one weight item");
static_assert(LDS_RSL + 512 <= RING_BYTES && LDS_KT + 128 * RT_STRIDE <= RING_BYTES, "LDS seq map");

__device__ __forceinline__ bf16x8 tr_frag(const LAS unsigned char* tile, int row0, int col0, int fr) {
    const int q = fr >> 2, p = fr & 3;
    const v4i16_t lo = __builtin_amdgcn_ds_read_tr16_b64_v4i16((LAS v4i16_t*)(tile + (row0 + q) * RT_STRIDE + (col0 + 4 * p) * 2));
    const v4i16_t hi = __builtin_amdgcn_ds_read_tr16_b64_v4i16((LAS v4i16_t*)(tile + (row0 + 4 + q) * RT_STRIDE + (col0 + 4 * p) * 2));
    bf16x8 r; r[0] = lo[0]; r[1] = lo[1]; r[2] = lo[2]; r[3] = lo[3]; r[4] = hi[0]; r[5] = hi[1]; r[6] = hi[2]; r[7] = hi[3]; return r;
}
__device__ __forceinline__ void stage_tile(LAS unsigned char* dst, const bf16_t* src, int tid) {
#pragma unroll
    for (int i = 0; i < 4; ++i) { const int p = tid + 512 * i, r = p >> 4, c = p & 15;
        const u32x4 v = *(const u32x4*)(src + (size_t)r * DIN + c * 8); *(LAS u32x4*)(dst + r * RT_STRIDE + c * 16) = v; }
}

template <bool FINAL>
__device__ __forceinline__ void lru_unit(LAS unsigned char* lds, int b, int n, const bf16_t* __restrict__ proj, const float* __restrict__ conv_w, const float* __restrict__ conv_b, const bf16_t* __restrict__ waf,
                                         const float* __restrict__ ba, const float* __restrict__ bx, const float* __restrict__ lam, const float* __restrict__ lru_ng,
                                         float* __restrict__ lap, float* __restrict__ lah, const float* __restrict__ carry, bf16_t* __restrict__ ycat, float* __restrict__ rsl_out, const MoeConv& MC, int item0, int wv) {
    int tid_ = wv * 64 + LANE_ID(); OPAQUE(tid_);
    const int tid = tid_, lane = tid & 63, w = __builtin_amdgcn_readfirstlane(tid >> 6), fr = lane & 15, fq = lane >> 4, c = tid;
    LAS unsigned char* xa = lds + LDS_XA + w * LRU_WAVE; LAS unsigned char* ag = xa + XA_WAVE;
    LAS float* ss = (LAS float*)(lds + LDS_SS);
    bf16x8 Ba[2][4], Bx[2][4];
#pragma unroll
    for (int ks = 0; ks < 2; ++ks)
#pragma unroll
        for (int nt = 0; nt < 4; ++nt) { const size_t fi = ((size_t)(w * 2 + ks) * 4 + nt) * 64 + lane; Ba[ks][nt] = *(const bf16x8*)(waf + fi * 8); Bx[ks][nt] = *(const bf16x8*)(waf + (fi + 4096) * 8); }
    float bav[4], bxv[4], spl[4];
#pragma unroll
    for (int nt = 0; nt < 4; ++nt) { const int co = w * 64 + 16 * nt + fr; bav[nt] = ba[co]; bxv[nt] = bx[co]; const float l = lam[co];
        spl[nt] = -8.0f * 1.4426950408889634f * (fmaxf(-l, 0.f) + log1pf(expf(-fabsf(l)))); }
    const float w0 = conv_w[c], w1 = conv_w[512 + c], w2 = conv_w[1024 + c], w3 = conv_w[1536 + c], cb = conv_b[c];
    const float gn = FINAL ? lru_ng[c] : 0.f;
    const size_t t0 = (size_t)b * SEQ + (size_t)n * 128;
    float xm3 = 0.f, xm2 = 0.f, xm1 = 0.f;
    if (n > 0) { xm3 = bf2f(proj[(t0 - 3) * DIN + c]); xm2 = bf2f(proj[(t0 - 2) * DIN + c]); xm1 = bf2f(proj[(t0 - 1) * DIN + c]); }
    float h = FINAL ? carry[((size_t)b * NCH + n) * 512 + c] : 0.f, P = 1.f;
    unsigned xr[16];
#pragma unroll
    for (int i = 0; i < 16; ++i) xr[i] = proj[(t0 + i) * DIN + c];
    for (int tt = 0; tt < 8; ++tt) {
        float xcv[16]; unsigned gr[16];
#pragma unroll
        for (int i = 0; i < 16; ++i) { xcv[i] = bf2f(xr[i]); gr[i] = FINAL ? (unsigned)proj[(t0 + tt * 16 + i) * DIN + 512 + c] : 0u; }
        if (tt < 7) {
#pragma unroll
            for (int i = 0; i < 16; ++i) xr[i] = proj[(t0 + (tt + 1) * 16 + i) * DIN + c];
        }
        constexpr int KP = FINAL ? MOE_K1 : MOE_K0;
        const int cit = item0 + (w * KP + tt);
        const bool chas = (tt < KP) && (cit < MOE_STREAMED);
        P0Item cd; f32x4 cv[16]; float csc = 1.f;
        if (chas) { cd = moe_item(MC, cit); p0_load(cd, lane, cv, csc); }
#pragma unroll
        for (int i = 0; i < 16; ++i) {
            const float x0 = xcv[i];
            const float xc = w0 * xm3 + w1 * xm2 + w2 * xm1 + w3 * x0 + cb;
            xm3 = xm2; xm2 = xm1; xm1 = x0; xcv[i] = xc;
            *(LAS bf16_t*)(xa + i * XA_STRIDE + lane * 2) = (bf16_t)f2bf(xc);
        }
        WAVE_SYNC();
        bf16x8 af[2];
#pragma unroll
        for (int ks = 0; ks < 2; ++ks) af[ks] = *(const LAS bf16x8*)(xa + fr * XA_STRIDE + (32 * ks + 8 * fq) * 2);
#pragma unroll
        for (int nt = 0; nt < 4; ++nt) {
            f32x4 ar = {0.f, 0.f, 0.f, 0.f}, ai = {0.f, 0.f, 0.f, 0.f};
#pragma unroll
            for (int ks = 0; ks < 2; ++ks) { ar = __builtin_amdgcn_mfma_f32_16x16x32_bf16(af[ks], Ba[ks][nt], ar, 0, 0, 0); ai = __builtin_amdgcn_mfma_f32_16x16x32_bf16(af[ks], Bx[ks][nt], ai, 0, 0, 0); }
#pragma unroll
            for (int r = 0; r < 4; ++r) {
                const float rr = sigmoid_f(ar[r] + bav[nt]), ii = sigmoid_f(ai[r] + bxv[nt]);
                const float a = fexp2(rr * spl[nt]);
                const float g = sqrtf(fmaxf(1.0f - a * a, 0.f)) * ii;
                *(LAS f32x2*)(ag + (4 * fq + r) * AG_STRIDE + (16 * nt + fr) * 8) = (f32x2){a, g};
            }
        }
        WAVE_SYNC();
        unsigned upk[8];
#pragma unroll
        for (int i = 0; i < 16; ++i) {
            const f32x2 v = *(const LAS f32x2*)(ag + i * AG_STRIDE + lane * 8);
            h = v.x * h + v.y * xcv[i];
            if (!FINAL) P *= v.x;
            if (FINAL) {
                const float u = h * bf2f(gr[i]);
                const unsigned ub = f2bf(u * gn);
                if (i & 1) upk[i >> 1] |= ub << 16; else upk[i >> 1] = ub;
                *(LAS float*)(ag + i * AG_STRIDE + lane * 8) = u;
            }
        }
        if (FINAL) {
            WAVE_SYNC();
            const int tk = lane & 15, qd = lane >> 4; float s = 0.f;
#pragma unroll
            for (int i = 0; i < 16; ++i) { const float u = *(const LAS float*)(ag + tk * AG_STRIDE + (16 * qd + i) * 8); s += u * u; }
            s += SHFLX_F(s, 16, lane); s += SHFLX_F(s, 32, lane);
            if (qd == 0) ss[w * 128 + tt * 16 + tk] = s;
        }
        WAVE_SYNC();
        if (chas) p0_process(cd, lane, cv, csc, xa);
        if (FINAL) {
#pragma unroll
            for (int i = 0; i < 16; ++i) ycat[(t0 + tt * 16 + i) * D + c] = (bf16_t)((i & 1) ? (upk[i >> 1] >> 16) : (upk[i >> 1] & 0xffffu));
        }
    }
    if (!FINAL) { lap[((size_t)b * NCH + n) * 512 + c] = P; lah[((size_t)b * NCH + n) * 512 + c] = h; }
    else {
        __syncthreads();
        if (tid < 128) { float tot = 0.f;
#pragma unroll
            for (int q = 0; q < 8; ++q) tot += ss[q * 128 + tid];
            rsl_out[t0 + tid] = 1.0f / sqrtf(tot * (1.0f / 512.0f) + NORM_EPS); }
    }
    __syncthreads();
}

__device__ __forceinline__ void ret_kv_load(u32x4 (&tk)[4], u32x4 (&tv)[4], int unit, const bf16_t* __restrict__ proj, int tid) {
    const int bh = unit / NCH, n = unit % NCH, b = bh >> 2, hh = bh & 3;
    const size_t t0 = (size_t)b * SEQ + (size_t)n * 128;
#pragma unroll
    for (int i = 0; i < 4; ++i) { const int p = tid + 512 * i, r = p >> 4, c = p & 15;
        tk[i] = *(const u32x4*)(proj + (t0 + r) * DIN + 1536 + hh * 128 + c * 8); tv[i] = *(const u32x4*)(proj + (t0 + r) * DIN + 2048 + hh * 128 + c * 8); }
}
__device__ __forceinline__ void ret_kv_stage(LAS unsigned char* lds, const u32x4 (&tk)[4], const u32x4 (&tv)[4], int tid) {
#pragma unroll
    for (int i = 0; i < 4; ++i) { const int p = tid + 512 * i, r = p >> 4, c = p & 15;
        *(LAS u32x4*)(lds + LDS_KT + r * RT_STRIDE + c * 16) = tk[i]; *(LAS u32x4*)(lds + LDS_VT + r * RT_STRIDE + c * 16) = tv[i]; }
}
__device__ __forceinline__ void ret_kv_phase(LAS unsigned char* lds, const bf16_t* __restrict__ proj, bf16_t* __restrict__ kvt, int G, int bx, int wv) {
    int tid_ = wv * 64 + LANE_ID(); OPAQUE(tid_);
    const int tid = tid_, lane = tid & 63, w = wv, fr = lane & 15, fq = lane >> 4;
    u32x4 tk[4], tv[4];
    int unit = bx;
    if (unit < NBH * NCH) { ret_kv_load(tk, tv, unit, proj, tid); ret_kv_stage(lds, tk, tv, tid); __syncthreads(); if (unit + G < NBH * NCH) ret_kv_load(tk, tv, unit + G, proj, tid); }
    for (; unit < NBH * NCH; unit += G) {
        f32x4 acc[8];
#pragma unroll
        for (int et = 0; et < 8; ++et) acc[et] = (f32x4){0.f, 0.f, 0.f, 0.f};
#pragma unroll
        for (int ks = 0; ks < 4; ++ks) {
            const bf16x8 af = tr_frag(lds + LDS_KT, 32 * ks + 8 * fq, 16 * w, fr);
#pragma unroll
            for (int et = 0; et < 8; ++et) { const bf16x8 bfv = tr_frag(lds + LDS_VT, 32 * ks + 8 * fq, 16 * et, fr);
                acc[et] = __builtin_amdgcn_mfma_f32_16x16x32_bf16(af, bfv, acc[et], 0, 0, 0); }
        }
        u32x2 o[8];
#pragma unroll
        for (int et = 0; et < 8; ++et) { o[et].x = pk2v(acc[et][0], acc[et][1]); o[et].y = pk2v(acc[et][2], acc[et][3]); }
        __syncthreads();
        if (unit + G < NBH * NCH) ret_kv_stage(lds, tk, tv, tid);
        bf16_t* out = kvt + (size_t)unit * 16384;
#pragma unroll
        for (int et = 0; et < 8; ++et) *(u32x2*)(out + (size_t)(16 * et + fr) * 128 + 16 * w + 4 * fq) = o[et];
        __syncthreads();
        if (unit + 2 * G < NBH * NCH) ret_kv_load(tk, tv, unit + 2 * G, proj, tid);
    }
}

__device__ __forceinline__ int swz_off(int row, int chunk) { return row * 256 + ((chunk ^ (row & 15)) << 4); }
constexpr int LDS_RV = 0, LDS_RK = 32768, LDS_RP = 65536, LDS_RPT = 98304;
__device__ __forceinline__ bf16x8 tr_frag_swz(const LAS unsigned char* tile, int row0, int col0, int fr) {
    const int q = fr >> 2, p = fr & 3, ch = (col0 >> 3) + (p >> 1), bo = (p & 1) * 8;
    const v4i16_t lo = __builtin_amdgcn_ds_read_tr16_b64_v4i16((LAS v4i16_t*)(tile + swz_off(row0 + q, ch) + bo));
    const v4i16_t hi = __builtin_amdgcn_ds_read_tr16_b64_v4i16((LAS v4i16_t*)(tile + swz_off(row0 + 4 + q, ch) + bo));
    bf16x8 r; r[0] = lo[0]; r[1] = lo[1]; r[2] = lo[2]; r[3] = lo[3]; r[4] = hi[0]; r[5] = hi[1]; r[6] = hi[2]; r[7] = hi[3]; return r;
}
struct RetRegs { u32x4 tv[4], tk[4], tp[4]; bf16x8 bq[4]; u32x2 sg[8]; };
__device__ __forceinline__ void ret_out_load(RetRegs& R, int unit, const bf16_t* __restrict__ proj, const bf16_t* __restrict__ prevt, int tid, int w, int fr, int fq) {
    const int bh = unit / NCH, n = unit % NCH, b = bh >> 2, hh = bh & 3;
    const size_t t0 = (size_t)b * SEQ + (size_t)n * 128;
#pragma unroll
    for (int i = 0; i < 4; ++i) { const int p = tid + 512 * i, r = p >> 4, c = p & 15;
        R.tv[i] = *(const u32x4*)(proj + (t0 + r) * DIN + 2048 + hh * 128 + c * 8);
        R.tk[i] = *(const u32x4*)(proj + (t0 + r) * DIN + 1536 + hh * 128 + c * 8);
        R.tp[i] = *(const u32x4*)(prevt + (size_t)unit * 16384 + r * 128 + c * 8); }
#pragma unroll
    for (int ks = 0; ks < 4; ++ks) R.bq[ks] = *(const bf16x8*)(proj + (t0 + 16 * w + fr) * DIN + 1024 + hh * 128 + 32 * ks + 8 * fq);
#pragma unroll
    for (int et = 0; et < 8; ++et) R.sg[et] = *(const u32x2*)(proj + (t0 + 16 * w + fr) * DIN + 2560 + hh * 128 + 16 * et + 4 * fq);
}
__device__ __forceinline__ void ret_out_phase(LAS unsigned char* lds, const bf16_t* __restrict__ proj, const bf16_t* __restrict__ prevt, const float* __restrict__ gng, const float* __restrict__ gnb, bf16_t* __restrict__ ycat, int G, int bx, int wv) {
    int tid_ = wv * 64 + LANE_ID(); OPAQUE(tid_);
    const int tid = tid_, lane = tid & 63, w = __builtin_amdgcn_readfirstlane(tid >> 6), fr = lane & 15, fq = lane >> 4;
    RetRegs R;
    int unit = bx;
    bf16x8 bq[4]; u32x2 sg[8];
    if (unit < NBH * NCH) {
        ret_out_load(R, unit, proj, prevt, tid, w, fr, fq);
#pragma unroll
        for (int i = 0; i < 4; ++i) { const int p = tid + 512 * i, r = p >> 4, c = p & 15, o = swz_off(r, c);
            *(LAS u32x4*)(lds + LDS_RV + o) = R.tv[i]; *(LAS u32x4*)(lds + LDS_RK + o) = R.tk[i]; *(LAS u32x4*)(lds + LDS_RP + o) = R.tp[i]; }
#pragma unroll
        for (int ks = 0; ks < 4; ++ks) bq[ks] = R.bq[ks];
#pragma unroll
        for (int et = 0; et < 8; ++et) sg[et] = R.sg[et];
        __syncthreads();
        if (unit + G < NBH * NCH) ret_out_load(R, unit + G, proj, prevt, tid, w, fr, fq);
    }
    for (; unit < NBH * NCH; unit += G) {
        const int bh = unit / NCH, n = unit % NCH, b = bh >> 2, hh = bh & 3;
        const size_t t0 = (size_t)b * SEQ + (size_t)n * 128;
        const int crow = 16 * w + fr;
#pragma unroll
        for (int mt = 0; mt < 8; ++mt) {
            if (mt <= w) {
                f32x4 sacc = {0.f, 0.f, 0.f, 0.f};
#pragma unroll
                for (int ks = 0; ks < 4; ++ks) { const bf16x8 ak = *(const LAS bf16x8*)(lds + LDS_RK + swz_off(16 * mt + fr, 4 * ks + fq));
                    sacc = __builtin_amdgcn_mfma_f32_16x16x32_bf16(ak, bq[ks], sacc, 0, 0, 0); }
                if (mt == w) {
#pragma unroll
                    for (int r = 0; r < 4; ++r) if (4 * fq + r > fr) sacc[r] = 0.f;
                }
                u32x2 o; o.x = pk2v(sacc[0], sacc[1]); o.y = pk2v(sacc[2], sacc[3]);
                *(LAS u32x2*)(lds + LDS_RPT + swz_off(crow, 2 * mt + (fq >> 1)) + (fq & 1) * 8) = o;
            } else if (mt == w + 1 && (mt & 1)) {
                *(LAS u32x2*)(lds + LDS_RPT + swz_off(crow, 2 * mt + (fq >> 1)) + (fq & 1) * 8) = (u32x2){0u, 0u};
            }
        }
        WAVE_SYNC();
        f32x4 acc[8];
#pragma unroll
        for (int et = 0; et < 8; ++et) acc[et] = (f32x4){0.f, 0.f, 0.f, 0.f};
        const int nks = (w + 2) >> 1;
#pragma unroll
        for (int ksm = 0; ksm < 4; ++ksm) {
            if (ksm < nks) {
                const bf16x8 bp = *(const LAS bf16x8*)(lds + LDS_RPT + swz_off(crow, 4 * ksm + fq));
#pragma unroll
                for (int et = 0; et < 8; ++et) { const bf16x8 av = tr_frag_swz(lds + LDS_RV, 32 * ksm + 8 * fq, 16 * et, fr);
                    acc[et] = __builtin_amdgcn_mfma_f32_16x16x32_bf16(av, bp, acc[et], 0, 0, 0); }
            }
        }
#pragma unroll
        for (int et = 0; et < 8; ++et)
#pragma unroll
            for (int ks = 0; ks < 4; ++ks) { const bf16x8 ap = *(const LAS bf16x8*)(lds + LDS_RP + swz_off(16 * et + fr, 4 * ks + fq));
                acc[et] = __builtin_amdgcn_mfma_f32_16x16x32_bf16(ap, bq[ks], acc[et], 0, 0, 0); }
        float s1 = 0.f;
#pragma unroll
        for (int et = 0; et < 8; ++et) s1 += (acc[et][0] + acc[et][1]) + (acc[et][2] + acc[et][3]);
        s1 += SHFLX_F(s1, 16, lane); s1 += SHFLX_F(s1, 32, lane);
        const float mu = s1 * (1.0f / 128.0f);
        float s2 = 0.f;
#pragma unroll
        for (int et = 0; et < 8; ++et)
#pragma unroll
            for (int r = 0; r < 4; ++r) { const float dlt = acc[et][r] - mu; s2 += dlt * dlt; }
        s2 += SHFLX_F(s2, 16, lane); s2 += SHFLX_F(s2, 32, lane);
        const float rstd = 1.0f / sqrtf(s2 * (1.0f / 128.0f) + NORM_EPS);
        const size_t t = t0 + 16 * w + fr;
        u32x2 yo[8];
#pragma unroll
        for (int et = 0; et < 8; ++et) {
            const int e0 = hh * 128 + 16 * et + 4 * fq;
            const f32x4 gv = *(const f32x4*)(gng + e0), bv = *(const f32x4*)(gnb + e0);
            const float y0 = ((acc[et][0] - mu) * rstd * gv[0] + bv[0]) * bflo(sg[et].x), y1 = ((acc[et][1] - mu) * rstd * gv[1] + bv[1]) * bfhi(sg[et].x);
            const float y2 = ((acc[et][2] - mu) * rstd * gv[2] + bv[2]) * bflo(sg[et].y), y3 = ((acc[et][3] - mu) * rstd * gv[3] + bv[3]) * bfhi(sg[et].y);
            yo[et].x = pk2v(y0, y1); yo[et].y = pk2v(y2, y3);
        }
        __syncthreads();
        const bool has_next = unit + G < NBH * NCH;
        if (has_next) {
#pragma unroll
            for (int i = 0; i < 4; ++i) { const int p = tid + 512 * i, r = p >> 4, c = p & 15, o = swz_off(r, c);
                *(LAS u32x4*)(lds + LDS_RV + o) = R.tv[i]; *(LAS u32x4*)(lds + LDS_RK + o) = R.tk[i]; *(LAS u32x4*)(lds + LDS_RP + o) = R.tp[i]; }
#pragma unroll
            for (int ks = 0; ks < 4; ++ks) bq[ks] = R.bq[ks];
#pragma unroll
            for (int et = 0; et < 8; ++et) sg[et] = R.sg[et];
        }
#pragma unroll
        for (int et = 0; et < 8; ++et) *(u32x2*)(ycat + t * D + 512 + hh * 128 + 16 * et + 4 * fq) = yo[et];
        __syncthreads();
        if (unit + 2 * G < NBH * NCH) ret_out_load(R, unit + 2 * G, proj, prevt, tid, w, fr, fq);
    }
}

struct Ptrs {
    const float *x, *attn_g, *w_in, *conv_w, *conv_b, *lru_wa, *lru_ba, *lru_wx, *lru_bx, *lru_lam, *lru_ng, *ret_ng, *ret_nb, *w_out, *ffn_g, *router_w, *router_b;
    const float *moe_wg, *moe_bg, *moe_wu, *moe_bu, *moe_wd, *moe_bd, *final_g; const int* positions;
    float *RS1, *RS2S, *SSQ, *GW, *LAP, *LAH, *CARRY, *out; unsigned *LIST, *ctl;
    bf16_t *WR_T, *WIN_T, *WOUT_T, *PROJ, *XB, *YCAT, *YB23, *KVT, *PREVT, *YB01, *WAF; float* RSL; unsigned char *WGU8, *WD8, *X8, *ACT; int wv;
};
__device__ __forceinline__ MoeConv moe_conv(const Ptrs& P) { MoeConv M; M.wg = P.moe_wg; M.wu = P.moe_wu; M.wd = P.moe_wd; M.ffn_g = P.ffn_g; M.wgu8 = P.WGU8; M.wd8 = P.WD8; return M; }
#define PHASE_IDS() int tid = P.wv * 64 + LANE_ID(); OPAQUE(tid); const int lane = tid & 63, wave = P.wv; const int gw = bx * NWAVES + wave, NGW = G * NWAVES; (void)lane; (void)gw; (void)NGW

__device__ __forceinline__ P0Item p0_decode(const Ptrs& P, int it) {
    P0Item d; d.scale = nullptr; d.off = 0; d.mode = 0; d.fp8 = 0; int r = it, nblk;
    if (r < P0_I_IN) { d.W = P.w_in; d.scale = P.attn_g; d.N = DIN; d.WT = P.WIN_T; d.mode = 1; }
    else if ((r -= P0_I_IN) < P0_I_OUT) { d.W = P.w_out; d.N = D; d.WT = P.WOUT_T; }
    else { r -= P0_I_OUT; r += MOE_STREAMED;
        const int e = r / (3 * P0_I_E), q = (r / P0_I_E) % 3; r = r % P0_I_E; d.N = D;
        d.fp8 = 1;
        if (q == 0) { d.W = P.moe_wg + (size_t)e * D * D; d.scale = P.ffn_g; d.WT = P.WGU8; d.mode = 2; d.off = e * 2048; }
        else if (q == 1) { d.W = P.moe_wu + (size_t)e * D * D; d.scale = P.ffn_g; d.WT = P.WGU8; d.mode = 2; d.off = e * 2048 + 128; }
        else { d.W = P.moe_wd + (size_t)e * D * D; d.WT = P.WD8; d.off = e * D; } }
    nblk = d.N / 64; d.k0 = 64 * (r / nblk); d.n0 = 64 * (r % nblk); return d;
}
__device__ __forceinline__ void p0_prologue(LAS unsigned char* lds, const Ptrs& P, int G, int bx) {
    PHASE_IDS();
    {
        f32x4 v[4], nv[4];
        int m = gw;
        if (m < T) {
#pragma unroll
            for (int j = 0; j < 4; ++j) v[j] = ((const f32x4*)(P.x + (size_t)m * D))[lane + 64 * j];
        }
        for (; m < T; m += NGW) {
            const int mn = m + NGW;
            if (mn < T) {
#pragma unroll
                for (int j = 0; j < 4; ++j) nv[j] = ((const f32x4*)(P.x + (size_t)mn * D))[lane + 64 * j];
            }
            float s = 0.f;
#pragma unroll
            for (int j = 0; j < 4; ++j) s += (v[j].x * v[j].x + v[j].y * v[j].y) + (v[j].z * v[j].z + v[j].w * v[j].w);
            s = wave_sum(s, lane);
            if (lane == 0) P.RS1[m] = 1.0f / sqrtf(s * (1.0f / D) + NORM_EPS);
            u32x2* o8 = (u32x2*)(P.XB + (size_t)m * D) + lane;
#pragma unroll
            for (int j = 0; j < 4; ++j) { u32x2 o; o.x = pk2(v[j].x, v[j].y); o.y = pk2(v[j].z, v[j].w); o8[64 * j] = o; }
#pragma unroll
            for (int j = 0; j < 4; ++j) v[j] = nv[j];
        }
    }
    {
        LAS unsigned char* scr = lds + wave * 16384;
        f32x4 v[16], nv[16]; float sc = 1.f, nsc = 1.f;
        int it = gw;
        P0Item d, nd;
        if (it < P0_NITEMS) { d = p0_decode(P, it); p0_load(d, lane, v, sc); }
        for (; it < P0_NITEMS; it += NGW) {
            const int nit = it + NGW;
            if (nit < P0_NITEMS) { nd = p0_decode(P, nit); p0_load(nd, lane, nv, nsc); }
            p0_process(d, lane, v, sc, scr);
            d = nd; sc = nsc;
#pragma unroll
            for (int i = 0; i < 16; ++i) v[i] = nv[i];
        }
    }
    for (int i = bx * NTHREADS + tid; i < 32 * D; i += G * NTHREADS) { const int e = i / D, k = i % D; P.WR_T[i] = (bf16_t)((e < NEXP) ? f2bf(P.router_w[(size_t)k * NEXP + e] * P.ffn_g[k]) : 0u); }
    for (int i = bx * NTHREADS + tid; i < 2 * 8 * 2 * 4 * 64; i += G * NTHREADS) {
        const int ln = i & 63, nt = (i >> 6) & 3, ks = (i >> 8) & 1, h = (i >> 9) & 7, mat = i >> 12, fr = ln & 15, fq = ln >> 4;
        const float* w = mat ? P.lru_wx : P.lru_wa; unsigned pk[4];
#pragma unroll
        for (int j = 0; j < 4; ++j) { const size_t i0 = ((size_t)h * 64 + 32 * ks + 8 * fq + 2 * j) * 64 + 16 * nt + fr; pk[j] = pk2(w[i0], w[i0 + 64]); }
        *(u32x4*)(P.WAF + (size_t)i * 8) = (u32x4){pk[0], pk[1], pk[2], pk[3]};
    }
}

__device__ __forceinline__ void p3_scans(const Ptrs& P, int G, int bx) {
    PHASE_IDS();
    if (wave == NWAVES - 1) {
        const int per = (BATCH * 512 + G - 1) / G;
        for (int i = bx * per + lane; lane < per && i < BATCH * 512 && i < (bx + 1) * per; i += 64) { const int b = i / 512, c = i % 512; float st = 0.f;
            for (int n0 = 0; n0 < NCH; n0 += 32) {
                float ap[32], ah[32];
#pragma unroll
                for (int j = 0; j < 32; ++j) { const size_t o = ((size_t)b * NCH + (n0 + j < NCH ? n0 + j : 0)) * 512 + c; ap[j] = P.LAP[o]; ah[j] = P.LAH[o]; }
#pragma unroll
                for (int j = 0; j < 32; ++j) { if (n0 + j < NCH) { P.CARRY[((size_t)b * NCH + n0 + j) * 512 + c] = st; st = ap[j] * st + ah[j]; } }
            }
        }
    }
    for (int i = bx * NTHREADS + tid; i < NBH * 8192; i += G * NTHREADS) {
        const int bh = i / 8192, rem = i % 8192, hh = bh & 3;
        const float lamb = exp2f(128.0f * log2_gamma(hh));
        float s0 = 0.f, s1 = 0.f;
        const unsigned* src = (const unsigned*)(P.KVT + (size_t)bh * NCH * 16384) + rem; unsigned* dst = (unsigned*)(P.PREVT + (size_t)bh * NCH * 16384) + rem;
        for (int n0 = 0; n0 < NCH; n0 += 64) {
            unsigned kv[64];
#pragma unroll
            for (int j = 0; j < 64; ++j) kv[j] = (n0 + j < NCH) ? src[(size_t)(n0 + j) * 8192] : 0u;
#pragma unroll
            for (int j = 0; j < 64; ++j) { if (n0 + j < NCH) { dst[(size_t)(n0 + j) * 8192] = pk2(s0, s1); s0 = lamb * (s0 + bflo(kv[j])); s1 = lamb * (s1 + bfhi(kv[j])); } }
        }
    }
}

constexpr int CW_HIST = 32768;
__device__ __forceinline__ void p6_router(LAS unsigned char* lds, const Ptrs& P, int G, int bx, const XcdBarrier& bar) {
    PHASE_IDS();
    LAS unsigned* hist = (LAS unsigned*)(lds + 0); LAS unsigned* base = (LAS unsigned*)(lds + 256); LAS unsigned* part = (LAS unsigned*)(lds + 512);
    const int fr = lane & 15, fq = lane >> 4;
    const bool act = bx < T / 128;
    if (tid < 64) hist[tid] = 0u;
    __syncthreads();
    const int tok = (act ? bx : 0) * 128 + wave * 16 + fr;
    f32x4 lg[2] = {{0.f, 0.f, 0.f, 0.f}, {0.f, 0.f, 0.f, 0.f}};
    for (int ks = 0; ks < 32; ++ks) {
        const bf16x8 bt = *(const bf16x8*)(P.YB01 + (size_t)tok * 2048 + 32 * ks + 8 * fq);
#pragma unroll
        for (int tt = 0; tt < 2; ++tt) { const bf16x8 aw = *(const bf16x8*)(P.WR_T + (size_t)(16 * tt + fr) * D + 32 * ks + 8 * fq);
            lg[tt] = __builtin_amdgcn_mfma_f32_16x16x32_bf16(aw, bt, lg[tt], 0, 0, 0); }
    }
    float tot = 0.f;
#pragma unroll
    for (int p = 0; p < 16; ++p) tot += P.SSQ[(size_t)p * T + tok];
    const float rs = 1.0f / sqrtf(tot * (1.0f / D) + NORM_EPS);
    float val[8];
#pragma unroll
    for (int tt = 0; tt < 2; ++tt)
#pragma unroll
        for (int r = 0; r < 4; ++r) { const int e = 16 * tt + 4 * fq + r; val[4 * tt + r] = (e < NEXP) ? (lg[tt][r] * rs + P.router_b[e < NEXP ? e : 0]) : -3.0e38f; }
    float tv[4]; int ti[4];
#pragma unroll
    for (int k = 0; k < 4; ++k) {
        float bv = -3.4e38f; int bi = 1 << 20;
#pragma unroll
        for (int q = 0; q < 8; ++q) { const int e = 16 * (q >> 2) + 4 * fq + (q & 3); if (val[q] > bv || (val[q] == bv && e < bi)) { bv = val[q]; bi = e; } }
#pragma unroll
        for (int o = 16; o <= 32; o <<= 1) { const float ov = SHFLX_F(bv, o, lane); const int oi = SHFLX_I(bi, o, lane); if (ov > bv || (ov == bv && oi < bi)) { bv = ov; bi = oi; } }
        tv[k] = bv; ti[k] = bi;
#pragma unroll
        for (int q = 0; q < 8; ++q) { const int e = 16 * (q >> 2) + 4 * fq + (q & 3); if (e == bi) val[q] = -3.4e38f; }
    }
    float ex[4], den = 0.f;
#pragma unroll
    for (int k = 0; k < 4; ++k) { ex[k] = expf(tv[k] - tv[0]); den += ex[k]; }
    unsigned lp[4] = {0u, 0u, 0u, 0u};
    if (act && fq == 0) {
#pragma unroll
        for (int k = 0; k < 4; ++k) lp[k] = __hip_atomic_fetch_add(&hist[ti[k]], 1u, __ATOMIC_RELAXED, __HIP_MEMORY_SCOPE_WORKGROUP);
    }
    __syncthreads();
    if (tid < 32) P.ctl[CW_HIST + bx * 32 + tid] = hist[tid];
    xcd_barrier(bar, P.wv);
    {
        const int e = tid & 31, pt = tid >> 5; unsigned sum = 0u;
#pragma unroll
        for (int i = 0; i < 16; ++i) { const int w = pt * 16 + i; const unsigned c = P.ctl[CW_HIST + (w < G ? w : 0) * 32 + e]; sum += (w < bx) ? c : 0u; }
        part[pt * 32 + e] = sum;
    }
    __syncthreads();
    if (tid < 32) { unsigned sum = 0u;
#pragma unroll
        for (int i = 0; i < 16; ++i) sum += part[i * 32 + tid];
        base[tid] = sum;
        if (bx == G - 1 && tid < NEXP) P.ctl[CW_CNT + 64 * tid] = sum + hist[tid]; }
    __syncthreads();
    if (act && fq == 0) {
#pragma unroll
        for (int k = 0; k < 4; ++k) { const size_t o = (size_t)ti[k] * T + base[ti[k]] + lp[k]; P.LIST[o] = (unsigned)tok * 4u + (unsigned)k; P.GW[o] = ex[k] / den; P.RS2S[o] = rs; }
    }
    __syncthreads();
}

__device__ __forceinline__ void p9_final(const Ptrs& P, int G, int bx) {
    PHASE_IDS();
    const unsigned char* Y8 = (const unsigned char*)P.YB23;
    u32x4 q[2], nq[2], nnq[2]; u32x2 e[8], ne[8], nne[8];
    int m = gw;
#define P9_LOAD(dq, de, row) do { _Pragma("unroll") for (int j = 0; j < 2; ++j) { const int col = (j * 64 + lane) * 8; \
        dq[j] = *(const u32x4*)(P.YB01 + (size_t)(row) * 2048 + col); \
        _Pragma("unroll") for (int k = 0; k < 4; ++k) de[4 * j + k] = *(const u32x2*)(Y8 + (size_t)(row) * 4096 + k * 1024 + col); } } while (0)
    if (m < T) P9_LOAD(q, e, m);
    if (m + NGW < T) P9_LOAD(nq, ne, m + NGW);
    f32x4 g0[2], g1[2];
#pragma unroll
    for (int j = 0; j < 2; ++j) { const int col = (j * 64 + lane) * 8; g0[j] = *(const f32x4*)(P.final_g + col); g1[j] = *(const f32x4*)(P.final_g + col + 4); }
    for (; m < T; m += NGW) {
        const int mn = m + 2 * NGW;
        if (mn < T) P9_LOAD(nnq, nne, mn);
        float v[2][8]; float s = 0.f;
#pragma unroll
        for (int j = 0; j < 2; ++j) {
            f32x2 t[4] = {{0.f, 0.f}, {0.f, 0.f}, {0.f, 0.f}, {0.f, 0.f}};
#pragma unroll
            for (int k = 0; k < 4; ++k) { const u32x2 w = e[4 * j + k]; t[0] += unpk2_fp8(w.x, false); t[1] += unpk2_fp8(w.x, true); t[2] += unpk2_fp8(w.y, false); t[3] += unpk2_fp8(w.y, true); }
            const u32x4 a = q[j];
            v[j][0] = bflo(a.x) + t[0].x * (1.0f / Y8_SCALE); v[j][1] = bfhi(a.x) + t[0].y * (1.0f / Y8_SCALE); v[j][2] = bflo(a.y) + t[1].x * (1.0f / Y8_SCALE); v[j][3] = bfhi(a.y) + t[1].y * (1.0f / Y8_SCALE);
            v[j][4] = bflo(a.z) + t[2].x * (1.0f / Y8_SCALE); v[j][5] = bfhi(a.z) + t[2].y * (1.0f / Y8_SCALE); v[j][6] = bflo(a.w) + t[3].x * (1.0f / Y8_SCALE); v[j][7] = bfhi(a.w) + t[3].y * (1.0f / Y8_SCALE);
#pragma unroll
            for (int k = 0; k < 8; ++k) s += v[j][k] * v[j][k];
        }
        s = wave_sum(s, lane);
        const float rs = 1.0f / sqrtf(s * (1.0f / D) + NORM_EPS);
#pragma unroll
        for (int j = 0; j < 2; ++j) {
            const int col = (j * 64 + lane) * 8;
            f32x4 o0, o1;
#pragma unroll
            for (int k = 0; k < 4; ++k) { o0[k] = v[j][k] * rs * g0[j][k]; o1[k] = v[j][4 + k] * rs * g1[j][k]; }
            *(f32x4*)(P.out + (size_t)m * D + col) = o0; *(f32x4*)(P.out + (size_t)m * D + col + 4) = o1;
        }
#pragma unroll
        for (int k = 0; k < 2; ++k) { q[k] = nq[k]; nq[k] = nnq[k]; }
#pragma unroll
        for (int k = 0; k < 8; ++k) { e[k] = ne[k]; ne[k] = nne[k]; }
    }
#undef P9_LOAD
}

#ifndef REPEAT_PHASE
#define REPEAT_PHASE -1
#define REPEAT_N 0
#endif
#define RUN_PHASE(k, call) do { call; xcd_barrier(bar, P.wv); \
    if (REPEAT_PHASE == (k) && REPEAT_N >= 1) { call; xcd_barrier(bar, P.wv); } \
    if (REPEAT_PHASE == (k) && REPEAT_N >= 2) { call; xcd_barrier(bar, P.wv); } \
    if (REPEAT_PHASE == (k) && REPEAT_N >= 3) { call; xcd_barrier(bar, P.wv); } } while (0)

struct Args { const void* in[25]; float* out; unsigned char* ws; };

__device__ __forceinline__ void p1_gemm(LAS unsigned char* lds, const Ptrs& P, int G, int bx) { ProbIn pr; pr.xb = P.XB; pr.wt = P.WIN_T; pr.rs1 = P.RS1; pr.pos = P.positions; pr.proj = P.PROJ; pr.G = G; pr.c = bx; pg8::gemm_phase(lds, pr, P.wv); }
__device__ __forceinline__ void p2_seq(LAS unsigned char* lds, const Ptrs& P, int G, int bx) {
    for (int u = bx; u < BATCH * NCH; u += G) lru_unit<false>(lds, u / NCH, u % NCH, P.PROJ, P.conv_w, P.conv_b, P.WAF, P.lru_ba, P.lru_bx, P.lru_lam, P.lru_ng, P.LAP, P.LAH, nullptr, nullptr, nullptr, moe_conv(P), u * 8 * MOE_K0, P.wv);
    ret_kv_phase(lds, P.PROJ, P.KVT, G, bx, P.wv);
}
__device__ __forceinline__ void p4_lru(LAS unsigned char* lds, const Ptrs& P, int G, int bx) {
    for (int u = bx; u < BATCH * NCH; u += G) lru_unit<true>(lds, u / NCH, u % NCH, P.PROJ, P.conv_w, P.conv_b, P.WAF, P.lru_ba, P.lru_bx, P.lru_lam, P.lru_ng, nullptr, nullptr, P.CARRY, P.YCAT, P.RSL, moe_conv(P), MOE_PASS0_ITEMS + u * 8 * MOE_K1, P.wv);
}
__device__ __forceinline__ void p4_ret(LAS unsigned char* lds, const Ptrs& P, int G, int bx) {
    ret_out_phase(lds, P.PROJ, P.PREVT, P.ret_ng, P.ret_nb, P.YCAT, G, bx, P.wv);
}
__device__ __forceinline__ void p4_seq(LAS unsigned char* lds, const Ptrs& P, int G, int bx) {
    for (int u = bx; u < BATCH * NCH; u += G) lru_unit<true>(lds, u / NCH, u % NCH, P.PROJ, P.conv_w, P.conv_b, P.WAF, P.lru_ba, P.lru_bx, P.lru_lam, P.lru_ng, nullptr, nullptr, P.CARRY, P.YCAT, P.RSL, moe_conv(P), MOE_PASS0_ITEMS + u * 8 * MOE_K1, P.wv);
    ret_out_phase(lds, P.PROJ, P.PREVT, P.ret_ng, P.ret_nb, P.YCAT, G, bx, P.wv);
}
__device__ __forceinline__ void p5_gemm(LAS unsigned char* lds, const Ptrs& P, int G, int bx) { ProbOut pr; pr.ycat = P.YCAT; pr.wt = P.WOUT_T; pr.xb = P.XB; pr.rsl = P.RSL; pr.yb01 = P.YB01; pr.x8 = P.X8; pr.ssq = P.SSQ; pr.G = G; pr.c = bx; pg8::gemm_phase(lds, pr, P.wv); }
__device__ __forceinline__ void p7_gemm(LAS unsigned char* lds, const Ptrs& P, int G, int bx, int probe_mode = 0) {
    const MoeTabs tabs = moe_build_tabs(lds, P.ctl, P.wv);
    ProbUp pr; pr.probe_mode = probe_mode; pr.tabs = tabs; pr.x8 = P.X8; pr.wgu = P.WGU8; pr.list = P.LIST; pr.rs2s = P.RS2S; pr.bg = P.moe_bg; pr.bu = P.moe_bu; pr.act = P.ACT; pr.G = G; pr.c = bx;
    pg8::gemm_phase(lds, pr, P.wv);
}
__device__ __forceinline__ void p8_gemm(LAS unsigned char* lds, const Ptrs& P, int G, int bx, int probe_mode = 0) {
    const MoeTabs tabs = moe_build_tabs(lds, P.ctl, P.wv);
    ProbDown pr; pr.probe_mode = probe_mode; pr.tabs = tabs; pr.act = P.ACT; pr.wd = P.WD8; pr.list = P.LIST; pr.gw = P.GW; pr.bd = P.moe_bd; pr.y8 = (unsigned char*)P.YB23; pr.G = G; pr.c = bx;
    pg8::gemm_phase(lds, pr, P.wv);
}

__global__ void __launch_bounds__(NTHREADS, 2) mega_fwd(Args args) {
#ifdef CPU_EMU
    unsigned char* lds_raw = emu::cur->blk->lds;
#else
    extern __shared__ __attribute__((aligned(16))) unsigned char lds_raw[];
#endif
    LAS unsigned char* lds = (LAS unsigned char*)lds_raw;
    volatile LAS unsigned* MISC = (volatile LAS unsigned*)(lds + MISC_OFF);
    const int G = gridDim.x, bx = blockIdx.x;
    unsigned char* ws = args.ws;
    Ptrs P;
    P.wv = __builtin_amdgcn_readfirstlane((int)(threadIdx.x >> 6));
    P.x = (const float*)args.in[0]; P.positions = (const int*)args.in[1]; P.attn_g = (const float*)args.in[2];
    P.w_in = (const float*)args.in[3]; P.conv_w = (const float*)args.in[4]; P.conv_b = (const float*)args.in[5];
    P.lru_wa = (const float*)args.in[6]; P.lru_ba = (const float*)args.in[7]; P.lru_wx = (const float*)args.in[8]; P.lru_bx = (const float*)args.in[9];
    P.lru_lam = (const float*)args.in[10]; P.lru_ng = (const float*)args.in[11]; P.ret_ng = (const float*)args.in[12]; P.ret_nb = (const float*)args.in[13];
    P.w_out = (const float*)args.in[14]; P.ffn_g = (const float*)args.in[15]; P.router_w = (const float*)args.in[16]; P.router_b = (const float*)args.in[17];
    P.moe_wg = (const float*)args.in[18]; P.moe_bg = (const float*)args.in[19]; P.moe_wu = (const float*)args.in[20]; P.moe_bu = (const float*)args.in[21];
    P.moe_wd = (const float*)args.in[22]; P.moe_bd = (const float*)args.in[23]; P.final_g = (const float*)args.in[24];
    P.ctl = (unsigned*)(ws + WS_CTL);
    P.RS1 = (float*)(ws + WS_RS1); P.RS2S = (float*)(ws + WS_RS2S); P.SSQ = (float*)(ws + WS_SSQ); P.GW = (float*)(ws + WS_GW);
    P.LIST = (unsigned*)(ws + WS_LIST); P.LAP = (float*)(ws + WS_LAP); P.LAH = (float*)(ws + WS_LAH); P.CARRY = (float*)(ws + WS_CARRY);
    P.WAF = (bf16_t*)(ws + WS_WAF); P.RSL = (float*)(ws + WS_RSL);
    P.WR_T = (bf16_t*)(ws + WS_WR); P.WIN_T = (bf16_t*)(ws + WS_WIN); P.WOUT_T = (bf16_t*)(ws + WS_WOUT); P.WGU8 = ws + WS_WGU; P.WD8 = ws + WS_WD; P.X8 = ws + WS_X8;
    P.PROJ = (bf16_t*)(ws + WS_PROJ); P.XB = (bf16_t*)(ws + WS_XB); P.YCAT = (bf16_t*)(ws + WS_YCAT); P.ACT = ws + WS_ACT; P.YB23 = (bf16_t*)(ws + WS_YB23);
    P.KVT = (bf16_t*)((unsigned char*)args.out + DO_KVT); P.PREVT = (bf16_t*)((unsigned char*)args.out + DO_PREVT); P.YB01 = (bf16_t*)args.out; P.out = args.out;

    for (int u = (int)threadIdx.x; u < (LDS_BYTES - RING_BYTES) / 4; u += NTHREADS) ((LAS unsigned*)(lds + RING_BYTES))[u] = 0u;
    __syncthreads();
    const XcdBarrier bar = xcd_barrier_post(P.ctl + CW_BAR, MISC + 8, P.wv);

    if (REPEAT_PHASE == 100) { xcd_barrier(bar, P.wv); xcd_barrier(bar, P.wv); xcd_barrier(bar, P.wv); xcd_barrier(bar, P.wv); xcd_barrier(bar, P.wv); xcd_barrier(bar, P.wv); xcd_barrier(bar, P.wv); xcd_barrier(bar, P.wv); }
    RUN_PHASE(0, p0_prologue(lds, P, G, bx));
    RUN_PHASE(1, p1_gemm(lds, P, G, bx));
    RUN_PHASE(2, p2_seq(lds, P, G, bx));
    RUN_PHASE(3, p3_scans(P, G, bx));
    RUN_PHASE(4, p4_seq(lds, P, G, bx));
    if (REPEAT_PHASE == 41) { p4_lru(lds, P, G, bx); xcd_barrier(bar, P.wv); p4_lru(lds, P, G, bx); xcd_barrier(bar, P.wv); }
    if (REPEAT_PHASE == 42) { p4_ret(lds, P, G, bx); xcd_barrier(bar, P.wv); p4_ret(lds, P, G, bx); xcd_barrier(bar, P.wv); }
    RUN_PHASE(5, p5_gemm(lds, P, G, bx));
    RUN_PHASE(6, p6_router(lds, P, G, bx, bar));
    if (REPEAT_PHASE == 71) { p7_gemm(lds, P, G, bx, 1); xcd_barrier(bar, P.wv); p7_gemm(lds, P, G, bx, 1); xcd_barrier(bar, P.wv); }
    if (REPEAT_PHASE == 72) { p7_gemm(lds, P, G, bx, 2); xcd_barrier(bar, P.wv); }
#if REPEAT_PHASE >= 300 && REPEAT_PHASE < 316
    {   const MoeTabs tabs = moe_build_tabs(lds, P.ctl, P.wv);
        ProbUpDiag<REPEAT_PHASE - 300> pr; pr.probe_mode = 1; pr.tabs = tabs; pr.x8 = P.X8; pr.wgu = P.WGU8; pr.list = P.LIST; pr.rs2s = P.RS2S; pr.bg = P.moe_bg; pr.bu = P.moe_bu; pr.act = P.ACT; pr.G = G; pr.c = bx;
        pg8::gemm_phase(lds, pr, P.wv); xcd_barrier(bar, P.wv); pg8::gemm_phase(lds, pr, P.wv); xcd_barrier(bar, P.wv); }
#endif
#if REPEAT_PHASE == 200 || REPEAT_PHASE == 201
    {
        const unsigned long long t0 = __builtin_amdgcn_s_memtime(), r0 = __builtin_amdgcn_s_memrealtime();
        if (REPEAT_PHASE == 200) p7_gemm(lds, P, G, bx, 1); else p1_gemm(lds, P, G, bx);
        const unsigned long long t1 = __builtin_amdgcn_s_memtime(), r1 = __builtin_amdgcn_s_memrealtime();
        if (bx == 0) { const unsigned long long mhz = (t1 - t0) * 100ull / (r1 - r0); while (__builtin_amdgcn_s_memrealtime() - r1 < mhz * 10ull) __builtin_amdgcn_s_sleep(8); }
        xcd_barrier(bar, P.wv);
    }
#endif
    RUN_PHASE(7, p7_gemm(lds, P, G, bx));
    if (REPEAT_PHASE == 81) { p8_gemm(lds, P, G, bx, 1); xcd_barrier(bar, P.wv); p8_gemm(lds, P, G, bx, 1); xcd_barrier(bar, P.wv); }
    RUN_PHASE(8, p8_gemm(lds, P, G, bx));
    if (REPEAT_PHASE == 9) { Ptrs Q = P; Q.out = (float*)P.ACT; p9_final(Q, G, bx); xcd_barrier(bar, P.wv); }
    p9_final(P, G, bx);
}

extern "C" void kernel_launch(void* const* d_in, const int* in_sizes, int n_in, void* d_out, int out_size, void* d_ws, size_t ws_size, hipStream_t stream) {
    static int grid = 0;
    if (grid == 0) {
        if (n_in != 25 || out_size != T * D || ws_size < WS_END) { fprintf(stderr, "kernel_launch: unexpected shapes (n_in %d, out %d, ws %zu, need %zu)\n", n_in, out_size, ws_size, (size_t)WS_END); grid = -1; return; }
        int dev = 0, cus = 0;
        if (hipGetDevice(&dev) != hipSuccess || hipDeviceGetAttribute(&cus, hipDeviceAttributeMultiprocessorCount, dev) != hipSuccess) { fprintf(stderr, "kernel_launch: device query failed\n"); grid = -1; return; }
        if (hipFuncSetAttribute((const void*)mega_fwd, hipFuncAttributeMaxDynamicSharedMemorySize, LDS_BYTES) != hipSuccess) { fprintf(stderr, "kernel_launch: hipFuncSetAttribute failed\n"); grid = -1; return; }
        (void)hipGetLastError();
        if (cus < T / 128 || cus > 256) { fprintf(stderr, "kernel_launch: the router phase needs T/128 <= CUs <= 256 (have %d)\n", cus); grid = -1; return; }
        grid = cus;
    }
    if (grid < 0) return;
    (void)in_sizes;
    (void)hipMemsetAsync((char*)d_ws + WS_CTL, 0, CTL_ZERO_BYTES, stream);
    Args a{};
    for (int i = 0; i < 25; ++i) a.in[i] = d_in[i];
    a.out = (float*)d_out; a.ws = (unsigned char*)d_ws;
    hipLaunchKernelGGL(mega_fwd, dim3(grid), dim3(NTHREADS), LDS_BYTES, stream, a);
}
```

```cpp
#ifndef CPU_EMU
#include <hip/hip_runtime.h>
#include <cstdio>
#define LAS __attribute__((address_space(3)))
#define GAS __attribute__((address_space(1)))
#define ASM_VMCNT(n) asm volatile("s_waitcnt vmcnt(" #n ")" ::: "memory")
#define ASM_LGKMCNT(n) asm volatile("s_waitcnt lgkmcnt(" #n ")" ::: "memory")
#define WAVE_SYNC() do { asm volatile("s_waitcnt lgkmcnt(0)" ::: "memory"); __builtin_amdgcn_wave_barrier(); } while (0)
#define OPAQUE(x) asm volatile("" : "+v"(x))
__device__ __forceinline__ int lane_id_fresh() { int l; asm volatile("v_mbcnt_lo_u32_b32 %0, -1, 0\n\tv_mbcnt_hi_u32_b32 %0, -1, %0" : "=v"(l)); return l; }
#define LANE_ID() lane_id_fresh()
#define SHFLX_F(v, mask, lane) __builtin_bit_cast(float, __builtin_amdgcn_ds_bpermute((((lane) ^ (mask)) << 2), __builtin_bit_cast(int, (float)(v))))
#define SHFLX_I(v, mask, lane) __builtin_amdgcn_ds_bpermute((((lane) ^ (mask)) << 2), (int)(v))
#else
#define ASM_VMCNT(n) ((void)0)
#define ASM_LGKMCNT(n) ((void)0)
#define WAVE_SYNC() emu::wave_collective(nullptr, 0, nullptr, 0, [](emu::Wave&) {})
#define OPAQUE(x) ((void)0)
#define LANE_ID() ((int)emu::cur->lane)
#define SHFLX_F(v, mask, lane) __shfl_xor((float)(v), (mask))
#define SHFLX_I(v, mask, lane) __shfl_xor((int)(v), (mask))
#endif

typedef unsigned short bf16_t;
typedef float f32x4 __attribute__((ext_vector_type(4)));
typedef float f32x2 __attribute__((ext_vector_type(2)));
typedef unsigned u32x4 __attribute__((ext_vector_type(4)));
typedef unsigned u32x2 __attribute__((ext_vector_type(2)));
typedef short bf16x8 __attribute__((ext_vector_type(8)));
typedef short v4i16_t __attribute__((ext_vector_type(4)));
typedef int v8i32_t __attribute__((ext_vector_type(8)));

#ifdef CPU_EMU
constexpr int BATCH = CFG_BATCH, SEQ = CFG_SEQ, NEXP = CFG_NEXP;
#else
constexpr int BATCH = 4, SEQ = 8192, NEXP = 32;
#endif
constexpr int NWAVES = 8, NTHREADS = 512;
constexpr int T = BATCH * SEQ, D = 1024, DIN = 3072, NCH = SEQ / 128, NBH = BATCH * 4;
constexpr int TOPK = 4, NSLOT = T * TOPK;
constexpr float NORM_EPS = 1e-5f;
constexpr int MAXTILES = NSLOT / 256 + NEXP;

constexpr size_t MiB = 1u << 20;
constexpr size_t al256(size_t x) { return (x + 255) & ~(size_t)255; }
constexpr size_t WS_CTL = 0, CTL_ZERO_BYTES = 1 * MiB;
constexpr int CW_BAR = 4096, CW_CNT = 16384;
constexpr size_t WS_RS1 = 1 * MiB;
constexpr size_t WS_RS2 = WS_RS1 + al256((size_t)T * 4);
constexpr size_t WS_SSQ = WS_RS2 + al256((size_t)T * 4);
constexpr size_t WS_GW = WS_SSQ + al256((size_t)16 * T * 4);
constexpr size_t WS_LIST = WS_GW + al256((size_t)NEXP * T * 4);
constexpr size_t WS_RS2S = WS_LIST + al256((size_t)NEXP * T * 4);
constexpr size_t WS_LAP = WS_RS2S + al256((size_t)NEXP * T * 4);
constexpr size_t WS_LAH = WS_LAP + al256((size_t)BATCH * NCH * 512 * 4);
constexpr size_t WS_CARRY = WS_LAH + al256((size_t)BATCH * NCH * 512 * 4);
constexpr size_t WS_WR = WS_CARRY + al256((size_t)BATCH * NCH * 512 * 4);
constexpr size_t WS_WAF = WS_WR + al256((size_t)32 * D * 2);
constexpr size_t WS_RSL = WS_WAF + 2 * 65536;
constexpr size_t WS_WIN = (WS_RSL + al256((size_t)T * 4) + MiB - 1) / MiB * MiB;
constexpr size_t WS_WOUT = WS_WIN + (size_t)DIN * D * 2;
constexpr size_t WS_WGU = WS_WOUT + (size_t)D * D * 2;
constexpr size_t WS_WD = WS_WGU + (size_t)NEXP * 2048 * D;
constexpr size_t WS_X8 = WS_WD + (size_t)NEXP * D * D;
constexpr size_t WS_R1 = WS_X8 + (size_t)T * D;
constexpr size_t WS_PROJ = WS_R1;
constexpr size_t WS_XB = WS_R1 + (size_t)T * DIN * 2;
constexpr size_t WS_ACT = WS_R1;
constexpr size_t WS_YB23 = WS_ACT + (size_t)(NSLOT + 256) * D;
constexpr size_t WS_YCAT = WS_YB23 + (size_t)T * 2 * D * 2;
constexpr size_t WS_END = WS_YCAT + (size_t)T * D * 2;
static_assert(WS_XB + (size_t)T * D * 2 <= WS_END, "map");
constexpr size_t DO_KVT = 0, DO_PREVT = (size_t)T * 1024;
static_assert(2 * (size_t)T * 1024 <= (size_t)T * D * 4, "d_out scratch");

constexpr int RING_BYTES = 131072, MISC_OFF = RING_BYTES + 320, TAB_OFF = RING_BYTES + 1024, LDS_BYTES = 147456;
constexpr int TAB_CNT = TAB_OFF, TAB_EOFF = TAB_CNT + 4 * 64, TAB_TBASE = TAB_EOFF + 4 * 64, TAB_TILEE = TAB_TBASE + 4 * 80;
constexpr int META_OFF = RING_BYTES + 8192;
static_assert(NEXP <= 64 && TAB_TILEE + 2 * MAXTILES + 16 <= META_OFF && META_OFF + 8192 <= LDS_BYTES, "LDS tables");

__device__ __forceinline__ unsigned f2bf(float f) { unsigned u = __builtin_bit_cast(unsigned, f); return (u + 0x7fffu + ((u >> 16) & 1u)) >> 16; }
__device__ __forceinline__ unsigned pk2(float lo, float hi) {
#ifdef CPU_EMU
    return f2bf(lo) | (f2bf(hi) << 16);
#else
    unsigned r; asm volatile("v_cvt_pk_bf16_f32 %0, %1, %2" : "=v"(r) : "v"(lo), "v"(hi)); return r;
#endif
}
__device__ __forceinline__ unsigned pk2v(float lo, float hi) {
#ifdef CPU_EMU
    return f2bf(lo) | (f2bf(hi) << 16);
#else
    unsigned r; asm volatile("s_nop 7\n\ts_nop 7\n\tv_cvt_pk_bf16_f32 %0, %1, %2" : "=v"(r) : "v"(lo), "v"(hi)); return r;
#endif
}
#define unpk2_fp8(w, hi) __builtin_amdgcn_cvt_pk_f32_fp8((int)(w), hi)
__device__ __forceinline__ unsigned pk4_fp8(float a, float b, float c, float d) {
    int r = __builtin_amdgcn_cvt_pk_fp8_f32(a, b, 0, false); r = __builtin_amdgcn_cvt_pk_fp8_f32(c, d, r, true); return (unsigned)r;
}
__device__ __forceinline__ float bf2f(unsigned h) { return __builtin_bit_cast(float, h << 16); }
__device__ __forceinline__ float bflo(unsigned w) { return __builtin_bit_cast(float, w << 16); }
__device__ __forceinline__ float bfhi(unsigned w) { return __builtin_bit_cast(float, w & 0xffff0000u); }
__device__ __forceinline__ float fexp2(float x) { return __builtin_amdgcn_exp2f(x); }
__device__ __forceinline__ float frcp(float x) { return __builtin_amdgcn_rcpf(x); }
__device__ __forceinline__ float sigmoid_f(float x) { return frcp(1.0f + fexp2(-1.4426950408889634f * x)); }
__device__ __forceinline__ float gelu_tanh(float x) { const float u = 0.7978845608028654f * (x + 0.044715f * x * x * x); return x * frcp(1.0f + fexp2(-2.8853900817779268f * u)); }
__device__ __forceinline__ float silu_f(float x) { return x * sigmoid_f(x); }
__device__ __forceinline__ float wave_sum(float v, int lane) {
#pragma unroll
    for (int o = 1; o < 64; o <<= 1) v += SHFLX_F(v, o, lane);
    return v;
}

#define XB_TMO      128
#define XB_XCNT(j)  (256  + 64 * (j))
#define XB_XSUB(j)  (1280 + 64 * (j))
#define XB_XGEN(j)  (2304 + 64 * (j))
#define XB_TOP      3328
#define XB_TOPGEN   3392
#define XCD_BAR_WORDS 3456
#define XB_SPIN_CAP (1u << 20)
__device__ __forceinline__ unsigned xb_ld(unsigned* p)              { return __hip_atomic_load(p, __ATOMIC_RELAXED, __HIP_MEMORY_SCOPE_AGENT); }
__device__ __forceinline__ unsigned xb_add(unsigned* p, unsigned v) { return __hip_atomic_fetch_add(p, v, __ATOMIC_RELAXED, __HIP_MEMORY_SCOPE_AGENT); }
__device__ __forceinline__ unsigned xb_xcc_id() { return (unsigned)__builtin_amdgcn_s_getreg((3 << 11) | 20) & 0xFu; }
#define XB_SPIN(cond, bar) do { unsigned _sp = 0; while (cond) { __builtin_amdgcn_s_sleep(1); \
    if ((++_sp & 255u) == 0u) { if (xb_ld(&(bar)[XB_TMO])) break; if (_sp > XB_SPIN_CAP) { atomicAdd(&(bar)[XB_TMO], 1u); break; } } } } while (0)
struct XcdBarrier { unsigned* bar; unsigned x; volatile LAS unsigned* st; };
__device__ __forceinline__ XcdBarrier xcd_barrier_post(unsigned* bar, volatile LAS unsigned* st, int wv) {
    XcdBarrier b; b.bar = bar; b.x = xb_xcc_id(); b.st = st;
    if (wv == 0 && LANE_ID() == 0) (void)xb_add(&bar[XB_XCNT(b.x)], 1u);
    return b;
}
__device__ __forceinline__ void xcd_barrier_complete(unsigned* bar, unsigned x, unsigned& nloc, unsigned& nx) {
    const unsigned G = gridDim.x;
    unsigned sum, cnt, mine, sp = 0u;
    for (;;) {
        sum = 0u; cnt = 0u; mine = 0u;
#pragma unroll
        for (unsigned j = 0; j < 16; ++j) { const unsigned c = xb_ld(&bar[XB_XCNT(j)]); sum += c; cnt += (c > 0u) ? 1u : 0u; mine = (j == x) ? c : mine; }
        if (sum == G) break;
        __builtin_amdgcn_s_sleep(1);
        if ((++sp & 255u) == 0u) { if (xb_ld(&bar[XB_TMO])) break; if (sp > XB_SPIN_CAP) { atomicAdd(&bar[XB_TMO], 1u); break; } }
    }
    nloc = mine > 0u ? mine : 1u; nx = cnt > 0u ? cnt : 1u;
}
__device__ __forceinline__ void xcd_barrier(const XcdBarrier& b, int wv) {
    ASM_VMCNT(0);
    __syncthreads();
    if (wv == 0 && LANE_ID() == 0) {
        unsigned* bar = b.bar;
        __builtin_amdgcn_s_waitcnt(0);
        unsigned nloc = b.st[0], nx = b.st[1];
        if (nloc == 0u) { xcd_barrier_complete(bar, b.x, nloc, nx); b.st[0] = nloc; b.st[1] = nx; }
        const unsigned old = xb_add(&bar[XB_XSUB(b.x)], 1u);
        const unsigned gen = old / nloc;
        if (old + 1u == (gen + 1u) * nloc) {
            __builtin_amdgcn_fence(__ATOMIC_RELEASE, "agent");
            ASM_VMCNT(0);
            const unsigned og = xb_add(&bar[XB_TOP], 1u);
            const unsigned tg = og / nx;
            if (og + 1u == (tg + 1u) * nx) xb_add(&bar[XB_TOPGEN], 1u);
            else XB_SPIN(xb_ld(&bar[XB_TOPGEN]) == tg, bar);
            __builtin_amdgcn_fence(__ATOMIC_ACQUIRE, "agent");
            xb_add(&bar[XB_XGEN(b.x)], 1u);
            ASM_VMCNT(0);
        } else {
            XB_SPIN(xb_ld(&bar[XB_XGEN(b.x)]) == gen, bar);
            __builtin_amdgcn_fence(__ATOMIC_ACQUIRE, "agent");
            ASM_VMCNT(0);
        }
    }
    __syncthreads();
}

namespace pg8 {
constexpr int BM = 256, BK = 64, HALF = 128, HTB = HALF * BK * 2, STAGE_BYTES = 8 * HTB, NXCD = 8, WGM = 8;
__device__ __forceinline__ int lds_byte(int r, int c) { const int st = (r >> 4) * 2 + (c >> 5), rr = r & 15, cc = c & 31, ob = rr * 64 + cc * 2; return st * 1024 + (ob ^ (((ob >> 9) & 1) << 5)); }
__device__ __forceinline__ void stage_rc(int b, int& R, int& C) { const int st = b / 1024, sb = b % 1024, swz = sb ^ (((sb >> 9) & 1) << 5); R = (st >> 1) * 16 + swz / 64; C = (st & 1) * 32 + (swz % 64) / 2; }
__device__ __forceinline__ int lds_byte8(int r, int fq) { const int st = (r >> 4) * 2 + (fq >> 1), rr = r & 15, ob = rr * 64 + 32 * (fq & 1); return st * 1024 + (ob ^ (((ob >> 9) & 1) << 5)); }
__device__ __forceinline__ int perm32(int rho) { const int n = rho >> 4, i = rho & 15; return 8 * (i >> 2) + 4 * n + (i & 3); }
struct Unit { int pm, pn, e, pos0, nvalid, eoff; };
__device__ __forceinline__ f32x4 mma_fp8(u32x4 a0, u32x4 a1, u32x4 b0, u32x4 b1, f32x4 c) {
    typedef int i32x4 __attribute__((ext_vector_type(4)));
    const v8i32_t a = __builtin_shufflevector(__builtin_bit_cast(i32x4, a0), __builtin_bit_cast(i32x4, a1), 0, 1, 2, 3, 4, 5, 6, 7);
    const v8i32_t b = __builtin_shufflevector(__builtin_bit_cast(i32x4, b0), __builtin_bit_cast(i32x4, b1), 0, 1, 2, 3, 4, 5, 6, 7);
#ifdef CPU_EMU
    return __builtin_amdgcn_mfma_scale_f32_16x16x128_f8f6f4(a, b, c, 0, 0, 0, 0x7F7F7F7F, 0, 0x7F7F7F7F);
#else
    const int one = 0x7F7F7F7F;
    asm volatile("v_mfma_scale_f32_16x16x128_f8f6f4 %0, %1, %2, %0, %3, %3 op_sel_hi:[0,0,0]" : "+v"(c) : "v"(a), "v"(b), "v"(one));
    return c;
#endif
}
__device__ __forceinline__ bool static_order(int i, int G, int c, int nM, int nN, int& pm, int& pn) {
    const int nwg = nM * nN; const long L = (long)i * G + c; if (L >= nwg) return false;
    int wgid = (int)L; { const int q = nwg / NXCD, r = nwg % NXCD, xcd = wgid % NXCD, off = wgid / NXCD; wgid = (xcd < r ? xcd * (q + 1) : r * (q + 1) + (xcd - r) * q) + off; }
    const int nig = WGM * nN, gid = wgid / nig, fm = gid * WGM, gsz = (nM - fm) < WGM ? (nM - fm) : WGM;
    pm = fm + ((wgid % nig) % gsz); pn = (wgid % nig) / gsz; return true;
}

template <class P>
__device__ __forceinline__ void gemm_phase(LAS unsigned char* lds, const P& prob, int wv) {
    int tid_ = wv * 64 + LANE_ID(); OPAQUE(tid_);
    const int tid = tid_, wid = __builtin_amdgcn_readfirstlane(tid >> 6), lane = tid & 63, wr = wid >> 2, wc = wid & 3, fr = lane & 15, fq = lane >> 4;
    constexpr int ROWB = P::FP8 ? 1024 : 2048, NT = ROWB / 128, CH = 1024;
    unsigned voffA[2][2], nvoffA[2][2], voffB[2];
#pragma unroll
    for (int i = 0; i < 2; ++i) { int R, C; stage_rc(tid * 16 + i * 8192, R, C); const int Rb = (R & ~31) + perm32(R & 31);
        voffA[0][i] = (unsigned)(R * ROWB + C * 2); voffA[1][i] = voffA[0][i] + (unsigned)(HALF * ROWB); voffB[i] = (unsigned)(Rb * ROWB + C * 2);
        nvoffA[0][i] = voffA[0][i]; nvoffA[1][i] = voffA[1][i]; }
    const size_t kstep = (size_t)(BK * 2);
    const size_t hstep = (size_t)HALF * ROWB;
    const unsigned ldsw = (unsigned)wid * 1024u;
    const int aoff = lds_byte(wr * 64 + fr, fq * 8), boff = lds_byte(wc * 32 + fr, fq * 8);
#define PG8_SA(b, h) (((b) * 2 + (h)) * HTB)
#define PG8_SB(b, h) ((4 + (b) * 2 + (h)) * HTB)
#define PG8_STAGE(bufoff, gbase, voff) do { if constexpr (!(P::DIAG & 2)) _Pragma("unroll") for (int _i = 0; _i < 2; ++_i) \
        __builtin_amdgcn_global_load_lds((const unsigned*)((const char*)(gbase) + (voff)[_i]), (LAS unsigned*)(lds + (bufoff) + ldsw + _i * 8192), 16, 0, 0); } while (0)
#define PG8_LDA(dst, b, h) do { if constexpr (!(P::DIAG & 1)) _Pragma("unroll") for (int m = 0; m < 4; ++m) _Pragma("unroll") for (int k = 0; k < 2; ++k) dst[m][k] = *(const LAS u32x4*)(lds + PG8_SA(b, h) + aoff + m * 2048 + k * CH); } while (0)
#define PG8_LDB(dst, b, h) do { if constexpr (!(P::DIAG & 1)) _Pragma("unroll") for (int n = 0; n < 2; ++n) _Pragma("unroll") for (int k = 0; k < 2; ++k) dst[n][k] = *(const LAS u32x4*)(lds + PG8_SB(b, h) + boff + n * 2048 + k * CH); } while (0)
#define PG8_MMA(ai, bj, At, Bt) do { if constexpr (!(P::DIAG & 8)) { __builtin_amdgcn_s_setprio(1); _Pragma("unroll") for (int m = 0; m < 4; ++m) _Pragma("unroll") for (int n = 0; n < 2; ++n) { \
        if constexpr (P::FP8) acc[ai][bj][m][n] = mma_fp8(Bt[n][0], Bt[n][1], At[m][0], At[m][1], acc[ai][bj][m][n]); \
        else { _Pragma("unroll") for (int k = 0; k < 2; ++k) acc[ai][bj][m][n] = __builtin_amdgcn_mfma_f32_16x16x32_bf16(__builtin_bit_cast(bf16x8, Bt[n][k]), __builtin_bit_cast(bf16x8, At[m][k]), acc[ai][bj][m][n], 0, 0, 0); } } \
        __builtin_amdgcn_s_setprio(0); } } while (0)
#define PG8_BAR do { if constexpr (!(P::DIAG & 4)) __builtin_amdgcn_s_barrier(); } while (0)
#define PG8_SCHED __builtin_amdgcn_sched_barrier(0)
    Unit cur, nxt; int ui = 0;
    if (!prob.next(0, cur)) return;
    f32x4 acc[2][2][4][2];
#pragma unroll
    for (int a = 0; a < 2; ++a)
#pragma unroll
        for (int b = 0; b < 2; ++b)
#pragma unroll
            for (int m = 0; m < 4; ++m)
#pragma unroll
                for (int n = 0; n < 2; ++n) acc[a][b][m][n] = (f32x4){0.f, 0.f, 0.f, 0.f};
    u32x4 At[4][2] = {}, B0[2][2] = {}, B1[2][2] = {};
    const char* cA = prob.a_base(cur); const char* cB = prob.b_base(cur);
    if constexpr (P::GATHER) prob.a_offsets(cur, tid, voffA);
#define PG8_META(u, par) do { _Pragma("unroll") for (int _j = 0; _j < 2; ++_j) { const int _a = (wid >> 2) + 2 * _j; if (_a < P::NMETA) \
        __builtin_amdgcn_global_load_lds(prob.meta_ptr(u, _a, (wid & 3) * 64 + lane), (LAS unsigned*)(lds + META_OFF + (par) * 4096 + _a * 1024 + (wid & 3) * 256), 4, 0, 0); } } while (0)
    if constexpr (P::NMETA > 0) PG8_META(cur, 0);
    PG8_STAGE(PG8_SB(0, 0), cB, voffB); PG8_STAGE(PG8_SA(0, 0), cA, voffA[0]); PG8_STAGE(PG8_SB(0, 1), cB + hstep, voffB); PG8_STAGE(PG8_SA(0, 1), cA, voffA[1]);
    if (wr == 1) PG8_BAR;
    ASM_VMCNT(4); PG8_BAR;
    PG8_STAGE(PG8_SB(1, 0), cB + kstep, voffB); PG8_STAGE(PG8_SA(1, 0), cA + kstep, voffA[0]); PG8_STAGE(PG8_SB(1, 1), cB + hstep + kstep, voffB);
    ASM_VMCNT(6); PG8_BAR;
    for (;;) {
        const bool has_next = prob.next(ui + 1, nxt);
        const char* nA = has_next ? prob.a_base(nxt) : cA; const char* nB = has_next ? prob.b_base(nxt) : cB;
        for (int t = 0; t < NT; t += 2) {
            const bool last = (t == NT - 2);
            const char* a1 = cA + (size_t)(t + 1) * kstep;
            const char* a2 = last ? nA : cA + (size_t)(t + 2) * kstep; const char* b2 = last ? nB : cB + (size_t)(t + 2) * kstep;
            const char* a3 = a2 + kstep; const char* b3 = b2 + kstep;
            if constexpr (P::GATHER) { if (last && has_next) prob.a_offsets(nxt, tid, nvoffA); }
            unsigned va0[2], va1[2];
#pragma unroll
            for (int i = 0; i < 2; ++i) { va0[i] = (P::GATHER && last) ? nvoffA[0][i] : voffA[0][i]; va1[i] = (P::GATHER && last) ? nvoffA[1][i] : voffA[1][i]; }
            if constexpr (P::MIDK) { if (t == NT / 2) prob.midk(acc, cur, wr, fr, lds + META_OFF + (ui & 1) * 4096); }
            PG8_LDB(B0, 0, 0); PG8_SCHED; PG8_LDA(At, 0, 0); PG8_STAGE(PG8_SA(1, 1), a1, voffA[1]);
            ASM_LGKMCNT(8); ASM_VMCNT(10); PG8_BAR; ASM_LGKMCNT(0); PG8_MMA(0, 0, At, B0); PG8_BAR; PG8_SCHED;
            PG8_LDB(B1, 0, 1); PG8_STAGE(PG8_SB(0, 0), b2, voffB);
            ASM_VMCNT(10); PG8_BAR; ASM_LGKMCNT(0); PG8_MMA(0, 1, At, B1); PG8_BAR;
            PG8_LDA(At, 0, 1); PG8_STAGE(PG8_SA(0, 0), a2, va0);
            PG8_BAR; ASM_LGKMCNT(0); PG8_MMA(1, 0, At, B0); PG8_BAR; PG8_SCHED;
            PG8_STAGE(PG8_SB(0, 1), b2 + hstep, voffB);
            ASM_VMCNT(10); PG8_BAR; PG8_MMA(1, 1, At, B1); PG8_BAR;
            if constexpr (P::NMETA > 0) { if (t == 2 && has_next) PG8_META(nxt, (ui + 1) & 1); }
            PG8_LDB(B0, 1, 0); PG8_SCHED; PG8_LDA(At, 1, 0); PG8_STAGE(PG8_SA(0, 1), a2, va1);
            ASM_LGKMCNT(8); ASM_VMCNT(10); PG8_BAR; ASM_LGKMCNT(0); PG8_MMA(0, 0, At, B0); PG8_BAR; PG8_SCHED;
            PG8_LDB(B1, 1, 1); PG8_STAGE(PG8_SB(1, 0), b3, voffB);
            ASM_VMCNT(10); PG8_BAR; ASM_LGKMCNT(0); PG8_MMA(0, 1, At, B1); PG8_BAR;
            PG8_LDA(At, 1, 1); PG8_STAGE(PG8_SA(1, 0), a3, va0);
            PG8_BAR; ASM_LGKMCNT(0); PG8_MMA(1, 0, At, B0); PG8_BAR; PG8_SCHED;
            PG8_STAGE(PG8_SB(1, 1), b3 + hstep, voffB);
            ASM_VMCNT(10); PG8_BAR; PG8_MMA(1, 1, At, B1); PG8_BAR;
        }
        if (wr == 0) PG8_BAR;
        prob.epi(acc, cur, wr, wc, fr, fq, lds + META_OFF + (ui & 1) * 4096);
        if (!has_next) break;
#pragma unroll
        for (int a = 0; a < 2; ++a)
#pragma unroll
            for (int b = 0; b < 2; ++b)
#pragma unroll
                for (int m = 0; m < 4; ++m)
#pragma unroll
                    for (int n = 0; n < 2; ++n) acc[a][b][m][n] = (f32x4){0.f, 0.f, 0.f, 0.f};
        cur = nxt; cA = nA; cB = nB; ++ui;
        if constexpr (P::GATHER) {
#pragma unroll
            for (int h = 0; h < 2; ++h)
#pragma unroll
                for (int i = 0; i < 2; ++i) voffA[h][i] = nvoffA[h][i];
        }
        if (wr == 1) PG8_BAR;
    }
    ASM_VMCNT(0);
    PG8_BAR;
#undef PG8_META
#undef PG8_SA
#undef PG8_SB
#undef PG8_STAGE
#undef PG8_LDA
#undef PG8_LDB
#undef PG8_MMA
#undef PG8_BAR
#undef PG8_SCHED
}
}
using pg8::Unit;

constexpr float Y8_SCALE = 16.0f;
constexpr float LOG2_THETA_64 = 13.287712379549449f / 64.0f;
__device__ __forceinline__ float log2_gamma(int h) { return __builtin_log2f(1.0f - __builtin_exp2f(-5.0f - (float)h)); }

struct ProbIn {
    static constexpr int DIAG = 0;
    static constexpr bool GATHER = false, MIDK = false, FP8 = false; static constexpr int NMETA = 2;
    const bf16_t* xb; const bf16_t* wt; const float* rs1; const int* pos; bf16_t* proj; int G, c;
    __device__ __forceinline__ bool next(int i, Unit& u) const { u.e = 0; u.pos0 = 0; u.nvalid = 256; u.eoff = 0; return pg8::static_order(i, G, c, T / 256, DIN / 256, u.pm, u.pn); }
    __device__ __forceinline__ const char* a_base(const Unit& u) const { return (const char*)xb + (size_t)u.pm * 256 * D * 2; }
    __device__ __forceinline__ const char* b_base(const Unit& u) const { return (const char*)wt + (size_t)u.pn * 256 * D * 2; }
    __device__ __forceinline__ void a_offsets(const Unit&, int, unsigned (&)[2][2]) const {}
    __device__ __forceinline__ const unsigned* meta_ptr(const Unit& u, int a, int idx) const { return (a == 0 ? (const unsigned*)rs1 : (const unsigned*)pos) + u.pm * 256 + idx; }
    __device__ __forceinline__ void epi(const f32x4 (&acc)[2][2][4][2], const Unit& u, int wr, int wc, int fr, int fq, const LAS unsigned char* mbuf) const {
        const int seg = u.pn >> 1;
        float invf[4];
#pragma unroll
        for (int q = 0; q < 4; ++q) invf[q] = exp2f(-(float)(16 * wc + 4 * fq + q) * LOG2_THETA_64) * 0.15915494309189535f;
#pragma unroll
        for (int ai = 0; ai < 2; ++ai)
#pragma unroll
            for (int m = 0; m < 4; ++m) {
                const int rl = ai * 128 + wr * 64 + m * 16 + fr, row = u.pm * 256 + rl;
                const float rs = *(const LAS float*)(mbuf + rl * 4);
                float cs[4], sn[4];
                if (seg == 2 || seg == 3) {
                    const float p = (float)*(const LAS int*)(mbuf + 1024 + rl * 4);
#pragma unroll
                    for (int q = 0; q < 4; ++q) { float rev = p * invf[q]; rev = rev - floorf(rev); cs[q] = __builtin_amdgcn_cosf(rev); sn[q] = __builtin_amdgcn_sinf(rev); }
                }
#pragma unroll
                for (int bj = 0; bj < 2; ++bj) {
                    f32x4 v0 = acc[ai][bj][m][0] * rs, v1 = acc[ai][bj][m][1] * rs;
                    if (seg == 1) {
#pragma unroll
                        for (int j = 0; j < 4; ++j) { v0[j] = gelu_tanh(v0[j]); v1[j] = gelu_tanh(v1[j]); }
                    } else if (seg == 5) {
#pragma unroll
                        for (int j = 0; j < 4; ++j) { v0[j] = silu_f(v0[j]); v1[j] = silu_f(v1[j]); }
                    } else if (seg == 2 || seg == 3) {
                        const int head = 2 * (u.pn & 1) + bj;
                        const float e1 = (float)((row & 127) + 1) * log2_gamma(head);
                        const float f = (seg == 2) ? exp2f(e1) : exp2f(-e1) * 0.08838834764831845f;
                        f32x4 o0, o1;
                        o0[0] = (v0[0] * cs[0] - v0[1] * sn[0]) * f; o0[1] = (v0[1] * cs[0] + v0[0] * sn[0]) * f;
                        o0[2] = (v0[2] * cs[1] - v0[3] * sn[1]) * f; o0[3] = (v0[3] * cs[1] + v0[2] * sn[1]) * f;
                        o1[0] = (v1[0] * cs[2] - v1[1] * sn[2]) * f; o1[1] = (v1[1] * cs[2] + v1[0] * sn[2]) * f;
                        o1[2] = (v1[2] * cs[3] - v1[3] * sn[3]) * f; o1[3] = (v1[3] * cs[3] + v1[2] * sn[3]) * f;
                        v0 = o0; v1 = o1;
                    }
                    u32x4 w; w.x = pk2(v0[0], v0[1]); w.y = pk2(v0[2], v0[3]); w.z = pk2(v1[0], v1[1]); w.w = pk2(v1[2], v1[3]);
                    *(u32x4*)(proj + (size_t)row * DIN + u.pn * 256 + bj * 128 + wc * 32 + 8 * fq) = w;
                }
            }
    }
};

struct ProbOut {
    static constexpr int DIAG = 0;
    static constexpr bool GATHER = false, MIDK = true, FP8 = false; static constexpr int NMETA = 1;
    const bf16_t* ycat; const bf16_t* wt; const bf16_t* xb; const float* rsl; bf16_t* yb01; unsigned char* x8; float* ssq; int G, c;
    __device__ __forceinline__ void midk(f32x4 (&acc)[2][2][4][2], const Unit&, int wr, int fr, const LAS unsigned char* mbuf) const {
#pragma unroll
        for (int ai = 0; ai < 2; ++ai)
#pragma unroll
            for (int m = 0; m < 4; ++m) { const float sc = *(const LAS float*)(mbuf + (ai * 128 + wr * 64 + m * 16 + fr) * 4);
#pragma unroll
                for (int bj = 0; bj < 2; ++bj)
#pragma unroll
                    for (int n = 0; n < 2; ++n) acc[ai][bj][m][n] *= sc; }
    }
    __device__ __forceinline__ bool next(int i, Unit& u) const { u.e = 0; u.pos0 = 0; u.nvalid = 256; u.eoff = 0; return pg8::static_order(i, G, c, T / 256, D / 256, u.pm, u.pn); }
    __device__ __forceinline__ const char* a_base(const Unit& u) const { return (const char*)ycat + (size_t)u.pm * 256 * D * 2; }
    __device__ __forceinline__ const char* b_base(const Unit& u) const { return (const char*)wt + (size_t)u.pn * 256 * D * 2; }
    __device__ __forceinline__ void a_offsets(const Unit&, int, unsigned (&)[2][2]) const {}
    __device__ __forceinline__ const unsigned* meta_ptr(const Unit& u, int, int idx) const { return (const unsigned*)rsl + u.pm * 256 + idx; }
    __device__ __forceinline__ void epi(const f32x4 (&acc)[2][2][4][2], const Unit& u, int wr, int wc, int fr, int fq, const LAS unsigned char*) const {
#pragma unroll
        for (int ai = 0; ai < 2; ++ai)
#pragma unroll
            for (int m = 0; m < 4; ++m) {
                const int row = u.pm * 256 + ai * 128 + wr * 64 + m * 16 + fr;
                float ss = 0.f;
#pragma unroll
                for (int bj = 0; bj < 2; ++bj) {
                    const int col = u.pn * 256 + bj * 128 + wc * 32 + 8 * fq;
                    const u32x4 xv = *(const u32x4*)(xb + (size_t)row * D + col);
                    const f32x4 x0 = {bflo(xv.x), bfhi(xv.x), bflo(xv.y), bfhi(xv.y)}, x1 = {bflo(xv.z), bfhi(xv.z), bflo(xv.w), bfhi(xv.w)};
                    const f32x4 v0 = acc[ai][bj][m][0] + x0, v1 = acc[ai][bj][m][1] + x1;
                    ss += (v0[0] * v0[0] + v0[1] * v0[1]) + (v0[2] * v0[2] + v0[3] * v0[3]) + (v1[0] * v1[0] + v1[1] * v1[1]) + (v1[2] * v1[2] + v1[3] * v1[3]);
                    u32x4 w; w.x = pk2(v0[0], v0[1]); w.y = pk2(v0[2], v0[3]); w.z = pk2(v1[0], v1[1]); w.w = pk2(v1[2], v1[3]);
                    *(u32x4*)(yb01 + (size_t)row * 2048 + col) = w;
                    u32x2 w8; w8.x = pk4_fp8(v0[0], v0[1], v0[2], v0[3]); w8.y = pk4_fp8(v1[0], v1[1], v1[2], v1[3]);
                    *(u32x2*)(x8 + (size_t)row * D + col) = w8;
                }
                ss += SHFLX_F(ss, 16, fr + 16 * fq); ss += SHFLX_F(ss, 32, fr + 16 * fq);
                if (fq == 0) ssq[(size_t)(u.pn * 4 + wc) * T + row] = ss;
            }
    }
};

struct MoeTabs {
    const LAS unsigned* cnt; const LAS unsigned* eoff; const LAS unsigned* tbase; const LAS unsigned short* tile_e; int ntiles;
    __device__ __forceinline__ bool next(int i, int G, int c, int nN, Unit& u) const {
        int pm, pn; if (!pg8::static_order(i, G, c, ntiles, nN, pm, pn)) return false;
        const int e = __builtin_amdgcn_readfirstlane((int)tile_e[pm]);
        const int tb = __builtin_amdgcn_readfirstlane((int)tbase[e]), ce = __builtin_amdgcn_readfirstlane((int)cnt[e]), eo = __builtin_amdgcn_readfirstlane((int)eoff[e]);
        u.pm = pm; u.pn = pn; u.e = e; u.pos0 = (pm - tb) * 256; u.nvalid = (ce - u.pos0) < 256 ? (ce - u.pos0) : 256; u.eoff = eo; return true;
    }
};
__device__ __forceinline__ MoeTabs moe_build_tabs(LAS unsigned char* lds, const unsigned* ctl, int wv) {
    LAS unsigned* cnt = (LAS unsigned*)(lds + TAB_CNT); LAS unsigned* eoff = (LAS unsigned*)(lds + TAB_EOFF); LAS unsigned* tbase = (LAS unsigned*)(lds + TAB_TBASE);
    LAS unsigned short* tile_e = (LAS unsigned short*)(lds + TAB_TILEE);
    __syncthreads();
    const int l = LANE_ID();
    if (wv == 0 && l < NEXP) cnt[l] = ctl[CW_CNT + 64 * l];
    __syncthreads();
    if (wv == 0 && l < NEXP) {
        unsigned eo = 0, tb = 0;
        for (int j = 0; j < NEXP; ++j) { const unsigned cj = cnt[j]; if (j < l) { eo += cj; tb += (cj + 255u) >> 8; } }
        const unsigned nt = (cnt[l] + 255u) >> 8;
        eoff[l] = eo; tbase[l] = tb;
        for (unsigned t = 0; t < nt; ++t) tile_e[tb + t] = (unsigned short)l;
        if (l == NEXP - 1) tbase[NEXP] = tb + nt;
    }
    __syncthreads();
    MoeTabs mt; mt.cnt = cnt; mt.eoff = eoff; mt.tbase = tbase; mt.tile_e = tile_e; mt.ntiles = __builtin_amdgcn_readfirstlane((int)tbase[NEXP]); return mt;
}

struct ProbUp {
    static constexpr int DIAG = 0;
    static constexpr bool GATHER = true, MIDK = false, FP8 = true; static constexpr int NMETA = 2;
    int probe_mode; MoeTabs tabs; const unsigned char* x8; const unsigned char* wgu; const unsigned* list; const float* rs2s; const float* bg; const float* bu; unsigned char* act; int G, c;
    __device__ __forceinline__ bool next(int i, Unit& u) const { return tabs.next(i, G, c, 8, u); }
    __device__ __forceinline__ const char* a_base(const Unit&) const { return (const char*)x8; }
    __device__ __forceinline__ const char* b_base(const Unit& u) const { return (const char*)wgu + ((size_t)u.e * 2048 + (size_t)u.pn * 256) * D; }
    __device__ __forceinline__ void a_offsets(const Unit& u, int tid, unsigned (&vo)[2][2]) const {
        int R[2], C[2];
#pragma unroll
        for (int i = 0; i < 2; ++i) pg8::stage_rc(tid * 16 + i * 8192, R[i], C[i]);
#pragma unroll
        for (int h = 0; h < 2; ++h)
#pragma unroll
            for (int i = 0; i < 2; ++i) { const int rl = h * 128 + R[i]; const int pos = u.pos0 + (rl < u.nvalid ? rl : 0);
                const unsigned slot = list[(size_t)u.e * T + pos]; vo[h][i] = (slot >> 2) * 1024u + (unsigned)C[i] * 2u; }
    }
    __device__ __forceinline__ const unsigned* meta_ptr(const Unit& u, int a, int idx) const {
        if (a == 0) return (const unsigned*)rs2s + (size_t)u.e * T + u.pos0 + idx;
        return (const unsigned*)(idx < 128 ? bg : bu) + (size_t)u.e * D + u.pn * 128 + (idx & 127);
    }
    __device__ __forceinline__ void epi(const f32x4 (&acc)[2][2][4][2], const Unit& u, int wr, int wc, int fr, int fq, const LAS unsigned char* mbuf) const {
        if (probe_mode == 1) return;
        const int col8 = u.pn * 128 + wc * 32 + 8 * fq;
        f32x4 bgv[2], buv[2];
#pragma unroll
        for (int n = 0; n < 2; ++n) { bgv[n] = *(const LAS f32x4*)(mbuf + 1024 + (wc * 32 + 8 * fq + 4 * n) * 4); buv[n] = *(const LAS f32x4*)(mbuf + 1536 + (wc * 32 + 8 * fq + 4 * n) * 4); }
        float rsv[2][4];
#pragma unroll
        for (int ai = 0; ai < 2; ++ai)
#pragma unroll
            for (int m = 0; m < 4; ++m) { const int rl = ai * 128 + wr * 64 + m * 16 + fr; rsv[ai][m] = *(const LAS float*)(mbuf + rl * 4) * (1.0f / 64.0f);
            }
#pragma unroll
        for (int ai = 0; ai < 2; ++ai)
#pragma unroll
            for (int m = 0; m < 4; ++m) {
                const int rl = ai * 128 + wr * 64 + m * 16 + fr;
                const float rs = rsv[ai][m];
                float o[8];
#pragma unroll
                for (int n = 0; n < 2; ++n)
#pragma unroll
                    for (int jp = 0; jp < 2; ++jp) {
                        const f32x2 ag = {acc[ai][0][m][n][2 * jp], acc[ai][0][m][n][2 * jp + 1]}, au = {acc[ai][1][m][n][2 * jp], acc[ai][1][m][n][2 * jp + 1]};
                        const f32x2 bg2 = {bgv[n][2 * jp], bgv[n][2 * jp + 1]}, bu2 = {buv[n][2 * jp], buv[n][2 * jp + 1]};
                        f32x2 g = ag * rs + bg2, up = au * rs + bu2;
                        g.x = fminf(g.x, 7.0f); g.y = fminf(g.y, 7.0f);
                        up.x = fminf(fmaxf(up.x, -7.0f), 7.0f); up.y = fminf(fmaxf(up.y, -7.0f), 7.0f);
                        const f32x2 z = g * (-1.702f * 1.4426950408889634f);
                        f32x2 e; e.x = fexp2(z.x); e.y = fexp2(z.y);
                        const f32x2 den = e + 1.0f;
                        f32x2 r; r.x = frcp(den.x); r.y = frcp(den.y);
                        const f32x2 res = (g * r) * (up + 1.0f);
                        o[4 * n + 2 * jp] = res.x; o[4 * n + 2 * jp + 1] = res.y;
                    }
                u32x2 w; w.x = pk4_fp8(o[0], o[1], o[2], o[3]); w.y = pk4_fp8(o[4], o[5], o[6], o[7]);
                if (rl < u.nvalid) *(u32x2*)(act + (size_t)(u.eoff + u.pos0 + rl) * D + col8) = w;
            }
    }
};

template <int DG> struct ProbUpDiag : ProbUp { static constexpr int DIAG = DG; };
struct ProbDown {
    static constexpr int DIAG = 0;
    static constexpr bool GATHER = false, MIDK = false, FP8 = true; static constexpr int NMETA = 3;
    int probe_mode; MoeTabs tabs; const unsigned char* act; const unsigned char* wd; const unsigned* list; const float* gw; const float* bd; unsigned char* y8; int G, c;
    __device__ __forceinline__ bool next(int i, Unit& u) const { return tabs.next(i, G, c, 4, u); }
    __device__ __forceinline__ const char* a_base(const Unit& u) const { return (const char*)act + (size_t)(u.eoff + u.pos0) * D; }
    __device__ __forceinline__ const char* b_base(const Unit& u) const { return (const char*)wd + ((size_t)u.e * D + (size_t)u.pn * 256) * D; }
    __device__ __forceinline__ void a_offsets(const Unit&, int, unsigned (&)[2][2]) const {}
    __device__ __forceinline__ const unsigned* meta_ptr(const Unit& u, int a, int idx) const {
        if (a == 2) return (const unsigned*)bd + (size_t)u.e * D + u.pn * 256 + idx;
        return (a == 0 ? list : (const unsigned*)gw) + (size_t)u.e * T + u.pos0 + idx;
    }
    __device__ __forceinline__ void epi(const f32x4 (&acc)[2][2][4][2], const Unit& u, int wr, int wc, int fr, int fq, const LAS unsigned char* mbuf) const {
        if (probe_mode == 1) return;
        const int cofs = u.pn * 256 + wc * 32 + 8 * fq;
        f32x4 bdv[2][2];
#pragma unroll
        for (int bj = 0; bj < 2; ++bj) { bdv[bj][0] = *(const LAS f32x4*)(mbuf + 2048 + (bj * 128 + wc * 32 + 8 * fq) * 4); bdv[bj][1] = *(const LAS f32x4*)(mbuf + 2048 + (bj * 128 + wc * 32 + 8 * fq + 4) * 4); }
#pragma unroll
        for (int ai = 0; ai < 2; ++ai)
#pragma unroll
            for (int m = 0; m < 4; ++m) {
                const int rl = ai * 128 + wr * 64 + m * 16 + fr;
                const unsigned sl = *(const LAS unsigned*)(mbuf + rl * 4);
                const float g = *(const LAS float*)(mbuf + 1024 + rl * 4), s1 = g * (Y8_SCALE / 64.0f), s2 = g * Y8_SCALE;
                unsigned char* dst = y8 + (size_t)sl * D + cofs;
#pragma unroll
                for (int bj = 0; bj < 2; ++bj) {
                    const f32x4 v0 = acc[ai][bj][m][0] * s1 + bdv[bj][0] * s2, v1 = acc[ai][bj][m][1] * s1 + bdv[bj][1] * s2;
                    u32x2 w; w.x = pk4_fp8(v0[0], v0[1], v0[2], v0[3]); w.y = pk4_fp8(v1[0], v1[1], v1[2], v1[3]);
                    if (rl < u.nvalid) *(u32x2*)(dst + bj * 128) = w;
                }
            }
    }
};

struct P0Item { const float* W; const float* scale; void* WT; int N, mode, off, k0, n0, fp8; };
__device__ __forceinline__ int p0_dest(const P0Item& d, int n) {
    if (d.mode == 1) { const int seg = n >> 9; if (seg == 2 || seg == 3) { const int w = n & 511, head = w >> 7, dd = w & 127; return (seg << 9) + (head << 7) + 2 * (dd & 63) + (dd >> 6); } return n; }
    if (d.mode == 2) return d.off + 256 * (n >> 7) + (n & 127);
    return d.off + n;
}
constexpr int P0_I_IN = 16 * (DIN / 64), P0_I_OUT = 16 * (D / 64), P0_I_E = 16 * (D / 64), P0_NITEMS_ALL = P0_I_IN + P0_I_OUT + 3 * NEXP * P0_I_E;
__device__ __forceinline__ void p0_load(const P0Item& d, int lane, f32x4 (&v)[16], float& sc) {
#pragma unroll
    for (int i = 0; i < 16; ++i) v[i] = *(const f32x4*)(d.W + (size_t)(d.k0 + (lane >> 4) + 4 * i) * d.N + d.n0 + 4 * (lane & 15));
    sc = d.scale ? d.scale[d.k0 + lane] : 1.0f;
    if (d.fp8) sc *= 64.0f;
}
__device__ __forceinline__ void p0_process(const P0Item& d, int lane, const f32x4 (&v)[16], float sc, LAS unsigned char* scr) {
    LAS float* ssc = (LAS float*)(scr + 64 * 136);
    ssc[lane] = sc;
    WAVE_SYNC();
#pragma unroll
    for (int i = 0; i < 16; ++i) { const int kk = (lane >> 4) + 4 * i; const float f = ssc[kk];
        u32x2 o; o.x = pk2(v[i].x * f, v[i].y * f); o.y = pk2(v[i].z * f, v[i].w * f);
        *(LAS u32x2*)(scr + kk * 136 + 8 * (lane & 15)) = o; }
    WAVE_SYNC();
    const int q = (lane & 15) >> 2, p = lane & 3;
    if (d.fp8) {
#pragma unroll
        for (int st = 0; st < 4; ++st) {
            const int n16 = 16 * st; unsigned o[4];
#pragma unroll
            for (int hf = 0; hf < 2; ++hf) {
                const int kb8 = 2 * (lane >> 4) + hf;
                const v4i16_t lo = __builtin_amdgcn_ds_read_tr16_b64_v4i16((LAS v4i16_t*)(scr + (8 * kb8 + q) * 136 + (n16 + 4 * p) * 2));
                const v4i16_t hi = __builtin_amdgcn_ds_read_tr16_b64_v4i16((LAS v4i16_t*)(scr + (8 * kb8 + 4 + q) * 136 + (n16 + 4 * p) * 2));
                o[2 * hf] = pk4_fp8(bf2f((unsigned short)lo[0]), bf2f((unsigned short)lo[1]), bf2f((unsigned short)lo[2]), bf2f((unsigned short)lo[3]));
                o[2 * hf + 1] = pk4_fp8(bf2f((unsigned short)hi[0]), bf2f((unsigned short)hi[1]), bf2f((unsigned short)hi[2]), bf2f((unsigned short)hi[3]));
            }
            *(u32x4*)((unsigned char*)d.WT + (size_t)p0_dest(d, d.n0 + n16 + (lane & 15)) * D + d.k0 + 16 * (lane >> 4)) = (u32x4){o[0], o[1], o[2], o[3]};
        }
    } else {
#pragma unroll
    for (int st = 0; st < 8; ++st) {
        const int n16 = 16 * (st & 3), kb8 = (st >> 2) * 4 + (lane >> 4);
        const v4i16_t lo = __builtin_amdgcn_ds_read_tr16_b64_v4i16((LAS v4i16_t*)(scr + (8 * kb8 + q) * 136 + (n16 + 4 * p) * 2));
        const v4i16_t hi = __builtin_amdgcn_ds_read_tr16_b64_v4i16((LAS v4i16_t*)(scr + (8 * kb8 + 4 + q) * 136 + (n16 + 4 * p) * 2));
        u32x4 o; o.x = (unsigned)(unsigned short)lo[0] | ((unsigned)(unsigned short)lo[1] << 16); o.y = (unsigned)(unsigned short)lo[2] | ((unsigned)(unsigned short)lo[3] << 16);
        o.z = (unsigned)(unsigned short)hi[0] | ((unsigned)(unsigned short)hi[1] << 16); o.w = (unsigned)(unsigned short)hi[2] | ((unsigned)(unsigned short)hi[3] << 16);
        *(u32x4*)((bf16_t*)d.WT + (size_t)p0_dest(d, d.n0 + n16 + (lane & 15)) * D + d.k0 + 8 * kb8) = o;
    }
    }
    WAVE_SYNC();
}

#ifndef STREAM_FINAL
#define STREAM_FINAL 1
#endif
#define STREAM_IN_PASS(fin) ((fin) ? (STREAM_FINAL != 0) : true)
struct MoeConv { const float *wg, *wu, *wd, *ffn_g; unsigned char *wgu8, *wd8; };
constexpr int MOE_ITEMS = 3 * NEXP * P0_I_E, NLRU = BATCH * NCH;
constexpr int MOE_PER_WU = (MOE_ITEMS + NLRU * 8 - 1) / (NLRU * 8);
constexpr int MOE_K0 = MOE_PER_WU >= 12 ? 8 : (MOE_PER_WU * 2 + 2) / 3, MOE_K1_RAW = MOE_PER_WU - MOE_K0, MOE_K1 = MOE_K1_RAW < 0 ? 0 : (MOE_K1_RAW > 8 ? 8 : MOE_K1_RAW);
constexpr int MOE_PASS0_ITEMS = NLRU * 8 * MOE_K0, MOE_CAP = NLRU * 8 * (MOE_K0 + MOE_K1), MOE_STREAMED = MOE_ITEMS < MOE_CAP ? MOE_ITEMS : MOE_CAP;
constexpr int P0_NITEMS = P0_NITEMS_ALL - MOE_STREAMED;
__device__ __forceinline__ P0Item moe_item(const MoeConv& M, int it) {
    P0Item d; d.scale = nullptr; d.off = 0; d.mode = 0; d.fp8 = 1; d.N = D;
    const int e = it / (3 * P0_I_E), q = (it / P0_I_E) % 3, r = it % P0_I_E;
    if (q == 0) { d.W = M.wg + (size_t)e * D * D; d.scale = M.ffn_g; d.WT = M.wgu8; d.mode = 2; d.off = e * 2048; }
    else if (q == 1) { d.W = M.wu + (size_t)e * D * D; d.scale = M.ffn_g; d.WT = M.wgu8; d.mode = 2; d.off = e * 2048 + 128; }
    else { d.W = M.wd + (size_t)e * D * D; d.WT = M.wd8; d.off = e * D; }
    d.k0 = 64 * (r / (D / 64)); d.n0 = 64 * (r % (D / 64)); return d;
}

constexpr int RT_STRIDE = 272;
constexpr int LDS_VT = 0, LDS_KT = 128 * RT_STRIDE;
constexpr int XA_STRIDE = 144, XA_WAVE = 16 * XA_STRIDE;
constexpr int AG_STRIDE = 520, AG_WAVE = 16 * AG_STRIDE;
constexpr int LRU_WAVE = XA_WAVE + AG_WAVE;
constexpr int LDS_XA = 0, LDS_SS = 8 * LRU_WAVE, LDS_RSL = LDS_SS + 8 * 128 * 4;
static_assert(LRU_WAVE % 16 == 0 && LRU_WAVE >= 64 * 136 + 256, "LRU per-wave LDS block must hold one weight item");
static_assert(LDS_RSL + 512 <= RING_BYTES && LDS_KT + 128 * RT_STRIDE <= RING_BYTES, "LDS seq map");

__device__ __forceinline__ bf16x8 tr_frag(const LAS unsigned char* tile, int row0, int col0, int fr) {
    const int q = fr >> 2, p = fr & 3;
    const v4i16_t lo = __builtin_amdgcn_ds_read_tr16_b64_v4i16((LAS v4i16_t*)(tile + (row0 + q) * RT_STRIDE + (col0 + 4 * p) * 2));
    const v4i16_t hi = __builtin_amdgcn_ds_read_tr16_b64_v4i16((LAS v4i16_t*)(tile + (row0 + 4 + q) * RT_STRIDE + (col0 + 4 * p) * 2));
    bf16x8 r; r[0] = lo[0]; r[1] = lo[1]; r[2] = lo[2]; r[3] = lo[3]; r[4] = hi[0]; r[5] = hi[1]; r[6] = hi[2]; r[7] = hi[3]; return r;
}
__device__ __forceinline__ void stage_tile(LAS unsigned char* dst, const bf16_t* src, int tid) {
#pragma unroll
    for (int i = 0; i < 4; ++i) { const int p = tid + 512 * i, r = p >> 4, c = p & 15;
        const u32x4 v = *(const u32x4*)(src + (size_t)r * DIN + c * 8); *(LAS u32x4*)(dst + r * RT_STRIDE + c * 16) = v; }
}

template <bool FINAL>
__device__ __forceinline__ void lru_unit(LAS unsigned char* lds, int b, int n, const bf16_t* __restrict__ proj, const float* __restrict__ conv_w, const float* __restrict__ conv_b, const bf16_t* __restrict__ waf,
                                         const float* __restrict__ ba, const float* __restrict__ bx, const float* __restrict__ lam, const float* __restrict__ lru_ng,
                                         float* __restrict__ lap, float* __restrict__ lah, const float* __restrict__ carry, bf16_t* __restrict__ ycat, float* __restrict__ rsl_out, const MoeConv& MC, int item0, int wv) {
    int tid_ = wv * 64 + LANE_ID(); OPAQUE(tid_);
    const int tid = tid_, lane = tid & 63, w = __builtin_amdgcn_readfirstlane(tid >> 6), fr = lane & 15, fq = lane >> 4, c = tid;
    LAS unsigned char* xa = lds + LDS_XA + w * LRU_WAVE; LAS unsigned char* ag = xa + XA_WAVE;
    LAS float* ss = (LAS float*)(lds + LDS_SS);
    bf16x8 Ba[2][4], Bx[2][4];
#pragma unroll
    for (int ks = 0; ks < 2; ++ks)
#pragma unroll
        for (int nt = 0; nt < 4; ++nt) { const size_t fi = ((size_t)(w * 2 + ks) * 4 + nt) * 64 + lane; Ba[ks][nt] = *(const bf16x8*)(waf + fi * 8); Bx[ks][nt] = *(const bf16x8*)(waf + (fi + 4096) * 8); }
    float bav[4], bxv[4], spl[4];
#pragma unroll
    for (int nt = 0; nt < 4; ++nt) { const int co = w * 64 + 16 * nt + fr; bav[nt] = ba[co]; bxv[nt] = bx[co]; const float l = lam[co];
        spl[nt] = -8.0f * 1.4426950408889634f * (fmaxf(-l, 0.f) + log1pf(expf(-fabsf(l)))); }
    const float w0 = conv_w[c], w1 = conv_w[512 + c], w2 = conv_w[1024 + c], w3 = conv_w[1536 + c], cb = conv_b[c];
    const float gn = FINAL ? lru_ng[c] : 0.f;
    const size_t t0 = (size_t)b * SEQ + (size_t)n * 128;
    float xm3 = 0.f, xm2 = 0.f, xm1 = 0.f;
    if (n > 0) { xm3 = bf2f(proj[(t0 - 3) * DIN + c]); xm2 = bf2f(proj[(t0 - 2) * DIN + c]); xm1 = bf2f(proj[(t0 - 1) * DIN + c]); }
    float h = FINAL ? carry[((size_t)b * NCH + n) * 512 + c] : 0.f, P = 1.f;
    unsigned xr[16];
#pragma unroll
    for (int i = 0; i < 16; ++i) xr[i] = proj[(t0 + i) * DIN + c];
    for (int tt = 0; tt < 8; ++tt) {
        float xcv[16]; unsigned gr[16];
#pragma unroll
        for (int i = 0; i < 16; ++i) { xcv[i] = bf2f(xr[i]); gr[i] = FINAL ? (unsigned)proj[(t0 + tt * 16 + i) * DIN + 512 + c] : 0u; }
        if (tt < 7) {
#pragma unroll
            for (int i = 0; i < 16; ++i) xr[i] = proj[(t0 + (tt + 1) * 16 + i) * DIN + c];
        }
        constexpr int KP = FINAL ? MOE_K1 : MOE_K0;
        const int cit = item0 + (w * KP + tt);
        const bool chas = (tt < KP) && (cit < MOE_STREAMED);
        P0Item cd; f32x4 cv[16]; float csc = 1.f;
        if (chas) { cd = moe_item(MC, cit); p0_load(cd, lane, cv, csc); }
#pragma unroll
        for (int i = 0; i < 16; ++i) {
            const float x0 = xcv[i];
            const float xc = w0 * xm3 + w1 * xm2 + w2 * xm1 + w3 * x0 + cb;
            xm3 = xm2; xm2 = xm1; xm1 = x0; xcv[i] = xc;
            *(LAS bf16_t*)(xa + i * XA_STRIDE + lane * 2) = (bf16_t)f2bf(xc);
        }
        WAVE_SYNC();
        bf16x8 af[2];
#pragma unroll
        for (int ks = 0; ks < 2; ++ks) af[ks] = *(const LAS bf16x8*)(xa + fr * XA_STRIDE + (32 * ks + 8 * fq) * 2);
#pragma unroll
        for (int nt = 0; nt < 4; ++nt) {
            f32x4 ar = {0.f, 0.f, 0.f, 0.f}, ai = {0.f, 0.f, 0.f, 0.f};
#pragma unroll
            for (int ks = 0; ks < 2; ++ks) { ar = __builtin_amdgcn_mfma_f32_16x16x32_bf16(af[ks], Ba[ks][nt], ar, 0, 0, 0); ai = __builtin_amdgcn_mfma_f32_16x16x32_bf16(af[ks], Bx[ks][nt], ai, 0, 0, 0); }
#pragma unroll
            for (int r = 0; r < 4; ++r) {
                const float rr = sigmoid_f(ar[r] + bav[nt]), ii = sigmoid_f(ai[r] + bxv[nt]);
                const float a = fexp2(rr * spl[nt]);
                const float g = sqrtf(fmaxf(1.0f - a * a, 0.f)) * ii;
                *(LAS f32x2*)(ag + (4 * fq + r) * AG_STRIDE + (16 * nt + fr) * 8) = (f32x2){a, g};
            }
        }
        WAVE_SYNC();
        unsigned upk[8];
#pragma unroll
        for (int i = 0; i < 16; ++i) {
            const f32x2 v = *(const LAS f32x2*)(ag + i * AG_STRIDE + lane * 8);
            h = v.x * h + v.y * xcv[i];
            if (!FINAL) P *= v.x;
            if (FINAL) {
                const float u = h * bf2f(gr[i]);
                const unsigned ub = f2bf(u * gn);
                if (i & 1) upk[i >> 1] |= ub << 16; else upk[i >> 1] = ub;
                *(LAS float*)(ag + i * AG_STRIDE + lane * 8) = u;
            }
        }
        if (FINAL) {
            WAVE_SYNC();
            const int tk = lane & 15, qd = lane >> 4; float s = 0.f;
#pragma unroll
            for (int i = 0; i < 16; ++i) { const float u = *(const LAS float*)(ag + tk * AG_STRIDE + (16 * qd + i) * 8); s += u * u; }
            s += SHFLX_F(s, 16, lane); s += SHFLX_F(s, 32, lane);
            if (qd == 0) ss[w * 128 + tt * 16 + tk] = s;
        }
        WAVE_SYNC();
        if (chas) p0_process(cd, lane, cv, csc, xa);
        if (FINAL) {
#pragma unroll
            for (int i = 0; i < 16; ++i) ycat[(t0 + tt * 16 + i) * D + c] = (bf16_t)((i & 1) ? (upk[i >> 1] >> 16) : (upk[i >> 1] & 0xffffu));
        }
    }
    if (!FINAL) { lap[((size_t)b * NCH + n) * 512 + c] = P; lah[((size_t)b * NCH + n) * 512 + c] = h; }
    else {
        __syncthreads();
        if (tid < 128) { float tot = 0.f;
#pragma unroll
            for (int q = 0; q < 8; ++q) tot += ss[q * 128 + tid];
            rsl_out[t0 + tid] = 1.0f / sqrtf(tot * (1.0f / 512.0f) + NORM_EPS); }
    }
    __syncthreads();
}

__device__ __forceinline__ void ret_kv_load(u32x4 (&tk)[4], u32x4 (&tv)[4], int unit, const bf16_t* __restrict__ proj, int tid) {
    const int bh = unit / NCH, n = unit % NCH, b = bh >> 2, hh = bh & 3;
    const size_t t0 = (size_t)b * SEQ + (size_t)n * 128;
#pragma unroll
    for (int i = 0; i < 4; ++i) { const int p = tid + 512 * i, r = p >> 4, c = p & 15;
        tk[i] = *(const u32x4*)(proj + (t0 + r) * DIN + 1536 + hh * 128 + c * 8); tv[i] = *(const u32x4*)(proj + (t0 + r) * DIN + 2048 + hh * 128 + c * 8); }
}
__device__ __forceinline__ void ret_kv_stage(LAS unsigned char* lds, const u32x4 (&tk)[4], const u32x4 (&tv)[4], int tid) {
#pragma unroll
    for (int i = 0; i < 4; ++i) { const int p = tid + 512 * i, r = p >> 4, c = p & 15;
        *(LAS u32x4*)(lds + LDS_KT + r * RT_STRIDE + c * 16) = tk[i]; *(LAS u32x4*)(lds + LDS_VT + r * RT_STRIDE + c * 16) = tv[i]; }
}
__device__ __forceinline__ void ret_kv_phase(LAS unsigned char* lds, const bf16_t* __restrict__ proj, bf16_t* __restrict__ kvt, int G, int bx, int wv) {
    int tid_ = wv * 64 + LANE_ID(); OPAQUE(tid_);
    const int tid = tid_, lane = tid & 63, w = wv, fr = lane & 15, fq = lane >> 4;
    u32x4 tk[4], tv[4];
    int unit = bx;
    if (unit < NBH * NCH) { ret_kv_load(tk, tv, unit, proj, tid); ret_kv_stage(lds, tk, tv, tid); __syncthreads(); if (unit + G < NBH * NCH) ret_kv_load(tk, tv, unit + G, proj, tid); }
    for (; unit < NBH * NCH; unit += G) {
        f32x4 acc[8];
#pragma unroll
        for (int et = 0; et < 8; ++et) acc[et] = (f32x4){0.f, 0.f, 0.f, 0.f};
#pragma unroll
        for (int ks = 0; ks < 4; ++ks) {
            const bf16x8 af = tr_frag(lds + LDS_KT, 32 * ks + 8 * fq, 16 * w, fr);
#pragma unroll
            for (int et = 0; et < 8; ++et) { const bf16x8 bfv = tr_frag(lds + LDS_VT, 32 * ks + 8 * fq, 16 * et, fr);
                acc[et] = __builtin_amdgcn_mfma_f32_16x16x32_bf16(af, bfv, acc[et], 0, 0, 0); }
        }
        u32x2 o[8];
#pragma unroll
        for (int et = 0; et < 8; ++et) { o[et].x = pk2v(acc[et][0], acc[et][1]); o[et].y = pk2v(acc[et][2], acc[et][3]); }
        __syncthreads();
        if (unit + G < NBH * NCH) ret_kv_stage(lds, tk, tv, tid);
        bf16_t* out = kvt + (size_t)unit * 16384;
#pragma unroll
        for (int et = 0; et < 8; ++et) *(u32x2*)(out + (size_t)(16 * et + fr) * 128 + 16 * w + 4 * fq) = o[et];
        __syncthreads();
        if (unit + 2 * G < NBH * NCH) ret_kv_load(tk, tv, unit + 2 * G, proj, tid);
    }
}

__device__ __forceinline__ int swz_off(int row, int chunk) { return row * 256 + ((chunk ^ (row & 15)) << 4); }
constexpr int LDS_RV = 0, LDS_RK = 32768, LDS_RP = 65536, LDS_RPT = 98304;
__device__ __forceinline__ bf16x8 tr_frag_swz(const LAS unsigned char* tile, int row0, int col0, int fr) {
    const int q = fr >> 2, p = fr & 3, ch = (col0 >> 3) + (p >> 1), bo = (p & 1) * 8;
    const v4i16_t lo = __builtin_amdgcn_ds_read_tr16_b64_v4i16((LAS v4i16_t*)(tile + swz_off(row0 + q, ch) + bo));
    const v4i16_t hi = __builtin_amdgcn_ds_read_tr16_b64_v4i16((LAS v4i16_t*)(tile + swz_off(row0 + 4 + q, ch) + bo));
    bf16x8 r; r[0] = lo[0]; r[1] = lo[1]; r[2] = lo[2]; r[3] = lo[3]; r[4] = hi[0]; r[5] = hi[1]; r[6] = hi[2]; r[7] = hi[3]; return r;
}
struct RetRegs { u32x4 tv[4], tk[4], tp[4]; bf16x8 bq[4]; u32x2 sg[8]; };
__device__ __forceinline__ void ret_out_load(RetRegs& R, int unit, const bf16_t* __restrict__ proj, const bf16_t* __restrict__ prevt, int tid, int w, int fr, int fq) {
    const int bh = unit / NCH, n = unit % NCH, b = bh >> 2, hh = bh & 3;
    const size_t t0 = (size_t)b * SEQ + (size_t)n * 128;
#pragma unroll
    for (int i = 0; i < 4; ++i) { const int p = tid + 512 * i, r = p >> 4, c = p & 15;
        R.tv[i] = *(const u32x4*)(proj + (t0 + r) * DIN + 2048 + hh * 128 + c * 8);
        R.tk[i] = *(const u32x4*)(proj + (t0 + r) * DIN + 1536 + hh * 128 + c * 8);
        R.tp[i] = *(const u32x4*)(prevt + (size_t)unit * 16384 + r * 128 + c * 8); }
#pragma unroll
    for (int ks = 0; ks < 4; ++ks) R.bq[ks] = *(const bf16x8*)(proj + (t0 + 16 * w + fr) * DIN + 1024 + hh * 128 + 32 * ks + 8 * fq);
#pragma unroll
    for (int et = 0; et < 8; ++et) R.sg[et] = *(const u32x2*)(proj + (t0 + 16 * w + fr) * DIN + 2560 + hh * 128 + 16 * et + 4 * fq);
}
__device__ __forceinline__ void ret_out_phase(LAS unsigned char* lds, const bf16_t* __restrict__ proj, const bf16_t* __restrict__ prevt, const float* __restrict__ gng, const float* __restrict__ gnb, bf16_t* __restrict__ ycat, int G, int bx, int wv) {
    int tid_ = wv * 64 + LANE_ID(); OPAQUE(tid_);
    const int tid = tid_, lane = tid & 63, w = __builtin_amdgcn_readfirstlane(tid >> 6), fr = lane & 15, fq = lane >> 4;
    RetRegs R;
    int unit = bx;
    bf16x8 bq[4]; u32x2 sg[8];
    if (unit < NBH * NCH) {
        ret_out_load(R, unit, proj, prevt, tid, w, fr, fq);
#pragma unroll
        for (int i = 0; i < 4; ++i) { const int p = tid + 512 * i, r = p >> 4, c = p & 15, o = swz_off(r, c);
            *(LAS u32x4*)(lds + LDS_RV + o) = R.tv[i]; *(LAS u32x4*)(lds + LDS_RK + o) = R.tk[i]; *(LAS u32x4*)(lds + LDS_RP + o) = R.tp[i]; }
#pragma unroll
        for (int ks = 0; ks < 4; ++ks) bq[ks] = R.bq[ks];
#pragma unroll
        for (int et = 0; et < 8; ++et) sg[et] = R.sg[et];
        __syncthreads();
        if (unit + G < NBH * NCH) ret_out_load(R, unit + G, proj, prevt, tid, w, fr, fq);
    }
    for (; unit < NBH * NCH; unit += G) {
        const int bh = unit / NCH, n = unit % NCH, b = bh >> 2, hh = bh & 3;
        const size_t t0 = (size_t)b * SEQ + (size_t)n * 128;
        const int crow = 16 * w + fr;
#pragma unroll
        for (int mt = 0; mt < 8; ++mt) {
            if (mt <= w) {
                f32x4 sacc = {0.f, 0.f, 0.f, 0.f};
#pragma unroll
                for (int ks = 0; ks < 4; ++ks) { const bf16x8 ak = *(const LAS bf16x8*)(lds + LDS_RK + swz_off(16 * mt + fr, 4 * ks + fq));
                    sacc = __builtin_amdgcn_mfma_f32_16x16x32_bf16(ak, bq[ks], sacc, 0, 0, 0); }
                if (mt == w) {
#pragma unroll
                    for (int r = 0; r < 4; ++r) if (4 * fq + r > fr) sacc[r] = 0.f;
                }
                u32x2 o; o.x = pk2v(sacc[0], sacc[1]); o.y = pk2v(sacc[2], sacc[3]);
                *(LAS u32x2*)(lds + LDS_RPT + swz_off(crow, 2 * mt + (fq >> 1)) + (fq & 1) * 8) = o;
            } else if (mt == w + 1 && (mt & 1)) {
                *(LAS u32x2*)(lds + LDS_RPT + swz_off(crow, 2 * mt + (fq >> 1)) + (fq & 1) * 8) = (u32x2){0u, 0u};
            }
        }
        WAVE_SYNC();
        f32x4 acc[8];
#pragma unroll
        for (int et = 0; et < 8; ++et) acc[et] = (f32x4){0.f, 0.f, 0.f, 0.f};
        const int nks = (w + 2) >> 1;
#pragma unroll
        for (int ksm = 0; ksm < 4; ++ksm) {
            if (ksm < nks) {
                const bf16x8 bp = *(const LAS bf16x8*)(lds + LDS_RPT + swz_off(crow, 4 * ksm + fq));
#pragma unroll
                for (int et = 0; et < 8; ++et) { const bf16x8 av = tr_frag_swz(lds + LDS_RV, 32 * ksm + 8 * fq, 16 * et, fr);
                    acc[et] = __builtin_amdgcn_mfma_f32_16x16x32_bf16(av, bp, acc[et], 0, 0, 0); }
            }
        }
#pragma unroll
        for (int et = 0; et < 8; ++et)
#pragma unroll
            for (int ks = 0; ks < 4; ++ks) { const bf16x8 ap = *(const LAS bf16x8*)(lds + LDS_RP + swz_off(16 * et + fr, 4 * ks + fq));
                acc[et] = __builtin_amdgcn_mfma_f32_16x16x32_bf16(ap, bq[ks], acc[et], 0, 0, 0); }
        float s1 = 0.f;
#pragma unroll
        for (int et = 0; et < 8; ++et) s1 += (acc[et][0] + acc[et][1]) + (acc[et][2] + acc[et][3]);
        s1 += SHFLX_F(s1, 16, lane); s1 += SHFLX_F(s1, 32, lane);
        const float mu = s1 * (1.0f / 128.0f);
        float s2 = 0.f;
#pragma unroll
        for (int et = 0; et < 8; ++et)
#pragma unroll
            for (int r = 0; r < 4; ++r) { const float dlt = acc[et][r] - mu; s2 += dlt * dlt; }
        s2 += SHFLX_F(s2, 16, lane); s2 += SHFLX_F(s2, 32, lane);
        const float rstd = 1.0f / sqrtf(s2 * (1.0f / 128.0f) + NORM_EPS);
        const size_t t = t0 + 16 * w + fr;
        u32x2 yo[8];
#pragma unroll
        for (int et = 0; et < 8; ++et) {
            const int e0 = hh * 128 + 16 * et + 4 * fq;
            const f32x4 gv = *(const f32x4*)(gng + e0), bv = *(const f32x4*)(gnb + e0);
            const float y0 = ((acc[et][0] - mu) * rstd * gv[0] + bv[0]) * bflo(sg[et].x), y1 = ((acc[et][1] - mu) * rstd * gv[1] + bv[1]) * bfhi(sg[et].x);
            const float y2 = ((acc[et][2] - mu) * rstd * gv[2] + bv[2]) * bflo(sg[et].y), y3 = ((acc[et][3] - mu) * rstd * gv[3] + bv[3]) * bfhi(sg[et].y);
            yo[et].x = pk2v(y0, y1); yo[et].y = pk2v(y2, y3);
        }
        __syncthreads();
        const bool has_next = unit + G < NBH * NCH;
        if (has_next) {
#pragma unroll
            for (int i = 0; i < 4; ++i) { const int p = tid + 512 * i, r = p >> 4, c = p & 15, o = swz_off(r, c);
                *(LAS u32x4*)(lds + LDS_RV + o) = R.tv[i]; *(LAS u32x4*)(lds + LDS_RK + o) = R.tk[i]; *(LAS u32x4*)(lds + LDS_RP + o) = R.tp[i]; }
#pragma unroll
            for (int ks = 0; ks < 4; ++ks) bq[ks] = R.bq[ks];
#pragma unroll
            for (int et = 0; et < 8; ++et) sg[et] = R.sg[et];
        }
#pragma unroll
        for (int et = 0; et < 8; ++et) *(u32x2*)(ycat + t * D + 512 + hh * 128 + 16 * et + 4 * fq) = yo[et];
        __syncthreads();
        if (unit + 2 * G < NBH * NCH) ret_out_load(R, unit + 2 * G, proj, prevt, tid, w, fr, fq);
    }
}

struct Ptrs {
    const float *x, *attn_g, *w_in, *conv_w, *conv_b, *lru_wa, *lru_ba, *lru_wx, *lru_bx, *lru_lam, *lru_ng, *ret_ng, *ret_nb, *w_out, *ffn_g, *router_w, *router_b;
    const float *moe_wg, *moe_bg, *moe_wu, *moe_bu, *moe_wd, *moe_bd, *final_g; const int* positions;
    float *RS1, *RS2S, *SSQ, *GW, *LAP, *LAH, *CARRY, *out; unsigned *LIST, *ctl;
    bf16_t *WR_T, *WIN_T, *WOUT_T, *PROJ, *XB, *YCAT, *YB23, *KVT, *PREVT, *YB01, *WAF; float* RSL; unsigned char *WGU8, *WD8, *X8, *ACT; int wv;
};
__device__ __forceinline__ MoeConv moe_conv(const Ptrs& P) { MoeConv M; M.wg = P.moe_wg; M.wu = P.moe_wu; M.wd = P.moe_wd; M.ffn_g = P.ffn_g; M.wgu8 = P.WGU8; M.wd8 = P.WD8; return M; }
#define PHASE_IDS() int tid = P.wv * 64 + LANE_ID(); OPAQUE(tid); const int lane = tid & 63, wave = P.wv; const int gw = bx * NWAVES + wave, NGW = G * NWAVES; (void)lane; (void)gw; (void)NGW

__device__ __forceinline__ P0Item p0_decode(const Ptrs& P, int it) {
    P0Item d; d.scale = nullptr; d.off = 0; d.mode = 0; d.fp8 = 0; int r = it, nblk;
    if (r < P0_I_IN) { d.W = P.w_in; d.scale = P.attn_g; d.N = DIN; d.WT = P.WIN_T; d.mode = 1; }
    else if ((r -= P0_I_IN) < P0_I_OUT) { d.W = P.w_out; d.N = D; d.WT = P.WOUT_T; }
    else { r -= P0_I_OUT; r += MOE_STREAMED;
        const int e = r / (3 * P0_I_E), q = (r / P0_I_E) % 3; r = r % P0_I_E; d.N = D;
        d.fp8 = 1;
        if (q == 0) { d.W = P.moe_wg + (size_t)e * D * D; d.scale = P.ffn_g; d.WT = P.WGU8; d.mode = 2; d.off = e * 2048; }
        else if (q == 1) { d.W = P.moe_wu + (size_t)e * D * D; d.scale = P.ffn_g; d.WT = P.WGU8; d.mode = 2; d.off = e * 2048 + 128; }
        else { d.W = P.moe_wd + (size_t)e * D * D; d.WT = P.WD8; d.off = e * D; } }
    nblk = d.N / 64; d.k0 = 64 * (r / nblk); d.n0 = 64 * (r % nblk); return d;
}
__device__ __forceinline__ void p0_prologue(LAS unsigned char* lds, const Ptrs& P, int G, int bx) {
    PHASE_IDS();
    {
        f32x4 v[4], nv[4];
        int m = gw;
        if (m < T) {
#pragma unroll
            for (int j = 0; j < 4; ++j) v[j] = ((const f32x4*)(P.x + (size_t)m * D))[lane + 64 * j];
        }
        for (; m < T; m += NGW) {
            const int mn = m + NGW;
            if (mn < T) {
#pragma unroll
                for (int j = 0; j < 4; ++j) nv[j] = ((const f32x4*)(P.x + (size_t)mn * D))[lane + 64 * j];
            }
            float s = 0.f;
#pragma unroll
            for (int j = 0; j < 4; ++j) s += (v[j].x * v[j].x + v[j].y * v[j].y) + (v[j].z * v[j].z + v[j].w * v[j].w);
            s = wave_sum(s, lane);
            if (lane == 0) P.RS1[m] = 1.0f / sqrtf(s * (1.0f / D) + NORM_EPS);
            u32x2* o8 = (u32x2*)(P.XB + (size_t)m * D) + lane;
#pragma unroll
            for (int j = 0; j < 4; ++j) { u32x2 o; o.x = pk2(v[j].x, v[j].y); o.y = pk2(v[j].z, v[j].w); o8[64 * j] = o; }
#pragma unroll
            for (int j = 0; j < 4; ++j) v[j] = nv[j];
        }
    }
    {
        LAS unsigned char* scr = lds + wave * 16384;
        f32x4 v[16], nv[16]; float sc = 1.f, nsc = 1.f;
        int it = gw;
        P0Item d, nd;
        if (it < P0_NITEMS) { d = p0_decode(P, it); p0_load(d, lane, v, sc); }
        for (; it < P0_NITEMS; it += NGW) {
            const int nit = it + NGW;
            if (nit < P0_NITEMS) { nd = p0_decode(P, nit); p0_load(nd, lane, nv, nsc); }
            p0_process(d, lane, v, sc, scr);
            d = nd; sc = nsc;
#pragma unroll
            for (int i = 0; i < 16; ++i) v[i] = nv[i];
        }
    }
    for (int i = bx * NTHREADS + tid; i < 32 * D; i += G * NTHREADS) { const int e = i / D, k = i % D; P.WR_T[i] = (bf16_t)((e < NEXP) ? f2bf(P.router_w[(size_t)k * NEXP + e] * P.ffn_g[k]) : 0u); }
    for (int i = bx * NTHREADS + tid; i < 2 * 8 * 2 * 4 * 64; i += G * NTHREADS) {
        const int ln = i & 63, nt = (i >> 6) & 3, ks = (i >> 8) & 1, h = (i >> 9) & 7, mat = i >> 12, fr = ln & 15, fq = ln >> 4;
        const float* w = mat ? P.lru_wx : P.lru_wa; unsigned pk[4];
#pragma unroll
        for (int j = 0; j < 4; ++j) { const size_t i0 = ((size_t)h * 64 + 32 * ks + 8 * fq + 2 * j) * 64 + 16 * nt + fr; pk[j] = pk2(w[i0], w[i0 + 64]); }
        *(u32x4*)(P.WAF + (size_t)i * 8) = (u32x4){pk[0], pk[1], pk[2], pk[3]};
    }
}

__device__ __forceinline__ void p3_scans(const Ptrs& P, int G, int bx) {
    PHASE_IDS();
    if (wave == NWAVES - 1) {
        const int per = (BATCH * 512 + G - 1) / G;
        for (int i = bx * per + lane; lane < per && i < BATCH * 512 && i < (bx + 1) * per; i += 64) { const int b = i / 512, c = i % 512; float st = 0.f;
            for (int n0 = 0; n0 < NCH; n0 += 32) {
                float ap[32], ah[32];
#pragma unroll
                for (int j = 0; j < 32; ++j) { const size_t o = ((size_t)b * NCH + (n0 + j < NCH ? n0 + j : 0)) * 512 + c; ap[j] = P.LAP[o]; ah[j] = P.LAH[o]; }
#pragma unroll
                for (int j = 0; j < 32; ++j) { if (n0 + j < NCH) { P.CARRY[((size_t)b * NCH + n0 + j) * 512 + c] = st; st = ap[j] * st + ah[j]; } }
            }
        }
    }
    for (int i = bx * NTHREADS + tid; i < NBH * 8192; i += G * NTHREADS) {
        const int bh = i / 8192, rem = i % 8192, hh = bh & 3;
        const float lamb = exp2f(128.0f * log2_gamma(hh));
        float s0 = 0.f, s1 = 0.f;
        const unsigned* src = (const unsigned*)(P.KVT + (size_t)bh * NCH * 16384) + rem; unsigned* dst = (unsigned*)(P.PREVT + (size_t)bh * NCH * 16384) + rem;
        for (int n0 = 0; n0 < NCH; n0 += 64) {
            unsigned kv[64];
#pragma unroll
            for (int j = 0; j < 64; ++j) kv[j] = (n0 + j < NCH) ? src[(size_t)(n0 + j) * 8192] : 0u;
#pragma unroll
            for (int j = 0; j < 64; ++j) { if (n0 + j < NCH) { dst[(size_t)(n0 + j) * 8192] = pk2(s0, s1); s0 = lamb * (s0 + bflo(kv[j])); s1 = lamb * (s1 + bfhi(kv[j])); } }
        }
    }
}

constexpr int CW_HIST = 32768;
__device__ __forceinline__ void p6_router(LAS unsigned char* lds, const Ptrs& P, int G, int bx, const XcdBarrier& bar) {
    PHASE_IDS();
    LAS unsigned* hist = (LAS unsigned*)(lds + 0); LAS unsigned* base = (LAS unsigned*)(lds + 256); LAS unsigned* part = (LAS unsigned*)(lds + 512);
    const int fr = lane & 15, fq = lane >> 4;
    const bool act = bx < T / 128;
    if (tid < 64) hist[tid] = 0u;
    __syncthreads();
    const int tok = (act ? bx : 0) * 128 + wave * 16 + fr;
    f32x4 lg[2] = {{0.f, 0.f, 0.f, 0.f}, {0.f, 0.f, 0.f, 0.f}};
    for (int ks = 0; ks < 32; ++ks) {
        const bf16x8 bt = *(const bf16x8*)(P.YB01 + (size_t)tok * 2048 + 32 * ks + 8 * fq);
#pragma unroll
        for (int tt = 0; tt < 2; ++tt) { const bf16x8 aw = *(const bf16x8*)(P.WR_T + (size_t)(16 * tt + fr) * D + 32 * ks + 8 * fq);
            lg[tt] = __builtin_amdgcn_mfma_f32_16x16x32_bf16(aw, bt, lg[tt], 0, 0, 0); }
    }
    float tot = 0.f;
#pragma unroll
    for (int p = 0; p < 16; ++p) tot += P.SSQ[(size_t)p * T + tok];
    const float rs = 1.0f / sqrtf(tot * (1.0f / D) + NORM_EPS);
    float val[8];
#pragma unroll
    for (int tt = 0; tt < 2; ++tt)
#pragma unroll
        for (int r = 0; r < 4; ++r) { const int e = 16 * tt + 4 * fq + r; val[4 * tt + r] = (e < NEXP) ? (lg[tt][r] * rs + P.router_b[e < NEXP ? e : 0]) : -3.0e38f; }
    float tv[4]; int ti[4];
#pragma unroll
    for (int k = 0; k < 4; ++k) {
        float bv = -3.4e38f; int bi = 1 << 20;
#pragma unroll
        for (int q = 0; q < 8; ++q) { const int e = 16 * (q >> 2) + 4 * fq + (q & 3); if (val[q] > bv || (val[q] == bv && e < bi)) { bv = val[q]; bi = e; } }
#pragma unroll
        for (int o = 16; o <= 32; o <<= 1) { const float ov = SHFLX_F(bv, o, lane); const int oi = SHFLX_I(bi, o, lane); if (ov > bv || (ov == bv && oi < bi)) { bv = ov; bi = oi; } }
        tv[k] = bv; ti[k] = bi;
#pragma unroll
        for (int q = 0; q < 8; ++q) { const int e = 16 * (q >> 2) + 4 * fq + (q & 3); if (e == bi) val[q] = -3.4e38f; }
    }
    float ex[4], den = 0.f;
#pragma unroll
    for (int k = 0; k < 4; ++k) { ex[k] = expf(tv[k] - tv[0]); den += ex[k]; }
    unsigned lp[4] = {0u, 0u, 0u, 0u};
    if (act && fq == 0) {
#pragma unroll
        for (int k = 0; k < 4; ++k) lp[k] = __hip_atomic_fetch_add(&hist[ti[k]], 1u, __ATOMIC_RELAXED, __HIP_MEMORY_SCOPE_WORKGROUP);
    }
    __syncthreads();
    if (tid < 32) P.ctl[CW_HIST + bx * 32 + tid] = hist[tid];
    xcd_barrier(bar, P.wv);
    {
        const int e = tid & 31, pt = tid >> 5; unsigned sum = 0u;
#pragma unroll
        for (int i = 0; i < 16; ++i) { const int w = pt * 16 + i; const unsigned c = P.ctl[CW_HIST + (w < G ? w : 0) * 32 + e]; sum += (w < bx) ? c : 0u; }
        part[pt * 32 + e] = sum;
    }
    __syncthreads();
    if (tid < 32) { unsigned sum = 0u;
#pragma unroll
        for (int i = 0; i < 16; ++i) sum += part[i * 32 + tid];
        base[tid] = sum;
        if (bx == G - 1 && tid < NEXP) P.ctl[CW_CNT + 64 * tid] = sum + hist[tid]; }
    __syncthreads();
    if (act && fq == 0) {
#pragma unroll
        for (int k = 0; k < 4; ++k) { const size_t o = (size_t)ti[k] * T + base[ti[k]] + lp[k]; P.LIST[o] = (unsigned)tok * 4u + (unsigned)k; P.GW[o] = ex[k] / den; P.RS2S[o] = rs; }
    }
    __syncthreads();
}

__device__ __forceinline__ void p9_final(const Ptrs& P, int G, int bx) {
    PHASE_IDS();
    const unsigned char* Y8 = (const unsigned char*)P.YB23;
    u32x4 q[2], nq[2], nnq[2]; u32x2 e[8], ne[8], nne[8];
    int m = gw;
#define P9_LOAD(dq, de, row) do { _Pragma("unroll") for (int j = 0; j < 2; ++j) { const int col = (j * 64 + lane) * 8; \
        dq[j] = *(const u32x4*)(P.YB01 + (size_t)(row) * 2048 + col); \
        _Pragma("unroll") for (int k = 0; k < 4; ++k) de[4 * j + k] = *(const u32x2*)(Y8 + (size_t)(row) * 4096 + k * 1024 + col); } } while (0)
    if (m < T) P9_LOAD(q, e, m);
    if (m + NGW < T) P9_LOAD(nq, ne, m + NGW);
    f32x4 g0[2], g1[2];
#pragma unroll
    for (int j = 0; j < 2; ++j) { const int col = (j * 64 + lane) * 8; g0[j] = *(const f32x4*)(P.final_g + col); g1[j] = *(const f32x4*)(P.final_g + col + 4); }
    for (; m < T; m += NGW) {
        const int mn = m + 2 * NGW;
        if (mn < T) P9_LOAD(nnq, nne, mn);
        float v[2][8]; float s = 0.f;
#pragma unroll
        for (int j = 0; j < 2; ++j) {
            f32x2 t[4] = {{0.f, 0.f}, {0.f, 0.f}, {0.f, 0.f}, {0.f, 0.f}};
#pragma unroll
            for (int k = 0; k < 4; ++k) { const u32x2 w = e[4 * j + k]; t[0] += unpk2_fp8(w.x, false); t[1] += unpk2_fp8(w.x, true); t[2] += unpk2_fp8(w.y, false); t[3] += unpk2_fp8(w.y, true); }
            const u32x4 a = q[j];
            v[j][0] = bflo(a.x) + t[0].x * (1.0f / Y8_SCALE); v[j][1] = bfhi(a.x) + t[0].y * (1.0f / Y8_SCALE); v[j][2] = bflo(a.y) + t[1].x * (1.0f / Y8_SCALE); v[j][3] = bfhi(a.y) + t[1].y * (1.0f / Y8_SCALE);
            v[j][4] = bflo(a.z) + t[2].x * (1.0f / Y8_SCALE); v[j][5] = bfhi(a.z) + t[2].y * (1.0f / Y8_SCALE); v[j][6] = bflo(a.w) + t[3].x * (1.0f / Y8_SCALE); v[j][7] = bfhi(a.w) + t[3].y * (1.0f / Y8_SCALE);
#pragma unroll
            for (int k = 0; k < 8; ++k) s += v[j][k] * v[j][k];
        }
        s = wave_sum(s, lane);
        const float rs = 1.0f / sqrtf(s * (1.0f / D) + NORM_EPS);
#pragma unroll
        for (int j = 0; j < 2; ++j) {
            const int col = (j * 64 + lane) * 8;
            f32x4 o0, o1;
#pragma unroll
            for (int k = 0; k < 4; ++k) { o0[k] = v[j][k] * rs * g0[j][k]; o1[k] = v[j][4 + k] * rs * g1[j][k]; }
            *(f32x4*)(P.out + (size_t)m * D + col) = o0; *(f32x4*)(P.out + (size_t)m * D + col + 4) = o1;
        }
#pragma unroll
        for (int k = 0; k < 2; ++k) { q[k] = nq[k]; nq[k] = nnq[k]; }
#pragma unroll
        for (int k = 0; k < 8; ++k) { e[k] = ne[k]; ne[k] = nne[k]; }
    }
#undef P9_LOAD
}

#ifndef REPEAT_PHASE
#define REPEAT_PHASE -1
#define REPEAT_N 0
#endif
#define RUN_PHASE(k, call) do { call; xcd_barrier(bar, P.wv); \
    if (REPEAT_PHASE == (k) && REPEAT_N >= 1) { call; xcd_barrier(bar, P.wv); } \
    if (REPEAT_PHASE == (k) && REPEAT_N >= 2) { call; xcd_barrier(bar, P.wv); } \
    if (REPEAT_PHASE == (k) && REPEAT_N >= 3) { call; xcd_barrier(bar, P.wv); } } while (0)

struct Args { const void* in[25]; float* out; unsigned char* ws; };

__device__ __forceinline__ void p1_gemm(LAS unsigned char* lds, const Ptrs& P, int G, int bx) { ProbIn pr; pr.xb = P.XB; pr.wt = P.WIN_T; pr.rs1 = P.RS1; pr.pos = P.positions; pr.proj = P.PROJ; pr.G = G; pr.c = bx; pg8::gemm_phase(lds, pr, P.wv); }
__device__ __forceinline__ void p2_seq(LAS unsigned char* lds, const Ptrs& P, int G, int bx) {
    for (int u = bx; u < BATCH * NCH; u += G) lru_unit<false>(lds, u / NCH, u % NCH, P.PROJ, P.conv_w, P.conv_b, P.WAF, P.lru_ba, P.lru_bx, P.lru_lam, P.lru_ng, P.LAP, P.LAH, nullptr, nullptr, nullptr, moe_conv(P), u * 8 * MOE_K0, P.wv);
    ret_kv_phase(lds, P.PROJ, P.KVT, G, bx, P.wv);
}
__device__ __forceinline__ void p4_lru(LAS unsigned char* lds, const Ptrs& P, int G, int bx) {
    for (int u = bx; u < BATCH * NCH; u += G) lru_unit<true>(lds, u / NCH, u % NCH, P.PROJ, P.conv_w, P.conv_b, P.WAF, P.lru_ba, P.lru_bx, P.lru_lam, P.lru_ng, nullptr, nullptr, P.CARRY, P.YCAT, P.RSL, moe_conv(P), MOE_PASS0_ITEMS + u * 8 * MOE_K1, P.wv);
}
__device__ __forceinline__ void p4_ret(LAS unsigned char* lds, const Ptrs& P, int G, int bx) {
    ret_out_phase(lds, P.PROJ, P.PREVT, P.ret_ng, P.ret_nb, P.YCAT, G, bx, P.wv);
}
__device__ __forceinline__ void p4_seq(LAS unsigned char* lds, const Ptrs& P, int G, int bx) {
    for (int u = bx; u < BATCH * NCH; u += G) lru_unit<true>(lds, u / NCH, u % NCH, P.PROJ, P.conv_w, P.conv_b, P.WAF, P.lru_ba, P.lru_bx, P.lru_lam, P.lru_ng, nullptr, nullptr, P.CARRY, P.YCAT, P.RSL, moe_conv(P), MOE_PASS0_ITEMS + u * 8 * MOE_K1, P.wv);
    ret_out_phase(lds, P.PROJ, P.PREVT, P.ret_ng, P.ret_nb, P.YCAT, G, bx, P.wv);
}
__device__ __forceinline__ void p5_gemm(LAS unsigned char* lds, const Ptrs& P, int G, int bx) { ProbOut pr; pr.ycat = P.YCAT; pr.wt = P.WOUT_T; pr.xb = P.XB; pr.rsl = P.RSL; pr.yb01 = P.YB01; pr.x8 = P.X8; pr.ssq = P.SSQ; pr.G = G; pr.c = bx; pg8::gemm_phase(lds, pr, P.wv); }
__device__ __forceinline__ void p7_gemm(LAS unsigned char* lds, const Ptrs& P, int G, int bx, int probe_mode = 0) {
    const MoeTabs tabs = moe_build_tabs(lds, P.ctl, P.wv);
    ProbUp pr; pr.probe_mode = probe_mode; pr.tabs = tabs; pr.x8 = P.X8; pr.wgu = P.WGU8; pr.list = P.LIST; pr.rs2s = P.RS2S; pr.bg = P.moe_bg; pr.bu = P.moe_bu; pr.act = P.ACT; pr.G = G; pr.c = bx;
    pg8::gemm_phase(lds, pr, P.wv);
}
__device__ __forceinline__ void p8_gemm(LAS unsigned char* lds, const Ptrs& P, int G, int bx, int probe_mode = 0) {
    const MoeTabs tabs = moe_build_tabs(lds, P.ctl, P.wv);
    ProbDown pr; pr.probe_mode = probe_mode; pr.tabs = tabs; pr.act = P.ACT; pr.wd = P.WD8; pr.list = P.LIST; pr.gw = P.GW; pr.bd = P.moe_bd; pr.y8 = (unsigned char*)P.YB23; pr.G = G; pr.c = bx;
    pg8::gemm_phase(lds, pr, P.wv);
}

__global__ void __launch_bounds__(NTHREADS, 2) mega_fwd(Args args) {
#ifdef CPU_EMU
    unsigned char* lds_raw = emu::cur->blk->lds;
#else
    extern __shared__ __attribute__((aligned(16))) unsigned char lds_raw[];
#endif
    LAS unsigned char* lds = (LAS unsigned char*)lds_raw;
    volatile LAS unsigned* MISC = (volatile LAS unsigned*)(lds + MISC_OFF);
    const int G = gridDim.x, bx = blockIdx.x;
    unsigned char* ws = args.ws;
    Ptrs P;
    P.wv = __builtin_amdgcn_readfirstlane((int)(threadIdx.x >> 6));
    P.x = (const float*)args.in[0]; P.positions = (const int*)args.in[1]; P.attn_g = (const float*)args.in[2];
    P.w_in = (const float*)args.in[3]; P.conv_w = (const float*)args.in[4]; P.conv_b = (const float*)args.in[5];
    P.lru_wa = (const float*)args.in[6]; P.lru_ba = (const float*)args.in[7]; P.lru_wx = (const float*)args.in[8]; P.lru_bx = (const float*)args.in[9];
    P.lru_lam = (const float*)args.in[10]; P.lru_ng = (const float*)args.in[11]; P.ret_ng = (const float*)args.in[12]; P.ret_nb = (const float*)args.in[13];
    P.w_out = (const float*)args.in[14]; P.ffn_g = (const float*)args.in[15]; P.router_w = (const float*)args.in[16]; P.router_b = (const float*)args.in[17];
    P.moe_wg = (const float*)args.in[18]; P.moe_bg = (const float*)args.in[19]; P.moe_wu = (const float*)args.in[20]; P.moe_bu = (const float*)args.in[21];
    P.moe_wd = (const float*)args.in[22]; P.moe_bd = (const float*)args.in[23]; P.final_g = (const float*)args.in[24];
    P.ctl = (unsigned*)(ws + WS_CTL);
    P.RS1 = (float*)(ws + WS_RS1); P.RS2S = (float*)(ws + WS_RS2S); P.SSQ = (float*)(ws + WS_SSQ); P.GW = (float*)(ws + WS_GW);
    P.LIST = (unsigned*)(ws + WS_LIST); P.LAP = (float*)(ws + WS_LAP); P.LAH = (float*)(ws + WS_LAH); P.CARRY = (float*)(ws + WS_CARRY);
    P.WAF = (bf16_t*)(ws + WS_WAF); P.RSL = (float*)(ws + WS_RSL);
    P.WR_T = (bf16_t*)(ws + WS_WR); P.WIN_T = (bf16_t*)(ws + WS_WIN); P.WOUT_T = (bf16_t*)(ws + WS_WOUT); P.WGU8 = ws + WS_WGU; P.WD8 = ws + WS_WD; P.X8 = ws + WS_X8;
    P.PROJ = (bf16_t*)(ws + WS_PROJ); P.XB = (bf16_t*)(ws + WS_XB); P.YCAT = (bf16_t*)(ws + WS_YCAT); P.ACT = ws + WS_ACT; P.YB23 = (bf16_t*)(ws + WS_YB23);
    P.KVT = (bf16_t*)((unsigned char*)args.out + DO_KVT); P.PREVT = (bf16_t*)((unsigned char*)args.out + DO_PREVT); P.YB01 = (bf16_t*)args.out; P.out = args.out;

    for (int u = (int)threadIdx.x; u < (LDS_BYTES - RING_BYTES) / 4; u += NTHREADS) ((LAS unsigned*)(lds + RING_BYTES))[u] = 0u;
    __syncthreads();
    const XcdBarrier bar = xcd_barrier_post(P.ctl + CW_BAR, MISC + 8, P.wv);

    if (REPEAT_PHASE == 100) { xcd_barrier(bar, P.wv); xcd_barrier(bar, P.wv); xcd_barrier(bar, P.wv); xcd_barrier(bar, P.wv); xcd_barrier(bar, P.wv); xcd_barrier(bar, P.wv); xcd_barrier(bar, P.wv); xcd_barrier(bar, P.wv); }
    RUN_PHASE(0, p0_prologue(lds, P, G, bx));
    RUN_PHASE(1, p1_gemm(lds, P, G, bx));
    RUN_PHASE(2, p2_seq(lds, P, G, bx));
    RUN_PHASE(3, p3_scans(P, G, bx));
    RUN_PHASE(4, p4_seq(lds, P, G, bx));
    if (REPEAT_PHASE == 41) { p4_lru(lds, P, G, bx); xcd_barrier(bar, P.wv); p4_lru(lds, P, G, bx); xcd_barrier(bar, P.wv); }
    if (REPEAT_PHASE == 42) { p4_ret(lds, P, G, bx); xcd_barrier(bar, P.wv); p4_ret(lds, P, G, bx); xcd_barrier(bar, P.wv); }
    RUN_PHASE(5, p5_gemm(lds, P, G, bx));
    RUN_PHASE(6, p6_router(lds, P, G, bx, bar));
    if (REPEAT_PHASE == 71) { p7_gemm(lds, P, G, bx, 1); xcd_barrier(bar, P.wv); p7_gemm(lds, P, G, bx, 1); xcd_barrier(bar, P.wv); }
    if (REPEAT_PHASE == 72) { p7_gemm(lds, P, G, bx, 2); xcd_barrier(bar, P.wv); }
#if REPEAT_PHASE >= 300 && REPEAT_PHASE < 316
    {   const MoeTabs tabs = moe_build_tabs(lds, P.ctl, P.wv);
        ProbUpDiag<REPEAT_PHASE - 300> pr; pr.probe_mode = 1; pr.tabs = tabs; pr.x8 = P.X8; pr.wgu = P.WGU8; pr.list = P.LIST; pr.rs2s = P.RS2S; pr.bg = P.moe_bg; pr.bu = P.moe_bu; pr.act = P.ACT; pr.G = G; pr.c = bx;
        pg8::gemm_phase(lds, pr, P.wv); xcd_barrier(bar, P.wv); pg8::gemm_phase(lds, pr, P.wv); xcd_barrier(bar, P.wv); }
#endif
#if REPEAT_PHASE == 200 || REPEAT_PHASE == 201
    {
        const unsigned long long t0 = __builtin_amdgcn_s_memtime(), r0 = __builtin_amdgcn_s_memrealtime();
        if (REPEAT_PHASE == 200) p7_gemm(lds, P, G, bx, 1); else p1_gemm(lds, P, G, bx);
        const unsigned long long t1 = __builtin_amdgcn_s_memtime(), r1 = __builtin_amdgcn_s_memrealtime();
        if (bx == 0) { const unsigned long long mhz = (t1 - t0) * 100ull / (r1 - r0); while (__builtin_amdgcn_s_memrealtime() - r1 < mhz * 10ull) __builtin_amdgcn_s_sleep(8); }
        xcd_barrier(bar, P.wv);
    }
#endif
    RUN_PHASE(7, p7_gemm(lds, P, G, bx));
    if (REPEAT_PHASE == 81) { p8_gemm(lds, P, G, bx, 1); xcd_barrier(bar, P.wv); p8_gemm(lds, P, G, bx, 1); xcd_barrier(bar, P.wv); }
    RUN_PHASE(8, p8_gemm(lds, P, G, bx));
    if (REPEAT_PHASE == 9) { Ptrs Q = P; Q.out = (float*)P.ACT; p9_final(Q, G, bx); xcd_barrier(bar, P.wv); }
    p9_final(P, G, bx);
}

extern "C" void kernel_launch(void* const* d_in, const int* in_sizes, int n_in, void* d_out, int out_size, void* d_ws, size_t ws_size, hipStream_t stream) {
    static int grid = 0;
    if (grid == 0) {
        if (n_in != 25 || out_size != T * D || ws_size < WS_END) { fprintf(stderr, "kernel_launch: unexpected shapes (n_in %d, out %d, ws %zu, need %zu)\n", n_in, out_size, ws_size, (size_t)WS_END); grid = -1; return; }
        int dev = 0, cus = 0;
        if (hipGetDevice(&dev) != hipSuccess || hipDeviceGetAttribute(&cus, hipDeviceAttributeMultiprocessorCount, dev) != hipSuccess) { fprintf(stderr, "kernel_launch: device query failed\n"); grid = -1; return; }
        if (hipFuncSetAttribute((const void*)mega_fwd, hipFuncAttributeMaxDynamicSharedMemorySize, LDS_BYTES) != hipSuccess) { fprintf(stderr, "kernel_launch: hipFuncSetAttribute failed\n"); grid = -1; return; }
        (void)hipGetLastError();
        if (cus < T / 128 || cus > 256) { fprintf(stderr, "kernel_launch: the router phase needs T/128 <= CUs <= 256 (have %d)\n", cus); grid = -1; return; }
        grid = cus;
    }
    if (grid < 0) return;
    (void)in_sizes;
    (void)hipMemsetAsync((char*)d_ws + WS_CTL, 0, CTL_ZERO_BYTES, stream);
    Args a{};
    for (int i = 0; i < 25; ++i) a.in[i] = d_in[i];
    a.out = (float*)d_out; a.ws = (unsigned char*)d_ws;
    hipLaunchKernelGGL(mega_fwd, dim3(grid), dim3(NTHREADS), LDS_BYTES, stream, a);
}
```

```cpp
#ifndef CPU_EMU
#include <hip/hip_runtime.h>
#include <cstdio>
#define LAS __attribute__((address_space(3)))
#define GAS __attribute__((address_space(1)))
#define ASM_VMCNT(n) asm volatile("s_waitcnt vmcnt(" #n ")" ::: "memory")
#define ASM_LGKMCNT(n) asm volatile("s_waitcnt lgkmcnt(" #n ")" ::: "memory")
#define WAVE_SYNC() do { asm volatile("s_waitcnt lgkmcnt(0)" ::: "memory"); __builtin_amdgcn_wave_barrier(); } while (0)
#define OPAQUE(x) asm volatile("" : "+v"(x))
__device__ __forceinline__ int lane_id_fresh() { int l; asm volatile("v_mbcnt_lo_u32_b32 %0, -1, 0\n\tv_mbcnt_hi_u32_b32 %0, -1, %0" : "=v"(l)); return l; }
#define LANE_ID() lane_id_fresh()
#define SHFLX_F(v, mask, lane) __builtin_bit_cast(float, __builtin_amdgcn_ds_bpermute((((lane) ^ (mask)) << 2), __builtin_bit_cast(int, (float)(v))))
#define SHFLX_I(v, mask, lane) __builtin_amdgcn_ds_bpermute((((lane) ^ (mask)) << 2), (int)(v))
#else
#define ASM_VMCNT(n) ((void)0)
#define ASM_LGKMCNT(n) ((void)0)
#define WAVE_SYNC() emu::wave_collective(nullptr, 0, nullptr, 0, [](emu::Wave&) {})
#define OPAQUE(x) ((void)0)
#define LANE_ID() ((int)emu::cur->lane)
#define SHFLX_F(v, mask, lane) __shfl_xor((float)(v), (mask))
#define SHFLX_I(v, mask, lane) __shfl_xor((int)(v), (mask))
#endif

typedef unsigned short bf16_t;
typedef float f32x4 __attribute__((ext_vector_type(4)));
typedef float f32x2 __attribute__((ext_vector_type(2)));
typedef unsigned u32x4 __attribute__((ext_vector_type(4)));
typedef unsigned u32x2 __attribute__((ext_vector_type(2)));
typedef short bf16x8 __attribute__((ext_vector_type(8)));
typedef short v4i16_t __attribute__((ext_vector_type(4)));
typedef int v8i32_t __attribute__((ext_vector_type(8)));

#ifdef CPU_EMU
constexpr int BATCH = CFG_BATCH, SEQ = CFG_SEQ, NEXP = CFG_NEXP;
#else
constexpr int BATCH = 4, SEQ = 8192, NEXP = 32;
#endif
constexpr int NWAVES = 8, NTHREADS = 512;
constexpr int T = BATCH * SEQ, D = 1024, DIN = 3072, NCH = SEQ / 128, NBH = BATCH * 4;
constexpr int TOPK = 4, NSLOT = T * TOPK;
constexpr float NORM_EPS = 1e-5f;
constexpr int MAXTILES = NSLOT / 256 + NEXP;

constexpr size_t MiB = 1u << 20;
constexpr size_t al256(size_t x) { return (x + 255) & ~(size_t)255; }
constexpr size_t WS_CTL = 0, CTL_ZERO_BYTES = 1 * MiB;
constexpr int CW_BAR = 4096, CW_CNT = 16384;
constexpr size_t WS_RS1 = 1 * MiB;
constexpr size_t WS_RS2 = WS_RS1 + al256((size_t)T * 4);
constexpr size_t WS_SSQ = WS_RS2 + al256((size_t)T * 4);
constexpr size_t WS_GW = WS_SSQ + al256((size_t)16 * T * 4);
constexpr size_t WS_LIST = WS_GW + al256((size_t)NEXP * T * 4);
constexpr size_t WS_RS2S = WS_LIST + al256((size_t)NEXP * T * 4);
constexpr size_t WS_LAP = WS_RS2S + al256((size_t)NEXP * T * 4);
constexpr size_t WS_LAH = WS_LAP + al256((size_t)BATCH * NCH * 512 * 4);
constexpr size_t WS_CARRY = WS_LAH + al256((size_t)BATCH * NCH * 512 * 4);
constexpr size_t WS_WR = WS_CARRY + al256((size_t)BATCH * NCH * 512 * 4);
constexpr size_t WS_WAF = WS_WR + al256((size_t)32 * D * 2);
constexpr size_t WS_RSL = WS_WAF + 2 * 65536;
constexpr size_t WS_WIN = (WS_RSL + al256((size_t)T * 4) + MiB - 1) / MiB * MiB;
constexpr size_t WS_WOUT = WS_WIN + (size_t)DIN * D * 2;
constexpr size_t WS_WGU = WS_WOUT + (size_t)D * D * 2;
constexpr size_t WS_WD = WS_WGU + (size_t)NEXP * 2048 * D;
constexpr size_t WS_X8 = WS_WD + (size_t)NEXP * D * D;
constexpr size_t WS_R1 = WS_X8 + (size_t)T * D;
constexpr size_t WS_PROJ = WS_R1;
constexpr size_t WS_XB = WS_R1 + (size_t)T * DIN * 2;
constexpr size_t WS_ACT = WS_R1;
constexpr size_t WS_YB23 = WS_ACT + (size_t)(NSLOT + 256) * D;
constexpr size_t WS_YCAT = WS_YB23 + (size_t)T * 2 * D * 2;
constexpr size_t WS_END = WS_YCAT + (size_t)T * D * 2;
static_assert(WS_XB + (size_t)T * D * 2 <= WS_END, "map");
constexpr size_t DO_KVT = 0, DO_PREVT = (size_t)T * 1024;
static_assert(2 * (size_t)T * 1024 <= (size_t)T * D * 4, "d_out scratch");

constexpr int RING_BYTES = 131072, MISC_OFF = RING_BYTES + 320, TAB_OFF = RING_BYTES + 1024, LDS_BYTES = 147456;
constexpr int TAB_CNT = TAB_OFF, TAB_EOFF = TAB_CNT + 4 * 64, TAB_TBASE = TAB_EOFF + 4 * 64, TAB_TILEE = TAB_TBASE + 4 * 80;
constexpr int META_OFF = RING_BYTES + 8192;
static_assert(NEXP <= 64 && TAB_TILEE + 2 * MAXTILES + 16 <= META_OFF && META_OFF + 8192 <= LDS_BYTES, "LDS tables");

__device__ __forceinline__ unsigned f2bf(float f) { unsigned u = __builtin_bit_cast(unsigned, f); return (u + 0x7fffu + ((u >> 16) & 1u)) >> 16; }
__device__ __forceinline__ unsigned pk2(float lo, float hi) {
#ifdef CPU_EMU
    return f2bf(lo) | (f2bf(hi) << 16);
#else
    unsigned r; asm volatile("v_cvt_pk_bf16_f32 %0, %1, %2" : "=v"(r) : "v"(lo), "v"(hi)); return r;
#endif
}
__device__ __forceinline__ unsigned pk2v(float lo, float hi) {
#ifdef CPU_EMU
    return f2bf(lo) | (f2bf(hi) << 16);
#else
    unsigned r; asm volatile("s_nop 7\n\ts_nop 7\n\tv_cvt_pk_bf16_f32 %0, %1, %2" : "=v"(r) : "v"(lo), "v"(hi)); return r;
#endif
}
#define unpk2_fp8(w, hi) __builtin_amdgcn_cvt_pk_f32_fp8((int)(w), hi)
__device__ __forceinline__ unsigned pk4_fp8(float a, float b, float c, float d) {
    int r = __builtin_amdgcn_cvt_pk_fp8_f32(a, b, 0, false); r = __builtin_amdgcn_cvt_pk_fp8_f32(c, d, r, true); return (unsigned)r;
}
__device__ __forceinline__ float bf2f(unsigned h) { return __builtin_bit_cast(float, h << 16); }
__device__ __forceinline__ float bflo(unsigned w) { return __builtin_bit_cast(float, w << 16); }
__device__ __forceinline__ float bfhi(unsigned w) { return __builtin_bit_cast(float, w & 0xffff0000u); }
__device__ __forceinline__ float fexp2(float x) { return __builtin_amdgcn_exp2f(x); }
__device__ __forceinline__ float frcp(float x) { return __builtin_amdgcn_rcpf(x); }
__device__ __forceinline__ float sigmoid_f(float x) { return frcp(1.0f + fexp2(-1.4426950408889634f * x)); }
__device__ __forceinline__ float gelu_tanh(float x) { const float u = 0.7978845608028654f * (x + 0.044715f * x * x * x); return x * frcp(1.0f + fexp2(-2.8853900817779268f * u)); }
__device__ __forceinline__ float silu_f(float x) { return x * sigmoid_f(x); }
__device__ __forceinline__ float wave_sum(float v, int lane) {
#pragma unroll
    for (int o = 1; o < 64; o <<= 1) v += SHFLX_F(v, o, lane);
    return v;
}

#define XB_TMO      128
#define XB_XCNT(j)  (256  + 64 * (j))
#define XB_XSUB(j)  (1280 + 64 * (j))
#define XB_XGEN(j)  (2304 + 64 * (j))
#define XB_TOP      3328
#define XB_TOPGEN   3392
#define XCD_BAR_WORDS 3456
#define XB_SPIN_CAP (1u << 20)
__device__ __forceinline__ unsigned xb_ld(unsigned* p)              { return __hip_atomic_load(p, __ATOMIC_RELAXED, __HIP_MEMORY_SCOPE_AGENT); }
__device__ __forceinline__ unsigned xb_add(unsigned* p, unsigned v) { return __hip_atomic_fetch_add(p, v, __ATOMIC_RELAXED, __HIP_MEMORY_SCOPE_AGENT); }
__device__ __forceinline__ unsigned xb_xcc_id() { return (unsigned)__builtin_amdgcn_s_getreg((3 << 11) | 20) & 0xFu; }
#define XB_SPIN(cond, bar) do { unsigned _sp = 0; while (cond) { __builtin_amdgcn_s_sleep(1); \
    if ((++_sp & 255u) == 0u) { if (xb_ld(&(bar)[XB_TMO])) break; if (_sp > XB_SPIN_CAP) { atomicAdd(&(bar)[XB_TMO], 1u); break; } } } } while (0)
struct XcdBarrier { unsigned* bar; unsigned x; volatile LAS unsigned* st; };
__device__ __forceinline__ XcdBarrier xcd_barrier_post(unsigned* bar, volatile LAS unsigned* st, int wv) {
    XcdBarrier b; b.bar = bar; b.x = xb_xcc_id(); b.st = st;
    if (wv == 0 && LANE_ID() == 0) (void)xb_add(&bar[XB_XCNT(b.x)], 1u);
    return b;
}
__device__ __forceinline__ void xcd_barrier_complete(unsigned* bar, unsigned x, unsigned& nloc, unsigned& nx) {
    const unsigned G = gridDim.x;
    unsigned sum, cnt, mine, sp = 0u;
    for (;;) {
        sum = 0u; cnt = 0u; mine = 0u;
#pragma unroll
        for (unsigned j = 0; j < 16; ++j) { const unsigned c = xb_ld(&bar[XB_XCNT(j)]); sum += c; cnt += (c > 0u) ? 1u : 0u; mine = (j == x) ? c : mine; }
        if (sum == G) break;
        __builtin_amdgcn_s_sleep(1);
        if ((++sp & 255u) == 0u) { if (xb_ld(&bar[XB_TMO])) break; if (sp > XB_SPIN_CAP) { atomicAdd(&bar[XB_TMO], 1u); break; } }
    }
    nloc = mine > 0u ? mine : 1u; nx = cnt > 0u ? cnt : 1u;
}
__device__ __forceinline__ void xcd_barrier(const XcdBarrier& b, int wv) {
    ASM_VMCNT(0);
    __syncthreads();
    if (wv == 0 && LANE_ID() == 0) {
        unsigned* bar = b.bar;
        __builtin_amdgcn_s_waitcnt(0);
        unsigned nloc = b.st[0], nx = b.st[1];
        if (nloc == 0u) { xcd_barrier_complete(bar, b.x, nloc, nx); b.st[0] = nloc; b.st[1] = nx; }
        const unsigned old = xb_add(&bar[XB_XSUB(b.x)], 1u);
        const unsigned gen = old / nloc;
        if (old + 1u == (gen + 1u) * nloc) {
            __builtin_amdgcn_fence(__ATOMIC_RELEASE, "agent");
            ASM_VMCNT(0);
            const unsigned og = xb_add(&bar[XB_TOP], 1u);
            const unsigned tg = og / nx;
            if (og + 1u == (tg + 1u) * nx) xb_add(&bar[XB_TOPGEN], 1u);
            else XB_SPIN(xb_ld(&bar[XB_TOPGEN]) == tg, bar);
            __builtin_amdgcn_fence(__ATOMIC_ACQUIRE, "agent");
            xb_add(&bar[XB_XGEN(b.x)], 1u);
            ASM_VMCNT(0);
        } else {
            XB_SPIN(xb_ld(&bar[XB_XGEN(b.x)]) == gen, bar);
            __builtin_amdgcn_fence(__ATOMIC_ACQUIRE, "agent");
            ASM_VMCNT(0);
        }
    }
    __syncthreads();
}

namespace pg8 {
constexpr int BM = 256, BK = 64, HALF = 128, HTB = HALF * BK * 2, STAGE_BYTES = 8 * HTB, NXCD = 8, WGM = 8;
__device__ __forceinline__ int lds_byte(int r, int c) { const int st = (r >> 4) * 2 + (c >> 5), rr = r & 15, cc = c & 31, ob = rr * 64 + cc * 2; return st * 1024 + (ob ^ (((ob >> 9) & 1) << 5)); }
__device__ __forceinline__ void stage_rc(int b, int& R, int& C) { const int st = b / 1024, sb = b % 1024, swz = sb ^ (((sb >> 9) & 1) << 5); R = (st >> 1) * 16 + swz / 64; C = (st & 1) * 32 + (swz % 64) / 2; }
__device__ __forceinline__ int lds_byte8(int r, int fq) { const int st = (r >> 4) * 2 + (fq >> 1), rr = r & 15, ob = rr * 64 + 32 * (fq & 1); return st * 1024 + (ob ^ (((ob >> 9) & 1) << 5)); }
__device__ __forceinline__ int perm32(int rho) { const int n = rho >> 4, i = rho & 15; return 8 * (i >> 2) + 4 * n + (i & 3); }
struct Unit { int pm, pn, e, pos0, nvalid, eoff; };
__device__ __forceinline__ f32x4 mma_fp8(u32x4 a0, u32x4 a1, u32x4 b0, u32x4 b1, f32x4 c) {
    typedef int i32x4 __attribute__((ext_vector_type(4)));
    const v8i32_t a = __builtin_shufflevector(__builtin_bit_cast(i32x4, a0), __builtin_bit_cast(i32x4, a1), 0, 1, 2, 3, 4, 5, 6, 7);
    const v8i32_t b = __builtin_shufflevector(__builtin_bit_cast(i32x4, b0), __builtin_bit_cast(i32x4, b1), 0, 1, 2, 3, 4, 5, 6, 7);
#ifdef CPU_EMU
    return __builtin_amdgcn_mfma_scale_f32_16x16x128_f8f6f4(a, b, c, 0, 0, 0, 0x7F7F7F7F, 0, 0x7F7F7F7F);
#else
    const int one = 0x7F7F7F7F;
    asm volatile("v_mfma_scale_f32_16x16x128_f8f6f4 %0, %1, %2, %0, %3, %3 op_sel_hi:[0,0,0]" : "+v"(c) : "v"(a), "v"(b), "v"(one));
    return c;
#endif
}
__device__ __forceinline__ bool static_order(int i, int G, int c, int nM, int nN, int& pm, int& pn) {
    const int nwg = nM * nN; const long L = (long)i * G + c; if (L >= nwg) return false;
    int wgid = (int)L; { const int q = nwg / NXCD, r = nwg % NXCD, xcd = wgid % NXCD, off = wgid / NXCD; wgid = (xcd < r ? xcd * (q + 1) : r * (q + 1) + (xcd - r) * q) + off; }
    const int nig = WGM * nN, gid = wgid / nig, fm = gid * WGM, gsz = (nM - fm) < WGM ? (nM - fm) : WGM;
    pm = fm + ((wgid % nig) % gsz); pn = (wgid % nig) / gsz; return true;
}

template <class P>
__device__ __forceinline__ void gemm_phase(LAS unsigned char* lds, const P& prob, int wv) {
    int tid_ = wv * 64 + LANE_ID(); OPAQUE(tid_);
    const int tid = tid_, wid = __builtin_amdgcn_readfirstlane(tid >> 6), lane = tid & 63, wr = wid >> 2, wc = wid & 3, fr = lane & 15, fq = lane >> 4;
    constexpr int ROWB = P::FP8 ? 1024 : 2048, NT = ROWB / 128, CH = 1024;
    unsigned voffA[2][2], nvoffA[2][2], voffB[2];
#pragma unroll
    for (int i = 0; i < 2; ++i) { int R, C; stage_rc(tid * 16 + i * 8192, R, C); const int Rb = (R & ~31) + perm32(R & 31);
        voffA[0][i] = (unsigned)(R * ROWB + C * 2); voffA[1][i] = voffA[0][i] + (unsigned)(HALF * ROWB); voffB[i] = (unsigned)(Rb * ROWB + C * 2);
        nvoffA[0][i] = voffA[0][i]; nvoffA[1][i] = voffA[1][i]; }
    const size_t kstep = (size_t)(BK * 2);
    const size_t hstep = (size_t)HALF * ROWB;
    const unsigned ldsw = (unsigned)wid * 1024u;
    const int aoff = lds_byte(wr * 64 + fr, fq * 8), boff = lds_byte(wc * 32 + fr, fq * 8);
#define PG8_SA(b, h) (((b) * 2 + (h)) * HTB)
#define PG8_SB(b, h) ((4 + (b) * 2 + (h)) * HTB)
#define PG8_STAGE(bufoff, gbase, voff) do { if constexpr (!(P::DIAG & 2)) _Pragma("unroll") for (int _i = 0; _i < 2; ++_i) \
        __builtin_amdgcn_global_load_lds((const unsigned*)((const char*)(gbase) + (voff)[_i]), (LAS unsigned*)(lds + (bufoff) + ldsw + _i * 8192), 16, 0, 0); } while (0)
#define PG8_LDA(dst, b, h) do { if constexpr (!(P::DIAG & 1)) _Pragma("unroll") for (int m = 0; m < 4; ++m) _Pragma("unroll") for (int k = 0; k < 2; ++k) dst[m][k] = *(const LAS u32x4*)(lds + PG8_SA(b, h) + aoff + m * 2048 + k * CH); } while (0)
#define PG8_LDB(dst, b, h) do { if constexpr (!(P::DIAG & 1)) _Pragma("unroll") for (int n = 0; n < 2; ++n) _Pragma("unroll") for (int k = 0; k < 2; ++k) dst[n][k] = *(const LAS u32x4*)(lds + PG8_SB(b, h) + boff + n * 2048 + k * CH); } while (0)
#define PG8_MMA(ai, bj, At, Bt) do { if constexpr (!(P::DIAG & 8)) { __builtin_amdgcn_s_setprio(1); _Pragma("unroll") for (int m = 0; m < 4; ++m) _Pragma("unroll") for (int n = 0; n < 2; ++n) { \
        if constexpr (P::FP8) acc[ai][bj][m][n] = mma_fp8(Bt[n][0], Bt[n][1], At[m][0], At[m][1], acc[ai][bj][m][n]); \
        else { _Pragma("unroll") for (int k = 0; k < 2; ++k) acc[ai][bj][m][n] = __builtin_amdgcn_mfma_f32_16x16x32_bf16(__builtin_bit_cast(bf16x8, Bt[n][k]), __builtin_bit_cast(bf16x8, At[m][k]), acc[ai][bj][m][n], 0, 0, 0); } } \
        __builtin_amdgcn_s_setprio(0); } } while (0)
#define PG8_BAR do { if constexpr (!(P::DIAG & 4)) __builtin_amdgcn_s_barrier(); } while (0)
#define PG8_SCHED __builtin_amdgcn_sched_barrier(0)
    Unit cur, nxt; int ui = 0;
    if (!prob.next(0, cur)) return;
    f32x4 acc[2][2][4][2];
#pragma unroll
    for (int a = 0; a < 2; ++a)
#pragma unroll
        for (int b = 0; b < 2; ++b)
#pragma unroll
            for (int m = 0; m < 4; ++m)
#pragma unroll
                for (int n = 0; n < 2; ++n) acc[a][b][m][n] = (f32x4){0.f, 0.f, 0.f, 0.f};
    u32x4 At[4][2] = {}, B0[2][2] = {}, B1[2][2] = {};
    const char* cA = prob.a_base(cur); const char* cB = prob.b_base(cur);
    if constexpr (P::GATHER) prob.a_offsets(cur, tid, voffA);
#define PG8_META(u, par) do { _Pragma("unroll") for (int _j = 0; _j < 2; ++_j) { const int _a = (wid >> 2) + 2 * _j; if (_a < P::NMETA) \
        __builtin_amdgcn_global_load_lds(prob.meta_ptr(u, _a, (wid & 3) * 64 + lane), (LAS unsigned*)(lds + META_OFF + (par) * 4096 + _a * 1024 + (wid & 3) * 256), 4, 0, 0); } } while (0)
    if constexpr (P::NMETA > 0) PG8_META(cur, 0);
    PG8_STAGE(PG8_SB(0, 0), cB, voffB); PG8_STAGE(PG8_SA(0, 0), cA, voffA[0]); PG8_STAGE(PG8_SB(0, 1), cB + hstep, voffB); PG8_STAGE(PG8_SA(0, 1), cA, voffA[1]);
    if (wr == 1) PG8_BAR;
    ASM_VMCNT(4); PG8_BAR;
    PG8_STAGE(PG8_SB(1, 0), cB + kstep, voffB); PG8_STAGE(PG8_SA(1, 0), cA + kstep, voffA[0]); PG8_STAGE(PG8_SB(1, 1), cB + hstep + kstep, voffB);
    ASM_VMCNT(6); PG8_BAR;
    for (;;) {
        const bool has_next = prob.next(ui + 1, nxt);
        const char* nA = has_next ? prob.a_base(nxt) : cA; const char* nB = has_next ? prob.b_base(nxt) : cB;
        for (int t = 0; t < NT; t += 2) {
            const bool last = (t == NT - 2);
            const char* a1 = cA + (size_t)(t + 1) * kstep;
            const char* a2 = last ? nA : cA + (size_t)(t + 2) * kstep; const char* b2 = last ? nB : cB + (size_t)(t + 2) * kstep;
            const char* a3 = a2 + kstep; const char* b3 = b2 + kstep;
            if constexpr (P::GATHER) { if (t == 2 && has_next) prob.a_offsets(nxt, tid, nvoffA); }
            unsigned va0[2], va1[2];
#pragma unroll
            for (int i = 0; i < 2; ++i) { va0[i] = (P::GATHER && last) ? nvoffA[0][i] : voffA[0][i]; va1[i] = (P::GATHER && last) ? nvoffA[1][i] : voffA[1][i]; }
            if constexpr (P::MIDK) { if (t == NT / 2) prob.midk(acc, cur, wr, fr, lds + META_OFF + (ui & 1) * 4096); }
            PG8_LDB(B0, 0, 0); PG8_SCHED; PG8_LDA(At, 0, 0); PG8_STAGE(PG8_SA(1, 1), a1, voffA[1]);
            ASM_LGKMCNT(8); ASM_VMCNT(10); PG8_BAR; ASM_LGKMCNT(0); PG8_MMA(0, 0, At, B0); PG8_BAR; PG8_SCHED;
            PG8_LDB(B1, 0, 1); PG8_STAGE(PG8_SB(0, 0), b2, voffB);
            ASM_VMCNT(10); PG8_BAR; ASM_LGKMCNT(0); PG8_MMA(0, 1, At, B1); PG8_BAR;
            PG8_LDA(At, 0, 1); PG8_STAGE(PG8_SA(0, 0), a2, va0);
            PG8_BAR; ASM_LGKMCNT(0); PG8_MMA(1, 0, At, B0); PG8_BAR; PG8_SCHED;
            PG8_STAGE(PG8_SB(0, 1), b2 + hstep, voffB);
            ASM_VMCNT(10); PG8_BAR; PG8_MMA(1, 1, At, B1); PG8_BAR;
            if constexpr (P::NMETA > 0) { if (t == 2 && has_next) PG8_META(nxt, (ui + 1) & 1); }
            PG8_LDB(B0, 1, 0); PG8_SCHED; PG8_LDA(At, 1, 0); PG8_STAGE(PG8_SA(0, 1), a2, va1);
            ASM_LGKMCNT(8); ASM_VMCNT(10); PG8_BAR; ASM_LGKMCNT(0); PG8_MMA(0, 0, At, B0); PG8_BAR; PG8_SCHED;
            PG8_LDB(B1, 1, 1); PG8_STAGE(PG8_SB(1, 0), b3, voffB);
            ASM_VMCNT(10); PG8_BAR; ASM_LGKMCNT(0); PG8_MMA(0, 1, At, B1); PG8_BAR;
            PG8_LDA(At, 1, 1); PG8_STAGE(PG8_SA(1, 0), a3, va0);
            PG8_BAR; ASM_LGKMCNT(0); PG8_MMA(1, 0, At, B0); PG8_BAR; PG8_SCHED;
            PG8_STAGE(PG8_SB(1, 1), b3 + hstep, voffB);
            ASM_VMCNT(10); PG8_BAR; PG8_MMA(1, 1, At, B1); PG8_BAR;
        }
        if (wr == 0) PG8_BAR;
        prob.epi(acc, cur, wr, wc, fr, fq, lds + META_OFF + (ui & 1) * 4096);
        if (!has_next) break;
#pragma unroll
        for (int a = 0; a < 2; ++a)
#pragma unroll
            for (int b = 0; b < 2; ++b)
#pragma unroll
                for (int m = 0; m < 4; ++m)
#pragma unroll
                    for (int n = 0; n < 2; ++n) acc[a][b][m][n] = (f32x4){0.f, 0.f, 0.f, 0.f};
        cur = nxt; cA = nA; cB = nB; ++ui;
        if constexpr (P::GATHER) {
#pragma unroll
            for (int h = 0; h < 2; ++h)
#pragma unroll
                for (int i = 0; i < 2; ++i) voffA[h][i] = nvoffA[h][i];
        }
        if (wr == 1) PG8_BAR;
    }
    ASM_VMCNT(0);
    PG8_BAR;
#undef PG8_META
#undef PG8_SA
#undef PG8_SB
#undef PG8_STAGE
#undef PG8_LDA
#undef PG8_LDB
#undef PG8_MMA
#undef PG8_BAR
#undef PG8_SCHED
}
}
using pg8::Unit;

constexpr float Y8_SCALE = 16.0f;
constexpr float LOG2_THETA_64 = 13.287712379549449f / 64.0f;
__device__ __forceinline__ float log2_gamma(int h) { return __builtin_log2f(1.0f - __builtin_exp2f(-5.0f - (float)h)); }

struct ProbIn {
    static constexpr int DIAG = 0;
    static constexpr bool GATHER = false, MIDK = false, FP8 = false; static constexpr int NMETA = 2;
    const bf16_t* xb; const bf16_t* wt; const float* rs1; const int* pos; bf16_t* proj; int G, c;
    __device__ __forceinline__ bool next(int i, Unit& u) const { u.e = 0; u.pos0 = 0; u.nvalid = 256; u.eoff = 0; return pg8::static_order(i, G, c, T / 256, DIN / 256, u.pm, u.pn); }
    __device__ __forceinline__ const char* a_base(const Unit& u) const { return (const char*)xb + (size_t)u.pm * 256 * D * 2; }
    __device__ __forceinline__ const char* b_base(const Unit& u) const { return (const char*)wt + (size_t)u.pn * 256 * D * 2; }
    __device__ __forceinline__ void a_offsets(const Unit&, int, unsigned (&)[2][2]) const {}
    __device__ __forceinline__ const unsigned* meta_ptr(const Unit& u, int a, int idx) const { return (a == 0 ? (const unsigned*)rs1 : (const unsigned*)pos) + u.pm * 256 + idx; }
    __device__ __forceinline__ void epi(const f32x4 (&acc)[2][2][4][2], const Unit& u, int wr, int wc, int fr, int fq, const LAS unsigned char* mbuf) const {
        const int seg = u.pn >> 1;
        float invf[4];
#pragma unroll
        for (int q = 0; q < 4; ++q) invf[q] = exp2f(-(float)(16 * wc + 4 * fq + q) * LOG2_THETA_64) * 0.15915494309189535f;
#pragma unroll
        for (int ai = 0; ai < 2; ++ai)
#pragma unroll
            for (int m = 0; m < 4; ++m) {
                const int rl = ai * 128 + wr * 64 + m * 16 + fr, row = u.pm * 256 + rl;
                const float rs = *(const LAS float*)(mbuf + rl * 4);
                float cs[4], sn[4];
                if (seg == 2 || seg == 3) {
                    const float p = (float)*(const LAS int*)(mbuf + 1024 + rl * 4);
#pragma unroll
                    for (int q = 0; q < 4; ++q) { float rev = p * invf[q]; rev = rev - floorf(rev); cs[q] = __builtin_amdgcn_cosf(rev); sn[q] = __builtin_amdgcn_sinf(rev); }
                }
#pragma unroll
                for (int bj = 0; bj < 2; ++bj) {
                    f32x4 v0 = acc[ai][bj][m][0] * rs, v1 = acc[ai][bj][m][1] * rs;
                    if (seg == 1) {
#pragma unroll
                        for (int j = 0; j < 4; ++j) { v0[j] = gelu_tanh(v0[j]); v1[j] = gelu_tanh(v1[j]); }
                    } else if (seg == 5) {
#pragma unroll
                        for (int j = 0; j < 4; ++j) { v0[j] = silu_f(v0[j]); v1[j] = silu_f(v1[j]); }
                    } else if (seg == 2 || seg == 3) {
                        const int head = 2 * (u.pn & 1) + bj;
                        const float e1 = (float)((row & 127) + 1) * log2_gamma(head);
                        const float f = (seg == 2) ? exp2f(e1) : exp2f(-e1) * 0.08838834764831845f;
                        f32x4 o0, o1;
                        o0[0] = (v0[0] * cs[0] - v0[1] * sn[0]) * f; o0[1] = (v0[1] * cs[0] + v0[0] * sn[0]) * f;
                        o0[2] = (v0[2] * cs[1] - v0[3] * sn[1]) * f; o0[3] = (v0[3] * cs[1] + v0[2] * sn[1]) * f;
                        o1[0] = (v1[0] * cs[2] - v1[1] * sn[2]) * f; o1[1] = (v1[1] * cs[2] + v1[0] * sn[2]) * f;
                        o1[2] = (v1[2] * cs[3] - v1[3] * sn[3]) * f; o1[3] = (v1[3] * cs[3] + v1[2] * sn[3]) * f;
                        v0 = o0; v1 = o1;
                    }
                    u32x4 w; w.x = pk2(v0[0], v0[1]); w.y = pk2(v0[2], v0[3]); w.z = pk2(v1[0], v1[1]); w.w = pk2(v1[2], v1[3]);
                    *(u32x4*)(proj + (size_t)row * DIN + u.pn * 256 + bj * 128 + wc * 32 + 8 * fq) = w;
                }
            }
    }
};

struct ProbOut {
    static constexpr int DIAG = 0;
    static constexpr bool GATHER = false, MIDK = true, FP8 = false; static constexpr int NMETA = 1;
    const bf16_t* ycat; const bf16_t* wt; const bf16_t* xb; const float* rsl; bf16_t* yb01; unsigned char* x8; float* ssq; int G, c;
    __device__ __forceinline__ void midk(f32x4 (&acc)[2][2][4][2], const Unit&, int wr, int fr, const LAS unsigned char* mbuf) const {
#pragma unroll
        for (int ai = 0; ai < 2; ++ai)
#pragma unroll
            for (int m = 0; m < 4; ++m) { const float sc = *(const LAS float*)(mbuf + (ai * 128 + wr * 64 + m * 16 + fr) * 4);
#pragma unroll
                for (int bj = 0; bj < 2; ++bj)
#pragma unroll
                    for (int n = 0; n < 2; ++n) acc[ai][bj][m][n] *= sc; }
    }
    __device__ __forceinline__ bool next(int i, Unit& u) const { u.e = 0; u.pos0 = 0; u.nvalid = 256; u.eoff = 0; return pg8::static_order(i, G, c, T / 256, D / 256, u.pm, u.pn); }
    __device__ __forceinline__ const char* a_base(const Unit& u) const { return (const char*)ycat + (size_t)u.pm * 256 * D * 2; }
    __device__ __forceinline__ const char* b_base(const Unit& u) const { return (const char*)wt + (size_t)u.pn * 256 * D * 2; }
    __device__ __forceinline__ void a_offsets(const Unit&, int, unsigned (&)[2][2]) const {}
    __device__ __forceinline__ const unsigned* meta_ptr(const Unit& u, int, int idx) const { return (const unsigned*)rsl + u.pm * 256 + idx; }
    __device__ __forceinline__ void epi(const f32x4 (&acc)[2][2][4][2], const Unit& u, int wr, int wc, int fr, int fq, const LAS unsigned char*) const {
#pragma unroll
        for (int ai = 0; ai < 2; ++ai)
#pragma unroll
            for (int m = 0; m < 4; ++m) {
                const int row = u.pm * 256 + ai * 128 + wr * 64 + m * 16 + fr;
                float ss = 0.f;
#pragma unroll
                for (int bj = 0; bj < 2; ++bj) {
                    const int col = u.pn * 256 + bj * 128 + wc * 32 + 8 * fq;
                    const u32x4 xv = *(const u32x4*)(xb + (size_t)row * D + col);
                    const f32x4 x0 = {bflo(xv.x), bfhi(xv.x), bflo(xv.y), bfhi(xv.y)}, x1 = {bflo(xv.z), bfhi(xv.z), bflo(xv.w), bfhi(xv.w)};
                    const f32x4 v0 = acc[ai][bj][m][0] + x0, v1 = acc[ai][bj][m][1] + x1;
                    ss += (v0[0] * v0[0] + v0[1] * v0[1]) + (v0[2] * v0[2] + v0[3] * v0[3]) + (v1[0] * v1[0] + v1[1] * v1[1]) + (v1[2] * v1[2] + v1[3] * v1[3]);
                    u32x4 w; w.x = pk2(v0[0], v0[1]); w.y = pk2(v0[2], v0[3]); w.z = pk2(v1[0], v1[1]); w.w = pk2(v1[2], v1[3]);
                    *(u32x4*)(yb01 + (size_t)row * 2048 + col) = w;
                    u32x2 w8; w8.x = pk4_fp8(v0[0], v0[1], v0[2], v0[3]); w8.y = pk4_fp8(v1[0], v1[1], v1[2], v1[3]);
                    *(u32x2*)(x8 + (size_t)row * D + col) = w8;
                }
                ss += SHFLX_F(ss, 16, fr + 16 * fq); ss += SHFLX_F(ss, 32, fr + 16 * fq);
                if (fq == 0) ssq[(size_t)(u.pn * 4 + wc) * T + row] = ss;
            }
    }
};

struct MoeTabs {
    const LAS unsigned* cnt; const LAS unsigned* eoff; const LAS unsigned* tbase; const LAS unsigned short* tile_e; int ntiles;
    __device__ __forceinline__ bool next(int i, int G, int c, int nN, Unit& u) const {
        int pm, pn; if (!pg8::static_order(i, G, c, ntiles, nN, pm, pn)) return false;
        const int e = __builtin_amdgcn_readfirstlane((int)tile_e[pm]);
        const int tb = __builtin_amdgcn_readfirstlane((int)tbase[e]), ce = __builtin_amdgcn_readfirstlane((int)cnt[e]), eo = __builtin_amdgcn_readfirstlane((int)eoff[e]);
        u.pm = pm; u.pn = pn; u.e = e; u.pos0 = (pm - tb) * 256; u.nvalid = (ce - u.pos0) < 256 ? (ce - u.pos0) : 256; u.eoff = eo; return true;
    }
};
__device__ __forceinline__ MoeTabs moe_build_tabs(LAS unsigned char* lds, const unsigned* ctl, int wv) {
    LAS unsigned* cnt = (LAS unsigned*)(lds + TAB_CNT); LAS unsigned* eoff = (LAS unsigned*)(lds + TAB_EOFF); LAS unsigned* tbase = (LAS unsigned*)(lds + TAB_TBASE);
    LAS unsigned short* tile_e = (LAS unsigned short*)(lds + TAB_TILEE);
    __syncthreads();
    const int l = LANE_ID();
    if (wv == 0 && l < NEXP) cnt[l] = ctl[CW_CNT + 64 * l];
    __syncthreads();
    if (wv == 0 && l < NEXP) {
        unsigned eo = 0, tb = 0;
        for (int j = 0; j < NEXP; ++j) { const unsigned cj = cnt[j]; if (j < l) { eo += cj; tb += (cj + 255u) >> 8; } }
        const unsigned nt = (cnt[l] + 255u) >> 8;
        eoff[l] = eo; tbase[l] = tb;
        for (unsigned t = 0; t < nt; ++t) tile_e[tb + t] = (unsigned short)l;
        if (l == NEXP - 1) tbase[NEXP] = tb + nt;
    }
    __syncthreads();
    MoeTabs mt; mt.cnt = cnt; mt.eoff = eoff; mt.tbase = tbase; mt.tile_e = tile_e; mt.ntiles = __builtin_amdgcn_readfirstlane((int)tbase[NEXP]); return mt;
}

struct ProbUp {
    static constexpr int DIAG = 0;
    static constexpr bool GATHER = true, MIDK = false, FP8 = true; static constexpr int NMETA = 2;
    int probe_mode; MoeTabs tabs; const unsigned char* x8; const unsigned char* wgu; const unsigned* list; const float* rs2s; const float* bg; const float* bu; unsigned char* act; int G, c;
    __device__ __forceinline__ bool next(int i, Unit& u) const { return tabs.next(i, G, c, 8, u); }
    __device__ __forceinline__ const char* a_base(const Unit&) const { return (const char*)x8; }
    __device__ __forceinline__ const char* b_base(const Unit& u) const { return (const char*)wgu + ((size_t)u.e * 2048 + (size_t)u.pn * 256) * D; }
    __device__ __forceinline__ void a_offsets(const Unit& u, int tid, unsigned (&vo)[2][2]) const {
        int R[2], C[2];
#pragma unroll
        for (int i = 0; i < 2; ++i) pg8::stage_rc(tid * 16 + i * 8192, R[i], C[i]);
#pragma unroll
        for (int h = 0; h < 2; ++h)
#pragma unroll
            for (int i = 0; i < 2; ++i) { const int rl = h * 128 + R[i]; const int pos = u.pos0 + (rl < u.nvalid ? rl : 0);
                const unsigned slot = list[(size_t)u.e * T + pos]; vo[h][i] = (slot >> 2) * 1024u + (unsigned)C[i] * 2u; }
    }
    __device__ __forceinline__ const unsigned* meta_ptr(const Unit& u, int a, int idx) const {
        if (a == 0) return (const unsigned*)rs2s + (size_t)u.e * T + u.pos0 + idx;
        return (const unsigned*)(idx < 128 ? bg : bu) + (size_t)u.e * D + u.pn * 128 + (idx & 127);
    }
    __device__ __forceinline__ void epi(const f32x4 (&acc)[2][2][4][2], const Unit& u, int wr, int wc, int fr, int fq, const LAS unsigned char* mbuf) const {
        if (probe_mode == 1) return;
        const int col8 = u.pn * 128 + wc * 32 + 8 * fq;
        f32x4 bgv[2], buv[2];
#pragma unroll
        for (int n = 0; n < 2; ++n) { bgv[n] = *(const LAS f32x4*)(mbuf + 1024 + (wc * 32 + 8 * fq + 4 * n) * 4); buv[n] = *(const LAS f32x4*)(mbuf + 1536 + (wc * 32 + 8 * fq + 4 * n) * 4); }
        float rsv[2][4];
#pragma unroll
        for (int ai = 0; ai < 2; ++ai)
#pragma unroll
            for (int m = 0; m < 4; ++m) { const int rl = ai * 128 + wr * 64 + m * 16 + fr; rsv[ai][m] = *(const LAS float*)(mbuf + rl * 4) * (1.0f / 64.0f);
            }
#pragma unroll
        for (int ai = 0; ai < 2; ++ai)
#pragma unroll
            for (int m = 0; m < 4; ++m) {
                const int rl = ai * 128 + wr * 64 + m * 16 + fr;
                const float rs = rsv[ai][m];
                float o[8];
#pragma unroll
                for (int n = 0; n < 2; ++n)
#pragma unroll
                    for (int jp = 0; jp < 2; ++jp) {
                        const f32x2 ag = {acc[ai][0][m][n][2 * jp], acc[ai][0][m][n][2 * jp + 1]}, au = {acc[ai][1][m][n][2 * jp], acc[ai][1][m][n][2 * jp + 1]};
                        const f32x2 bg2 = {bgv[n][2 * jp], bgv[n][2 * jp + 1]}, bu2 = {buv[n][2 * jp], buv[n][2 * jp + 1]};
                        f32x2 g = ag * rs + bg2, up = au * rs + bu2;
                        g.x = fminf(g.x, 7.0f); g.y = fminf(g.y, 7.0f);
                        up.x = fminf(fmaxf(up.x, -7.0f), 7.0f); up.y = fminf(fmaxf(up.y, -7.0f), 7.0f);
                        const f32x2 z = g * (-1.702f * 1.4426950408889634f);
                        f32x2 e; e.x = fexp2(z.x); e.y = fexp2(z.y);
                        const f32x2 den = e + 1.0f;
                        f32x2 r; r.x = frcp(den.x); r.y = frcp(den.y);
                        const f32x2 res = (g * r) * (up + 1.0f);
                        o[4 * n + 2 * jp] = res.x; o[4 * n + 2 * jp + 1] = res.y;
                    }
                u32x2 w; w.x = pk4_fp8(o[0], o[1], o[2], o[3]); w.y = pk4_fp8(o[4], o[5], o[6], o[7]);
                if (rl < u.nvalid) *(u32x2*)(act + (size_t)(u.eoff + u.pos0 + rl) * D + col8) = w;
            }
    }
};

template <int DG> struct ProbUpDiag : ProbUp { static constexpr int DIAG = DG; };
struct ProbDown {
    static constexpr int DIAG = 0;
    static constexpr bool GATHER = false, MIDK = false, FP8 = true; static constexpr int NMETA = 3;
    int probe_mode; MoeTabs tabs; const unsigned char* act; const unsigned char* wd; const unsigned* list; const float* gw; const float* bd; unsigned char* y8; int G, c;
    __device__ __forceinline__ bool next(int i, Unit& u) const { return tabs.next(i, G, c, 4, u); }
    __device__ __forceinline__ const char* a_base(const Unit& u) const { return (const char*)act + (size_t)(u.eoff + u.pos0) * D; }
    __device__ __forceinline__ const char* b_base(const Unit& u) const { return (const char*)wd + ((size_t)u.e * D + (size_t)u.pn * 256) * D; }
    __device__ __forceinline__ void a_offsets(const Unit&, int, unsigned (&)[2][2]) const {}
    __device__ __forceinline__ const unsigned* meta_ptr(const Unit& u, int a, int idx) const {
        if (a == 2) return (const unsigned*)bd + (size_t)u.e * D + u.pn * 256 + idx;
        return (a == 0 ? list : (const unsigned*)gw) + (size_t)u.e * T + u.pos0 + idx;
    }
    __device__ __forceinline__ void epi(const f32x4 (&acc)[2][2][4][2], const Unit& u, int wr, int wc, int fr, int fq, const LAS unsigned char* mbuf) const {
        if (probe_mode == 1) return;
        const int cofs = u.pn * 256 + wc * 32 + 8 * fq;
        f32x4 bdv[2][2];
#pragma unroll
        for (int bj = 0; bj < 2; ++bj) { bdv[bj][0] = *(const LAS f32x4*)(mbuf + 2048 + (bj * 128 + wc * 32 + 8 * fq) * 4); bdv[bj][1] = *(const LAS f32x4*)(mbuf + 2048 + (bj * 128 + wc * 32 + 8 * fq + 4) * 4); }
#pragma unroll
        for (int ai = 0; ai < 2; ++ai)
#pragma unroll
            for (int m = 0; m < 4; ++m) {
                const int rl = ai * 128 + wr * 64 + m * 16 + fr;
                const unsigned sl = *(const LAS unsigned*)(mbuf + rl * 4);
                const float g = *(const LAS float*)(mbuf + 1024 + rl * 4), s1 = g * (Y8_SCALE / 64.0f), s2 = g * Y8_SCALE;
                unsigned char* dst = y8 + (size_t)sl * D + cofs;
#pragma unroll
                for (int bj = 0; bj < 2; ++bj) {
                    const f32x4 v0 = acc[ai][bj][m][0] * s1 + bdv[bj][0] * s2, v1 = acc[ai][bj][m][1] * s1 + bdv[bj][1] * s2;
                    u32x2 w; w.x = pk4_fp8(v0[0], v0[1], v0[2], v0[3]); w.y = pk4_fp8(v1[0], v1[1], v1[2], v1[3]);
                    if (rl < u.nvalid) *(u32x2*)(dst + bj * 128) = w;
                }
            }
    }
};

struct P0Item { const float* W; const float* scale; void* WT; int N, mode, off, k0, n0, fp8; };
__device__ __forceinline__ int p0_dest(const P0Item& d, int n) {
    if (d.mode == 1) { const int seg = n >> 9; if (seg == 2 || seg == 3) { const int w = n & 511, head = w >> 7, dd = w & 127; return (seg << 9) + (head << 7) + 2 * (dd & 63) + (dd >> 6); } return n; }
    if (d.mode == 2) return d.off + 256 * (n >> 7) + (n & 127);
    return d.off + n;
}
constexpr int P0_I_IN = 16 * (DIN / 64), P0_I_OUT = 16 * (D / 64), P0_I_E = 16 * (D / 64), P0_NITEMS_ALL = P0_I_IN + P0_I_OUT + 3 * NEXP * P0_I_E;
__device__ __forceinline__ void p0_load(const P0Item& d, int lane, f32x4 (&v)[16], float& sc) {
#pragma unroll
    for (int i = 0; i < 16; ++i) v[i] = *(const f32x4*)(d.W + (size_t)(d.k0 + (lane >> 4) + 4 * i) * d.N + d.n0 + 4 * (lane & 15));
    sc = d.scale ? d.scale[d.k0 + lane] : 1.0f;
    if (d.fp8) sc *= 64.0f;
}
__device__ __forceinline__ void p0_process(const P0Item& d, int lane, const f32x4 (&v)[16], float sc, LAS unsigned char* scr) {
    LAS float* ssc = (LAS float*)(scr + 64 * 136);
    ssc[lane] = sc;
    WAVE_SYNC();
#pragma unroll
    for (int i = 0; i < 16; ++i) { const int kk = (lane >> 4) + 4 * i; const float f = ssc[kk];
        u32x2 o; o.x = pk2(v[i].x * f, v[i].y * f); o.y = pk2(v[i].z * f, v[i].w * f);
        *(LAS u32x2*)(scr + kk * 136 + 8 * (lane & 15)) = o; }
    WAVE_SYNC();
    const int q = (lane & 15) >> 2, p = lane & 3;
    if (d.fp8) {
#pragma unroll
        for (int st = 0; st < 4; ++st) {
            const int n16 = 16 * st; unsigned o[4];
#pragma unroll
            for (int hf = 0; hf < 2; ++hf) {
                const int kb8 = 2 * (lane >> 4) + hf;
                const v4i16_t lo = __builtin_amdgcn_ds_read_tr16_b64_v4i16((LAS v4i16_t*)(scr + (8 * kb8 + q) * 136 + (n16 + 4 * p) * 2));
                const v4i16_t hi = __builtin_amdgcn_ds_read_tr16_b64_v4i16((LAS v4i16_t*)(scr + (8 * kb8 + 4 + q) * 136 + (n16 + 4 * p) * 2));
                o[2 * hf] = pk4_fp8(bf2f((unsigned short)lo[0]), bf2f((unsigned short)lo[1]), bf2f((unsigned short)lo[2]), bf2f((unsigned short)lo[3]));
                o[2 * hf + 1] = pk4_fp8(bf2f((unsigned short)hi[0]), bf2f((unsigned short)hi[1]), bf2f((unsigned short)hi[2]), bf2f((unsigned short)hi[3]));
            }
            *(u32x4*)((unsigned char*)d.WT + (size_t)p0_dest(d, d.n0 + n16 + (lane & 15)) * D + d.k0 + 16 * (lane >> 4)) = (u32x4){o[0], o[1], o[2], o[3]};
        }
    } else {
#pragma unroll
    for (int st = 0; st < 8; ++st) {
        const int n16 = 16 * (st & 3), kb8 = (st >> 2) * 4 + (lane >> 4);
        const v4i16_t lo = __builtin_amdgcn_ds_read_tr16_b64_v4i16((LAS v4i16_t*)(scr + (8 * kb8 + q) * 136 + (n16 + 4 * p) * 2));
        const v4i16_t hi = __builtin_amdgcn_ds_read_tr16_b64_v4i16((LAS v4i16_t*)(scr + (8 * kb8 + 4 + q) * 136 + (n16 + 4 * p) * 2));
        u32x4 o; o.x = (unsigned)(unsigned short)lo[0] | ((unsigned)(unsigned short)lo[1] << 16); o.y = (unsigned)(unsigned short)lo[2] | ((unsigned)(unsigned short)lo[3] << 16);
        o.z = (unsigned)(unsigned short)hi[0] | ((unsigned)(unsigned short)hi[1] << 16); o.w = (unsigned)(unsigned short)hi[2] | ((unsigned)(unsigned short)hi[3] << 16);
        *(u32x4*)((bf16_t*)d.WT + (size_t)p0_dest(d, d.n0 + n16 + (lane & 15)) * D + d.k0 + 8 * kb8) = o;
    }
    }
    WAVE_SYNC();
}

#ifndef STREAM_FINAL
#define STREAM_FINAL 1
#endif
#define STREAM_IN_PASS(fin) ((fin) ? (STREAM_FINAL != 0) : true)
struct MoeConv { const float *wg, *wu, *wd, *ffn_g; unsigned char *wgu8, *wd8; };
constexpr int MOE_ITEMS = 3 * NEXP * P0_I_E, NLRU = BATCH * NCH;
constexpr int MOE_PER_WU = (MOE_ITEMS + NLRU * 8 - 1) / (NLRU * 8);
constexpr int MOE_K0 = MOE_PER_WU >= 12 ? 8 : (MOE_PER_WU * 2 + 2) / 3, MOE_K1_RAW = MOE_PER_WU - MOE_K0, MOE_K1 = MOE_K1_RAW < 0 ? 0 : (MOE_K1_RAW > 8 ? 8 : MOE_K1_RAW);
constexpr int MOE_PASS0_ITEMS = NLRU * 8 * MOE_K0, MOE_CAP = NLRU * 8 * (MOE_K0 + MOE_K1), MOE_STREAMED = MOE_ITEMS < MOE_CAP ? MOE_ITEMS : MOE_CAP;
constexpr int P0_NITEMS = P0_NITEMS_ALL - MOE_STREAMED;
__device__ __forceinline__ P0Item moe_item(const MoeConv& M, int it) {
    P0Item d; d.scale = nullptr; d.off = 0; d.mode = 0; d.fp8 = 1; d.N = D;
    const int e = it / (3 * P0_I_E), q = (it / P0_I_E) % 3, r = it % P0_I_E;
    if (q == 0) { d.W = M.wg + (size_t)e * D * D; d.scale = M.ffn_g; d.WT = M.wgu8; d.mode = 2; d.off = e * 2048; }
    else if (q == 1) { d.W = M.wu + (size_t)e * D * D; d.scale = M.ffn_g; d.WT = M.wgu8; d.mode = 2; d.off = e * 2048 + 128; }
    else { d.W = M.wd + (size_t)e * D * D; d.WT = M.wd8; d.off = e * D; }
    d.k0 = 64 * (r / (D / 64)); d.n0 = 64 * (r % (D / 64)); return d;
}

constexpr int RT_STRIDE = 272;
constexpr int LDS_VT = 0, LDS_KT = 128 * RT_STRIDE;
constexpr int XA_STRIDE = 144, XA_WAVE = 16 * XA_STRIDE;
constexpr int AG_STRIDE = 520, AG_WAVE = 16 * AG_STRIDE;
constexpr int LRU_WAVE = XA_WAVE + AG_WAVE;
constexpr int LDS_XA = 0, LDS_SS = 8 * LRU_WAVE, LDS_RSL = LDS_SS + 8 * 128 * 4;
static_assert(LRU_WAVE % 16 == 0 && LRU_WAVE >= 64 * 136 + 256, "LRU per-wave LDS block must hold one weight item");
static_assert(LDS_RSL + 512 <= RING_BYTES && LDS_KT + 128 * RT_STRIDE <= RING_BYTES, "LDS seq map");

__device__ __forceinline__ bf16x8 tr_frag(const LAS unsigned char* tile, int row0, int col0, int fr) {
    const int q = fr >> 2, p = fr & 3;
    const v4i16_t lo = __builtin_amdgcn_ds_read_tr16_b64_v4i16((LAS v4i16_t*)(tile + (row0 + q) * RT_STRIDE + (col0 + 4 * p) * 2));
    const v4i16_t hi = __builtin_amdgcn_ds_read_tr16_b64_v4i16((LAS v4i16_t*)(tile + (row0 + 4 + q) * RT_STRIDE + (col0 + 4 * p) * 2));
    bf16x8 r; r[0] = lo[0]; r[1] = lo[1]; r[2] = lo[2]; r[3] = lo[3]; r[4] = hi[0]; r[5] = hi[1]; r[6] = hi[2]; r[7] = hi[3]; return r;
}
__device__ __forceinline__ void stage_tile(LAS unsigned char* dst, const bf16_t* src, int tid) {
#pragma unroll
    for (int i = 0; i < 4; ++i) { const int p = tid + 512 * i, r = p >> 4, c = p & 15;
        const u32x4 v = *(const u32x4*)(src + (size_t)r * DIN + c * 8); *(LAS u32x4*)(dst + r * RT_STRIDE + c * 16) = v; }
}

template <bool FINAL>
__device__ __forceinline__ void lru_unit(LAS unsigned char* lds, int b, int n, const bf16_t* __restrict__ proj, const float* __restrict__ conv_w, const float* __restrict__ conv_b, const bf16_t* __restrict__ waf,
                                         const float* __restrict__ ba, const float* __restrict__ bx, const float* __restrict__ lam, const float* __restrict__ lru_ng,
                                         float* __restrict__ lap, float* __restrict__ lah, const float* __restrict__ carry, bf16_t* __restrict__ ycat, float* __restrict__ rsl_out, const MoeConv& MC, int item0, int wv) {
    int tid_ = wv * 64 + LANE_ID(); OPAQUE(tid_);
    const int tid = tid_, lane = tid & 63, w = __builtin_amdgcn_readfirstlane(tid >> 6), fr = lane & 15, fq = lane >> 4, c = tid;
    LAS unsigned char* xa = lds + LDS_XA + w * LRU_WAVE; LAS unsigned char* ag = xa + XA_WAVE;
    LAS float* ss = (LAS float*)(lds + LDS_SS);
    bf16x8 Ba[2][4], Bx[2][4];
#pragma unroll
    for (int ks = 0; ks < 2; ++ks)
#pragma unroll
        for (int nt = 0; nt < 4; ++nt) { const size_t fi = ((size_t)(w * 2 + ks) * 4 + nt) * 64 + lane; Ba[ks][nt] = *(const bf16x8*)(waf + fi * 8); Bx[ks][nt] = *(const bf16x8*)(waf + (fi + 4096) * 8); }
    float bav[4], bxv[4], spl[4];
#pragma unroll
    for (int nt = 0; nt < 4; ++nt) { const int co = w * 64 + 16 * nt + fr; bav[nt] = ba[co]; bxv[nt] = bx[co]; const float l = lam[co];
        spl[nt] = -8.0f * 1.4426950408889634f * (fmaxf(-l, 0.f) + log1pf(expf(-fabsf(l)))); }
    const float w0 = conv_w[c], w1 = conv_w[512 + c], w2 = conv_w[1024 + c], w3 = conv_w[1536 + c], cb = conv_b[c];
    const float gn = FINAL ? lru_ng[c] : 0.f;
    const size_t t0 = (size_t)b * SEQ + (size_t)n * 128;
    float xm3 = 0.f, xm2 = 0.f, xm1 = 0.f;
    if (n > 0) { xm3 = bf2f(proj[(t0 - 3) * DIN + c]); xm2 = bf2f(proj[(t0 - 2) * DIN + c]); xm1 = bf2f(proj[(t0 - 1) * DIN + c]); }
    float h = FINAL ? carry[((size_t)b * NCH + n) * 512 + c] : 0.f, P = 1.f;
    unsigned xr[16];
#pragma unroll
    for (int i = 0; i < 16; ++i) xr[i] = proj[(t0 + i) * DIN + c];
    for (int tt = 0; tt < 8; ++tt) {
        float xcv[16]; unsigned gr[16];
#pragma unroll
        for (int i = 0; i < 16; ++i) { xcv[i] = bf2f(xr[i]); gr[i] = FINAL ? (unsigned)proj[(t0 + tt * 16 + i) * DIN + 512 + c] : 0u; }
        if (tt < 7) {
#pragma unroll
            for (int i = 0; i < 16; ++i) xr[i] = proj[(t0 + (tt + 1) * 16 + i) * DIN + c];
        }
        constexpr int KP = FINAL ? MOE_K1 : MOE_K0;
        const int cit = item0 + (w * KP + tt);
        const bool chas = (tt < KP) && (cit < MOE_STREAMED);
        P0Item cd; f32x4 cv[16]; float csc = 1.f;
        if (chas) { cd = moe_item(MC, cit); p0_load(cd, lane, cv, csc); }
#pragma unroll
        for (int i = 0; i < 16; ++i) {
            const float x0 = xcv[i];
            const float xc = w0 * xm3 + w1 * xm2 + w2 * xm1 + w3 * x0 + cb;
            xm3 = xm2; xm2 = xm1; xm1 = x0; xcv[i] = xc;
            *(LAS bf16_t*)(xa + i * XA_STRIDE + lane * 2) = (bf16_t)f2bf(xc);
        }
        WAVE_SYNC();
        bf16x8 af[2];
#pragma unroll
        for (int ks = 0; ks < 2; ++ks) af[ks] = *(const LAS bf16x8*)(xa + fr * XA_STRIDE + (32 * ks + 8 * fq) * 2);
#pragma unroll
        for (int nt = 0; nt < 4; ++nt) {
            f32x4 ar = {0.f, 0.f, 0.f, 0.f}, ai = {0.f, 0.f, 0.f, 0.f};
#pragma unroll
            for (int ks = 0; ks < 2; ++ks) { ar = __builtin_amdgcn_mfma_f32_16x16x32_bf16(af[ks], Ba[ks][nt], ar, 0, 0, 0); ai = __builtin_amdgcn_mfma_f32_16x16x32_bf16(af[ks], Bx[ks][nt], ai, 0, 0, 0); }
#pragma unroll
            for (int r = 0; r < 4; ++r) {
                const float rr = sigmoid_f(ar[r] + bav[nt]), ii = sigmoid_f(ai[r] + bxv[nt]);
                const float a = fexp2(rr * spl[nt]);
                const float g = sqrtf(fmaxf(1.0f - a * a, 0.f)) * ii;
                *(LAS f32x2*)(ag + (4 * fq + r) * AG_STRIDE + (16 * nt + fr) * 8) = (f32x2){a, g};
            }
        }
        WAVE_SYNC();
        unsigned upk[8];
#pragma unroll
        for (int i = 0; i < 16; ++i) {
            const f32x2 v = *(const LAS f32x2*)(ag + i * AG_STRIDE + lane * 8);
            h = v.x * h + v.y * xcv[i];
            if (!FINAL) P *= v.x;
            if (FINAL) {
                const float u = h * bf2f(gr[i]);
                const unsigned ub = f2bf(u * gn);
                if (i & 1) upk[i >> 1] |= ub << 16; else upk[i >> 1] = ub;
                *(LAS float*)(ag + i * AG_STRIDE + lane * 8) = u;
            }
        }
        if (FINAL) {
            WAVE_SYNC();
            const int tk = lane & 15, qd = lane >> 4; float s = 0.f;
#pragma unroll
            for (int i = 0; i < 16; ++i) { const float u = *(const LAS float*)(ag + tk * AG_STRIDE + (16 * qd + i) * 8); s += u * u; }
            s += SHFLX_F(s, 16, lane); s += SHFLX_F(s, 32, lane);
            if (qd == 0) ss[w * 128 + tt * 16 + tk] = s;
        }
        WAVE_SYNC();
        if (chas) p0_process(cd, lane, cv, csc, xa);
        if (FINAL) {
#pragma unroll
            for (int i = 0; i < 16; ++i) ycat[(t0 + tt * 16 + i) * D + c] = (bf16_t)((i & 1) ? (upk[i >> 1] >> 16) : (upk[i >> 1] & 0xffffu));
        }
    }
    if (!FINAL) { lap[((size_t)b * NCH + n) * 512 + c] = P; lah[((size_t)b * NCH + n) * 512 + c] = h; }
    else {
        __syncthreads();
        if (tid < 128) { float tot = 0.f;
#pragma unroll
            for (int q = 0; q < 8; ++q) tot += ss[q * 128 + tid];
            rsl_out[t0 + tid] = 1.0f / sqrtf(tot * (1.0f / 512.0f) + NORM_EPS); }
    }
    __syncthreads();
}

__device__ __forceinline__ void ret_kv_load(u32x4 (&tk)[4], u32x4 (&tv)[4], int unit, const bf16_t* __restrict__ proj, int tid) {
    const int bh = unit / NCH, n = unit % NCH, b = bh >> 2, hh = bh & 3;
    const size_t t0 = (size_t)b * SEQ + (size_t)n * 128;
#pragma unroll
    for (int i = 0; i < 4; ++i) { const int p = tid + 512 * i, r = p >> 4, c = p & 15;
        tk[i] = *(const u32x4*)(proj + (t0 + r) * DIN + 1536 + hh * 128 + c * 8); tv[i] = *(const u32x4*)(proj + (t0 + r) * DIN + 2048 + hh * 128 + c * 8); }
}
__device__ __forceinline__ void ret_kv_stage(LAS unsigned char* lds, const u32x4 (&tk)[4], const u32x4 (&tv)[4], int tid) {
#pragma unroll
    for (int i = 0; i < 4; ++i) { const int p = tid + 512 * i, r = p >> 4, c = p & 15;
        *(LAS u32x4*)(lds + LDS_KT + r * RT_STRIDE + c * 16) = tk[i]; *(LAS u32x4*)(lds + LDS_VT + r * RT_STRIDE + c * 16) = tv[i]; }
}
__device__ __forceinline__ void ret_kv_phase(LAS unsigned char* lds, const bf16_t* __restrict__ proj, bf16_t* __restrict__ kvt, int G, int bx, int wv) {
    int tid_ = wv * 64 + LANE_ID(); OPAQUE(tid_);
    const int tid = tid_, lane = tid & 63, w = wv, fr = lane & 15, fq = lane >> 4;
    u32x4 tk[4], tv[4];
    int unit = bx;
    if (unit < NBH * NCH) { ret_kv_load(tk, tv, unit, proj, tid); ret_kv_stage(lds, tk, tv, tid); __syncthreads(); if (unit + G < NBH * NCH) ret_kv_load(tk, tv, unit + G, proj, tid); }
    for (; unit < NBH * NCH; unit += G) {
        f32x4 acc[8];
#pragma unroll
        for (int et = 0; et < 8; ++et) acc[et] = (f32x4){0.f, 0.f, 0.f, 0.f};
#pragma unroll
        for (int ks = 0; ks < 4; ++ks) {
            const bf16x8 af = tr_frag(lds + LDS_KT, 32 * ks + 8 * fq, 16 * w, fr);
#pragma unroll
            for (int et = 0; et < 8; ++et) { const bf16x8 bfv = tr_frag(lds + LDS_VT, 32 * ks + 8 * fq, 16 * et, fr);
                acc[et] = __builtin_amdgcn_mfma_f32_16x16x32_bf16(af, bfv, acc[et], 0, 0, 0); }
        }
        u32x2 o[8];
#pragma unroll
        for (int et = 0; et < 8; ++et) { o[et].x = pk2v(acc[et][0], acc[et][1]); o[et].y = pk2v(acc[et][2], acc[et][3]); }
        __syncthreads();
        if (unit + G < NBH * NCH) ret_kv_stage(lds, tk, tv, tid);
        bf16_t* out = kvt + (size_t)unit * 16384;
#pragma unroll
        for (int et = 0; et < 8; ++et) *(u32x2*)(out + (size_t)(16 * et + fr) * 128 + 16 * w + 4 * fq) = o[et];
        __syncthreads();
        if (unit + 2 * G < NBH * NCH) ret_kv_load(tk, tv, unit + 2 * G, proj, tid);
    }
}

__device__ __forceinline__ int swz_off(int row, int chunk) { return row * 256 + ((chunk ^ (row & 15)) << 4); }
constexpr int LDS_RV = 0, LDS_RK = 32768, LDS_RP = 65536, LDS_RPT = 98304;
__device__ __forceinline__ bf16x8 tr_frag_swz(const LAS unsigned char* tile, int row0, int col0, int fr) {
    const int q = fr >> 2, p = fr & 3, ch = (col0 >> 3) + (p >> 1), bo = (p & 1) * 8;
    const v4i16_t lo = __builtin_amdgcn_ds_read_tr16_b64_v4i16((LAS v4i16_t*)(tile + swz_off(row0 + q, ch) + bo));
    const v4i16_t hi = __builtin_amdgcn_ds_read_tr16_b64_v4i16((LAS v4i16_t*)(tile + swz_off(row0 + 4 + q, ch) + bo));
    bf16x8 r; r[0] = lo[0]; r[1] = lo[1]; r[2] = lo[2]; r[3] = lo[3]; r[4] = hi[0]; r[5] = hi[1]; r[6] = hi[2]; r[7] = hi[3]; return r;
}
struct RetRegs { u32x4 tv[4], tk[4], tp[4]; bf16x8 bq[4]; u32x2 sg[8]; };
__device__ __forceinline__ void ret_out_load(RetRegs& R, int unit, const bf16_t* __restrict__ proj, const bf16_t* __restrict__ prevt, int tid, int w, int fr, int fq) {
    const int bh = unit / NCH, n = unit % NCH, b = bh >> 2, hh = bh & 3;
    const size_t t0 = (size_t)b * SEQ + (size_t)n * 128;
#pragma unroll
    for (int i = 0; i < 4; ++i) { const int p = tid + 512 * i, r = p >> 4, c = p & 15;
        R.tv[i] = *(const u32x4*)(proj + (t0 + r) * DIN + 2048 + hh * 128 + c * 8);
        R.tk[i] = *(const u32x4*)(proj + (t0 + r) * DIN + 1536 + hh * 128 + c * 8);
        R.tp[i] = *(const u32x4*)(prevt + (size_t)unit * 16384 + r * 128 + c * 8); }
#pragma unroll
    for (int ks = 0; ks < 4; ++ks) R.bq[ks] = *(const bf16x8*)(proj + (t0 + 16 * w + fr) * DIN + 1024 + hh * 128 + 32 * ks + 8 * fq);
#pragma unroll
    for (int et = 0; et < 8; ++et) R.sg[et] = *(const u32x2*)(proj + (t0 + 16 * w + fr) * DIN + 2560 + hh * 128 + 16 * et + 4 * fq);
}
__device__ __forceinline__ void ret_out_phase(LAS unsigned char* lds, const bf16_t* __restrict__ proj, const bf16_t* __restrict__ prevt, const float* __restrict__ gng, const float* __restrict__ gnb, bf16_t* __restrict__ ycat, int G, int bx, int wv) {
    int tid_ = wv * 64 + LANE_ID(); OPAQUE(tid_);
    const int tid = tid_, lane = tid & 63, w = __builtin_amdgcn_readfirstlane(tid >> 6), fr = lane & 15, fq = lane >> 4;
    RetRegs R;
    int unit = bx;
    bf16x8 bq[4]; u32x2 sg[8];
    if (unit < NBH * NCH) {
        ret_out_load(R, unit, proj, prevt, tid, w, fr, fq);
#pragma unroll
        for (int i = 0; i < 4; ++i) { const int p = tid + 512 * i, r = p >> 4, c = p & 15, o = swz_off(r, c);
            *(LAS u32x4*)(lds + LDS_RV + o) = R.tv[i]; *(LAS u32x4*)(lds + LDS_RK + o) = R.tk[i]; *(LAS u32x4*)(lds + LDS_RP + o) = R.tp[i]; }
#pragma unroll
        for (int ks = 0; ks < 4; ++ks) bq[ks] = R.bq[ks];
#pragma unroll
        for (int et = 0; et < 8; ++et) sg[et] = R.sg[et];
        __syncthreads();
        if (unit + G < NBH * NCH) ret_out_load(R, unit + G, proj, prevt, tid, w, fr, fq);
    }
    for (; unit < NBH * NCH; unit += G) {
        const int bh = unit / NCH, n = unit % NCH, b = bh >> 2, hh = bh & 3;
        const size_t t0 = (size_t)b * SEQ + (size_t)n * 128;
        const int crow = 16 * w + fr;
#pragma unroll
        for (int mt = 0; mt < 8; ++mt) {
            if (mt <= w) {
                f32x4 sacc = {0.f, 0.f, 0.f, 0.f};
#pragma unroll
                for (int ks = 0; ks < 4; ++ks) { const bf16x8 ak = *(const LAS bf16x8*)(lds + LDS_RK + swz_off(16 * mt + fr, 4 * ks + fq));
                    sacc = __builtin_amdgcn_mfma_f32_16x16x32_bf16(ak, bq[ks], sacc, 0, 0, 0); }
                if (mt == w) {
#pragma unroll
                    for (int r = 0; r < 4; ++r) if (4 * fq + r > fr) sacc[r] = 0.f;
                }
                u32x2 o; o.x = pk2v(sacc[0], sacc[1]); o.y = pk2v(sacc[2], sacc[3]);
                *(LAS u32x2*)(lds + LDS_RPT + swz_off(crow, 2 * mt + (fq >> 1)) + (fq & 1) * 8) = o;
            } else if (mt == w + 1 && (mt & 1)) {
                *(LAS u32x2*)(lds + LDS_RPT + swz_off(crow, 2 * mt + (fq >> 1)) + (fq & 1) * 8) = (u32x2){0u, 0u};
            }
        }
        WAVE_SYNC();
        f32x4 acc[8];
#pragma unroll
        for (int et = 0; et < 8; ++et) acc[et] = (f32x4){0.f, 0.f, 0.f, 0.f};
        const int nks = (w + 2) >> 1;
#pragma unroll
        for (int ksm = 0; ksm < 4; ++ksm) {
            if (ksm < nks) {
                const bf16x8 bp = *(const LAS bf16x8*)(lds + LDS_RPT + swz_off(crow, 4 * ksm + fq));
#pragma unroll
                for (int et = 0; et < 8; ++et) { const bf16x8 av = tr_frag_swz(lds + LDS_RV, 32 * ksm + 8 * fq, 16 * et, fr);
                    acc[et] = __builtin_amdgcn_mfma_f32_16x16x32_bf16(av, bp, acc[et], 0, 0, 0); }
            }
        }
#pragma unroll
        for (int et = 0; et < 8; ++et)
#pragma unroll
            for (int ks = 0; ks < 4; ++ks) { const bf16x8 ap = *(const LAS bf16x8*)(lds + LDS_RP + swz_off(16 * et + fr, 4 * ks + fq));
                acc[et] = __builtin_amdgcn_mfma_f32_16x16x32_bf16(ap, bq[ks], acc[et], 0, 0, 0); }
        float s1 = 0.f;
#pragma unroll
        for (int et = 0; et < 8; ++et) s1 += (acc[et][0] + acc[et][1]) + (acc[et][2] + acc[et][3]);
        s1 += SHFLX_F(s1, 16, lane); s1 += SHFLX_F(s1, 32, lane);
        const float mu = s1 * (1.0f / 128.0f);
        float s2 = 0.f;
#pragma unroll
        for (int et = 0; et < 8; ++et)
#pragma unroll
            for (int r = 0; r < 4; ++r) { const float dlt = acc[et][r] - mu; s2 += dlt * dlt; }
        s2 += SHFLX_F(s2, 16, lane); s2 += SHFLX_F(s2, 32, lane);
        const float rstd = 1.0f / sqrtf(s2 * (1.0f / 128.0f) + NORM_EPS);
        const size_t t = t0 + 16 * w + fr;
        u32x2 yo[8];
#pragma unroll
        for (int et = 0; et < 8; ++et) {
            const int e0 = hh * 128 + 16 * et + 4 * fq;
            const f32x4 gv = *(const f32x4*)(gng + e0), bv = *(const f32x4*)(gnb + e0);
            const float y0 = ((acc[et][0] - mu) * rstd * gv[0] + bv[0]) * bflo(sg[et].x), y1 = ((acc[et][1] - mu) * rstd * gv[1] + bv[1]) * bfhi(sg[et].x);
            const float y2 = ((acc[et][2] - mu) * rstd * gv[2] + bv[2]) * bflo(sg[et].y), y3 = ((acc[et][3] - mu) * rstd * gv[3] + bv[3]) * bfhi(sg[et].y);
            yo[et].x = pk2v(y0, y1); yo[et].y = pk2v(y2, y3);
        }
        __syncthreads();
        const bool has_next = unit + G < NBH * NCH;
        if (has_next) {
#pragma unroll
            for (int i = 0; i < 4; ++i) { const int p = tid + 512 * i, r = p >> 4, c = p & 15, o = swz_off(r, c);
                *(LAS u32x4*)(lds + LDS_RV + o) = R.tv[i]; *(LAS u32x4*)(lds + LDS_RK + o) = R.tk[i]; *(LAS u32x4*)(lds + LDS_RP + o) = R.tp[i]; }
#pragma unroll
            for (int ks = 0; ks < 4; ++ks) bq[ks] = R.bq[ks];
#pragma unroll
            for (int et = 0; et < 8; ++et) sg[et] = R.sg[et];
        }
#pragma unroll
        for (int et = 0; et < 8; ++et) *(u32x2*)(ycat + t * D + 512 + hh * 128 + 16 * et + 4 * fq) = yo[et];
        __syncthreads();
        if (unit + 2 * G < NBH * NCH) ret_out_load(R, unit + 2 * G, proj, prevt, tid, w, fr, fq);
    }
}

struct Ptrs {
    const float *x, *attn_g, *w_in, *conv_w, *conv_b, *lru_wa, *lru_ba, *lru_wx, *lru_bx, *lru_lam, *lru_ng, *ret_ng, *ret_nb, *w_out, *ffn_g, *router_w, *router_b;
    const float *moe_wg, *moe_bg, *moe_wu, *moe_bu, *moe_wd, *moe_bd, *final_g; const int* positions;
    float *RS1, *RS2S, *SSQ, *GW, *LAP, *LAH, *CARRY, *out; unsigned *LIST, *ctl;
    bf16_t *WR_T, *WIN_T, *WOUT_T, *PROJ, *XB, *YCAT, *YB23, *KVT, *PREVT, *YB01, *WAF; float* RSL; unsigned char *WGU8, *WD8, *X8, *ACT; int wv;
};
__device__ __forceinline__ MoeConv moe_conv(const Ptrs& P) { MoeConv M; M.wg = P.moe_wg; M.wu = P.moe_wu; M.wd = P.moe_wd; M.ffn_g = P.ffn_g; M.wgu8 = P.WGU8; M.wd8 = P.WD8; return M; }
#define PHASE_IDS() int tid = P.wv * 64 + LANE_ID(); OPAQUE(tid); const int lane = tid & 63, wave = P.wv; const int gw = bx * NWAVES + wave, NGW = G * NWAVES; (void)lane; (void)gw; (void)NGW

__device__ __forceinline__ P0Item p0_decode(const Ptrs& P, int it) {
    P0Item d; d.scale = nullptr; d.off = 0; d.mode = 0; d.fp8 = 0; int r = it, nblk;
    if (r < P0_I_IN) { d.W = P.w_in; d.scale = P.attn_g; d.N = DIN; d.WT = P.WIN_T; d.mode = 1; }
    else if ((r -= P0_I_IN) < P0_I_OUT) { d.W = P.w_out; d.N = D; d.WT = P.WOUT_T; }
    else { r -= P0_I_OUT; r += MOE_STREAMED;
        const int e = r / (3 * P0_I_E), q = (r / P0_I_E) % 3; r = r % P0_I_E; d.N = D;
        d.fp8 = 1;
        if (q == 0) { d.W = P.moe_wg + (size_t)e * D * D; d.scale = P.ffn_g; d.WT = P.WGU8; d.mode = 2; d.off = e * 2048; }
        else if (q == 1) { d.W = P.moe_wu + (size_t)e * D * D; d.scale = P.ffn_g; d.WT = P.WGU8; d.mode = 2; d.off = e * 2048 + 128; }
        else { d.W = P.moe_wd + (size_t)e * D * D; d.WT = P.WD8; d.off = e * D; } }
    nblk = d.N / 64; d.k0 = 64 * (r / nblk); d.n0 = 64 * (r % nblk); return d;
}
__device__ __forceinline__ void p0_prologue(LAS unsigned char* lds, const Ptrs& P, int G, int bx) {
    PHASE_IDS();
    {
        f32x4 v[4], nv[4];
        int m = gw;
        if (m < T) {
#pragma unroll
            for (int j = 0; j < 4; ++j) v[j] = ((const f32x4*)(P.x + (size_t)m * D))[lane + 64 * j];
        }
        for (; m < T; m += NGW) {
            const int mn = m + NGW;
            if (mn < T) {
#pragma unroll
                for (int j = 0; j < 4; ++j) nv[j] = ((const f32x4*)(P.x + (size_t)mn * D))[lane + 64 * j];
            }
            float s = 0.f;
#pragma unroll
            for (int j = 0; j < 4; ++j) s += (v[j].x * v[j].x + v[j].y * v[j].y) + (v[j].z * v[j].z + v[j].w * v[j].w);
            s = wave_sum(s, lane);
            if (lane == 0) P.RS1[m] = 1.0f / sqrtf(s * (1.0f / D) + NORM_EPS);
            u32x2* o8 = (u32x2*)(P.XB + (size_t)m * D) + lane;
#pragma unroll
            for (int j = 0; j < 4; ++j) { u32x2 o; o.x = pk2(v[j].x, v[j].y); o.y = pk2(v[j].z, v[j].w); o8[64 * j] = o; }
#pragma unroll
            for (int j = 0; j < 4; ++j) v[j] = nv[j];
        }
    }
    {
        LAS unsigned char* scr = lds + wave * 16384;
        f32x4 v[16], nv[16]; float sc = 1.f, nsc = 1.f;
        int it = gw;
        P0Item d, nd;
        if (it < P0_NITEMS) { d = p0_decode(P, it); p0_load(d, lane, v, sc); }
        for (; it < P0_NITEMS; it += NGW) {
            const int nit = it + NGW;
            if (nit < P0_NITEMS) { nd = p0_decode(P, nit); p0_load(nd, lane, nv, nsc); }
            p0_process(d, lane, v, sc, scr);
            d = nd; sc = nsc;
#pragma unroll
            for (int i = 0; i < 16; ++i) v[i] = nv[i];
        }
    }
    for (int i = bx * NTHREADS + tid; i < 32 * D; i += G * NTHREADS) { const int e = i / D, k = i % D; P.WR_T[i] = (bf16_t)((e < NEXP) ? f2bf(P.router_w[(size_t)k * NEXP + e] * P.ffn_g[k]) : 0u); }
    for (int i = bx * NTHREADS + tid; i < 2 * 8 * 2 * 4 * 64; i += G * NTHREADS) {
        const int ln = i & 63, nt = (i >> 6) & 3, ks = (i >> 8) & 1, h = (i >> 9) & 7, mat = i >> 12, fr = ln & 15, fq = ln >> 4;
        const float* w = mat ? P.lru_wx : P.lru_wa; unsigned pk[4];
#pragma unroll
        for (int j = 0; j < 4; ++j) { const size_t i0 = ((size_t)h * 64 + 32 * ks + 8 * fq + 2 * j) * 64 + 16 * nt + fr; pk[j] = pk2(w[i0], w[i0 + 64]); }
        *(u32x4*)(P.WAF + (size_t)i * 8) = (u32x4){pk[0], pk[1], pk[2], pk[3]};
    }
}

__device__ __forceinline__ void p3_scans(const Ptrs& P, int G, int bx) {
    PHASE_IDS();
    if (wave == NWAVES - 1) {
        const int per = (BATCH * 512 + G - 1) / G;
        for (int i = bx * per + lane; lane < per && i < BATCH * 512 && i < (bx + 1) * per; i += 64) { const int b = i / 512, c = i % 512; float st = 0.f;
            for (int n0 = 0; n0 < NCH; n0 += 32) {
                float ap[32], ah[32];
#pragma unroll
                for (int j = 0; j < 32; ++j) { const size_t o = ((size_t)b * NCH + (n0 + j < NCH ? n0 + j : 0)) * 512 + c; ap[j] = P.LAP[o]; ah[j] = P.LAH[o]; }
#pragma unroll
                for (int j = 0; j < 32; ++j) { if (n0 + j < NCH) { P.CARRY[((size_t)b * NCH + n0 + j) * 512 + c] = st; st = ap[j] * st + ah[j]; } }
            }
        }
    }
    for (int i = bx * NTHREADS + tid; i < NBH * 8192; i += G * NTHREADS) {
        const int bh = i / 8192, rem = i % 8192, hh = bh & 3;
        const float lamb = exp2f(128.0f * log2_gamma(hh));
        float s0 = 0.f, s1 = 0.f;
        const unsigned* src = (const unsigned*)(P.KVT + (size_t)bh * NCH * 16384) + rem; unsigned* dst = (unsigned*)(P.PREVT + (size_t)bh * NCH * 16384) + rem;
        for (int n0 = 0; n0 < NCH; n0 += 64) {
            unsigned kv[64];
#pragma unroll
            for (int j = 0; j < 64; ++j) kv[j] = (n0 + j < NCH) ? src[(size_t)(n0 + j) * 8192] : 0u;
#pragma unroll
            for (int j = 0; j < 64; ++j) { if (n0 + j < NCH) { dst[(size_t)(n0 + j) * 8192] = pk2(s0, s1); s0 = lamb * (s0 + bflo(kv[j])); s1 = lamb * (s1 + bfhi(kv[j])); } }
        }
    }
}

constexpr int CW_HIST = 32768;
__device__ __forceinline__ void p6_router(LAS unsigned char* lds, const Ptrs& P, int G, int bx, const XcdBarrier& bar) {
    PHASE_IDS();
    LAS unsigned* hist = (LAS unsigned*)(lds + 0); LAS unsigned* base = (LAS unsigned*)(lds + 256); LAS unsigned* part = (LAS unsigned*)(lds + 512);
    const int fr = lane & 15, fq = lane >> 4;
    const bool act = bx < T / 128;
    if (tid < 64) hist[tid] = 0u;
    __syncthreads();
    const int tok = (act ? bx : 0) * 128 + wave * 16 + fr;
    f32x4 lg[2] = {{0.f, 0.f, 0.f, 0.f}, {0.f, 0.f, 0.f, 0.f}};
    for (int ks = 0; ks < 32; ++ks) {
        const bf16x8 bt = *(const bf16x8*)(P.YB01 + (size_t)tok * 2048 + 32 * ks + 8 * fq);
#pragma unroll
        for (int tt = 0; tt < 2; ++tt) { const bf16x8 aw = *(const bf16x8*)(P.WR_T + (size_t)(16 * tt + fr) * D + 32 * ks + 8 * fq);
            lg[tt] = __builtin_amdgcn_mfma_f32_16x16x32_bf16(aw, bt, lg[tt], 0, 0, 0); }
    }
    float tot = 0.f;
#pragma unroll
    for (int p = 0; p < 16; ++p) tot += P.SSQ[(size_t)p * T + tok];
    const float rs = 1.0f / sqrtf(tot * (1.0f / D) + NORM_EPS);
    float val[8];
#pragma unroll
    for (int tt = 0; tt < 2; ++tt)
#pragma unroll
        for (int r = 0; r < 4; ++r) { const int e = 16 * tt + 4 * fq + r; val[4 * tt + r] = (e < NEXP) ? (lg[tt][r] * rs + P.router_b[e < NEXP ? e : 0]) : -3.0e38f; }
    float tv[4]; int ti[4];
#pragma unroll
    for (int k = 0; k < 4; ++k) {
        float bv = -3.4e38f; int bi = 1 << 20;
#pragma unroll
        for (int q = 0; q < 8; ++q) { const int e = 16 * (q >> 2) + 4 * fq + (q & 3); if (val[q] > bv || (val[q] == bv && e < bi)) { bv = val[q]; bi = e; } }
#pragma unroll
        for (int o = 16; o <= 32; o <<= 1) { const float ov = SHFLX_F(bv, o, lane); const int oi = SHFLX_I(bi, o, lane); if (ov > bv || (ov == bv && oi < bi)) { bv = ov; bi = oi; } }
        tv[k] = bv; ti[k] = bi;
#pragma unroll
        for (int q = 0; q < 8; ++q) { const int e = 16 * (q >> 2) + 4 * fq + (q & 3); if (e == bi) val[q] = -3.4e38f; }
    }
    float ex[4], den = 0.f;
#pragma unroll
    for (int k = 0; k < 4; ++k) { ex[k] = expf(tv[k] - tv[0]); den += ex[k]; }
    unsigned lp[4] = {0u, 0u, 0u, 0u};
    if (act && fq == 0) {
#pragma unroll
        for (int k = 0; k < 4; ++k) lp[k] = __hip_atomic_fetch_add(&hist[ti[k]], 1u, __ATOMIC_RELAXED, __HIP_MEMORY_SCOPE_WORKGROUP);
    }
    __syncthreads();
    if (tid < 32) P.ctl[CW_HIST + bx * 32 + tid] = hist[tid];
    xcd_barrier(bar, P.wv);
    {
        const int e = tid & 31, pt = tid >> 5; unsigned sum = 0u;
#pragma unroll
        for (int i = 0; i < 16; ++i) { const int w = pt * 16 + i; const unsigned c = P.ctl[CW_HIST + (w < G ? w : 0) * 32 + e]; sum += (w < bx) ? c : 0u; }
        part[pt * 32 + e] = sum;
    }
    __syncthreads();
    if (tid < 32) { unsigned sum = 0u;
#pragma unroll
        for (int i = 0; i < 16; ++i) sum += part[i * 32 + tid];
        base[tid] = sum;
        if (bx == G - 1 && tid < NEXP) P.ctl[CW_CNT + 64 * tid] = sum + hist[tid]; }
    __syncthreads();
    if (act && fq == 0) {
#pragma unroll
        for (int k = 0; k < 4; ++k) { const size_t o = (size_t)ti[k] * T + base[ti[k]] + lp[k]; P.LIST[o] = (unsigned)tok * 4u + (unsigned)k; P.GW[o] = ex[k] / den; P.RS2S[o] = rs; }
    }
    __syncthreads();
}

__device__ __forceinline__ void p9_final(const Ptrs& P, int G, int bx) {
    PHASE_IDS();
    const unsigned char* Y8 = (const unsigned char*)P.YB23;
    u32x4 q[2], nq[2], nnq[2]; u32x2 e[8], ne[8], nne[8];
    int m = gw;
#define P9_LOAD(dq, de, row) do { _Pragma("unroll") for (int j = 0; j < 2; ++j) { const int col = (j * 64 + lane) * 8; \
        dq[j] = *(const u32x4*)(P.YB01 + (size_t)(row) * 2048 + col); \
        _Pragma("unroll") for (int k = 0; k < 4; ++k) de[4 * j + k] = *(const u32x2*)(Y8 + (size_t)(row) * 4096 + k * 1024 + col); } } while (0)
    if (m < T) P9_LOAD(q, e, m);
    if (m + NGW < T) P9_LOAD(nq, ne, m + NGW);
    f32x4 g0[2], g1[2];
#pragma unroll
    for (int j = 0; j < 2; ++j) { const int col = (j * 64 + lane) * 8; g0[j] = *(const f32x4*)(P.final_g + col); g1[j] = *(const f32x4*)(P.final_g + col + 4); }
    for (; m < T; m += NGW) {
        const int mn = m + 2 * NGW;
        if (mn < T) P9_LOAD(nnq, nne, mn);
        float v[2][8]; float s = 0.f;
#pragma unroll
        for (int j = 0; j < 2; ++j) {
            f32x2 t[4] = {{0.f, 0.f}, {0.f, 0.f}, {0.f, 0.f}, {0.f, 0.f}};
#pragma unroll
            for (int k = 0; k < 4; ++k) { const u32x2 w = e[4 * j + k]; t[0] += unpk2_fp8(w.x, false); t[1] += unpk2_fp8(w.x, true); t[2] += unpk2_fp8(w.y, false); t[3] += unpk2_fp8(w.y, true); }
            const u32x4 a = q[j];
            v[j][0] = bflo(a.x) + t[0].x * (1.0f / Y8_SCALE); v[j][1] = bfhi(a.x) + t[0].y * (1.0f / Y8_SCALE); v[j][2] = bflo(a.y) + t[1].x * (1.0f / Y8_SCALE); v[j][3] = bfhi(a.y) + t[1].y * (1.0f / Y8_SCALE);
            v[j][4] = bflo(a.z) + t[2].x * (1.0f / Y8_SCALE); v[j][5] = bfhi(a.z) + t[2].y * (1.0f / Y8_SCALE); v[j][6] = bflo(a.w) + t[3].x * (1.0f / Y8_SCALE); v[j][7] = bfhi(a.w) + t[3].y * (1.0f / Y8_SCALE);
#pragma unroll
            for (int k = 0; k < 8; ++k) s += v[j][k] * v[j][k];
        }
        s = wave_sum(s, lane);
        const float rs = 1.0f / sqrtf(s * (1.0f / D) + NORM_EPS);
#pragma unroll
        for (int j = 0; j < 2; ++j) {
            const int col = (j * 64 + lane) * 8;
            f32x4 o0, o1;
#pragma unroll
            for (int k = 0; k < 4; ++k) { o0[k] = v[j][k] * rs * g0[j][k]; o1[k] = v[j][4 + k] * rs * g1[j][k]; }
            *(f32x4*)(P.out + (size_t)m * D + col) = o0; *(f32x4*)(P.out + (size_t)m * D + col + 4) = o1;
        }
#pragma unroll
        for (int k = 0; k < 2; ++k) { q[k] = nq[k]; nq[k] = nnq[k]; }
#pragma unroll
        for (int k = 0; k < 8; ++k) { e[k] = ne[k]; ne[k] = nne[k]; }
    }
#undef P9_LOAD
}

#ifndef REPEAT_PHASE
#define REPEAT_PHASE -1
#define REPEAT_N 0
#endif
#define RUN_PHASE(k, call) do { call; xcd_barrier(bar, P.wv); \
    if (REPEAT_PHASE == (k) && REPEAT_N >= 1) { call; xcd_barrier(bar, P.wv); } \
    if (REPEAT_PHASE == (k) && REPEAT_N >= 2) { call; xcd_barrier(bar, P.wv); } \
    if (REPEAT_PHASE == (k) && REPEAT_N >= 3) { call; xcd_barrier(bar, P.wv); } } while (0)

struct Args { const void* in[25]; float* out; unsigned char* ws; };

__device__ __forceinline__ void p1_gemm(LAS unsigned char* lds, const Ptrs& P, int G, int bx) { ProbIn pr; pr.xb = P.XB; pr.wt = P.WIN_T; pr.rs1 = P.RS1; pr.pos = P.positions; pr.proj = P.PROJ; pr.G = G; pr.c = bx; pg8::gemm_phase(lds, pr, P.wv); }
__device__ __forceinline__ void p2_seq(LAS unsigned char* lds, const Ptrs& P, int G, int bx) {
    for (int u = bx; u < BATCH * NCH; u += G) lru_unit<false>(lds, u / NCH, u % NCH, P.PROJ, P.conv_w, P.conv_b, P.WAF, P.lru_ba, P.lru_bx, P.lru_lam, P.lru_ng, P.LAP, P.LAH, nullptr, nullptr, nullptr, moe_conv(P), u * 8 * MOE_K0, P.wv);
    ret_kv_phase(lds, P.PROJ, P.KVT, G, bx, P.wv);
}
__device__ __forceinline__ void p4_lru(LAS unsigned char* lds, const Ptrs& P, int G, int bx) {
    for (int u = bx; u < BATCH * NCH; u += G) lru_unit<true>(lds, u / NCH, u % NCH, P.PROJ, P.conv_w, P.conv_b, P.WAF, P.lru_ba, P.lru_bx, P.lru_lam, P.lru_ng, nullptr, nullptr, P.CARRY, P.YCAT, P.RSL, moe_conv(P), MOE_PASS0_ITEMS + u * 8 * MOE_K1, P.wv);
}
__device__ __forceinline__ void p4_ret(LAS unsigned char* lds, const Ptrs& P, int G, int bx) {
    ret_out_phase(lds, P.PROJ, P.PREVT, P.ret_ng, P.ret_nb, P.YCAT, G, bx, P.wv);
}
__device__ __forceinline__ void p4_seq(LAS unsigned char* lds, const Ptrs& P, int G, int bx) {
    for (int u = bx; u < BATCH * NCH; u += G) lru_unit<true>(lds, u / NCH, u % NCH, P.PROJ, P.conv_w, P.conv_b, P.WAF, P.lru_ba, P.lru_bx, P.lru_lam, P.lru_ng, nullptr, nullptr, P.CARRY, P.YCAT, P.RSL, moe_conv(P), MOE_PASS0_ITEMS + u * 8 * MOE_K1, P.wv);
    ret_out_phase(lds, P.PROJ, P.PREVT, P.ret_ng, P.ret_nb, P.YCAT, G, bx, P.wv);
}
__device__ __forceinline__ void p5_gemm(LAS unsigned char* lds, const Ptrs& P, int G, int bx) { ProbOut pr; pr.ycat = P.YCAT; pr.wt = P.WOUT_T; pr.xb = P.XB; pr.rsl = P.RSL; pr.yb01 = P.YB01; pr.x8 = P.X8; pr.ssq = P.SSQ; pr.G = G; pr.c = bx; pg8::gemm_phase(lds, pr, P.wv); }
__device__ __forceinline__ void p7_gemm(LAS unsigned char* lds, const Ptrs& P, int G, int bx, int probe_mode = 0) {
    const MoeTabs tabs = moe_build_tabs(lds, P.ctl, P.wv);
    ProbUp pr; pr.probe_mode = probe_mode; pr.tabs = tabs; pr.x8 = P.X8; pr.wgu = P.WGU8; pr.list = P.LIST; pr.rs2s = P.RS2S; pr.bg = P.moe_bg; pr.bu = P.moe_bu; pr.act = P.ACT; pr.G = G; pr.c = bx;
    pg8::gemm_phase(lds, pr, P.wv);
}
__device__ __forceinline__ void p8_gemm(LAS unsigned char* lds, const Ptrs& P, int G, int bx, int probe_mode = 0) {
    const MoeTabs tabs = moe_build_tabs(lds, P.ctl, P.wv);
    ProbDown pr; pr.probe_mode = probe_mode; pr.tabs = tabs; pr.act = P.ACT; pr.wd = P.WD8; pr.list = P.LIST; pr.gw = P.GW; pr.bd = P.moe_bd; pr.y8 = (unsigned char*)P.YB23; pr.G = G; pr.c = bx;
    pg8::gemm_phase(lds, pr, P.wv);
}

__global__ void __launch_bounds__(NTHREADS, 2) mega_fwd(Args args) {
#ifdef CPU_EMU
    unsigned char* lds_raw = emu::cur->blk->lds;
#else
    extern __shared__ __attribute__((aligned(16))) unsigned char lds_raw[];
#endif
    LAS unsigned char* lds = (LAS unsigned char*)lds_raw;
    volatile LAS unsigned* MISC = (volatile LAS unsigned*)(lds + MISC_OFF);
    const int G = gridDim.x, bx = blockIdx.x;
    unsigned char* ws = args.ws;
    Ptrs P;
    P.wv = __builtin_amdgcn_readfirstlane((int)(threadIdx.x >> 6));
    P.x = (const float*)args.in[0]; P.positions = (const int*)args.in[1]; P.attn_g = (const float*)args.in[2];
    P.w_in = (const float*)args.in[3]; P.conv_w = (const float*)args.in[4]; P.conv_b = (const float*)args.in[5];
    P.lru_wa = (const float*)args.in[6]; P.lru_ba = (const float*)args.in[7]; P.lru_wx = (const float*)args.in[8]; P.lru_bx = (const float*)args.in[9];
    P.lru_lam = (const float*)args.in[10]; P.lru_ng = (const float*)args.in[11]; P.ret_ng = (const float*)args.in[12]; P.ret_nb = (const float*)args.in[13];
    P.w_out = (const float*)args.in[14]; P.ffn_g = (const float*)args.in[15]; P.router_w = (const float*)args.in[16]; P.router_b = (const float*)args.in[17];
    P.moe_wg = (const float*)args.in[18]; P.moe_bg = (const float*)args.in[19]; P.moe_wu = (const float*)args.in[20]; P.moe_bu = (const float*)args.in[21];
    P.moe_wd = (const float*)args.in[22]; P.moe_bd = (const float*)args.in[23]; P.final_g = (const float*)args.in[24];
    P.ctl = (unsigned*)(ws + WS_CTL);
    P.RS1 = (float*)(ws + WS_RS1); P.RS2S = (float*)(ws + WS_RS2S); P.SSQ = (float*)(ws + WS_SSQ); P.GW = (float*)(ws + WS_GW);
    P.LIST = (unsigned*)(ws + WS_LIST); P.LAP = (float*)(ws + WS_LAP); P.LAH = (float*)(ws + WS_LAH); P.CARRY = (float*)(ws + WS_CARRY);
    P.WAF = (bf16_t*)(ws + WS_WAF); P.RSL = (float*)(ws + WS_RSL);
    P.WR_T = (bf16_t*)(ws + WS_WR); P.WIN_T = (bf16_t*)(ws + WS_WIN); P.WOUT_T = (bf16_t*)(ws + WS_WOUT); P.WGU8 = ws + WS_WGU; P.WD8 = ws + WS_WD; P.X8 = ws + WS_X8;
    P.PROJ = (bf16_t*)(ws + WS_PROJ); P.XB = (bf16_t*)(ws + WS_XB); P.YCAT = (bf16_t*)(ws + WS_YCAT); P.ACT = ws + WS_ACT; P.YB23 = (bf16_t*)(ws + WS_YB23);
    P.KVT = (bf16_t*)((unsigned char*)args.out + DO_KVT); P.PREVT = (bf16_t*)((unsigned char*)args.out + DO_PREVT); P.YB01 = (bf16_t*)args.out; P.out = args.out;

    for (int u = (int)threadIdx.x; u < (LDS_BYTES - RING_BYTES) / 4; u += NTHREADS) ((LAS unsigned*)(lds + RING_BYTES))[u] = 0u;
    __syncthreads();
    const XcdBarrier bar = xcd_barrier_post(P.ctl + CW_BAR, MISC + 8, P.wv);

    if (REPEAT_PHASE == 100) { xcd_barrier(bar, P.wv); xcd_barrier(bar, P.wv); xcd_barrier(bar, P.wv); xcd_barrier(bar, P.wv); xcd_barrier(bar, P.wv); xcd_barrier(bar, P.wv); xcd_barrier(bar, P.wv); xcd_barrier(bar, P.wv); }
    RUN_PHASE(0, p0_prologue(lds, P, G, bx));
    RUN_PHASE(1, p1_gemm(lds, P, G, bx));
    RUN_PHASE(2, p2_seq(lds, P, G, bx));
    RUN_PHASE(3, p3_scans(P, G, bx));
    RUN_PHASE(4, p4_seq(lds, P, G, bx));
    if (REPEAT_PHASE == 41) { p4_lru(lds, P, G, bx); xcd_barrier(bar, P.wv); p4_lru(lds, P, G, bx); xcd_barrier(bar, P.wv); }
    if (REPEAT_PHASE == 42) { p4_ret(lds, P, G, bx); xcd_barrier(bar, P.wv); p4_ret(lds, P, G, bx); xcd_barrier(bar, P.wv); }
    RUN_PHASE(5, p5_gemm(lds, P, G, bx));
    RUN_PHASE(6, p6_router(lds, P, G, bx, bar));
    if (REPEAT_PHASE == 71) { p7_gemm(lds, P, G, bx, 1); xcd_barrier(bar, P.wv); p7_gemm(lds, P, G, bx, 1); xcd_barrier(bar, P.wv); }
    if (REPEAT_PHASE == 72) { p7_gemm(lds, P, G, bx, 2); xcd_barrier(bar, P.wv); }
#if REPEAT_PHASE >= 300 && REPEAT_PHASE < 316
    {   const MoeTabs tabs = moe_build_tabs(lds, P.ctl, P.wv);
        ProbUpDiag<REPEAT_PHASE - 300> pr; pr.probe_mode = 1; pr.tabs = tabs; pr.x8 = P.X8; pr.wgu = P.WGU8; pr.list = P.LIST; pr.rs2s = P.RS2S; pr.bg = P.moe_bg; pr.bu = P.moe_bu; pr.act = P.ACT; pr.G = G; pr.c = bx;
        pg8::gemm_phase(lds, pr, P.wv); xcd_barrier(bar, P.wv); pg8::gemm_phase(lds, pr, P.wv); xcd_barrier(bar, P.wv); }
#endif
#if REPEAT_PHASE == 200 || REPEAT_PHASE == 201
    {
        const unsigned long long t0 = __builtin_amdgcn_s_memtime(), r0 = __builtin_amdgcn_s_memrealtime();
        if (REPEAT_PHASE == 200) p7_gemm(lds, P, G, bx, 1); else p1_gemm(lds, P, G, bx);
        const unsigned long long t1 = __builtin_amdgcn_s_memtime(), r1 = __builtin_amdgcn_s_memrealtime();
        if (bx == 0) { const unsigned long long mhz = (t1 - t0) * 100ull / (r1 - r0); while (__builtin_amdgcn_s_memrealtime() - r1 < mhz * 10ull) __builtin_amdgcn_s_sleep(8); }
        xcd_barrier(bar, P.wv);
    }
#endif
    RUN_PHASE(7, p7_gemm(lds, P, G, bx));
    if (REPEAT_PHASE == 81) { p8_gemm(lds, P, G, bx, 1); xcd_barrier(bar, P.wv); p8_gemm(lds, P, G, bx, 1); xcd_barrier(bar, P.wv); }
    RUN_PHASE(8, p8_gemm(lds, P, G, bx));
    if (REPEAT_PHASE == 9) { Ptrs Q = P; Q.out = (float*)P.ACT; p9_final(Q, G, bx); xcd_barrier(bar, P.wv); }
    p9_final(P, G, bx);
}

extern "C" void kernel_launch(void* const* d_in, const int* in_sizes, int n_in, void* d_out, int out_size, void* d_ws, size_t ws_size, hipStream_t stream) {
    static int grid = 0;
    if (grid == 0) {
        if (n_in != 25 || out_size != T * D || ws_size < WS_END) { fprintf(stderr, "kernel_launch: unexpected shapes (n_in %d, out %d, ws %zu, need %zu)\n", n_in, out_size, ws_size, (size_t)WS_END); grid = -1; return; }
        int dev = 0, cus = 0;
        if (hipGetDevice(&dev) != hipSuccess || hipDeviceGetAttribute(&cus, hipDeviceAttributeMultiprocessorCount, dev) != hipSuccess) { fprintf(stderr, "kernel_launch: device query failed\n"); grid = -1; return; }
        if (hipFuncSetAttribute((const void*)mega_fwd, hipFuncAttributeMaxDynamicSharedMemorySize, LDS_BYTES) != hipSuccess) { fprintf(stderr, "kernel_launch: hipFuncSetAttribute failed\n"); grid = -1; return; }
        (void)hipGetLastError();
        if (cus < T / 128 || cus > 256) { fprintf(stderr, "kernel_launch: the router phase needs T/128 <= CUs <= 256 (have %d)\n", cus); grid = -1; return; }
        grid = cus;
    }
    if (grid < 0) return;
    (void)in_sizes;
    (void)hipMemsetAsync((char*)d_ws + WS_CTL, 0, CTL_ZERO_BYTES, stream);
    Args a{};
    for (int i = 0; i < 25; ++i) a.in[i] = d_in[i];
    a.out = (float*)d_out; a.ws = (unsigned char*)d_ws;
    hipLaunchKernelGGL(mega_fwd, dim3(grid), dim3(NTHREADS), LDS_BYTES, stream, a);
}
```

```cpp
#ifndef CPU_EMU
#include <hip/hip_runtime.h>
#include <cstdio>
#define LAS __attribute__((address_space(3)))
#define GAS __attribute__((address_space(1)))
#define ASM_VMCNT(n) asm volatile("s_waitcnt vmcnt(" #n ")" ::: "memory")
#define ASM_LGKMCNT(n) asm volatile("s_waitcnt lgkmcnt(" #n ")" ::: "memory")
#define WAVE_SYNC() do { asm volatile("s_waitcnt lgkmcnt(0)" ::: "memory"); __builtin_amdgcn_wave_barrier(); } while (0)
#define OPAQUE(x) asm volatile("" : "+v"(x))
__device__ __forceinline__ int lane_id_fresh() { int l; asm volatile("v_mbcnt_lo_u32_b32 %0, -1, 0\n\tv_mbcnt_hi_u32_b32 %0, -1, %0" : "=v"(l)); return l; }
#define LANE_ID() lane_id_fresh()
#define SHFLX_F(v, mask, lane) __builtin_bit_cast(float, __builtin_amdgcn_ds_bpermute((((lane) ^ (mask)) << 2), __builtin_bit_cast(int, (float)(v))))
#define SHFLX_I(v, mask, lane) __builtin_amdgcn_ds_bpermute((((lane) ^ (mask)) << 2), (int)(v))
#else
#define ASM_VMCNT(n) ((void)0)
#define ASM_LGKMCNT(n) ((void)0)
#define WAVE_SYNC() emu::wave_collective(nullptr, 0, nullptr, 0, [](emu::Wave&) {})
#define OPAQUE(x) ((void)0)
#define LANE_ID() ((int)emu::cur->lane)
#define SHFLX_F(v, mask, lane) __shfl_xor((float)(v), (mask))
#define SHFLX_I(v, mask, lane) __shfl_xor((int)(v), (mask))
#endif

typedef unsigned short bf16_t;
typedef float f32x4 __attribute__((ext_vector_type(4)));
typedef float f32x2 __attribute__((ext_vector_type(2)));
typedef unsigned u32x4 __attribute__((ext_vector_type(4)));
typedef unsigned u32x2 __attribute__((ext_vector_type(2)));
typedef short bf16x8 __attribute__((ext_vector_type(8)));
typedef short v4i16_t __attribute__((ext_vector_type(4)));
typedef int v8i32_t __attribute__((ext_vector_type(8)));

#ifdef CPU_EMU
constexpr int BATCH = CFG_BATCH, SEQ = CFG_SEQ, NEXP = CFG_NEXP;
#else
constexpr int BATCH = 4, SEQ = 8192, NEXP = 32;
#endif
constexpr int NWAVES = 8, NTHREADS = 512;
constexpr int T = BATCH * SEQ, D = 1024, DIN = 3072, NCH = SEQ / 128, NBH = BATCH * 4;
constexpr int TOPK = 4, NSLOT = T * TOPK;
constexpr float NORM_EPS = 1e-5f;
constexpr int MAXTILES = NSLOT / 256 + NEXP;

constexpr size_t MiB = 1u << 20;
constexpr size_t al256(size_t x) { return (x + 255) & ~(size_t)255; }
constexpr size_t WS_CTL = 0, CTL_ZERO_BYTES = 1 * MiB;
constexpr int CW_BAR = 4096, CW_CNT = 16384;
constexpr size_t WS_RS1 = 1 * MiB;
constexpr size_t WS_RS2 = WS_RS1 + al256((size_t)T * 4);
constexpr size_t WS_SSQ = WS_RS2 + al256((size_t)T * 4);
constexpr size_t WS_GW = WS_SSQ + al256((size_t)16 * T * 4);
constexpr size_t WS_LIST = WS_GW + al256((size_t)NEXP * T * 4);
constexpr size_t WS_RS2S = WS_LIST + al256((size_t)NEXP * T * 4);
constexpr size_t WS_LAP = WS_RS2S + al256((size_t)NEXP * T * 4);
constexpr size_t WS_LAH = WS_LAP + al256((size_t)BATCH * NCH * 512 * 4);
constexpr size_t WS_CARRY = WS_LAH + al256((size_t)BATCH * NCH * 512 * 4);
constexpr size_t WS_WR = WS_CARRY + al256((size_t)BATCH * NCH * 512 * 4);
constexpr size_t WS_WAF = WS_WR + al256((size_t)32 * D * 2);
constexpr size_t WS_RSL = WS_WAF + 2 * 65536;
constexpr size_t WS_WIN = (WS_RSL + al256((size_t)T * 4) + MiB - 1) / MiB * MiB;
constexpr size_t WS_WOUT = WS_WIN + (size_t)DIN * D * 2;
constexpr size_t WS_WGU = WS_WOUT + (size_t)D * D * 2;
constexpr size_t WS_WD = WS_WGU + (size_t)NEXP * 2048 * D;
constexpr size_t WS_X8 = WS_WD + (size_t)NEXP * D * D;
constexpr size_t WS_R1 = WS_X8 + (size_t)T * D;
constexpr size_t WS_PROJ = WS_R1;
constexpr size_t WS_XB = WS_R1 + (size_t)T * DIN * 2;
constexpr size_t WS_ACT = WS_R1;
constexpr size_t WS_YB23 = WS_ACT + (size_t)(NSLOT + 256) * D;
constexpr size_t WS_YCAT = WS_YB23 + (size_t)T * 2 * D * 2;
constexpr size_t WS_END = WS_YCAT + (size_t)T * D * 2;
static_assert(WS_XB + (size_t)T * D * 2 <= WS_END, "map");
constexpr size_t DO_KVT = 0, DO_PREVT = (size_t)T * 1024;
static_assert(2 * (size_t)T * 1024 <= (size_t)T * D * 4, "d_out scratch");

constexpr int RING_BYTES = 131072, MISC_OFF = RING_BYTES + 320, TAB_OFF = RING_BYTES + 1024, LDS_BYTES = 147456;
constexpr int TAB_CNT = TAB_OFF, TAB_EOFF = TAB_CNT + 4 * 64, TAB_TBASE = TAB_EOFF + 4 * 64, TAB_TILEE = TAB_TBASE + 4 * 80;
constexpr int META_OFF = RING_BYTES + 8192;
static_assert(NEXP <= 64 && TAB_TILEE + 2 * MAXTILES + 16 <= META_OFF && META_OFF + 8192 <= LDS_BYTES, "LDS tables");

__device__ __forceinline__ unsigned f2bf(float f) { unsigned u = __builtin_bit_cast(unsigned, f); return (u + 0x7fffu + ((u >> 16) & 1u)) >> 16; }
__device__ __forceinline__ unsigned pk2(float lo, float hi) {
#ifdef CPU_EMU
    return f2bf(lo) | (f2bf(hi) << 16);
#else
    unsigned r; asm volatile("v_cvt_pk_bf16_f32 %0, %1, %2" : "=v"(r) : "v"(lo), "v"(hi)); return r;
#endif
}
__device__ __forceinline__ unsigned pk2v(float lo, float hi) {
#ifdef CPU_EMU
    return f2bf(lo) | (f2bf(hi) << 16);
#else
    unsigned r; asm volatile("s_nop 7\n\ts_nop 7\n\tv_cvt_pk_bf16_f32 %0, %1, %2" : "=v"(r) : "v"(lo), "v"(hi)); return r;
#endif
}
#define unpk2_fp8(w, hi) __builtin_amdgcn_cvt_pk_f32_fp8((int)(w), hi)
__device__ __forceinline__ unsigned pk4_fp8(float a, float b, float c, float d) {
    int r = __builtin_amdgcn_cvt_pk_fp8_f32(a, b, 0, false); r = __builtin_amdgcn_cvt_pk_fp8_f32(c, d, r, true); return (unsigned)r;
}
__device__ __forceinline__ float bf2f(unsigned h) { return __builtin_bit_cast(float, h << 16); }
__device__ __forceinline__ float bflo(unsigned w) { return __builtin_bit_cast(float, w << 16); }
__device__ __forceinline__ float bfhi(unsigned w) { return __builtin_bit_cast(float, w & 0xffff0000u); }
__device__ __forceinline__ float fexp2(float x) { return __builtin_amdgcn_exp2f(x); }
__device__ __forceinline__ float frcp(float x) { return __builtin_amdgcn_rcpf(x); }
__device__ __forceinline__ float sigmoid_f(float x) { return frcp(1.0f + fexp2(-1.4426950408889634f * x)); }
__device__ __forceinline__ float gelu_tanh(float x) { const float u = 0.7978845608028654f * (x + 0.044715f * x * x * x); return x * frcp(1.0f + fexp2(-2.8853900817779268f * u)); }
__device__ __forceinline__ float silu_f(float x) { return x * sigmoid_f(x); }
__device__ __forceinline__ float wave_sum(float v, int lane) {
#pragma unroll
    for (int o = 1; o < 64; o <<= 1) v += SHFLX_F(v, o, lane);
    return v;
}

#define XB_TMO      128
#define XB_XCNT(j)  (256  + 64 * (j))
#define XB_XSUB(j)  (1280 + 64 * (j))
#define XB_XGEN(j)  (2304 + 64 * (j))
#define XB_TOP      3328
#define XB_TOPGEN   3392
#define XCD_BAR_WORDS 3456
#define XB_SPIN_CAP (1u << 20)
__device__ __forceinline__ unsigned xb_ld(unsigned* p)              { return __hip_atomic_load(p, __ATOMIC_RELAXED, __HIP_MEMORY_SCOPE_AGENT); }
__device__ __forceinline__ unsigned xb_add(unsigned* p, unsigned v) { return __hip_atomic_fetch_add(p, v, __ATOMIC_RELAXED, __HIP_MEMORY_SCOPE_AGENT); }
__device__ __forceinline__ unsigned xb_xcc_id() { return (unsigned)__builtin_amdgcn_s_getreg((3 << 11) | 20) & 0xFu; }
#define XB_SPIN(cond, bar) do { unsigned _sp = 0; while (cond) { __builtin_amdgcn_s_sleep(1); \
    if ((++_sp & 255u) == 0u) { if (xb_ld(&(bar)[XB_TMO])) break; if (_sp > XB_SPIN_CAP) { atomicAdd(&(bar)[XB_TMO], 1u); break; } } } } while (0)
struct XcdBarrier { unsigned* bar; unsigned x; volatile LAS unsigned* st; };
__device__ __forceinline__ XcdBarrier xcd_barrier_post(unsigned* bar, volatile LAS unsigned* st, int wv) {
    XcdBarrier b; b.bar = bar; b.x = xb_xcc_id(); b.st = st;
    if (wv == 0 && LANE_ID() == 0) (void)xb_add(&bar[XB_XCNT(b.x)], 1u);
    return b;
}
__device__ __forceinline__ void xcd_barrier_complete(unsigned* bar, unsigned x, unsigned& nloc, unsigned& nx) {
    const unsigned G = gridDim.x;
    unsigned sum, cnt, mine, sp = 0u;
    for (;;) {
        sum = 0u; cnt = 0u; mine = 0u;
#pragma unroll
        for (unsigned j = 0; j < 16; ++j) { const unsigned c = xb_ld(&bar[XB_XCNT(j)]); sum += c; cnt += (c > 0u) ? 1u : 0u; mine = (j == x) ? c : mine; }
        if (sum == G) break;
        __builtin_amdgcn_s_sleep(1);
        if ((++sp & 255u) == 0u) { if (xb_ld(&bar[XB_TMO])) break; if (sp > XB_SPIN_CAP) { atomicAdd(&bar[XB_TMO], 1u); break; } }
    }
    nloc = mine > 0u ? mine : 1u; nx = cnt > 0u ? cnt : 1u;
}
__device__ __forceinline__ void xcd_barrier(const XcdBarrier& b, int wv) {
    ASM_VMCNT(0);
    __syncthreads();
    if (wv == 0 && LANE_ID() == 0) {
        unsigned* bar = b.bar;
        __builtin_amdgcn_s_waitcnt(0);
        unsigned nloc = b.st[0], nx = b.st[1];
        if (nloc == 0u) { xcd_barrier_complete(bar, b.x, nloc, nx); b.st[0] = nloc; b.st[1] = nx; }
        const unsigned old = xb_add(&bar[XB_XSUB(b.x)], 1u);
        const unsigned gen = old / nloc;
        if (old + 1u == (gen + 1u) * nloc) {
            __builtin_amdgcn_fence(__ATOMIC_RELEASE, "agent");
            ASM_VMCNT(0);
            const unsigned og = xb_add(&bar[XB_TOP], 1u);
            const unsigned tg = og / nx;
            if (og + 1u == (tg + 1u) * nx) xb_add(&bar[XB_TOPGEN], 1u);
            else XB_SPIN(xb_ld(&bar[XB_TOPGEN]) == tg, bar);
            __builtin_amdgcn_fence(__ATOMIC_ACQUIRE, "agent");
            xb_add(&bar[XB_XGEN(b.x)], 1u);
            ASM_VMCNT(0);
        } else {
            XB_SPIN(xb_ld(&bar[XB_XGEN(b.x)]) == gen, bar);
            __builtin_amdgcn_fence(__ATOMIC_ACQUIRE, "agent");
            ASM_VMCNT(0);
        }
    }
    __syncthreads();
}

namespace pg8 {
constexpr int BM = 256, BK = 64, HALF = 128, HTB = HALF * BK * 2, STAGE_BYTES = 8 * HTB, NXCD = 8, WGM = 8;
__device__ __forceinline__ int lds_byte(int r, int c) { const int st = (r >> 4) * 2 + (c >> 5), rr = r & 15, cc = c & 31, ob = rr * 64 + cc * 2; return st * 1024 + (ob ^ (((ob >> 9) & 1) << 5)); }
__device__ __forceinline__ void stage_rc(int b, int& R, int& C) { const int st = b / 1024, sb = b % 1024, swz = sb ^ (((sb >> 9) & 1) << 5); R = (st >> 1) * 16 + swz / 64; C = (st & 1) * 32 + (swz % 64) / 2; }
__device__ __forceinline__ int lds_byte8(int r, int fq) { const int st = (r >> 4) * 2 + (fq >> 1), rr = r & 15, ob = rr * 64 + 32 * (fq & 1); return st * 1024 + (ob ^ (((ob >> 9) & 1) << 5)); }
__device__ __forceinline__ int perm32(int rho) { const int n = rho >> 4, i = rho & 15; return 8 * (i >> 2) + 4 * n + (i & 3); }
struct Unit { int pm, pn, e, pos0, nvalid, eoff; };
__device__ __forceinline__ f32x4 mma_fp8(u32x4 a0, u32x4 a1, u32x4 b0, u32x4 b1, f32x4 c) {
    typedef int i32x4 __attribute__((ext_vector_type(4)));
    const v8i32_t a = __builtin_shufflevector(__builtin_bit_cast(i32x4, a0), __builtin_bit_cast(i32x4, a1), 0, 1, 2, 3, 4, 5, 6, 7);
    const v8i32_t b = __builtin_shufflevector(__builtin_bit_cast(i32x4, b0), __builtin_bit_cast(i32x4, b1), 0, 1, 2, 3, 4, 5, 6, 7);
#ifdef CPU_EMU
    return __builtin_amdgcn_mfma_scale_f32_16x16x128_f8f6f4(a, b, c, 0, 0, 0, 0x7F7F7F7F, 0, 0x7F7F7F7F);
#else
    const int one = 0x7F7F7F7F;
    asm volatile("v_mfma_scale_f32_16x16x128_f8f6f4 %0, %1, %2, %0, %3, %3 op_sel_hi:[0,0,0]" : "+v"(c) : "v"(a), "v"(b), "v"(one));
    return c;
#endif
}
__device__ __forceinline__ bool static_order(int i, int G, int c, int nM, int nN, int& pm, int& pn) {
    const int nwg = nM * nN; const long L = (long)i * G + c; if (L >= nwg) return false;
    int wgid = (int)L; { const int q = nwg / NXCD, r = nwg % NXCD, xcd = wgid % NXCD, off = wgid / NXCD; wgid = (xcd < r ? xcd * (q + 1) : r * (q + 1) + (xcd - r) * q) + off; }
    const int nig = WGM * nN, gid = wgid / nig, fm = gid * WGM, gsz = (nM - fm) < WGM ? (nM - fm) : WGM;
    pm = fm + ((wgid % nig) % gsz); pn = (wgid % nig) / gsz; return true;
}

template <class P>
__device__ __forceinline__ void gemm_phase(LAS unsigned char* lds, const P& prob, int wv) {
    int tid_ = wv * 64 + LANE_ID(); OPAQUE(tid_);
    const int tid = tid_, wid = __builtin_amdgcn_readfirstlane(tid >> 6), lane = tid & 63, wr = wid >> 2, wc = wid & 3, fr = lane & 15, fq = lane >> 4;
    constexpr int ROWB = P::FP8 ? 1024 : 2048, NT = ROWB / 128, CH = 1024;
    unsigned voffA[2][2], nvoffA[2][2], voffB[2];
#pragma unroll
    for (int i = 0; i < 2; ++i) { int R, C; stage_rc(tid * 16 + i * 8192, R, C); const int Rb = (R & ~31) + perm32(R & 31);
        voffA[0][i] = (unsigned)(R * ROWB + C * 2); voffA[1][i] = voffA[0][i] + (unsigned)(HALF * ROWB); voffB[i] = (unsigned)(Rb * ROWB + C * 2);
        nvoffA[0][i] = voffA[0][i]; nvoffA[1][i] = voffA[1][i]; }
    const size_t kstep = (size_t)(BK * 2);
    const size_t hstep = (size_t)HALF * ROWB;
    const unsigned ldsw = (unsigned)wid * 1024u;
    const int aoff = lds_byte(wr * 64 + fr, fq * 8), boff = lds_byte(wc * 32 + fr, fq * 8);
#define PG8_SA(b, h) (((b) * 2 + (h)) * HTB)
#define PG8_SB(b, h) ((4 + (b) * 2 + (h)) * HTB)
#define PG8_STAGE(bufoff, gbase, voff) do { if constexpr (!(P::DIAG & 2)) _Pragma("unroll") for (int _i = 0; _i < 2; ++_i) \
        __builtin_amdgcn_global_load_lds((const unsigned*)((const char*)(gbase) + (voff)[_i]), (LAS unsigned*)(lds + (bufoff) + ldsw + _i * 8192), 16, 0, 0); } while (0)
#define PG8_LDA(dst, b, h) do { if constexpr (!(P::DIAG & 1)) _Pragma("unroll") for (int m = 0; m < 4; ++m) _Pragma("unroll") for (int k = 0; k < 2; ++k) dst[m][k] = *(const LAS u32x4*)(lds + PG8_SA(b, h) + aoff + m * 2048 + k * CH); } while (0)
#define PG8_LDB(dst, b, h) do { if constexpr (!(P::DIAG & 1)) _Pragma("unroll") for (int n = 0; n < 2; ++n) _Pragma("unroll") for (int k = 0; k < 2; ++k) dst[n][k] = *(const LAS u32x4*)(lds + PG8_SB(b, h) + boff + n * 2048 + k * CH); } while (0)
#define PG8_MMA(ai, bj, At, Bt) do { if constexpr (!(P::DIAG & 8)) { __builtin_amdgcn_s_setprio(1); _Pragma("unroll") for (int m = 0; m < 4; ++m) _Pragma("unroll") for (int n = 0; n < 2; ++n) { \
        if constexpr (P::FP8) acc[ai][bj][m][n] = mma_fp8(Bt[n][0], Bt[n][1], At[m][0], At[m][1], acc[ai][bj][m][n]); \
        else { _Pragma("unroll") for (int k = 0; k < 2; ++k) acc[ai][bj][m][n] = __builtin_amdgcn_mfma_f32_16x16x32_bf16(__builtin_bit_cast(bf16x8, Bt[n][k]), __builtin_bit_cast(bf16x8, At[m][k]), acc[ai][bj][m][n], 0, 0, 0); } } \
        __builtin_amdgcn_s_setprio(0); } } while (0)
#define PG8_BAR do { if constexpr (!(P::DIAG & 4)) __builtin_amdgcn_s_barrier(); } while (0)
#define PG8_SCHED __builtin_amdgcn_sched_barrier(0)
    Unit cur, nxt; int ui = 0;
    if (!prob.next(0, cur)) return;
    f32x4 acc[2][2][4][2];
#pragma unroll
    for (int a = 0; a < 2; ++a)
#pragma unroll
        for (int b = 0; b < 2; ++b)
#pragma unroll
            for (int m = 0; m < 4; ++m)
#pragma unroll
                for (int n = 0; n < 2; ++n) acc[a][b][m][n] = (f32x4){0.f, 0.f, 0.f, 0.f};
    u32x4 At[4][2] = {}, B0[2][2] = {}, B1[2][2] = {};
    const char* cA = prob.a_base(cur); const char* cB = prob.b_base(cur);
    if constexpr (P::GATHER) prob.a_offsets(cur, tid, voffA);
#define PG8_META(u, par) do { _Pragma("unroll") for (int _j = 0; _j < 2; ++_j) { const int _a = (wid >> 2) + 2 * _j; if (_a < P::NMETA) \
        __builtin_amdgcn_global_load_lds(prob.meta_ptr(u, _a, (wid & 3) * 64 + lane), (LAS unsigned*)(lds + META_OFF + (par) * 4096 + _a * 1024 + (wid & 3) * 256), 4, 0, 0); } } while (0)
    if constexpr (P::NMETA > 0) PG8_META(cur, 0);
    PG8_STAGE(PG8_SB(0, 0), cB, voffB); PG8_STAGE(PG8_SA(0, 0), cA, voffA[0]); PG8_STAGE(PG8_SB(0, 1), cB + hstep, voffB); PG8_STAGE(PG8_SA(0, 1), cA, voffA[1]);
    if (wr == 1) PG8_BAR;
    ASM_VMCNT(4); PG8_BAR;
    PG8_STAGE(PG8_SB(1, 0), cB + kstep, voffB); PG8_STAGE(PG8_SA(1, 0), cA + kstep, voffA[0]); PG8_STAGE(PG8_SB(1, 1), cB + hstep + kstep, voffB);
    ASM_VMCNT(6); PG8_BAR;
    for (;;) {
        const bool has_next = prob.next(ui + 1, nxt);
        const char* nA = has_next ? prob.a_base(nxt) : cA; const char* nB = has_next ? prob.b_base(nxt) : cB;
        for (int t = 0; t < NT; t += 2) {
            const bool last = (t == NT - 2);
            const char* a1 = cA + (size_t)(t + 1) * kstep;
            const char* a2 = last ? nA : cA + (size_t)(t + 2) * kstep; const char* b2 = last ? nB : cB + (size_t)(t + 2) * kstep;
            const char* a3 = a2 + kstep; const char* b3 = b2 + kstep;
            if constexpr (P::GATHER) { if (last && has_next) prob.a_offsets_lds(nxt, tid, nvoffA, lds + META_OFF + ((ui + 1) & 1) * 4096); }
            unsigned va0[2], va1[2];
#pragma unroll
            for (int i = 0; i < 2; ++i) { va0[i] = (P::GATHER && last) ? nvoffA[0][i] : voffA[0][i]; va1[i] = (P::GATHER && last) ? nvoffA[1][i] : voffA[1][i]; }
            if constexpr (P::MIDK) { if (t == NT / 2) prob.midk(acc, cur, wr, fr, lds + META_OFF + (ui & 1) * 4096); }
            PG8_LDB(B0, 0, 0); PG8_SCHED; PG8_LDA(At, 0, 0); PG8_STAGE(PG8_SA(1, 1), a1, voffA[1]);
            ASM_LGKMCNT(8); ASM_VMCNT(10); PG8_BAR; ASM_LGKMCNT(0); PG8_MMA(0, 0, At, B0); PG8_BAR; PG8_SCHED;
            PG8_LDB(B1, 0, 1); PG8_STAGE(PG8_SB(0, 0), b2, voffB);
            ASM_VMCNT(10); PG8_BAR; ASM_LGKMCNT(0); PG8_MMA(0, 1, At, B1); PG8_BAR;
            PG8_LDA(At, 0, 1); PG8_STAGE(PG8_SA(0, 0), a2, va0);
            PG8_BAR; ASM_LGKMCNT(0); PG8_MMA(1, 0, At, B0); PG8_BAR; PG8_SCHED;
            PG8_STAGE(PG8_SB(0, 1), b2 + hstep, voffB);
            ASM_VMCNT(10); PG8_BAR; PG8_MMA(1, 1, At, B1); PG8_BAR;
            if constexpr (P::NMETA > 0) { if (t == 2 && has_next) PG8_META(nxt, (ui + 1) & 1); }
            PG8_LDB(B0, 1, 0); PG8_SCHED; PG8_LDA(At, 1, 0); PG8_STAGE(PG8_SA(0, 1), a2, va1);
            ASM_LGKMCNT(8); ASM_VMCNT(10); PG8_BAR; ASM_LGKMCNT(0); PG8_MMA(0, 0, At, B0); PG8_BAR; PG8_SCHED;
            PG8_LDB(B1, 1, 1); PG8_STAGE(PG8_SB(1, 0), b3, voffB);
            ASM_VMCNT(10); PG8_BAR; ASM_LGKMCNT(0); PG8_MMA(0, 1, At, B1); PG8_BAR;
            PG8_LDA(At, 1, 1); PG8_STAGE(PG8_SA(1, 0), a3, va0);
            PG8_BAR; ASM_LGKMCNT(0); PG8_MMA(1, 0, At, B0); PG8_BAR; PG8_SCHED;
            PG8_STAGE(PG8_SB(1, 1), b3 + hstep, voffB);
            ASM_VMCNT(10); PG8_BAR; PG8_MMA(1, 1, At, B1); PG8_BAR;
        }
        if (wr == 0) PG8_BAR;
        prob.epi(acc, cur, wr, wc, fr, fq, lds + META_OFF + (ui & 1) * 4096);
        if (!has_next) break;
#pragma unroll
        for (int a = 0; a < 2; ++a)
#pragma unroll
            for (int b = 0; b < 2; ++b)
#pragma unroll
                for (int m = 0; m < 4; ++m)
#pragma unroll
                    for (int n = 0; n < 2; ++n) acc[a][b][m][n] = (f32x4){0.f, 0.f, 0.f, 0.f};
        cur = nxt; cA = nA; cB = nB; ++ui;
        if constexpr (P::GATHER) {
#pragma unroll
            for (int h = 0; h < 2; ++h)
#pragma unroll
                for (int i = 0; i < 2; ++i) voffA[h][i] = nvoffA[h][i];
        }
        if (wr == 1) PG8_BAR;
    }
    ASM_VMCNT(0);
    PG8_BAR;
#undef PG8_META
#undef PG8_SA
#undef PG8_SB
#undef PG8_STAGE
#undef PG8_LDA
#undef PG8_LDB
#undef PG8_MMA
#undef PG8_BAR
#undef PG8_SCHED
}
}
using pg8::Unit;

constexpr float Y8_SCALE = 16.0f;
constexpr float LOG2_THETA_64 = 13.287712379549449f / 64.0f;
__device__ __forceinline__ float log2_gamma(int h) { return __builtin_log2f(1.0f - __builtin_exp2f(-5.0f - (float)h)); }

struct ProbIn {
    static constexpr int DIAG = 0;
    static constexpr bool GATHER = false, MIDK = false, FP8 = false; static constexpr int NMETA = 2;
    const bf16_t* xb; const bf16_t* wt; const float* rs1; const int* pos; bf16_t* proj; int G, c;
    __device__ __forceinline__ bool next(int i, Unit& u) const { u.e = 0; u.pos0 = 0; u.nvalid = 256; u.eoff = 0; return pg8::static_order(i, G, c, T / 256, DIN / 256, u.pm, u.pn); }
    __device__ __forceinline__ const char* a_base(const Unit& u) const { return (const char*)xb + (size_t)u.pm * 256 * D * 2; }
    __device__ __forceinline__ const char* b_base(const Unit& u) const { return (const char*)wt + (size_t)u.pn * 256 * D * 2; }
    __device__ __forceinline__ void a_offsets(const Unit&, int, unsigned (&)[2][2]) const {}
    __device__ __forceinline__ const unsigned* meta_ptr(const Unit& u, int a, int idx) const { return (a == 0 ? (const unsigned*)rs1 : (const unsigned*)pos) + u.pm * 256 + idx; }
    __device__ __forceinline__ void epi(const f32x4 (&acc)[2][2][4][2], const Unit& u, int wr, int wc, int fr, int fq, const LAS unsigned char* mbuf) const {
        const int seg = u.pn >> 1;
        float invf[4];
#pragma unroll
        for (int q = 0; q < 4; ++q) invf[q] = exp2f(-(float)(16 * wc + 4 * fq + q) * LOG2_THETA_64) * 0.15915494309189535f;
#pragma unroll
        for (int ai = 0; ai < 2; ++ai)
#pragma unroll
            for (int m = 0; m < 4; ++m) {
                const int rl = ai * 128 + wr * 64 + m * 16 + fr, row = u.pm * 256 + rl;
                const float rs = *(const LAS float*)(mbuf + rl * 4);
                float cs[4], sn[4];
                if (seg == 2 || seg == 3) {
                    const float p = (float)*(const LAS int*)(mbuf + 1024 + rl * 4);
#pragma unroll
                    for (int q = 0; q < 4; ++q) { float rev = p * invf[q]; rev = rev - floorf(rev); cs[q] = __builtin_amdgcn_cosf(rev); sn[q] = __builtin_amdgcn_sinf(rev); }
                }
#pragma unroll
                for (int bj = 0; bj < 2; ++bj) {
                    f32x4 v0 = acc[ai][bj][m][0] * rs, v1 = acc[ai][bj][m][1] * rs;
                    if (seg == 1) {
#pragma unroll
                        for (int j = 0; j < 4; ++j) { v0[j] = gelu_tanh(v0[j]); v1[j] = gelu_tanh(v1[j]); }
                    } else if (seg == 5) {
#pragma unroll
                        for (int j = 0; j < 4; ++j) { v0[j] = silu_f(v0[j]); v1[j] = silu_f(v1[j]); }
                    } else if (seg == 2 || seg == 3) {
                        const int head = 2 * (u.pn & 1) + bj;
                        const float e1 = (float)((row & 127) + 1) * log2_gamma(head);
                        const float f = (seg == 2) ? exp2f(e1) : exp2f(-e1) * 0.08838834764831845f;
                        f32x4 o0, o1;
                        o0[0] = (v0[0] * cs[0] - v0[1] * sn[0]) * f; o0[1] = (v0[1] * cs[0] + v0[0] * sn[0]) * f;
                        o0[2] = (v0[2] * cs[1] - v0[3] * sn[1]) * f; o0[3] = (v0[3] * cs[1] + v0[2] * sn[1]) * f;
                        o1[0] = (v1[0] * cs[2] - v1[1] * sn[2]) * f; o1[1] = (v1[1] * cs[2] + v1[0] * sn[2]) * f;
                        o1[2] = (v1[2] * cs[3] - v1[3] * sn[3]) * f; o1[3] = (v1[3] * cs[3] + v1[2] * sn[3]) * f;
                        v0 = o0; v1 = o1;
                    }
                    u32x4 w; w.x = pk2(v0[0], v0[1]); w.y = pk2(v0[2], v0[3]); w.z = pk2(v1[0], v1[1]); w.w = pk2(v1[2], v1[3]);
                    *(u32x4*)(proj + (size_t)row * DIN + u.pn * 256 + bj * 128 + wc * 32 + 8 * fq) = w;
                }
            }
    }
};

struct ProbOut {
    static constexpr int DIAG = 0;
    static constexpr bool GATHER = false, MIDK = true, FP8 = false; static constexpr int NMETA = 1;
    const bf16_t* ycat; const bf16_t* wt; const bf16_t* xb; const float* rsl; bf16_t* yb01; unsigned char* x8; float* ssq; int G, c;
    __device__ __forceinline__ void midk(f32x4 (&acc)[2][2][4][2], const Unit&, int wr, int fr, const LAS unsigned char* mbuf) const {
#pragma unroll
        for (int ai = 0; ai < 2; ++ai)
#pragma unroll
            for (int m = 0; m < 4; ++m) { const float sc = *(const LAS float*)(mbuf + (ai * 128 + wr * 64 + m * 16 + fr) * 4);
#pragma unroll
                for (int bj = 0; bj < 2; ++bj)
#pragma unroll
                    for (int n = 0; n < 2; ++n) acc[ai][bj][m][n] *= sc; }
    }
    __device__ __forceinline__ bool next(int i, Unit& u) const { u.e = 0; u.pos0 = 0; u.nvalid = 256; u.eoff = 0; return pg8::static_order(i, G, c, T / 256, D / 256, u.pm, u.pn); }
    __device__ __forceinline__ const char* a_base(const Unit& u) const { return (const char*)ycat + (size_t)u.pm * 256 * D * 2; }
    __device__ __forceinline__ const char* b_base(const Unit& u) const { return (const char*)wt + (size_t)u.pn * 256 * D * 2; }
    __device__ __forceinline__ void a_offsets(const Unit&, int, unsigned (&)[2][2]) const {}
    __device__ __forceinline__ const unsigned* meta_ptr(const Unit& u, int, int idx) const { return (const unsigned*)rsl + u.pm * 256 + idx; }
    __device__ __forceinline__ void epi(const f32x4 (&acc)[2][2][4][2], const Unit& u, int wr, int wc, int fr, int fq, const LAS unsigned char*) const {
#pragma unroll
        for (int ai = 0; ai < 2; ++ai)
#pragma unroll
            for (int m = 0; m < 4; ++m) {
                const int row = u.pm * 256 + ai * 128 + wr * 64 + m * 16 + fr;
                float ss = 0.f;
#pragma unroll
                for (int bj = 0; bj < 2; ++bj) {
                    const int col = u.pn * 256 + bj * 128 + wc * 32 + 8 * fq;
                    const u32x4 xv = *(const u32x4*)(xb + (size_t)row * D + col);
                    const f32x4 x0 = {bflo(xv.x), bfhi(xv.x), bflo(xv.y), bfhi(xv.y)}, x1 = {bflo(xv.z), bfhi(xv.z), bflo(xv.w), bfhi(xv.w)};
                    const f32x4 v0 = acc[ai][bj][m][0] + x0, v1 = acc[ai][bj][m][1] + x1;
                    ss += (v0[0] * v0[0] + v0[1] * v0[1]) + (v0[2] * v0[2] + v0[3] * v0[3]) + (v1[0] * v1[0] + v1[1] * v1[1]) + (v1[2] * v1[2] + v1[3] * v1[3]);
                    u32x4 w; w.x = pk2(v0[0], v0[1]); w.y = pk2(v0[2], v0[3]); w.z = pk2(v1[0], v1[1]); w.w = pk2(v1[2], v1[3]);
                    *(u32x4*)(yb01 + (size_t)row * 2048 + col) = w;
                    u32x2 w8; w8.x = pk4_fp8(v0[0], v0[1], v0[2], v0[3]); w8.y = pk4_fp8(v1[0], v1[1], v1[2], v1[3]);
                    *(u32x2*)(x8 + (size_t)row * D + col) = w8;
                }
                ss += SHFLX_F(ss, 16, fr + 16 * fq); ss += SHFLX_F(ss, 32, fr + 16 * fq);
                if (fq == 0) ssq[(size_t)(u.pn * 4 + wc) * T + row] = ss;
            }
    }
};

struct MoeTabs {
    const LAS unsigned* cnt; const LAS unsigned* eoff; const LAS unsigned* tbase; const LAS unsigned short* tile_e; int ntiles;
    __device__ __forceinline__ bool next(int i, int G, int c, int nN, Unit& u) const {
        int pm, pn; if (!pg8::static_order(i, G, c, ntiles, nN, pm, pn)) return false;
        const int e = __builtin_amdgcn_readfirstlane((int)tile_e[pm]);
        const int tb = __builtin_amdgcn_readfirstlane((int)tbase[e]), ce = __builtin_amdgcn_readfirstlane((int)cnt[e]), eo = __builtin_amdgcn_readfirstlane((int)eoff[e]);
        u.pm = pm; u.pn = pn; u.e = e; u.pos0 = (pm - tb) * 256; u.nvalid = (ce - u.pos0) < 256 ? (ce - u.pos0) : 256; u.eoff = eo; return true;
    }
};
__device__ __forceinline__ MoeTabs moe_build_tabs(LAS unsigned char* lds, const unsigned* ctl, int wv) {
    LAS unsigned* cnt = (LAS unsigned*)(lds + TAB_CNT); LAS unsigned* eoff = (LAS unsigned*)(lds + TAB_EOFF); LAS unsigned* tbase = (LAS unsigned*)(lds + TAB_TBASE);
    LAS unsigned short* tile_e = (LAS unsigned short*)(lds + TAB_TILEE);
    __syncthreads();
    const int l = LANE_ID();
    if (wv == 0 && l < NEXP) cnt[l] = ctl[CW_CNT + 64 * l];
    __syncthreads();
    if (wv == 0 && l < NEXP) {
        unsigned eo = 0, tb = 0;
        for (int j = 0; j < NEXP; ++j) { const unsigned cj = cnt[j]; if (j < l) { eo += cj; tb += (cj + 255u) >> 8; } }
        const unsigned nt = (cnt[l] + 255u) >> 8;
        eoff[l] = eo; tbase[l] = tb;
        for (unsigned t = 0; t < nt; ++t) tile_e[tb + t] = (unsigned short)l;
        if (l == NEXP - 1) tbase[NEXP] = tb + nt;
    }
    __syncthreads();
    MoeTabs mt; mt.cnt = cnt; mt.eoff = eoff; mt.tbase = tbase; mt.tile_e = tile_e; mt.ntiles = __builtin_amdgcn_readfirstlane((int)tbase[NEXP]); return mt;
}

struct ProbUp {
    static constexpr int DIAG = 0;
    static constexpr bool GATHER = true, MIDK = false, FP8 = true; static constexpr int NMETA = 3;
    int probe_mode; MoeTabs tabs; const unsigned char* x8; const unsigned char* wgu; const unsigned* list; const float* rs2s; const float* bg; const float* bu; unsigned char* act; int G, c;
    __device__ __forceinline__ bool next(int i, Unit& u) const { return tabs.next(i, G, c, 8, u); }
    __device__ __forceinline__ const char* a_base(const Unit&) const { return (const char*)x8; }
    __device__ __forceinline__ const char* b_base(const Unit& u) const { return (const char*)wgu + ((size_t)u.e * 2048 + (size_t)u.pn * 256) * D; }
    __device__ __forceinline__ void a_offsets(const Unit& u, int tid, unsigned (&vo)[2][2]) const {
        int R[2], C[2];
#pragma unroll
        for (int i = 0; i < 2; ++i) pg8::stage_rc(tid * 16 + i * 8192, R[i], C[i]);
#pragma unroll
        for (int h = 0; h < 2; ++h)
#pragma unroll
            for (int i = 0; i < 2; ++i) { const int rl = h * 128 + R[i]; const int pos = u.pos0 + (rl < u.nvalid ? rl : 0);
                const unsigned slot = list[(size_t)u.e * T + pos]; vo[h][i] = (slot >> 2) * 1024u + (unsigned)C[i] * 2u; }
    }
    __device__ __forceinline__ void a_offsets_lds(const Unit& u, int tid, unsigned (&vo)[2][2], const LAS unsigned char* mbuf) const {
        int R[2], C[2];
#pragma unroll
        for (int i = 0; i < 2; ++i) pg8::stage_rc(tid * 16 + i * 8192, R[i], C[i]);
#pragma unroll
        for (int h = 0; h < 2; ++h)
#pragma unroll
            for (int i = 0; i < 2; ++i) { const int rl = h * 128 + R[i]; const unsigned slot = *(const LAS unsigned*)(mbuf + 2048 + (rl < u.nvalid ? rl : 0) * 4); vo[h][i] = (slot >> 2) * 1024u + (unsigned)C[i] * 2u; }
    }
    __device__ __forceinline__ const unsigned* meta_ptr(const Unit& u, int a, int idx) const {
        if (a == 0) return (const unsigned*)rs2s + (size_t)u.e * T + u.pos0 + idx;
        if (a == 2) return list + (size_t)u.e * T + u.pos0 + idx;
        return (const unsigned*)(idx < 128 ? bg : bu) + (size_t)u.e * D + u.pn * 128 + (idx & 127);
    }
    __device__ __forceinline__ void epi(const f32x4 (&acc)[2][2][4][2], const Unit& u, int wr, int wc, int fr, int fq, const LAS unsigned char* mbuf) const {
        if (probe_mode == 1) return;
        const int col8 = u.pn * 128 + wc * 32 + 8 * fq;
        f32x4 bgv[2], buv[2];
#pragma unroll
        for (int n = 0; n < 2; ++n) { bgv[n] = *(const LAS f32x4*)(mbuf + 1024 + (wc * 32 + 8 * fq + 4 * n) * 4); buv[n] = *(const LAS f32x4*)(mbuf + 1536 + (wc * 32 + 8 * fq + 4 * n) * 4); }
        float rsv[2][4];
#pragma unroll
        for (int ai = 0; ai < 2; ++ai)
#pragma unroll
            for (int m = 0; m < 4; ++m) { const int rl = ai * 128 + wr * 64 + m * 16 + fr; rsv[ai][m] = *(const LAS float*)(mbuf + rl * 4) * (1.0f / 64.0f);
            }
#pragma unroll
        for (int ai = 0; ai < 2; ++ai)
#pragma unroll
            for (int m = 0; m < 4; ++m) {
                const int rl = ai * 128 + wr * 64 + m * 16 + fr;
                const float rs = rsv[ai][m];
                float o[8];
#pragma unroll
                for (int n = 0; n < 2; ++n)
#pragma unroll
                    for (int jp = 0; jp < 2; ++jp) {
                        const f32x2 ag = {acc[ai][0][m][n][2 * jp], acc[ai][0][m][n][2 * jp + 1]}, au = {acc[ai][1][m][n][2 * jp], acc[ai][1][m][n][2 * jp + 1]};
                        const f32x2 bg2 = {bgv[n][2 * jp], bgv[n][2 * jp + 1]}, bu2 = {buv[n][2 * jp], buv[n][2 * jp + 1]};
                        f32x2 g = ag * rs + bg2, up = au * rs + bu2;
                        g.x = fminf(g.x, 7.0f); g.y = fminf(g.y, 7.0f);
                        up.x = fminf(fmaxf(up.x, -7.0f), 7.0f); up.y = fminf(fmaxf(up.y, -7.0f), 7.0f);
                        const f32x2 z = g * (-1.702f * 1.4426950408889634f);
                        f32x2 e; e.x = fexp2(z.x); e.y = fexp2(z.y);
                        const f32x2 den = e + 1.0f;
                        f32x2 r; r.x = frcp(den.x); r.y = frcp(den.y);
                        const f32x2 res = (g * r) * (up + 1.0f);
                        o[4 * n + 2 * jp] = res.x; o[4 * n + 2 * jp + 1] = res.y;
                    }
                u32x2 w; w.x = pk4_fp8(o[0], o[1], o[2], o[3]); w.y = pk4_fp8(o[4], o[5], o[6], o[7]);
                if (rl < u.nvalid) *(u32x2*)(act + (size_t)(u.eoff + u.pos0 + rl) * D + col8) = w;
            }
    }
};

template <int DG> struct ProbUpDiag : ProbUp { static constexpr int DIAG = DG; };
struct ProbDown {
    static constexpr int DIAG = 0;
    static constexpr bool GATHER = false, MIDK = false, FP8 = true; static constexpr int NMETA = 3;
    int probe_mode; MoeTabs tabs; const unsigned char* act; const unsigned char* wd; const unsigned* list; const float* gw; const float* bd; unsigned char* y8; int G, c;
    __device__ __forceinline__ bool next(int i, Unit& u) const { return tabs.next(i, G, c, 4, u); }
    __device__ __forceinline__ const char* a_base(const Unit& u) const { return (const char*)act + (size_t)(u.eoff + u.pos0) * D; }
    __device__ __forceinline__ const char* b_base(const Unit& u) const { return (const char*)wd + ((size_t)u.e * D + (size_t)u.pn * 256) * D; }
    __device__ __forceinline__ void a_offsets(const Unit&, int, unsigned (&)[2][2]) const {}
    __device__ __forceinline__ const unsigned* meta_ptr(const Unit& u, int a, int idx) const {
        if (a == 2) return (const unsigned*)bd + (size_t)u.e * D + u.pn * 256 + idx;
        return (a == 0 ? list : (const unsigned*)gw) + (size_t)u.e * T + u.pos0 + idx;
    }
    __device__ __forceinline__ void epi(const f32x4 (&acc)[2][2][4][2], const Unit& u, int wr, int wc, int fr, int fq, const LAS unsigned char* mbuf) const {
        if (probe_mode == 1) return;
        const int cofs = u.pn * 256 + wc * 32 + 8 * fq;
        f32x4 bdv[2][2];
#pragma unroll
        for (int bj = 0; bj < 2; ++bj) { bdv[bj][0] = *(const LAS f32x4*)(mbuf + 2048 + (bj * 128 + wc * 32 + 8 * fq) * 4); bdv[bj][1] = *(const LAS f32x4*)(mbuf + 2048 + (bj * 128 + wc * 32 + 8 * fq + 4) * 4); }
#pragma unroll
        for (int ai = 0; ai < 2; ++ai)
#pragma unroll
            for (int m = 0; m < 4; ++m) {
                const int rl = ai * 128 + wr * 64 + m * 16 + fr;
                const unsigned sl = *(const LAS unsigned*)(mbuf + rl * 4);
                const float g = *(const LAS float*)(mbuf + 1024 + rl * 4), s1 = g * (Y8_SCALE / 64.0f), s2 = g * Y8_SCALE;
                unsigned char* dst = y8 + (size_t)sl * D + cofs;
#pragma unroll
                for (int bj = 0; bj < 2; ++bj) {
                    const f32x4 v0 = acc[ai][bj][m][0] * s1 + bdv[bj][0] * s2, v1 = acc[ai][bj][m][1] * s1 + bdv[bj][1] * s2;
                    u32x2 w; w.x = pk4_fp8(v0[0], v0[1], v0[2], v0[3]); w.y = pk4_fp8(v1[0], v1[1], v1[2], v1[3]);
                    if (rl < u.nvalid) *(u32x2*)(dst + bj * 128) = w;
                }
            }
    }
};

struct P0Item { const float* W; const float* scale; void* WT; int N, mode, off, k0, n0, fp8; };
__device__ __forceinline__ int p0_dest(const P0Item& d, int n) {
    if (d.mode == 1) { const int seg = n >> 9; if (seg == 2 || seg == 3) { const int w = n & 511, head = w >> 7, dd = w & 127; return (seg << 9) + (head << 7) + 2 * (dd & 63) + (dd >> 6); } return n; }
    if (d.mode == 2) return d.off + 256 * (n >> 7) + (n & 127);
    return d.off + n;
}
constexpr int P0_I_IN = 16 * (DIN / 64), P0_I_OUT = 16 * (D / 64), P0_I_E = 16 * (D / 64), P0_NITEMS_ALL = P0_I_IN + P0_I_OUT + 3 * NEXP * P0_I_E;
__device__ __forceinline__ void p0_load(const P0Item& d, int lane, f32x4 (&v)[16], float& sc) {
#pragma unroll
    for (int i = 0; i < 16; ++i) v[i] = *(const f32x4*)(d.W + (size_t)(d.k0 + (lane >> 4) + 4 * i) * d.N + d.n0 + 4 * (lane & 15));
    sc = d.scale ? d.scale[d.k0 + lane] : 1.0f;
    if (d.fp8) sc *= 64.0f;
}
__device__ __forceinline__ void p0_process(const P0Item& d, int lane, const f32x4 (&v)[16], float sc, LAS unsigned char* scr) {
    LAS float* ssc = (LAS float*)(scr + 64 * 136);
    ssc[lane] = sc;
    WAVE_SYNC();
#pragma unroll
    for (int i = 0; i < 16; ++i) { const int kk = (lane >> 4) + 4 * i; const float f = ssc[kk];
        u32x2 o; o.x = pk2(v[i].x * f, v[i].y * f); o.y = pk2(v[i].z * f, v[i].w * f);
        *(LAS u32x2*)(scr + kk * 136 + 8 * (lane & 15)) = o; }
    WAVE_SYNC();
    const int q = (lane & 15) >> 2, p = lane & 3;
    if (d.fp8) {
#pragma unroll
        for (int st = 0; st < 4; ++st) {
            const int n16 = 16 * st; unsigned o[4];
#pragma unroll
            for (int hf = 0; hf < 2; ++hf) {
                const int kb8 = 2 * (lane >> 4) + hf;
                const v4i16_t lo = __builtin_amdgcn_ds_read_tr16_b64_v4i16((LAS v4i16_t*)(scr + (8 * kb8 + q) * 136 + (n16 + 4 * p) * 2));
                const v4i16_t hi = __builtin_amdgcn_ds_read_tr16_b64_v4i16((LAS v4i16_t*)(scr + (8 * kb8 + 4 + q) * 136 + (n16 + 4 * p) * 2));
                o[2 * hf] = pk4_fp8(bf2f((unsigned short)lo[0]), bf2f((unsigned short)lo[1]), bf2f((unsigned short)lo[2]), bf2f((unsigned short)lo[3]));
                o[2 * hf + 1] = pk4_fp8(bf2f((unsigned short)hi[0]), bf2f((unsigned short)hi[1]), bf2f((unsigned short)hi[2]), bf2f((unsigned short)hi[3]));
            }
            *(u32x4*)((unsigned char*)d.WT + (size_t)p0_dest(d, d.n0 + n16 + (lane & 15)) * D + d.k0 + 16 * (lane >> 4)) = (u32x4){o[0], o[1], o[2], o[3]};
        }
    } else {
#pragma unroll
    for (int st = 0; st < 8; ++st) {
        const int n16 = 16 * (st & 3), kb8 = (st >> 2) * 4 + (lane >> 4);
        const v4i16_t lo = __builtin_amdgcn_ds_read_tr16_b64_v4i16((LAS v4i16_t*)(scr + (8 * kb8 + q) * 136 + (n16 + 4 * p) * 2));
        const v4i16_t hi = __builtin_amdgcn_ds_read_tr16_b64_v4i16((LAS v4i16_t*)(scr + (8 * kb8 + 4 + q) * 136 + (n16 + 4 * p) * 2));
        u32x4 o; o.x = (unsigned)(unsigned short)lo[0] | ((unsigned)(unsigned short)lo[1] << 16); o.y = (unsigned)(unsigned short)lo[2] | ((unsigned)(unsigned short)lo[3] << 16);
        o.z = (unsigned)(unsigned short)hi[0] | ((unsigned)(unsigned short)hi[1] << 16); o.w = (unsigned)(unsigned short)hi[2] | ((unsigned)(unsigned short)hi[3] << 16);
        *(u32x4*)((bf16_t*)d.WT + (size_t)p0_dest(d, d.n0 + n16 + (lane & 15)) * D + d.k0 + 8 * kb8) = o;
    }
    }
    WAVE_SYNC();
}

#ifndef STREAM_FINAL
#define STREAM_FINAL 1
#endif
#define STREAM_IN_PASS(fin) ((fin) ? (STREAM_FINAL != 0) : true)
struct MoeConv { const float *wg, *wu, *wd, *ffn_g; unsigned char *wgu8, *wd8; };
constexpr int MOE_ITEMS = 3 * NEXP * P0_I_E, NLRU = BATCH * NCH;
constexpr int MOE_PER_WU = (MOE_ITEMS + NLRU * 8 - 1) / (NLRU * 8);
constexpr int MOE_K0 = MOE_PER_WU >= 12 ? 8 : (MOE_PER_WU * 2 + 2) / 3, MOE_K1_RAW = MOE_PER_WU - MOE_K0, MOE_K1 = MOE_K1_RAW < 0 ? 0 : (MOE_K1_RAW > 8 ? 8 : MOE_K1_RAW);
constexpr int MOE_PASS0_ITEMS = NLRU * 8 * MOE_K0, MOE_CAP = NLRU * 8 * (MOE_K0 + MOE_K1), MOE_STREAMED = MOE_ITEMS < MOE_CAP ? MOE_ITEMS : MOE_CAP;
constexpr int P0_NITEMS = P0_NITEMS_ALL - MOE_STREAMED;
__device__ __forceinline__ P0Item moe_item(const MoeConv& M, int it) {
    P0Item d; d.scale = nullptr; d.off = 0; d.mode = 0; d.fp8 = 1; d.N = D;
    const int e = it / (3 * P0_I_E), q = (it / P0_I_E) % 3, r = it % P0_I_E;
    if (q == 0) { d.W = M.wg + (size_t)e * D * D; d.scale = M.ffn_g; d.WT = M.wgu8; d.mode = 2; d.off = e * 2048; }
    else if (q == 1) { d.W = M.wu + (size_t)e * D * D; d.scale = M.ffn_g; d.WT = M.wgu8; d.mode = 2; d.off = e * 2048 + 128; }
    else { d.W = M.wd + (size_t)e * D * D; d.WT = M.wd8; d.off = e * D; }
    d.k0 = 64 * (r / (D / 64)); d.n0 = 64 * (r % (D / 64)); return d;
}

constexpr int RT_STRIDE = 272;
constexpr int LDS_VT = 0, LDS_KT = 128 * RT_STRIDE;
constexpr int XA_STRIDE = 144, XA_WAVE = 16 * XA_STRIDE;
constexpr int AG_STRIDE = 520, AG_WAVE = 16 * AG_STRIDE;
constexpr int LRU_WAVE = XA_WAVE + AG_WAVE;
constexpr int LDS_XA = 0, LDS_SS = 8 * LRU_WAVE, LDS_RSL = LDS_SS + 8 * 128 * 4;
static_assert(LRU_WAVE % 16 == 0 && LRU_WAVE >= 64 * 136 + 256, "LRU per-wave LDS block must hold one weight item");
static_assert(LDS_RSL + 512 <= RING_BYTES && LDS_KT + 128 * RT_STRIDE <= RING_BYTES, "LDS seq map");

__device__ __forceinline__ bf16x8 tr_frag(const LAS unsigned char* tile, int row0, int col0, int fr) {
    const int q = fr >> 2, p = fr & 3;
    const v4i16_t lo = __builtin_amdgcn_ds_read_tr16_b64_v4i16((LAS v4i16_t*)(tile + (row0 + q) * RT_STRIDE + (col0 + 4 * p) * 2));
    const v4i16_t hi = __builtin_amdgcn_ds_read_tr16_b64_v4i16((LAS v4i16_t*)(tile + (row0 + 4 + q) * RT_STRIDE + (col0 + 4 * p) * 2));
    bf16x8 r; r[0] = lo[0]; r[1] = lo[1]; r[2] = lo[2]; r[3] = lo[3]; r[4] = hi[0]; r[5] = hi[1]; r[6] = hi[2]; r[7] = hi[3]; return r;
}
__device__ __forceinline__ void stage_tile(LAS unsigned char* dst, const bf16_t* src, int tid) {
#pragma unroll
    for (int i = 0; i < 4; ++i) { const int p = tid + 512 * i, r = p >> 4, c = p & 15;
        const u32x4 v = *(const u32x4*)(src + (size_t)r * DIN + c * 8); *(LAS u32x4*)(dst + r * RT_STRIDE + c * 16) = v; }
}

template <bool FINAL>
__device__ __forceinline__ void lru_unit(LAS unsigned char* lds, int b, int n, const bf16_t* __restrict__ proj, const float* __restrict__ conv_w, const float* __restrict__ conv_b, const bf16_t* __restrict__ waf,
                                         const float* __restrict__ ba, const float* __restrict__ bx, const float* __restrict__ lam, const float* __restrict__ lru_ng,
                                         float* __restrict__ lap, float* __restrict__ lah, const float* __restrict__ carry, bf16_t* __restrict__ ycat, float* __restrict__ rsl_out, const MoeConv& MC, int item0, int wv) {
    int tid_ = wv * 64 + LANE_ID(); OPAQUE(tid_);
    const int tid = tid_, lane = tid & 63, w = __builtin_amdgcn_readfirstlane(tid >> 6), fr = lane & 15, fq = lane >> 4, c = tid;
    LAS unsigned char* xa = lds + LDS_XA + w * LRU_WAVE; LAS unsigned char* ag = xa + XA_WAVE;
    LAS float* ss = (LAS float*)(lds + LDS_SS);
    bf16x8 Ba[2][4], Bx[2][4];
#pragma unroll
    for (int ks = 0; ks < 2; ++ks)
#pragma unroll
        for (int nt = 0; nt < 4; ++nt) { const size_t fi = ((size_t)(w * 2 + ks) * 4 + nt) * 64 + lane; Ba[ks][nt] = *(const bf16x8*)(waf + fi * 8); Bx[ks][nt] = *(const bf16x8*)(waf + (fi + 4096) * 8); }
    float bav[4], bxv[4], spl[4];
#pragma unroll
    for (int nt = 0; nt < 4; ++nt) { const int co = w * 64 + 16 * nt + fr; bav[nt] = ba[co]; bxv[nt] = bx[co]; const float l = lam[co];
        spl[nt] = -8.0f * 1.4426950408889634f * (fmaxf(-l, 0.f) + log1pf(expf(-fabsf(l)))); }
    const float w0 = conv_w[c], w1 = conv_w[512 + c], w2 = conv_w[1024 + c], w3 = conv_w[1536 + c], cb = conv_b[c];
    const float gn = FINAL ? lru_ng[c] : 0.f;
    const size_t t0 = (size_t)b * SEQ + (size_t)n * 128;
    float xm3 = 0.f, xm2 = 0.f, xm1 = 0.f;
    if (n > 0) { xm3 = bf2f(proj[(t0 - 3) * DIN + c]); xm2 = bf2f(proj[(t0 - 2) * DIN + c]); xm1 = bf2f(proj[(t0 - 1) * DIN + c]); }
    float h = FINAL ? carry[((size_t)b * NCH + n) * 512 + c] : 0.f, P = 1.f;
    unsigned xr[16];
#pragma unroll
    for (int i = 0; i < 16; ++i) xr[i] = proj[(t0 + i) * DIN + c];
    for (int tt = 0; tt < 8; ++tt) {
        float xcv[16]; unsigned gr[16];
#pragma unroll
        for (int i = 0; i < 16; ++i) { xcv[i] = bf2f(xr[i]); gr[i] = FINAL ? (unsigned)proj[(t0 + tt * 16 + i) * DIN + 512 + c] : 0u; }
        if (tt < 7) {
#pragma unroll
            for (int i = 0; i < 16; ++i) xr[i] = proj[(t0 + (tt + 1) * 16 + i) * DIN + c];
        }
        constexpr int KP = FINAL ? MOE_K1 : MOE_K0;
        const int cit = item0 + (w * KP + tt);
        const bool chas = (tt < KP) && (cit < MOE_STREAMED);
        P0Item cd; f32x4 cv[16]; float csc = 1.f;
        if (chas) { cd = moe_item(MC, cit); p0_load(cd, lane, cv, csc); }
#pragma unroll
        for (int i = 0; i < 16; ++i) {
            const float x0 = xcv[i];
            const float xc = w0 * xm3 + w1 * xm2 + w2 * xm1 + w3 * x0 + cb;
            xm3 = xm2; xm2 = xm1; xm1 = x0; xcv[i] = xc;
            *(LAS bf16_t*)(xa + i * XA_STRIDE + lane * 2) = (bf16_t)f2bf(xc);
        }
        WAVE_SYNC();
        bf16x8 af[2];
#pragma unroll
        for (int ks = 0; ks < 2; ++ks) af[ks] = *(const LAS bf16x8*)(xa + fr * XA_STRIDE + (32 * ks + 8 * fq) * 2);
#pragma unroll
        for (int nt = 0; nt < 4; ++nt) {
            f32x4 ar = {0.f, 0.f, 0.f, 0.f}, ai = {0.f, 0.f, 0.f, 0.f};
#pragma unroll
            for (int ks = 0; ks < 2; ++ks) { ar = __builtin_amdgcn_mfma_f32_16x16x32_bf16(af[ks], Ba[ks][nt], ar, 0, 0, 0); ai = __builtin_amdgcn_mfma_f32_16x16x32_bf16(af[ks], Bx[ks][nt], ai, 0, 0, 0); }
#pragma unroll
            for (int r = 0; r < 4; ++r) {
                const float rr = sigmoid_f(ar[r] + bav[nt]), ii = sigmoid_f(ai[r] + bxv[nt]);
                const float a = fexp2(rr * spl[nt]);
                const float g = sqrtf(fmaxf(1.0f - a * a, 0.f)) * ii;
                *(LAS f32x2*)(ag + (4 * fq + r) * AG_STRIDE + (16 * nt + fr) * 8) = (f32x2){a, g};
            }
        }
        WAVE_SYNC();
        unsigned upk[8];
#pragma unroll
        for (int i = 0; i < 16; ++i) {
            const f32x2 v = *(const LAS f32x2*)(ag + i * AG_STRIDE + lane * 8);
            h = v.x * h + v.y * xcv[i];
            if (!FINAL) P *= v.x;
            if (FINAL) {
                const float u = h * bf2f(gr[i]);
                const unsigned ub = f2bf(u * gn);
                if (i & 1) upk[i >> 1] |= ub << 16; else upk[i >> 1] = ub;
                *(LAS float*)(ag + i * AG_STRIDE + lane * 8) = u;
            }
        }
        if (FINAL) {
            WAVE_SYNC();
            const int tk = lane & 15, qd = lane >> 4; float s = 0.f;
#pragma unroll
            for (int i = 0; i < 16; ++i) { const float u = *(const LAS float*)(ag + tk * AG_STRIDE + (16 * qd + i) * 8); s += u * u; }
            s += SHFLX_F(s, 16, lane); s += SHFLX_F(s, 32, lane);
            if (qd == 0) ss[w * 128 + tt * 16 + tk] = s;
        }
        WAVE_SYNC();
        if (chas) p0_process(cd, lane, cv, csc, xa);
        if (FINAL) {
#pragma unroll
            for (int i = 0; i < 16; ++i) ycat[(t0 + tt * 16 + i) * D + c] = (bf16_t)((i & 1) ? (upk[i >> 1] >> 16) : (upk[i >> 1] & 0xffffu));
        }
    }
    if (!FINAL) { lap[((size_t)b * NCH + n) * 512 + c] = P; lah[((size_t)b * NCH + n) * 512 + c] = h; }
    else {
        __syncthreads();
        if (tid < 128) { float tot = 0.f;
#pragma unroll
            for (int q = 0; q < 8; ++q) tot += ss[q * 128 + tid];
            rsl_out[t0 + tid] = 1.0f / sqrtf(tot * (1.0f / 512.0f) + NORM_EPS); }
    }
    __syncthreads();
}

__device__ __forceinline__ void ret_kv_load(u32x4 (&tk)[4], u32x4 (&tv)[4], int unit, const bf16_t* __restrict__ proj, int tid) {
    const int bh = unit / NCH, n = unit % NCH, b = bh >> 2, hh = bh & 3;
    const size_t t0 = (size_t)b * SEQ + (size_t)n * 128;
#pragma unroll
    for (int i = 0; i < 4; ++i) { const int p = tid + 512 * i, r = p >> 4, c = p & 15;
        tk[i] = *(const u32x4*)(proj + (t0 + r) * DIN + 1536 + hh * 128 + c * 8); tv[i] = *(const u32x4*)(proj + (t0 + r) * DIN + 2048 + hh * 128 + c * 8); }
}
__device__ __forceinline__ void ret_kv_stage(LAS unsigned char* lds, const u32x4 (&tk)[4], const u32x4 (&tv)[4], int tid) {
#pragma unroll
    for (int i = 0; i < 4; ++i) { const int p = tid + 512 * i, r = p >> 4, c = p & 15;
        *(LAS u32x4*)(lds + LDS_KT + r * RT_STRIDE + c * 16) = tk[i]; *(LAS u32x4*)(lds + LDS_VT + r * RT_STRIDE + c * 16) = tv[i]; }
}
__device__ __forceinline__ void ret_kv_phase(LAS unsigned char* lds, const bf16_t* __restrict__ proj, bf16_t* __restrict__ kvt, int G, int bx, int wv) {
    int tid_ = wv * 64 + LANE_ID(); OPAQUE(tid_);
    const int tid = tid_, lane = tid & 63, w = wv, fr = lane & 15, fq = lane >> 4;
    u32x4 tk[4], tv[4];
    int unit = bx;
    if (unit < NBH * NCH) { ret_kv_load(tk, tv, unit, proj, tid); ret_kv_stage(lds, tk, tv, tid); __syncthreads(); if (unit + G < NBH * NCH) ret_kv_load(tk, tv, unit + G, proj, tid); }
    for (; unit < NBH * NCH; unit += G) {
        f32x4 acc[8];
#pragma unroll
        for (int et = 0; et < 8; ++et) acc[et] = (f32x4){0.f, 0.f, 0.f, 0.f};
#pragma unroll
        for (int ks = 0; ks < 4; ++ks) {
            const bf16x8 af = tr_frag(lds + LDS_KT, 32 * ks + 8 * fq, 16 * w, fr);
#pragma unroll
            for (int et = 0; et < 8; ++et) { const bf16x8 bfv = tr_frag(lds + LDS_VT, 32 * ks + 8 * fq, 16 * et, fr);
                acc[et] = __builtin_amdgcn_mfma_f32_16x16x32_bf16(af, bfv, acc[et], 0, 0, 0); }
        }
        u32x2 o[8];
#pragma unroll
        for (int et = 0; et < 8; ++et) { o[et].x = pk2v(acc[et][0], acc[et][1]); o[et].y = pk2v(acc[et][2], acc[et][3]); }
        __syncthreads();
        if (unit + G < NBH * NCH) ret_kv_stage(lds, tk, tv, tid);
        bf16_t* out = kvt + (size_t)unit * 16384;
#pragma unroll
        for (int et = 0; et < 8; ++et) *(u32x2*)(out + (size_t)(16 * et + fr) * 128 + 16 * w + 4 * fq) = o[et];
        __syncthreads();
        if (unit + 2 * G < NBH * NCH) ret_kv_load(tk, tv, unit + 2 * G, proj, tid);
    }
}

__device__ __forceinline__ int swz_off(int row, int chunk) { return row * 256 + ((chunk ^ (row & 15)) << 4); }
constexpr int LDS_RV = 0, LDS_RK = 32768, LDS_RP = 65536, LDS_RPT = 98304;
__device__ __forceinline__ bf16x8 tr_frag_swz(const LAS unsigned char* tile, int row0, int col0, int fr) {
    const int q = fr >> 2, p = fr & 3, ch = (col0 >> 3) + (p >> 1), bo = (p & 1) * 8;
    const v4i16_t lo = __builtin_amdgcn_ds_read_tr16_b64_v4i16((LAS v4i16_t*)(tile + swz_off(row0 + q, ch) + bo));
    const v4i16_t hi = __builtin_amdgcn_ds_read_tr16_b64_v4i16((LAS v4i16_t*)(tile + swz_off(row0 + 4 + q, ch) + bo));
    bf16x8 r; r[0] = lo[0]; r[1] = lo[1]; r[2] = lo[2]; r[3] = lo[3]; r[4] = hi[0]; r[5] = hi[1]; r[6] = hi[2]; r[7] = hi[3]; return r;
}
struct RetRegs { u32x4 tv[4], tk[4], tp[4]; bf16x8 bq[4]; u32x2 sg[8]; };
__device__ __forceinline__ void ret_out_load(RetRegs& R, int unit, const bf16_t* __restrict__ proj, const bf16_t* __restrict__ prevt, int tid, int w, int fr, int fq) {
    const int bh = unit / NCH, n = unit % NCH, b = bh >> 2, hh = bh & 3;
    const size_t t0 = (size_t)b * SEQ + (size_t)n * 128;
#pragma unroll
    for (int i = 0; i < 4; ++i) { const int p = tid + 512 * i, r = p >> 4, c = p & 15;
        R.tv[i] = *(const u32x4*)(proj + (t0 + r) * DIN + 2048 + hh * 128 + c * 8);
        R.tk[i] = *(const u32x4*)(proj + (t0 + r) * DIN + 1536 + hh * 128 + c * 8);
        R.tp[i] = *(const u32x4*)(prevt + (size_t)unit * 16384 + r * 128 + c * 8); }
#pragma unroll
    for (int ks = 0; ks < 4; ++ks) R.bq[ks] = *(const bf16x8*)(proj + (t0 + 16 * w + fr) * DIN + 1024 + hh * 128 + 32 * ks + 8 * fq);
#pragma unroll
    for (int et = 0; et < 8; ++et) R.sg[et] = *(const u32x2*)(proj + (t0 + 16 * w + fr) * DIN + 2560 + hh * 128 + 16 * et + 4 * fq);
}
__device__ __forceinline__ void ret_out_phase(LAS unsigned char* lds, const bf16_t* __restrict__ proj, const bf16_t* __restrict__ prevt, const float* __restrict__ gng, const float* __restrict__ gnb, bf16_t* __restrict__ ycat, int G, int bx, int wv) {
    int tid_ = wv * 64 + LANE_ID(); OPAQUE(tid_);
    const int tid = tid_, lane = tid & 63, w = __builtin_amdgcn_readfirstlane(tid >> 6), fr = lane & 15, fq = lane >> 4;
    RetRegs R;
    int unit = bx;
    bf16x8 bq[4]; u32x2 sg[8];
    if (unit < NBH * NCH) {
        ret_out_load(R, unit, proj, prevt, tid, w, fr, fq);
#pragma unroll
        for (int i = 0; i < 4; ++i) { const int p = tid + 512 * i, r = p >> 4, c = p & 15, o = swz_off(r, c);
            *(LAS u32x4*)(lds + LDS_RV + o) = R.tv[i]; *(LAS u32x4*)(lds + LDS_RK + o) = R.tk[i]; *(LAS u32x4*)(lds + LDS_RP + o) = R.tp[i]; }
#pragma unroll
        for (int ks = 0; ks < 4; ++ks) bq[ks] = R.bq[ks];
#pragma unroll
        for (int et = 0; et < 8; ++et) sg[et] = R.sg[et];
        __syncthreads();
        if (unit + G < NBH * NCH) ret_out_load(R, unit + G, proj, prevt, tid, w, fr, fq);
    }
    for (; unit < NBH * NCH; unit += G) {
        const int bh = unit / NCH, n = unit % NCH, b = bh >> 2, hh = bh & 3;
        const size_t t0 = (size_t)b * SEQ + (size_t)n * 128;
        const int crow = 16 * w + fr;
#pragma unroll
        for (int mt = 0; mt < 8; ++mt) {
            if (mt <= w) {
                f32x4 sacc = {0.f, 0.f, 0.f, 0.f};
#pragma unroll
                for (int ks = 0; ks < 4; ++ks) { const bf16x8 ak = *(const LAS bf16x8*)(lds + LDS_RK + swz_off(16 * mt + fr, 4 * ks + fq));
                    sacc = __builtin_amdgcn_mfma_f32_16x16x32_bf16(ak, bq[ks], sacc, 0, 0, 0); }
                if (mt == w) {
#pragma unroll
                    for (int r = 0; r < 4; ++r) if (4 * fq + r > fr) sacc[r] = 0.f;
                }
                u32x2 o; o.x = pk2v(sacc[0], sacc[1]); o.y = pk2v(sacc[2], sacc[3]);
                *(LAS u32x2*)(lds + LDS_RPT + swz_off(crow, 2 * mt + (fq >> 1)) + (fq & 1) * 8) = o;
            } else if (mt == w + 1 && (mt & 1)) {
                *(LAS u32x2*)(lds + LDS_RPT + swz_off(crow, 2 * mt + (fq >> 1)) + (fq & 1) * 8) = (u32x2){0u, 0u};
            }
        }
        WAVE_SYNC();
        f32x4 acc[8];
#pragma unroll
        for (int et = 0; et < 8; ++et) acc[et] = (f32x4){0.f, 0.f, 0.f, 0.f};
        const int nks = (w + 2) >> 1;
#pragma unroll
        for (int ksm = 0; ksm < 4; ++ksm) {
            if (ksm < nks) {
                const bf16x8 bp = *(const LAS bf16x8*)(lds + LDS_RPT + swz_off(crow, 4 * ksm + fq));
#pragma unroll
                for (int et = 0; et < 8; ++et) { const bf16x8 av = tr_frag_swz(lds + LDS_RV, 32 * ksm + 8 * fq, 16 * et, fr);
                    acc[et] = __builtin_amdgcn_mfma_f32_16x16x32_bf16(av, bp, acc[et], 0, 0, 0); }
            }
        }
#pragma unroll
        for (int et = 0; et < 8; ++et)
#pragma unroll
            for (int ks = 0; ks < 4; ++ks) { const bf16x8 ap = *(const LAS bf16x8*)(lds + LDS_RP + swz_off(16 * et + fr, 4 * ks + fq));
                acc[et] = __builtin_amdgcn_mfma_f32_16x16x32_bf16(ap, bq[ks], acc[et], 0, 0, 0); }
        float s1 = 0.f;
#pragma unroll
        for (int et = 0; et < 8; ++et) s1 += (acc[et][0] + acc[et][1]) + (acc[et][2] + acc[et][3]);
        s1 += SHFLX_F(s1, 16, lane); s1 += SHFLX_F(s1, 32, lane);
        const float mu = s1 * (1.0f / 128.0f);
        float s2 = 0.f;
#pragma unroll
        for (int et = 0; et < 8; ++et)
#pragma unroll
            for (int r = 0; r < 4; ++r) { const float dlt = acc[et][r] - mu; s2 += dlt * dlt; }
        s2 += SHFLX_F(s2, 16, lane); s2 += SHFLX_F(s2, 32, lane);
        const float rstd = 1.0f / sqrtf(s2 * (1.0f / 128.0f) + NORM_EPS);
        const size_t t = t0 + 16 * w + fr;
        u32x2 yo[8];
#pragma unroll
        for (int et = 0; et < 8; ++et) {
            const int e0 = hh * 128 + 16 * et + 4 * fq;
            const f32x4 gv = *(const f32x4*)(gng + e0), bv = *(const f32x4*)(gnb + e0);
            const float y0 = ((acc[et][0] - mu) * rstd * gv[0] + bv[0]) * bflo(sg[et].x), y1 = ((acc[et][1] - mu) * rstd * gv[1] + bv[1]) * bfhi(sg[et].x);
            const float y2 = ((acc[et][2] - mu) * rstd * gv[2] + bv[2]) * bflo(sg[et].y), y3 = ((acc[et][3] - mu) * rstd * gv[3] + bv[3]) * bfhi(sg[et].y);
            yo[et].x = pk2v(y0, y1); yo[et].y = pk2v(y2, y3);
        }
        __syncthreads();
        const bool has_next = unit + G < NBH * NCH;
        if (has_next) {
#pragma unroll
            for (int i = 0; i < 4; ++i) { const int p = tid + 512 * i, r = p >> 4, c = p & 15, o = swz_off(r, c);
                *(LAS u32x4*)(lds + LDS_RV + o) = R.tv[i]; *(LAS u32x4*)(lds + LDS_RK + o) = R.tk[i]; *(LAS u32x4*)(lds + LDS_RP + o) = R.tp[i]; }
#pragma unroll
            for (int ks = 0; ks < 4; ++ks) bq[ks] = R.bq[ks];
#pragma unroll
            for (int et = 0; et < 8; ++et) sg[et] = R.sg[et];
        }
#pragma unroll
        for (int et = 0; et < 8; ++et) *(u32x2*)(ycat + t * D + 512 + hh * 128 + 16 * et + 4 * fq) = yo[et];
        __syncthreads();
        if (unit + 2 * G < NBH * NCH) ret_out_load(R, unit + 2 * G, proj, prevt, tid, w, fr, fq);
    }
}

struct Ptrs {
    const float *x, *attn_g, *w_in, *conv_w, *conv_b, *lru_wa, *lru_ba, *lru_wx, *lru_bx, *lru_lam, *lru_ng, *ret_ng, *ret_nb, *w_out, *ffn_g, *router_w, *router_b;
    const float *moe_wg, *moe_bg, *moe_wu, *moe_bu, *moe_wd, *moe_bd, *final_g; const int* positions;
    float *RS1, *RS2S, *SSQ, *GW, *LAP, *LAH, *CARRY, *out; unsigned *LIST, *ctl;
    bf16_t *WR_T, *WIN_T, *WOUT_T, *PROJ, *XB, *YCAT, *YB23, *KVT, *PREVT, *YB01, *WAF; float* RSL; unsigned char *WGU8, *WD8, *X8, *ACT; int wv;
};
__device__ __forceinline__ MoeConv moe_conv(const Ptrs& P) { MoeConv M; M.wg = P.moe_wg; M.wu = P.moe_wu; M.wd = P.moe_wd; M.ffn_g = P.ffn_g; M.wgu8 = P.WGU8; M.wd8 = P.WD8; return M; }
#define PHASE_IDS() int tid = P.wv * 64 + LANE_ID(); OPAQUE(tid); const int lane = tid & 63, wave = P.wv; const int gw = bx * NWAVES + wave, NGW = G * NWAVES; (void)lane; (void)gw; (void)NGW

__device__ __forceinline__ P0Item p0_decode(const Ptrs& P, int it) {
    P0Item d; d.scale = nullptr; d.off = 0; d.mode = 0; d.fp8 = 0; int r = it, nblk;
    if (r < P0_I_IN) { d.W = P.w_in; d.scale = P.attn_g; d.N = DIN; d.WT = P.WIN_T; d.mode = 1; }
    else if ((r -= P0_I_IN) < P0_I_OUT) { d.W = P.w_out; d.N = D; d.WT = P.WOUT_T; }
    else { r -= P0_I_OUT; r += MOE_STREAMED;
        const int e = r / (3 * P0_I_E), q = (r / P0_I_E) % 3; r = r % P0_I_E; d.N = D;
        d.fp8 = 1;
        if (q == 0) { d.W = P.moe_wg + (size_t)e * D * D; d.scale = P.ffn_g; d.WT = P.WGU8; d.mode = 2; d.off = e * 2048; }
        else if (q == 1) { d.W = P.moe_wu + (size_t)e * D * D; d.scale = P.ffn_g; d.WT = P.WGU8; d.mode = 2; d.off = e * 2048 + 128; }
        else { d.W = P.moe_wd + (size_t)e * D * D; d.WT = P.WD8; d.off = e * D; } }
    nblk = d.N / 64; d.k0 = 64 * (r / nblk); d.n0 = 64 * (r % nblk); return d;
}
__device__ __forceinline__ void p0_prologue(LAS unsigned char* lds, const Ptrs& P, int G, int bx) {
    PHASE_IDS();
    {
        f32x4 v[4], nv[4];
        int m = gw;
        if (m < T) {
#pragma unroll
            for (int j = 0; j < 4; ++j) v[j] = ((const f32x4*)(P.x + (size_t)m * D))[lane + 64 * j];
        }
        for (; m < T; m += NGW) {
            const int mn = m + NGW;
            if (mn < T) {
#pragma unroll
                for (int j = 0; j < 4; ++j) nv[j] = ((const f32x4*)(P.x + (size_t)mn * D))[lane + 64 * j];
            }
            float s = 0.f;
#pragma unroll
            for (int j = 0; j < 4; ++j) s += (v[j].x * v[j].x + v[j].y * v[j].y) + (v[j].z * v[j].z + v[j].w * v[j].w);
            s = wave_sum(s, lane);
            if (lane == 0) P.RS1[m] = 1.0f / sqrtf(s * (1.0f / D) + NORM_EPS);
            u32x2* o8 = (u32x2*)(P.XB + (size_t)m * D) + lane;
#pragma unroll
            for (int j = 0; j < 4; ++j) { u32x2 o; o.x = pk2(v[j].x, v[j].y); o.y = pk2(v[j].z, v[j].w); o8[64 * j] = o; }
#pragma unroll
            for (int j = 0; j < 4; ++j) v[j] = nv[j];
        }
    }
    {
        LAS unsigned char* scr = lds + wave * 16384;
        f32x4 v[16], nv[16]; float sc = 1.f, nsc = 1.f;
        int it = gw;
        P0Item d, nd;
        if (it < P0_NITEMS) { d = p0_decode(P, it); p0_load(d, lane, v, sc); }
        for (; it < P0_NITEMS; it += NGW) {
            const int nit = it + NGW;
            if (nit < P0_NITEMS) { nd = p0_decode(P, nit); p0_load(nd, lane, nv, nsc); }
            p0_process(d, lane, v, sc, scr);
            d = nd; sc = nsc;
#pragma unroll
            for (int i = 0; i < 16; ++i) v[i] = nv[i];
        }
    }
    for (int i = bx * NTHREADS + tid; i < 32 * D; i += G * NTHREADS) { const int e = i / D, k = i % D; P.WR_T[i] = (bf16_t)((e < NEXP) ? f2bf(P.router_w[(size_t)k * NEXP + e] * P.ffn_g[k]) : 0u); }
    for (int i = bx * NTHREADS + tid; i < 2 * 8 * 2 * 4 * 64; i += G * NTHREADS) {
        const int ln = i & 63, nt = (i >> 6) & 3, ks = (i >> 8) & 1, h = (i >> 9) & 7, mat = i >> 12, fr = ln & 15, fq = ln >> 4;
        const float* w = mat ? P.lru_wx : P.lru_wa; unsigned pk[4];
#pragma unroll
        for (int j = 0; j < 4; ++j) { const size_t i0 = ((size_t)h * 64 + 32 * ks + 8 * fq + 2 * j) * 64 + 16 * nt + fr; pk[j] = pk2(w[i0], w[i0 + 64]); }
        *(u32x4*)(P.WAF + (size_t)i * 8) = (u32x4){pk[0], pk[1], pk[2], pk[3]};
    }
}

__device__ __forceinline__ void p3_scans(const Ptrs& P, int G, int bx) {
    PHASE_IDS();
    if (wave == NWAVES - 1) {
        const int per = (BATCH * 512 + G - 1) / G;
        for (int i = bx * per + lane; lane < per && i < BATCH * 512 && i < (bx + 1) * per; i += 64) { const int b = i / 512, c = i % 512; float st = 0.f;
            for (int n0 = 0; n0 < NCH; n0 += 32) {
                float ap[32], ah[32];
#pragma unroll
                for (int j = 0; j < 32; ++j) { const size_t o = ((size_t)b * NCH + (n0 + j < NCH ? n0 + j : 0)) * 512 + c; ap[j] = P.LAP[o]; ah[j] = P.LAH[o]; }
#pragma unroll
                for (int j = 0; j < 32; ++j) { if (n0 + j < NCH) { P.CARRY[((size_t)b * NCH + n0 + j) * 512 + c] = st; st = ap[j] * st + ah[j]; } }
            }
        }
    }
    for (int i = bx * NTHREADS + tid; i < NBH * 8192; i += G * NTHREADS) {
        const int bh = i / 8192, rem = i % 8192, hh = bh & 3;
        const float lamb = exp2f(128.0f * log2_gamma(hh));
        float s0 = 0.f, s1 = 0.f;
        const unsigned* src = (const unsigned*)(P.KVT + (size_t)bh * NCH * 16384) + rem; unsigned* dst = (unsigned*)(P.PREVT + (size_t)bh * NCH * 16384) + rem;
        for (int n0 = 0; n0 < NCH; n0 += 64) {
            unsigned kv[64];
#pragma unroll
            for (int j = 0; j < 64; ++j) kv[j] = (n0 + j < NCH) ? src[(size_t)(n0 + j) * 8192] : 0u;
#pragma unroll
            for (int j = 0; j < 64; ++j) { if (n0 + j < NCH) { dst[(size_t)(n0 + j) * 8192] = pk2(s0, s1); s0 = lamb * (s0 + bflo(kv[j])); s1 = lamb * (s1 + bfhi(kv[j])); } }
        }
    }
}

constexpr int CW_HIST = 32768;
__device__ __forceinline__ void p6_router(LAS unsigned char* lds, const Ptrs& P, int G, int bx, const XcdBarrier& bar) {
    PHASE_IDS();
    LAS unsigned* hist = (LAS unsigned*)(lds + 0); LAS unsigned* base = (LAS unsigned*)(lds + 256); LAS unsigned* part = (LAS unsigned*)(lds + 512);
    const int fr = lane & 15, fq = lane >> 4;
    const bool act = bx < T / 128;
    if (tid < 64) hist[tid] = 0u;
    __syncthreads();
    const int tok = (act ? bx : 0) * 128 + wave * 16 + fr;
    f32x4 lg[2] = {{0.f, 0.f, 0.f, 0.f}, {0.f, 0.f, 0.f, 0.f}};
    for (int ks = 0; ks < 32; ++ks) {
        const bf16x8 bt = *(const bf16x8*)(P.YB01 + (size_t)tok * 2048 + 32 * ks + 8 * fq);
#pragma unroll
        for (int tt = 0; tt < 2; ++tt) { const bf16x8 aw = *(const bf16x8*)(P.WR_T + (size_t)(16 * tt + fr) * D + 32 * ks + 8 * fq);
            lg[tt] = __builtin_amdgcn_mfma_f32_16x16x32_bf16(aw, bt, lg[tt], 0, 0, 0); }
    }
    float tot = 0.f;
#pragma unroll
    for (int p = 0; p < 16; ++p) tot += P.SSQ[(size_t)p * T + tok];
    const float rs = 1.0f / sqrtf(tot * (1.0f / D) + NORM_EPS);
    float val[8];
#pragma unroll
    for (int tt = 0; tt < 2; ++tt)
#pragma unroll
        for (int r = 0; r < 4; ++r) { const int e = 16 * tt + 4 * fq + r; val[4 * tt + r] = (e < NEXP) ? (lg[tt][r] * rs + P.router_b[e < NEXP ? e : 0]) : -3.0e38f; }
    float tv[4]; int ti[4];
#pragma unroll
    for (int k = 0; k < 4; ++k) {
        float bv = -3.4e38f; int bi = 1 << 20;
#pragma unroll
        for (int q = 0; q < 8; ++q) { const int e = 16 * (q >> 2) + 4 * fq + (q & 3); if (val[q] > bv || (val[q] == bv && e < bi)) { bv = val[q]; bi = e; } }
#pragma unroll
        for (int o = 16; o <= 32; o <<= 1) { const float ov = SHFLX_F(bv, o, lane); const int oi = SHFLX_I(bi, o, lane); if (ov > bv || (ov == bv && oi < bi)) { bv = ov; bi = oi; } }
        tv[k] = bv; ti[k] = bi;
#pragma unroll
        for (int q = 0; q < 8; ++q) { const int e = 16 * (q >> 2) + 4 * fq + (q & 3); if (e == bi) val[q] = -3.4e38f; }
    }
    float ex[4], den = 0.f;
#pragma unroll
    for (int k = 0; k < 4; ++k) { ex[k] = expf(tv[k] - tv[0]); den += ex[k]; }
    unsigned lp[4] = {0u, 0u, 0u, 0u};
    if (act && fq == 0) {
#pragma unroll
        for (int k = 0; k < 4; ++k) lp[k] = __hip_atomic_fetch_add(&hist[ti[k]], 1u, __ATOMIC_RELAXED, __HIP_MEMORY_SCOPE_WORKGROUP);
    }
    __syncthreads();
    if (tid < 32) P.ctl[CW_HIST + bx * 32 + tid] = hist[tid];
    xcd_barrier(bar, P.wv);
    {
        const int e = tid & 31, pt = tid >> 5; unsigned sum = 0u;
#pragma unroll
        for (int i = 0; i < 16; ++i) { const int w = pt * 16 + i; const unsigned c = P.ctl[CW_HIST + (w < G ? w : 0) * 32 + e]; sum += (w < bx) ? c : 0u; }
        part[pt * 32 + e] = sum;
    }
    __syncthreads();
    if (tid < 32) { unsigned sum = 0u;
#pragma unroll
        for (int i = 0; i < 16; ++i) sum += part[i * 32 + tid];
        base[tid] = sum;
        if (bx == G - 1 && tid < NEXP) P.ctl[CW_CNT + 64 * tid] = sum + hist[tid]; }
    __syncthreads();
    if (act && fq == 0) {
#pragma unroll
        for (int k = 0; k < 4; ++k) { const size_t o = (size_t)ti[k] * T + base[ti[k]] + lp[k]; P.LIST[o] = (unsigned)tok * 4u + (unsigned)k; P.GW[o] = ex[k] / den; P.RS2S[o] = rs; }
    }
    __syncthreads();
}

__device__ __forceinline__ void p9_final(const Ptrs& P, int G, int bx) {
    PHASE_IDS();
    const unsigned char* Y8 = (const unsigned char*)P.YB23;
    u32x4 q[2], nq[2], nnq[2]; u32x2 e[8], ne[8], nne[8];
    int m = gw;
#define P9_LOAD(dq, de, row) do { _Pragma("unroll") for (int j = 0; j < 2; ++j) { const int col = (j * 64 + lane) * 8; \
        dq[j] = *(const u32x4*)(P.YB01 + (size_t)(row) * 2048 + col); \
        _Pragma("unroll") for (int k = 0; k < 4; ++k) de[4 * j + k] = *(const u32x2*)(Y8 + (size_t)(row) * 4096 + k * 1024 + col); } } while (0)
    if (m < T) P9_LOAD(q, e, m);
    if (m + NGW < T) P9_LOAD(nq, ne, m + NGW);
    f32x4 g0[2], g1[2];
#pragma unroll
    for (int j = 0; j < 2; ++j) { const int col = (j * 64 + lane) * 8; g0[j] = *(const f32x4*)(P.final_g + col); g1[j] = *(const f32x4*)(P.final_g + col + 4); }
    for (; m < T; m += NGW) {
        const int mn = m + 2 * NGW;
        if (mn < T) P9_LOAD(nnq, nne, mn);
        float v[2][8]; float s = 0.f;
#pragma unroll
        for (int j = 0; j < 2; ++j) {
            f32x2 t[4] = {{0.f, 0.f}, {0.f, 0.f}, {0.f, 0.f}, {0.f, 0.f}};
#pragma unroll
            for (int k = 0; k < 4; ++k) { const u32x2 w = e[4 * j + k]; t[0] += unpk2_fp8(w.x, false); t[1] += unpk2_fp8(w.x, true); t[2] += unpk2_fp8(w.y, false); t[3] += unpk2_fp8(w.y, true); }
            const u32x4 a = q[j];
            v[j][0] = bflo(a.x) + t[0].x * (1.0f / Y8_SCALE); v[j][1] = bfhi(a.x) + t[0].y * (1.0f / Y8_SCALE); v[j][2] = bflo(a.y) + t[1].x * (1.0f / Y8_SCALE); v[j][3] = bfhi(a.y) + t[1].y * (1.0f / Y8_SCALE);
            v[j][4] = bflo(a.z) + t[2].x * (1.0f / Y8_SCALE); v[j][5] = bfhi(a.z) + t[2].y * (1.0f / Y8_SCALE); v[j][6] = bflo(a.w) + t[3].x * (1.0f / Y8_SCALE); v[j][7] = bfhi(a.w) + t[3].y * (1.0f / Y8_SCALE);
#pragma unroll
            for (int k = 0; k < 8; ++k) s += v[j][k] * v[j][k];
        }
        s = wave_sum(s, lane);
        const float rs = 1.0f / sqrtf(s * (1.0f / D) + NORM_EPS);
#pragma unroll
        for (int j = 0; j < 2; ++j) {
            const int col = (j * 64 + lane) * 8;
            f32x4 o0, o1;
#pragma unroll
            for (int k = 0; k < 4; ++k) { o0[k] = v[j][k] * rs * g0[j][k]; o1[k] = v[j][4 + k] * rs * g1[j][k]; }
            *(f32x4*)(P.out + (size_t)m * D + col) = o0; *(f32x4*)(P.out + (size_t)m * D + col + 4) = o1;
        }
#pragma unroll
        for (int k = 0; k < 2; ++k) { q[k] = nq[k]; nq[k] = nnq[k]; }
#pragma unroll
        for (int k = 0; k < 8; ++k) { e[k] = ne[k]; ne[k] = nne[k]; }
    }
#undef P9_LOAD
}

#ifndef REPEAT_PHASE
#define REPEAT_PHASE -1
#define REPEAT_N 0
#endif
#define RUN_PHASE(k, call) do { call; xcd_barrier(bar, P.wv); \
    if (REPEAT_PHASE == (k) && REPEAT_N >= 1) { call; xcd_barrier(bar, P.wv); } \
    if (REPEAT_PHASE == (k) && REPEAT_N >= 2) { call; xcd_barrier(bar, P.wv); } \
    if (REPEAT_PHASE == (k) && REPEAT_N >= 3) { call; xcd_barrier(bar, P.wv); } } while (0)

struct Args { const void* in[25]; float* out; unsigned char* ws; };

__device__ __forceinline__ void p1_gemm(LAS unsigned char* lds, const Ptrs& P, int G, int bx) { ProbIn pr; pr.xb = P.XB; pr.wt = P.WIN_T; pr.rs1 = P.RS1; pr.pos = P.positions; pr.proj = P.PROJ; pr.G = G; pr.c = bx; pg8::gemm_phase(lds, pr, P.wv); }
__device__ __forceinline__ void p2_seq(LAS unsigned char* lds, const Ptrs& P, int G, int bx) {
    for (int u = bx; u < BATCH * NCH; u += G) lru_unit<false>(lds, u / NCH, u % NCH, P.PROJ, P.conv_w, P.conv_b, P.WAF, P.lru_ba, P.lru_bx, P.lru_lam, P.lru_ng, P.LAP, P.LAH, nullptr, nullptr, nullptr, moe_conv(P), u * 8 * MOE_K0, P.wv);
    ret_kv_phase(lds, P.PROJ, P.KVT, G, bx, P.wv);
}
__device__ __forceinline__ void p4_lru(LAS unsigned char* lds, const Ptrs& P, int G, int bx) {
    for (int u = bx; u < BATCH * NCH; u += G) lru_unit<true>(lds, u / NCH, u % NCH, P.PROJ, P.conv_w, P.conv_b, P.WAF, P.lru_ba, P.lru_bx, P.lru_lam, P.lru_ng, nullptr, nullptr, P.CARRY, P.YCAT, P.RSL, moe_conv(P), MOE_PASS0_ITEMS + u * 8 * MOE_K1, P.wv);
}
__device__ __forceinline__ void p4_ret(LAS unsigned char* lds, const Ptrs& P, int G, int bx) {
    ret_out_phase(lds, P.PROJ, P.PREVT, P.ret_ng, P.ret_nb, P.YCAT, G, bx, P.wv);
}
__device__ __forceinline__ void p4_seq(LAS unsigned char* lds, const Ptrs& P, int G, int bx) {
    for (int u = bx; u < BATCH * NCH; u += G) lru_unit<true>(lds, u / NCH, u % NCH, P.PROJ, P.conv_w, P.conv_b, P.WAF, P.lru_ba, P.lru_bx, P.lru_lam, P.lru_ng, nullptr, nullptr, P.CARRY, P.YCAT, P.RSL, moe_conv(P), MOE_PASS0_ITEMS + u * 8 * MOE_K1, P.wv);
    ret_out_phase(lds, P.PROJ, P.PREVT, P.ret_ng, P.ret_nb, P.YCAT, G, bx, P.wv);
}
__device__ __forceinline__ void p5_gemm(LAS unsigned char* lds, const Ptrs& P, int G, int bx) { ProbOut pr; pr.ycat = P.YCAT; pr.wt = P.WOUT_T; pr.xb = P.XB; pr.rsl = P.RSL; pr.yb01 = P.YB01; pr.x8 = P.X8; pr.ssq = P.SSQ; pr.G = G; pr.c = bx; pg8::gemm_phase(lds, pr, P.wv); }
__device__ __forceinline__ void p7_gemm(LAS unsigned char* lds, const Ptrs& P, int G, int bx, int probe_mode = 0) {
    const MoeTabs tabs = moe_build_tabs(lds, P.ctl, P.wv);
    ProbUp pr; pr.probe_mode = probe_mode; pr.tabs = tabs; pr.x8 = P.X8; pr.wgu = P.WGU8; pr.list = P.LIST; pr.rs2s = P.RS2S; pr.bg = P.moe_bg; pr.bu = P.moe_bu; pr.act = P.ACT; pr.G = G; pr.c = bx;
    pg8::gemm_phase(lds, pr, P.wv);
}
__device__ __forceinline__ void p8_gemm(LAS unsigned char* lds, const Ptrs& P, int G, int bx, int probe_mode = 0) {
    const MoeTabs tabs = moe_build_tabs(lds, P.ctl, P.wv);
    ProbDown pr; pr.probe_mode = probe_mode; pr.tabs = tabs; pr.act = P.ACT; pr.wd = P.WD8; pr.list = P.LIST; pr.gw = P.GW; pr.bd = P.moe_bd; pr.y8 = (unsigned char*)P.YB23; pr.G = G; pr.c = bx;
    pg8::gemm_phase(lds, pr, P.wv);
}

__global__ void __launch_bounds__(NTHREADS, 2) mega_fwd(Args args) {
#ifdef CPU_EMU
    unsigned char* lds_raw = emu::cur->blk->lds;
#else
    extern __shared__ __attribute__((aligned(16))) unsigned char lds_raw[];
#endif
    LAS unsigned char* lds = (LAS unsigned char*)lds_raw;
    volatile LAS unsigned* MISC = (volatile LAS unsigned*)(lds + MISC_OFF);
    const int G = gridDim.x, bx = blockIdx.x;
    unsigned char* ws = args.ws;
    Ptrs P;
    P.wv = __builtin_amdgcn_readfirstlane((int)(threadIdx.x >> 6));
    P.x = (const float*)args.in[0]; P.positions = (const int*)args.in[1]; P.attn_g = (const float*)args.in[2];
    P.w_in = (const float*)args.in[3]; P.conv_w = (const float*)args.in[4]; P.conv_b = (const float*)args.in[5];
    P.lru_wa = (const float*)args.in[6]; P.lru_ba = (const float*)args.in[7]; P.lru_wx = (const float*)args.in[8]; P.lru_bx = (const float*)args.in[9];
    P.lru_lam = (const float*)args.in[10]; P.lru_ng = (const float*)args.in[11]; P.ret_ng = (const float*)args.in[12]; P.ret_nb = (const float*)args.in[13];
    P.w_out = (const float*)args.in[14]; P.ffn_g = (const float*)args.in[15]; P.router_w = (const float*)args.in[16]; P.router_b = (const float*)args.in[17];
    P.moe_wg = (const float*)args.in[18]; P.moe_bg = (const float*)args.in[19]; P.moe_wu = (const float*)args.in[20]; P.moe_bu = (const float*)args.in[21];
    P.moe_wd = (const float*)args.in[22]; P.moe_bd = (const float*)args.in[23]; P.final_g = (const float*)args.in[24];
    P.ctl = (unsigned*)(ws + WS_CTL);
    P.RS1 = (float*)(ws + WS_RS1); P.RS2S = (float*)(ws + WS_RS2S); P.SSQ = (float*)(ws + WS_SSQ); P.GW = (float*)(ws + WS_GW);
    P.LIST = (unsigned*)(ws + WS_LIST); P.LAP = (float*)(ws + WS_LAP); P.LAH = (float*)(ws + WS_LAH); P.CARRY = (float*)(ws + WS_CARRY);
    P.WAF = (bf16_t*)(ws + WS_WAF); P.RSL = (float*)(ws + WS_RSL);
    P.WR_T = (bf16_t*)(ws + WS_WR); P.WIN_T = (bf16_t*)(ws + WS_WIN); P.WOUT_T = (bf16_t*)(ws + WS_WOUT); P.WGU8 = ws + WS_WGU; P.WD8 = ws + WS_WD; P.X8 = ws + WS_X8;
    P.PROJ = (bf16_t*)(ws + WS_PROJ); P.XB = (bf16_t*)(ws + WS_XB); P.YCAT = (bf16_t*)(ws + WS_YCAT); P.ACT = ws + WS_ACT; P.YB23 = (bf16_t*)(ws + WS_YB23);
    P.KVT = (bf16_t*)((unsigned char*)args.out + DO_KVT); P.PREVT = (bf16_t*)((unsigned char*)args.out + DO_PREVT); P.YB01 = (bf16_t*)args.out; P.out = args.out;

    for (int u = (int)threadIdx.x; u < (LDS_BYTES - RING_BYTES) / 4; u += NTHREADS) ((LAS unsigned*)(lds + RING_BYTES))[u] = 0u;
    __syncthreads();
    const XcdBarrier bar = xcd_barrier_post(P.ctl + CW_BAR, MISC + 8, P.wv);

    if (REPEAT_PHASE == 100) { xcd_barrier(bar, P.wv); xcd_barrier(bar, P.wv); xcd_barrier(bar, P.wv); xcd_barrier(bar, P.wv); xcd_barrier(bar, P.wv); xcd_barrier(bar, P.wv); xcd_barrier(bar, P.wv); xcd_barrier(bar, P.wv); }
    RUN_PHASE(0, p0_prologue(lds, P, G, bx));
    RUN_PHASE(1, p1_gemm(lds, P, G, bx));
    RUN_PHASE(2, p2_seq(lds, P, G, bx));
    RUN_PHASE(3, p3_scans(P, G, bx));
    RUN_PHASE(4, p4_seq(lds, P, G, bx));
    if (REPEAT_PHASE == 41) { p4_lru(lds, P, G, bx); xcd_barrier(bar, P.wv); p4_lru(lds, P, G, bx); xcd_barrier(bar, P.wv); }
    if (REPEAT_PHASE == 42) { p4_ret(lds, P, G, bx); xcd_barrier(bar, P.wv); p4_ret(lds, P, G, bx); xcd_barrier(bar, P.wv); }
    RUN_PHASE(5, p5_gemm(lds, P, G, bx));
    RUN_PHASE(6, p6_router(lds, P, G, bx, bar));
    if (REPEAT_PHASE == 71) { p7_gemm(lds, P, G, bx, 1); xcd_barrier(bar, P.wv); p7_gemm(lds, P, G, bx, 1); xcd_barrier(bar, P.wv); }
    if (REPEAT_PHASE == 72) { p7_gemm(lds, P, G, bx, 2); xcd_barrier(bar, P.wv); }
#if REPEAT_PHASE >= 300 && REPEAT_PHASE < 316
    {   const MoeTabs tabs = moe_build_tabs(lds, P.ctl, P.wv);
        ProbUpDiag<REPEAT_PHASE - 300> pr; pr.probe_mode = 1; pr.tabs = tabs; pr.x8 = P.X8; pr.wgu = P.WGU8; pr.list = P.LIST; pr.rs2s = P.RS2S; pr.bg = P.moe_bg; pr.bu = P.moe_bu; pr.act = P.ACT; pr.G = G; pr.c = bx;
        pg8::gemm_phase(lds, pr, P.wv); xcd_barrier(bar, P.wv); pg8::gemm_phase(lds, pr, P.wv); xcd_barrier(bar, P.wv); }
#endif
#if REPEAT_PHASE == 200 || REPEAT_PHASE == 201
    {
        const unsigned long long t0 = __builtin_amdgcn_s_memtime(), r0 = __builtin_amdgcn_s_memrealtime();
        if (REPEAT_PHASE == 200) p7_gemm(lds, P, G, bx, 1); else p1_gemm(lds, P, G, bx);
        const unsigned long long t1 = __builtin_amdgcn_s_memtime(), r1 = __builtin_amdgcn_s_memrealtime();
        if (bx == 0) { const unsigned long long mhz = (t1 - t0) * 100ull / (r1 - r0); while (__builtin_amdgcn_s_memrealtime() - r1 < mhz * 10ull) __builtin_amdgcn_s_sleep(8); }
        xcd_barrier(bar, P.wv);
    }
#endif
    RUN_PHASE(7, p7_gemm(lds, P, G, bx));
    if (REPEAT_PHASE == 81) { p8_gemm(lds, P, G, bx, 1); xcd_barrier(bar, P.wv); p8_gemm(lds, P, G, bx, 1); xcd_barrier(bar, P.wv); }
    RUN_PHASE(8, p8_gemm(lds, P, G, bx));
    if (REPEAT_PHASE == 9) { Ptrs Q = P; Q.out = (float*)P.ACT; p9_final(Q, G, bx); xcd_barrier(bar, P.wv); }
    p9_final(P, G, bx);
}

extern "C" void kernel_launch(void* const* d_in, const int* in_sizes, int n_in, void* d_out, int out_size, void* d_ws, size_t ws_size, hipStream_t stream) {
    static int grid = 0;
    if (grid == 0) {
        if (n_in != 25 || out_size != T * D || ws_size < WS_END) { fprintf(stderr, "kernel_launch: unexpected shapes (n_in %d, out %d, ws %zu, need %zu)\n", n_in, out_size, ws_size, (size_t)WS_END); grid = -1; return; }
        int dev = 0, cus = 0;
        if (hipGetDevice(&dev) != hipSuccess || hipDeviceGetAttribute(&cus, hipDeviceAttributeMultiprocessorCount, dev) != hipSuccess) { fprintf(stderr, "kernel_launch: device query failed\n"); grid = -1; return; }
        if (hipFuncSetAttribute((const void*)mega_fwd, hipFuncAttributeMaxDynamicSharedMemorySize, LDS_BYTES) != hipSuccess) { fprintf(stderr, "kernel_launch: hipFuncSetAttribute failed\n"); grid = -1; return; }
        (void)hipGetLastError();
        if (cus < T / 128 || cus > 256) { fprintf(stderr, "kernel_launch: the router phase needs T/128 <= CUs <= 256 (have %d)\n", cus); grid = -1; return; }
        grid = cus;
    }
    if (grid < 0) return;
    (void)in_sizes;
    (void)hipMemsetAsync((char*)d_ws + WS_CTL, 0, CTL_ZERO_BYTES, stream);
    Args a{};
    for (int i = 0; i < 25; ++i) a.in[i] = d_in[i];
    a.out = (float*)d_out; a.ws = (unsigned char*)d_ws;
    hipLaunchKernelGGL(mega_fwd, dim3(grid), dim3(NTHREADS), LDS_BYTES, stream, a);
}
```

```cpp
#ifndef CPU_EMU
#include <hip/hip_runtime.h>
#include <cstdio>
#define LAS __attribute__((address_space(3)))
#define GAS __attribute__((address_space(1)))
#define ASM_VMCNT(n) asm volatile("s_waitcnt vmcnt(" #n ")" ::: "memory")
#define ASM_LGKMCNT(n) asm volatile("s_waitcnt lgkmcnt(" #n ")" ::: "memory")
#define WAVE_SYNC() do { asm volatile("s_waitcnt lgkmcnt(0)" ::: "memory"); __builtin_amdgcn_wave_barrier(); } while (0)
#define OPAQUE(x) asm volatile("" : "+v"(x))
__device__ __forceinline__ int lane_id_fresh() { int l; asm volatile("v_mbcnt_lo_u32_b32 %0, -1, 0\n\tv_mbcnt_hi_u32_b32 %0, -1, %0" : "=v"(l)); return l; }
#define LANE_ID() lane_id_fresh()
#define SHFLX_F(v, mask, lane) __builtin_bit_cast(float, __builtin_amdgcn_ds_bpermute((((lane) ^ (mask)) << 2), __builtin_bit_cast(int, (float)(v))))
#define SHFLX_I(v, mask, lane) __builtin_amdgcn_ds_bpermute((((lane) ^ (mask)) << 2), (int)(v))
#else
#define ASM_VMCNT(n) ((void)0)
#define ASM_LGKMCNT(n) ((void)0)
#define WAVE_SYNC() emu::wave_collective(nullptr, 0, nullptr, 0, [](emu::Wave&) {})
#define OPAQUE(x) ((void)0)
#define LANE_ID() ((int)emu::cur->lane)
#define SHFLX_F(v, mask, lane) __shfl_xor((float)(v), (mask))
#define SHFLX_I(v, mask, lane) __shfl_xor((int)(v), (mask))
#endif

typedef unsigned short bf16_t;
typedef float f32x4 __attribute__((ext_vector_type(4)));
typedef float f32x2 __attribute__((ext_vector_type(2)));
typedef unsigned u32x4 __attribute__((ext_vector_type(4)));
typedef unsigned u32x2 __attribute__((ext_vector_type(2)));
typedef short bf16x8 __attribute__((ext_vector_type(8)));
typedef short v4i16_t __attribute__((ext_vector_type(4)));
typedef int v8i32_t __attribute__((ext_vector_type(8)));

#ifdef CPU_EMU
constexpr int BATCH = CFG_BATCH, SEQ = CFG_SEQ, NEXP = CFG_NEXP;
#else
constexpr int BATCH = 4, SEQ = 8192, NEXP = 32;
#endif
constexpr int NWAVES = 8, NTHREADS = 512;
constexpr int T = BATCH * SEQ, D = 1024, DIN = 3072, NCH = SEQ / 128, NBH = BATCH * 4;
constexpr int TOPK = 4, NSLOT = T * TOPK;
constexpr float NORM_EPS = 1e-5f;
constexpr int MAXTILES = NSLOT / 256 + NEXP;

constexpr size_t MiB = 1u << 20;
constexpr size_t al256(size_t x) { return (x + 255) & ~(size_t)255; }
constexpr size_t WS_CTL = 0, CTL_ZERO_BYTES = 1 * MiB;
constexpr int CW_BAR = 4096, CW_CNT = 16384;
constexpr size_t WS_RS1 = 1 * MiB;
constexpr size_t WS_RS2 = WS_RS1 + al256((size_t)T * 4);
constexpr size_t WS_SSQ = WS_RS2 + al256((size_t)T * 4);
constexpr size_t WS_GW = WS_SSQ + al256((size_t)16 * T * 4);
constexpr size_t WS_LIST = WS_GW + al256((size_t)NEXP * T * 4);
constexpr size_t WS_RS2S = WS_LIST + al256((size_t)NEXP * T * 4);
constexpr size_t WS_LAP = WS_RS2S + al256((size_t)NEXP * T * 4);
constexpr size_t WS_LAH = WS_LAP + al256((size_t)BATCH * NCH * 512 * 4);
constexpr size_t WS_CARRY = WS_LAH + al256((size_t)BATCH * NCH * 512 * 4);
constexpr size_t WS_WR = WS_CARRY + al256((size_t)BATCH * NCH * 512 * 4);
constexpr size_t WS_WAF = WS_WR + al256((size_t)32 * D * 2);
constexpr size_t WS_RSL = WS_WAF + 2 * 65536;
constexpr size_t WS_WIN = (WS_RSL + al256((size_t)T * 4) + MiB - 1) / MiB * MiB;
constexpr size_t WS_WOUT = WS_WIN + (size_t)DIN * D * 2;
constexpr size_t WS_WGU = WS_WOUT + (size_t)D * D * 2;
constexpr size_t WS_WD = WS_WGU + (size_t)NEXP * 2048 * D;
constexpr size_t WS_X8 = WS_WD + (size_t)NEXP * D * D;
constexpr size_t WS_R1 = WS_X8 + (size_t)T * D;
constexpr size_t WS_PROJ = WS_R1;
constexpr size_t WS_XB = WS_R1 + (size_t)T * DIN * 2;
constexpr size_t WS_ACT = WS_R1;
constexpr size_t WS_YB23 = WS_ACT + (size_t)(NSLOT + 256) * D;
constexpr size_t WS_YCAT = WS_YB23 + (size_t)T * 2 * D * 2;
constexpr size_t WS_END = WS_YCAT + (size_t)T * D * 2;
static_assert(WS_XB + (size_t)T * D * 2 <= WS_END, "map");
constexpr size_t DO_KVT = 0, DO_PREVT = (size_t)T * 1024;
static_assert(2 * (size_t)T * 1024 <= (size_t)T * D * 4, "d_out scratch");

constexpr int RING_BYTES = 131072, MISC_OFF = RING_BYTES + 320, TAB_OFF = RING_BYTES + 1024, LDS_BYTES = 147456;
constexpr int TAB_CNT = TAB_OFF, TAB_EOFF = TAB_CNT + 4 * 64, TAB_TBASE = TAB_EOFF + 4 * 64, TAB_TILEE = TAB_TBASE + 4 * 80;
constexpr int META_OFF = RING_BYTES + 8192;
static_assert(NEXP <= 64 && TAB_TILEE + 2 * MAXTILES + 16 <= META_OFF && META_OFF + 8192 <= LDS_BYTES, "LDS tables");

__device__ __forceinline__ unsigned f2bf(float f) { unsigned u = __builtin_bit_cast(unsigned, f); return (u + 0x7fffu + ((u >> 16) & 1u)) >> 16; }
__device__ __forceinline__ unsigned pk2(float lo, float hi) {
#ifdef CPU_EMU
    return f2bf(lo) | (f2bf(hi) << 16);
#else
    unsigned r; asm volatile("v_cvt_pk_bf16_f32 %0, %1, %2" : "=v"(r) : "v"(lo), "v"(hi)); return r;
#endif
}
__device__ __forceinline__ unsigned pk2v(float lo, float hi) {
#ifdef CPU_EMU
    return f2bf(lo) | (f2bf(hi) << 16);
#else
    unsigned r; asm volatile("s_nop 7\n\ts_nop 7\n\tv_cvt_pk_bf16_f32 %0, %1, %2" : "=v"(r) : "v"(lo), "v"(hi)); return r;
#endif
}
__device__ __forceinline__ u32x4 pair16(u32x2 a, u32x2 b) {
    const auto rx = __builtin_amdgcn_permlane16_swap(a.x, b.x, false, false); const auto ry = __builtin_amdgcn_permlane16_swap(a.y, b.y, false, false);
    u32x4 o; o.x = rx[0]; o.y = ry[0]; o.z = rx[1]; o.w = ry[1]; return o;
}
#define unpk2_fp8(w, hi) __builtin_amdgcn_cvt_pk_f32_fp8((int)(w), hi)
__device__ __forceinline__ unsigned pk4_fp8(float a, float b, float c, float d) {
    int r = __builtin_amdgcn_cvt_pk_fp8_f32(a, b, 0, false); r = __builtin_amdgcn_cvt_pk_fp8_f32(c, d, r, true); return (unsigned)r;
}
__device__ __forceinline__ float bf2f(unsigned h) { return __builtin_bit_cast(float, h << 16); }
__device__ __forceinline__ float bflo(unsigned w) { return __builtin_bit_cast(float, w << 16); }
__device__ __forceinline__ float bfhi(unsigned w) { return __builtin_bit_cast(float, w & 0xffff0000u); }
__device__ __forceinline__ float fexp2(float x) { return __builtin_amdgcn_exp2f(x); }
__device__ __forceinline__ float frcp(float x) { return __builtin_amdgcn_rcpf(x); }
__device__ __forceinline__ float sigmoid_f(float x) { return frcp(1.0f + fexp2(-1.4426950408889634f * x)); }
__device__ __forceinline__ float gelu_tanh(float x) { const float u = 0.7978845608028654f * (x + 0.044715f * x * x * x); return x * frcp(1.0f + fexp2(-2.8853900817779268f * u)); }
__device__ __forceinline__ float silu_f(float x) { return x * sigmoid_f(x); }
__device__ __forceinline__ float wave_sum(float v, int lane) {
#pragma unroll
    for (int o = 1; o < 64; o <<= 1) v += SHFLX_F(v, o, lane);
    return v;
}

#define XB_TMO      128
#define XB_XCNT(j)  (256  + 64 * (j))
#define XB_XSUB(j)  (1280 + 64 * (j))
#define XB_XGEN(j)  (2304 + 64 * (j))
#define XB_TOP      3328
#define XB_TOPGEN   3392
#define XCD_BAR_WORDS 3456
#define XB_SPIN_CAP (1u << 20)
__device__ __forceinline__ unsigned xb_ld(unsigned* p)              { return __hip_atomic_load(p, __ATOMIC_RELAXED, __HIP_MEMORY_SCOPE_AGENT); }
__device__ __forceinline__ unsigned xb_add(unsigned* p, unsigned v) { return __hip_atomic_fetch_add(p, v, __ATOMIC_RELAXED, __HIP_MEMORY_SCOPE_AGENT); }
__device__ __forceinline__ unsigned xb_xcc_id() { return (unsigned)__builtin_amdgcn_s_getreg((3 << 11) | 20) & 0xFu; }
#define XB_SPIN(cond, bar) do { unsigned _sp = 0; while (cond) { __builtin_amdgcn_s_sleep(1); \
    if ((++_sp & 255u) == 0u) { if (xb_ld(&(bar)[XB_TMO])) break; if (_sp > XB_SPIN_CAP) { atomicAdd(&(bar)[XB_TMO], 1u); break; } } } } while (0)
struct XcdBarrier { unsigned* bar; unsigned x; volatile LAS unsigned* st; };
__device__ __forceinline__ XcdBarrier xcd_barrier_post(unsigned* bar, volatile LAS unsigned* st, int wv) {
    XcdBarrier b; b.bar = bar; b.x = xb_xcc_id(); b.st = st;
    if (wv == 0 && LANE_ID() == 0) (void)xb_add(&bar[XB_XCNT(b.x)], 1u);
    return b;
}
__device__ __forceinline__ void xcd_barrier_complete(unsigned* bar, unsigned x, unsigned& nloc, unsigned& nx) {
    const unsigned G = gridDim.x;
    unsigned sum, cnt, mine, sp = 0u;
    for (;;) {
        sum = 0u; cnt = 0u; mine = 0u;
#pragma unroll
        for (unsigned j = 0; j < 16; ++j) { const unsigned c = xb_ld(&bar[XB_XCNT(j)]); sum += c; cnt += (c > 0u) ? 1u : 0u; mine = (j == x) ? c : mine; }
        if (sum == G) break;
        __builtin_amdgcn_s_sleep(1);
        if ((++sp & 255u) == 0u) { if (xb_ld(&bar[XB_TMO])) break; if (sp > XB_SPIN_CAP) { atomicAdd(&bar[XB_TMO], 1u); break; } }
    }
    nloc = mine > 0u ? mine : 1u; nx = cnt > 0u ? cnt : 1u;
}
__device__ __forceinline__ void xcd_barrier(const XcdBarrier& b, int wv) {
    ASM_VMCNT(0);
    __syncthreads();
    if (wv == 0 && LANE_ID() == 0) {
        unsigned* bar = b.bar;
        __builtin_amdgcn_s_waitcnt(0);
        unsigned nloc = b.st[0], nx = b.st[1];
        if (nloc == 0u) { xcd_barrier_complete(bar, b.x, nloc, nx); b.st[0] = nloc; b.st[1] = nx; }
        const unsigned old = xb_add(&bar[XB_XSUB(b.x)], 1u);
        const unsigned gen = old / nloc;
        if (old + 1u == (gen + 1u) * nloc) {
            __builtin_amdgcn_fence(__ATOMIC_RELEASE, "agent");
            ASM_VMCNT(0);
            const unsigned og = xb_add(&bar[XB_TOP], 1u);
            const unsigned tg = og / nx;
            if (og + 1u == (tg + 1u) * nx) xb_add(&bar[XB_TOPGEN], 1u);
            else XB_SPIN(xb_ld(&bar[XB_TOPGEN]) == tg, bar);
            __builtin_amdgcn_fence(__ATOMIC_ACQUIRE, "agent");
            xb_add(&bar[XB_XGEN(b.x)], 1u);
            ASM_VMCNT(0);
        } else {
            XB_SPIN(xb_ld(&bar[XB_XGEN(b.x)]) == gen, bar);
            __builtin_amdgcn_fence(__ATOMIC_ACQUIRE, "agent");
            ASM_VMCNT(0);
        }
    }
    __syncthreads();
}

namespace pg8 {
constexpr int BM = 256, BK = 64, HALF = 128, HTB = HALF * BK * 2, STAGE_BYTES = 8 * HTB, NXCD = 8, WGM = 8;
__device__ __forceinline__ int lds_byte(int r, int c) { const int st = (r >> 4) * 2 + (c >> 5), rr = r & 15, cc = c & 31, ob = rr * 64 + cc * 2; return st * 1024 + (ob ^ (((ob >> 9) & 1) << 5)); }
__device__ __forceinline__ void stage_rc(int b, int& R, int& C) { const int st = b / 1024, sb = b % 1024, swz = sb ^ (((sb >> 9) & 1) << 5); R = (st >> 1) * 16 + swz / 64; C = (st & 1) * 32 + (swz % 64) / 2; }
__device__ __forceinline__ int lds_byte8(int r, int fq) { const int st = (r >> 4) * 2 + (fq >> 1), rr = r & 15, ob = rr * 64 + 32 * (fq & 1); return st * 1024 + (ob ^ (((ob >> 9) & 1) << 5)); }
__device__ __forceinline__ int perm32(int rho) { const int n = rho >> 4, i = rho & 15; return 8 * (i >> 2) + 4 * n + (i & 3); }
struct Unit { int pm, pn, e, pos0, nvalid, eoff; };
__device__ __forceinline__ f32x4 mma_fp8(u32x4 a0, u32x4 a1, u32x4 b0, u32x4 b1, f32x4 c) {
    typedef int i32x4 __attribute__((ext_vector_type(4)));
    const v8i32_t a = __builtin_shufflevector(__builtin_bit_cast(i32x4, a0), __builtin_bit_cast(i32x4, a1), 0, 1, 2, 3, 4, 5, 6, 7);
    const v8i32_t b = __builtin_shufflevector(__builtin_bit_cast(i32x4, b0), __builtin_bit_cast(i32x4, b1), 0, 1, 2, 3, 4, 5, 6, 7);
#ifdef CPU_EMU
    return __builtin_amdgcn_mfma_scale_f32_16x16x128_f8f6f4(a, b, c, 0, 0, 0, 0x7F7F7F7F, 0, 0x7F7F7F7F);
#else
    const int one = 0x7F7F7F7F;
    asm volatile("v_mfma_scale_f32_16x16x128_f8f6f4 %0, %1, %2, %0, %3, %3 op_sel_hi:[0,0,0]" : "+v"(c) : "v"(a), "v"(b), "v"(one));
    return c;
#endif
}
__device__ __forceinline__ bool static_order(int i, int G, int c, int nM, int nN, int& pm, int& pn) {
    const int nwg = nM * nN; const long L = (long)i * G + c; if (L >= nwg) return false;
    int wgid = (int)L; { const int q = nwg / NXCD, r = nwg % NXCD, xcd = wgid % NXCD, off = wgid / NXCD; wgid = (xcd < r ? xcd * (q + 1) : r * (q + 1) + (xcd - r) * q) + off; }
    const int nig = WGM * nN, gid = wgid / nig, fm = gid * WGM, gsz = (nM - fm) < WGM ? (nM - fm) : WGM;
    pm = fm + ((wgid % nig) % gsz); pn = (wgid % nig) / gsz; return true;
}

template <class P>
__device__ __forceinline__ void gemm_phase(LAS unsigned char* lds, const P& prob, int wv) {
    int tid_ = wv * 64 + LANE_ID(); OPAQUE(tid_);
    const int tid = tid_, wid = __builtin_amdgcn_readfirstlane(tid >> 6), lane = tid & 63, wr = wid >> 2, wc = wid & 3, fr = lane & 15, fq = lane >> 4;
    constexpr int ROWB = P::FP8 ? 1024 : 2048, NT = ROWB / 128, CH = 1024;
    unsigned voffA[2][2], nvoffA[2][2], voffB[2];
#pragma unroll
    for (int i = 0; i < 2; ++i) { int R, C; stage_rc(tid * 16 + i * 8192, R, C); const int Rb = (R & ~31) + perm32(R & 31);
        voffA[0][i] = (unsigned)(R * ROWB + C * 2); voffA[1][i] = voffA[0][i] + (unsigned)(HALF * ROWB); voffB[i] = (unsigned)(Rb * ROWB + C * 2);
        nvoffA[0][i] = voffA[0][i]; nvoffA[1][i] = voffA[1][i]; }
    const size_t kstep = (size_t)(BK * 2);
    const size_t hstep = (size_t)HALF * ROWB;
    const unsigned ldsw = (unsigned)wid * 1024u;
    const int aoff = lds_byte(wr * 64 + fr, fq * 8), boff = lds_byte(wc * 32 + fr, fq * 8);
#define PG8_SA(b, h) (((b) * 2 + (h)) * HTB)
#define PG8_SB(b, h) ((4 + (b) * 2 + (h)) * HTB)
#define PG8_STAGE(bufoff, gbase, voff) do { if constexpr (!(P::DIAG & 2)) _Pragma("unroll") for (int _i = 0; _i < 2; ++_i) \
        __builtin_amdgcn_global_load_lds((const unsigned*)((const char*)(gbase) + (voff)[_i]), (LAS unsigned*)(lds + (bufoff) + ldsw + _i * 8192), 16, 0, 0); } while (0)
#define PG8_LDA(dst, b, h) do { if constexpr (!(P::DIAG & 1)) _Pragma("unroll") for (int m = 0; m < 4; ++m) _Pragma("unroll") for (int k = 0; k < 2; ++k) dst[m][k] = *(const LAS u32x4*)(lds + PG8_SA(b, h) + aoff + m * 2048 + k * CH); } while (0)
#define PG8_LDB(dst, b, h) do { if constexpr (!(P::DIAG & 1)) _Pragma("unroll") for (int n = 0; n < 2; ++n) _Pragma("unroll") for (int k = 0; k < 2; ++k) dst[n][k] = *(const LAS u32x4*)(lds + PG8_SB(b, h) + boff + n * 2048 + k * CH); } while (0)
#define PG8_MMA(ai, bj, At, Bt) do { if constexpr (!(P::DIAG & 8)) { __builtin_amdgcn_s_setprio(1); _Pragma("unroll") for (int m = 0; m < 4; ++m) _Pragma("unroll") for (int n = 0; n < 2; ++n) { \
        if constexpr (P::FP8) acc[ai][bj][m][n] = mma_fp8(Bt[n][0], Bt[n][1], At[m][0], At[m][1], acc[ai][bj][m][n]); \
        else { _Pragma("unroll") for (int k = 0; k < 2; ++k) acc[ai][bj][m][n] = __builtin_amdgcn_mfma_f32_16x16x32_bf16(__builtin_bit_cast(bf16x8, Bt[n][k]), __builtin_bit_cast(bf16x8, At[m][k]), acc[ai][bj][m][n], 0, 0, 0); } } \
        __builtin_amdgcn_s_setprio(0); } } while (0)
#define PG8_BAR do { if constexpr (!(P::DIAG & 4)) __builtin_amdgcn_s_barrier(); } while (0)
#define PG8_SCHED __builtin_amdgcn_sched_barrier(0)
    Unit cur, nxt; int ui = 0;
    if (!prob.next(0, cur)) return;
    f32x4 acc[2][2][4][2];
#pragma unroll
    for (int a = 0; a < 2; ++a)
#pragma unroll
        for (int b = 0; b < 2; ++b)
#pragma unroll
            for (int m = 0; m < 4; ++m)
#pragma unroll
                for (int n = 0; n < 2; ++n) acc[a][b][m][n] = (f32x4){0.f, 0.f, 0.f, 0.f};
    u32x4 At[4][2] = {}, B0[2][2] = {}, B1[2][2] = {};
    const char* cA = prob.a_base(cur); const char* cB = prob.b_base(cur);
    if constexpr (P::GATHER) prob.a_offsets(cur, tid, voffA);
#define PG8_META(u, par) do { _Pragma("unroll") for (int _j = 0; _j < 2; ++_j) { const int _a = (wid >> 2) + 2 * _j; if (_a < P::NMETA) \
        __builtin_amdgcn_global_load_lds(prob.meta_ptr(u, _a, (wid & 3) * 64 + lane), (LAS unsigned*)(lds + META_OFF + (par) * 4096 + _a * 1024 + (wid & 3) * 256), 4, 0, 0); } } while (0)
    if constexpr (P::NMETA > 0) PG8_META(cur, 0);
    PG8_STAGE(PG8_SB(0, 0), cB, voffB); PG8_STAGE(PG8_SA(0, 0), cA, voffA[0]); PG8_STAGE(PG8_SB(0, 1), cB + hstep, voffB); PG8_STAGE(PG8_SA(0, 1), cA, voffA[1]);
    if (wr == 1) PG8_BAR;
    ASM_VMCNT(4); PG8_BAR;
    PG8_STAGE(PG8_SB(1, 0), cB + kstep, voffB); PG8_STAGE(PG8_SA(1, 0), cA + kstep, voffA[0]); PG8_STAGE(PG8_SB(1, 1), cB + hstep + kstep, voffB);
    ASM_VMCNT(6); PG8_BAR;
    for (;;) {
        const bool has_next = prob.next(ui + 1, nxt);
        const char* nA = has_next ? prob.a_base(nxt) : cA; const char* nB = has_next ? prob.b_base(nxt) : cB;
        for (int t = 0; t < NT; t += 2) {
            const bool last = (t == NT - 2);
            const char* a1 = cA + (size_t)(t + 1) * kstep;
            const char* a2 = last ? nA : cA + (size_t)(t + 2) * kstep; const char* b2 = last ? nB : cB + (size_t)(t + 2) * kstep;
            const char* a3 = a2 + kstep; const char* b3 = b2 + kstep;
            if constexpr (P::GATHER) { if (last && has_next) prob.a_offsets_lds(nxt, tid, nvoffA, lds + META_OFF + ((ui + 1) & 1) * 4096); }
            unsigned va0[2], va1[2];
#pragma unroll
            for (int i = 0; i < 2; ++i) { va0[i] = (P::GATHER && last) ? nvoffA[0][i] : voffA[0][i]; va1[i] = (P::GATHER && last) ? nvoffA[1][i] : voffA[1][i]; }
            if constexpr (P::MIDK) { if (t == NT / 2) prob.midk(acc, cur, wr, fr, lds + META_OFF + (ui & 1) * 4096); }
            PG8_LDB(B0, 0, 0); PG8_SCHED; PG8_LDA(At, 0, 0); PG8_STAGE(PG8_SA(1, 1), a1, voffA[1]);
            ASM_LGKMCNT(8); ASM_VMCNT(10); PG8_BAR; ASM_LGKMCNT(0); PG8_MMA(0, 0, At, B0); PG8_BAR; PG8_SCHED;
            PG8_LDB(B1, 0, 1); PG8_STAGE(PG8_SB(0, 0), b2, voffB);
            ASM_VMCNT(10); PG8_BAR; ASM_LGKMCNT(0); PG8_MMA(0, 1, At, B1); PG8_BAR;
            PG8_LDA(At, 0, 1); PG8_STAGE(PG8_SA(0, 0), a2, va0);
            PG8_BAR; ASM_LGKMCNT(0); PG8_MMA(1, 0, At, B0); PG8_BAR; PG8_SCHED;
            PG8_STAGE(PG8_SB(0, 1), b2 + hstep, voffB);
            ASM_VMCNT(10); PG8_BAR; PG8_MMA(1, 1, At, B1); PG8_BAR;
            if constexpr (P::NMETA > 0) { if (t == 2 && has_next) PG8_META(nxt, (ui + 1) & 1); }
            PG8_LDB(B0, 1, 0); PG8_SCHED; PG8_LDA(At, 1, 0); PG8_STAGE(PG8_SA(0, 1), a2, va1);
            ASM_LGKMCNT(8); ASM_VMCNT(10); PG8_BAR; ASM_LGKMCNT(0); PG8_MMA(0, 0, At, B0); PG8_BAR; PG8_SCHED;
            PG8_LDB(B1, 1, 1); PG8_STAGE(PG8_SB(1, 0), b3, voffB);
            ASM_VMCNT(10); PG8_BAR; ASM_LGKMCNT(0); PG8_MMA(0, 1, At, B1); PG8_BAR;
            PG8_LDA(At, 1, 1); PG8_STAGE(PG8_SA(1, 0), a3, va0);
            PG8_BAR; ASM_LGKMCNT(0); PG8_MMA(1, 0, At, B0); PG8_BAR; PG8_SCHED;
            PG8_STAGE(PG8_SB(1, 1), b3 + hstep, voffB);
            ASM_VMCNT(10); PG8_BAR; PG8_MMA(1, 1, At, B1); PG8_BAR;
        }
        if (wr == 0) PG8_BAR;
        prob.epi(acc, cur, wr, wc, fr, fq, lds + META_OFF + (ui & 1) * 4096);
        if (!has_next) break;
#pragma unroll
        for (int a = 0; a < 2; ++a)
#pragma unroll
            for (int b = 0; b < 2; ++b)
#pragma unroll
                for (int m = 0; m < 4; ++m)
#pragma unroll
                    for (int n = 0; n < 2; ++n) acc[a][b][m][n] = (f32x4){0.f, 0.f, 0.f, 0.f};
        cur = nxt; cA = nA; cB = nB; ++ui;
        if constexpr (P::GATHER) {
#pragma unroll
            for (int h = 0; h < 2; ++h)
#pragma unroll
                for (int i = 0; i < 2; ++i) voffA[h][i] = nvoffA[h][i];
        }
        if (wr == 1) PG8_BAR;
    }
    ASM_VMCNT(0);
    PG8_BAR;
#undef PG8_META
#undef PG8_SA
#undef PG8_SB
#undef PG8_STAGE
#undef PG8_LDA
#undef PG8_LDB
#undef PG8_MMA
#undef PG8_BAR
#undef PG8_SCHED
}
}
using pg8::Unit;

constexpr float Y8_SCALE = 16.0f;
constexpr float LOG2_THETA_64 = 13.287712379549449f / 64.0f;
__device__ __forceinline__ float log2_gamma(int h) { return __builtin_log2f(1.0f - __builtin_exp2f(-5.0f - (float)h)); }

struct ProbIn {
    static constexpr int DIAG = 0;
    static constexpr bool GATHER = false, MIDK = false, FP8 = false; static constexpr int NMETA = 2;
    const bf16_t* xb; const bf16_t* wt; const float* rs1; const int* pos; bf16_t* proj; int G, c;
    __device__ __forceinline__ bool next(int i, Unit& u) const { u.e = 0; u.pos0 = 0; u.nvalid = 256; u.eoff = 0; return pg8::static_order(i, G, c, T / 256, DIN / 256, u.pm, u.pn); }
    __device__ __forceinline__ const char* a_base(const Unit& u) const { return (const char*)xb + (size_t)u.pm * 256 * D * 2; }
    __device__ __forceinline__ const char* b_base(const Unit& u) const { return (const char*)wt + (size_t)u.pn * 256 * D * 2; }
    __device__ __forceinline__ void a_offsets(const Unit&, int, unsigned (&)[2][2]) const {}
    __device__ __forceinline__ const unsigned* meta_ptr(const Unit& u, int a, int idx) const { return (a == 0 ? (const unsigned*)rs1 : (const unsigned*)pos) + u.pm * 256 + idx; }
    __device__ __forceinline__ void epi(const f32x4 (&acc)[2][2][4][2], const Unit& u, int wr, int wc, int fr, int fq, const LAS unsigned char* mbuf) const {
        const int seg = u.pn >> 1;
        float invf[4];
#pragma unroll
        for (int q = 0; q < 4; ++q) invf[q] = exp2f(-(float)(16 * wc + 4 * fq + q) * LOG2_THETA_64) * 0.15915494309189535f;
#pragma unroll
        for (int ai = 0; ai < 2; ++ai)
#pragma unroll
            for (int m = 0; m < 4; ++m) {
                const int rl = ai * 128 + wr * 64 + m * 16 + fr, row = u.pm * 256 + rl;
                const float rs = *(const LAS float*)(mbuf + rl * 4);
                float cs[4], sn[4];
                if (seg == 2 || seg == 3) {
                    const float p = (float)*(const LAS int*)(mbuf + 1024 + rl * 4);
#pragma unroll
                    for (int q = 0; q < 4; ++q) { float rev = p * invf[q]; rev = rev - floorf(rev); cs[q] = __builtin_amdgcn_cosf(rev); sn[q] = __builtin_amdgcn_sinf(rev); }
                }
#pragma unroll
                for (int bj = 0; bj < 2; ++bj) {
                    f32x4 v0 = acc[ai][bj][m][0] * rs, v1 = acc[ai][bj][m][1] * rs;
                    if (seg == 1) {
#pragma unroll
                        for (int j = 0; j < 4; ++j) { v0[j] = gelu_tanh(v0[j]); v1[j] = gelu_tanh(v1[j]); }
                    } else if (seg == 5) {
#pragma unroll
                        for (int j = 0; j < 4; ++j) { v0[j] = silu_f(v0[j]); v1[j] = silu_f(v1[j]); }
                    } else if (seg == 2 || seg == 3) {
                        const int head = 2 * (u.pn & 1) + bj;
                        const float e1 = (float)((row & 127) + 1) * log2_gamma(head);
                        const float f = (seg == 2) ? exp2f(e1) : exp2f(-e1) * 0.08838834764831845f;
                        f32x4 o0, o1;
                        o0[0] = (v0[0] * cs[0] - v0[1] * sn[0]) * f; o0[1] = (v0[1] * cs[0] + v0[0] * sn[0]) * f;
                        o0[2] = (v0[2] * cs[1] - v0[3] * sn[1]) * f; o0[3] = (v0[3] * cs[1] + v0[2] * sn[1]) * f;
                        o1[0] = (v1[0] * cs[2] - v1[1] * sn[2]) * f; o1[1] = (v1[1] * cs[2] + v1[0] * sn[2]) * f;
                        o1[2] = (v1[2] * cs[3] - v1[3] * sn[3]) * f; o1[3] = (v1[3] * cs[3] + v1[2] * sn[3]) * f;
                        v0 = o0; v1 = o1;
                    }
                    u32x4 w; w.x = pk2(v0[0], v0[1]); w.y = pk2(v0[2], v0[3]); w.z = pk2(v1[0], v1[1]); w.w = pk2(v1[2], v1[3]);
                    *(u32x4*)(proj + (size_t)row * DIN + u.pn * 256 + bj * 128 + wc * 32 + 8 * fq) = w;
                }
            }
    }
};

struct ProbOut {
    static constexpr int DIAG = 0;
    static constexpr bool GATHER = false, MIDK = true, FP8 = false; static constexpr int NMETA = 1;
    const bf16_t* ycat; const bf16_t* wt; const bf16_t* xb; const float* rsl; bf16_t* yb01; unsigned char* x8; float* ssq; int G, c;
    __device__ __forceinline__ void midk(f32x4 (&acc)[2][2][4][2], const Unit&, int wr, int fr, const LAS unsigned char* mbuf) const {
#pragma unroll
        for (int ai = 0; ai < 2; ++ai)
#pragma unroll
            for (int m = 0; m < 4; ++m) { const float sc = *(const LAS float*)(mbuf + (ai * 128 + wr * 64 + m * 16 + fr) * 4);
#pragma unroll
                for (int bj = 0; bj < 2; ++bj)
#pragma unroll
                    for (int n = 0; n < 2; ++n) acc[ai][bj][m][n] *= sc; }
    }
    __device__ __forceinline__ bool next(int i, Unit& u) const { u.e = 0; u.pos0 = 0; u.nvalid = 256; u.eoff = 0; return pg8::static_order(i, G, c, T / 256, D / 256, u.pm, u.pn); }
    __device__ __forceinline__ const char* a_base(const Unit& u) const { return (const char*)ycat + (size_t)u.pm * 256 * D * 2; }
    __device__ __forceinline__ const char* b_base(const Unit& u) const { return (const char*)wt + (size_t)u.pn * 256 * D * 2; }
    __device__ __forceinline__ void a_offsets(const Unit&, int, unsigned (&)[2][2]) const {}
    __device__ __forceinline__ const unsigned* meta_ptr(const Unit& u, int, int idx) const { return (const unsigned*)rsl + u.pm * 256 + idx; }
    __device__ __forceinline__ void epi(const f32x4 (&acc)[2][2][4][2], const Unit& u, int wr, int wc, int fr, int fq, const LAS unsigned char*) const {
#pragma unroll
        for (int ai = 0; ai < 2; ++ai)
#pragma unroll
            for (int mp = 0; mp < 2; ++mp) {
                u32x2 w8[2][2];
#pragma unroll
                for (int h = 0; h < 2; ++h) {
                    const int m = 2 * mp + h, row = u.pm * 256 + ai * 128 + wr * 64 + m * 16 + fr;
                    float ss = 0.f;
#pragma unroll
                    for (int bj = 0; bj < 2; ++bj) {
                        const int col = u.pn * 256 + bj * 128 + wc * 32 + 8 * fq;
                        const u32x4 xv = *(const u32x4*)(xb + (size_t)row * D + col);
                        const f32x4 x0 = {bflo(xv.x), bfhi(xv.x), bflo(xv.y), bfhi(xv.y)}, x1 = {bflo(xv.z), bfhi(xv.z), bflo(xv.w), bfhi(xv.w)};
                        const f32x4 v0 = acc[ai][bj][m][0] + x0, v1 = acc[ai][bj][m][1] + x1;
                        ss += (v0[0] * v0[0] + v0[1] * v0[1]) + (v0[2] * v0[2] + v0[3] * v0[3]) + (v1[0] * v1[0] + v1[1] * v1[1]) + (v1[2] * v1[2] + v1[3] * v1[3]);
                        u32x4 w; w.x = pk2(v0[0], v0[1]); w.y = pk2(v0[2], v0[3]); w.z = pk2(v1[0], v1[1]); w.w = pk2(v1[2], v1[3]);
                        *(u32x4*)(yb01 + (size_t)row * 2048 + col) = w;
                        w8[h][bj].x = pk4_fp8(v0[0], v0[1], v0[2], v0[3]); w8[h][bj].y = pk4_fp8(v1[0], v1[1], v1[2], v1[3]);
                    }
                    ss += SHFLX_F(ss, 16, fr + 16 * fq); ss += SHFLX_F(ss, 32, fr + 16 * fq);
                    if (fq == 0) ssq[(size_t)(u.pn * 4 + wc) * T + row] = ss;
                }
                const int rows = u.pm * 256 + ai * 128 + wr * 64 + (2 * mp + (fq & 1)) * 16 + fr;
#pragma unroll
                for (int bj = 0; bj < 2; ++bj) *(u32x4*)(x8 + (size_t)rows * D + u.pn * 256 + bj * 128 + wc * 32 + 8 * (fq & ~1)) = pair16(w8[0][bj], w8[1][bj]);
            }
    }
};

struct MoeTabs {
    const LAS unsigned* cnt; const LAS unsigned* eoff; const LAS unsigned* tbase; const LAS unsigned short* tile_e; int ntiles;
    __device__ __forceinline__ bool next(int i, int G, int c, int nN, Unit& u) const {
        int pm, pn; if (!pg8::static_order(i, G, c, ntiles, nN, pm, pn)) return false;
        const int e = __builtin_amdgcn_readfirstlane((int)tile_e[pm]);
        const int tb = __builtin_amdgcn_readfirstlane((int)tbase[e]), ce = __builtin_amdgcn_readfirstlane((int)cnt[e]), eo = __builtin_amdgcn_readfirstlane((int)eoff[e]);
        u.pm = pm; u.pn = pn; u.e = e; u.pos0 = (pm - tb) * 256; u.nvalid = (ce - u.pos0) < 256 ? (ce - u.pos0) : 256; u.eoff = eo; return true;
    }
};
__device__ __forceinline__ MoeTabs moe_build_tabs(LAS unsigned char* lds, const unsigned* ctl, int wv) {
    LAS unsigned* cnt = (LAS unsigned*)(lds + TAB_CNT); LAS unsigned* eoff = (LAS unsigned*)(lds + TAB_EOFF); LAS unsigned* tbase = (LAS unsigned*)(lds + TAB_TBASE);
    LAS unsigned short* tile_e = (LAS unsigned short*)(lds + TAB_TILEE);
    __syncthreads();
    const int l = LANE_ID();
    if (ctl != nullptr) { if (wv == 0 && l < NEXP) cnt[l] = ctl[CW_CNT + 64 * l]; }
    __syncthreads();
    if (wv == 0 && l < NEXP) {
        unsigned eo = 0, tb = 0;
        for (int j = 0; j < NEXP; ++j) { const unsigned cj = cnt[j]; if (j < l) { eo += cj; tb += (cj + 255u) >> 8; } }
        const unsigned nt = (cnt[l] + 255u) >> 8;
        eoff[l] = eo; tbase[l] = tb;
        for (unsigned t = 0; t < nt; ++t) tile_e[tb + t] = (unsigned short)l;
        if (l == NEXP - 1) tbase[NEXP] = tb + nt;
    }
    __syncthreads();
    MoeTabs mt; mt.cnt = cnt; mt.eoff = eoff; mt.tbase = tbase; mt.tile_e = tile_e; mt.ntiles = __builtin_amdgcn_readfirstlane((int)tbase[NEXP]); return mt;
}

__device__ __forceinline__ MoeTabs moe_reuse_tabs(LAS unsigned char* lds) {
    MoeTabs mt; mt.cnt = (LAS unsigned*)(lds + TAB_CNT); mt.eoff = (LAS unsigned*)(lds + TAB_EOFF); mt.tbase = (LAS unsigned*)(lds + TAB_TBASE); mt.tile_e = (LAS unsigned short*)(lds + TAB_TILEE);
    mt.ntiles = __builtin_amdgcn_readfirstlane((int)mt.tbase[NEXP]); return mt;
}
struct ProbUp {
    static constexpr int DIAG = 0;
    static constexpr bool GATHER = true, MIDK = false, FP8 = true; static constexpr int NMETA = 3;
    int probe_mode; MoeTabs tabs; const unsigned char* x8; const unsigned char* wgu; const unsigned* list; const float* rs2s; const float* bg; const float* bu; unsigned char* act; int G, c;
    __device__ __forceinline__ bool next(int i, Unit& u) const { return tabs.next(i, G, c, 8, u); }
    __device__ __forceinline__ const char* a_base(const Unit&) const { return (const char*)x8; }
    __device__ __forceinline__ const char* b_base(const Unit& u) const { return (const char*)wgu + ((size_t)u.e * 2048 + (size_t)u.pn * 256) * D; }
    __device__ __forceinline__ void a_offsets(const Unit& u, int tid, unsigned (&vo)[2][2]) const {
        int R[2], C[2];
#pragma unroll
        for (int i = 0; i < 2; ++i) pg8::stage_rc(tid * 16 + i * 8192, R[i], C[i]);
#pragma unroll
        for (int h = 0; h < 2; ++h)
#pragma unroll
            for (int i = 0; i < 2; ++i) { const int rl = h * 128 + R[i]; const int pos = u.pos0 + (rl < u.nvalid ? rl : 0);
                const unsigned slot = list[(size_t)u.e * T + pos]; vo[h][i] = (slot >> 2) * 1024u + (unsigned)C[i] * 2u; }
    }
    __device__ __forceinline__ void a_offsets_lds(const Unit& u, int tid, unsigned (&vo)[2][2], const LAS unsigned char* mbuf) const {
        int R[2], C[2];
#pragma unroll
        for (int i = 0; i < 2; ++i) pg8::stage_rc(tid * 16 + i * 8192, R[i], C[i]);
#pragma unroll
        for (int h = 0; h < 2; ++h)
#pragma unroll
            for (int i = 0; i < 2; ++i) { const int rl = h * 128 + R[i]; const unsigned slot = *(const LAS unsigned*)(mbuf + 2048 + (rl < u.nvalid ? rl : 0) * 4); vo[h][i] = (slot >> 2) * 1024u + (unsigned)C[i] * 2u; }
    }
    __device__ __forceinline__ const unsigned* meta_ptr(const Unit& u, int a, int idx) const {
        if (a == 0) return (const unsigned*)rs2s + (size_t)u.e * T + u.pos0 + idx;
        if (a == 2) return list + (size_t)u.e * T + u.pos0 + idx;
        return (const unsigned*)(idx < 128 ? bg : bu) + (size_t)u.e * D + u.pn * 128 + (idx & 127);
    }
    __device__ __forceinline__ void epi(const f32x4 (&acc)[2][2][4][2], const Unit& u, int wr, int wc, int fr, int fq, const LAS unsigned char* mbuf) const {
        if (probe_mode == 1) return;
        const int col8 = u.pn * 128 + wc * 32 + 8 * fq;
        f32x4 bgv[2], buv[2];
#pragma unroll
        for (int n = 0; n < 2; ++n) { bgv[n] = *(const LAS f32x4*)(mbuf + 1024 + (wc * 32 + 8 * fq + 4 * n) * 4); buv[n] = *(const LAS f32x4*)(mbuf + 1536 + (wc * 32 + 8 * fq + 4 * n) * 4) + 1.0f; }
        float rsv[2][4];
#pragma unroll
        for (int ai = 0; ai < 2; ++ai)
#pragma unroll
            for (int m = 0; m < 4; ++m) { const int rl = ai * 128 + wr * 64 + m * 16 + fr; rsv[ai][m] = *(const LAS float*)(mbuf + rl * 4) * (1.0f / 64.0f);
            }
#pragma unroll
        for (int ai = 0; ai < 2; ++ai)
#pragma unroll
            for (int mp = 0; mp < 2; ++mp) {
                u32x2 wq[2];
#pragma unroll
                for (int h = 0; h < 2; ++h) {
                const int m = 2 * mp + h;
                const float rs = rsv[ai][m];
                float o[8];
#pragma unroll
                for (int n = 0; n < 2; ++n)
#pragma unroll
                    for (int jp = 0; jp < 2; ++jp) {
                        const f32x2 ag = {acc[ai][0][m][n][2 * jp], acc[ai][0][m][n][2 * jp + 1]}, au = {acc[ai][1][m][n][2 * jp], acc[ai][1][m][n][2 * jp + 1]};
                        const f32x2 bg2 = {bgv[n][2 * jp], bgv[n][2 * jp + 1]}, bu2 = {buv[n][2 * jp], buv[n][2 * jp + 1]};
                        f32x2 g = ag * rs + bg2, up = au * rs + bu2;
                        g.x = fminf(g.x, 7.0f); g.y = fminf(g.y, 7.0f);
                        up.x = __builtin_amdgcn_fmed3f(up.x, -6.0f, 8.0f); up.y = __builtin_amdgcn_fmed3f(up.y, -6.0f, 8.0f);
                        const f32x2 z = g * (-1.702f * 1.4426950408889634f);
                        f32x2 e; e.x = fexp2(z.x); e.y = fexp2(z.y);
                        const f32x2 den = e + 1.0f;
                        f32x2 r; r.x = frcp(den.x); r.y = frcp(den.y);
                        const f32x2 res = (g * r) * up;
                        o[4 * n + 2 * jp] = res.x; o[4 * n + 2 * jp + 1] = res.y;
                    }
                wq[h].x = pk4_fp8(o[0], o[1], o[2], o[3]); wq[h].y = pk4_fp8(o[4], o[5], o[6], o[7]);
                }
                const int rls = ai * 128 + wr * 64 + (2 * mp + (fq & 1)) * 16 + fr;
                const u32x4 ov = pair16(wq[0], wq[1]);
                if (rls < u.nvalid) *(u32x4*)(act + (size_t)(u.eoff + u.pos0 + rls) * D + u.pn * 128 + wc * 32 + 8 * (fq & ~1)) = ov;
            }
    }
};

template <int DG> struct ProbUpDiag : ProbUp { static constexpr int DIAG = DG; };
struct ProbDown {
    static constexpr int DIAG = 0;
    static constexpr bool GATHER = false, MIDK = false, FP8 = true; static constexpr int NMETA = 3;
    int probe_mode; MoeTabs tabs; const unsigned char* act; const unsigned char* wd; const unsigned* list; const float* gw; const float* bd; unsigned char* y8; int G, c;
    __device__ __forceinline__ bool next(int i, Unit& u) const { return tabs.next(i, G, c, 4, u); }
    __device__ __forceinline__ const char* a_base(const Unit& u) const { return (const char*)act + (size_t)(u.eoff + u.pos0) * D; }
    __device__ __forceinline__ const char* b_base(const Unit& u) const { return (const char*)wd + ((size_t)u.e * D + (size_t)u.pn * 256) * D; }
    __device__ __forceinline__ void a_offsets(const Unit&, int, unsigned (&)[2][2]) const {}
    __device__ __forceinline__ const unsigned* meta_ptr(const Unit& u, int a, int idx) const {
        if (a == 2) return (const unsigned*)bd + (size_t)u.e * D + u.pn * 256 + idx;
        return (a == 0 ? list : (const unsigned*)gw) + (size_t)u.e * T + u.pos0 + idx;
    }
    __device__ __forceinline__ void epi(const f32x4 (&acc)[2][2][4][2], const Unit& u, int wr, int wc, int fr, int fq, const LAS unsigned char* mbuf) const {
        if (probe_mode == 1) return;
        const int cofs = u.pn * 256 + wc * 32 + 8 * (fq & ~1);
        const int cown = wc * 32 + 8 * fq;
        f32x4 bdv[2][2];
#pragma unroll
        for (int bj = 0; bj < 2; ++bj) { bdv[bj][0] = *(const LAS f32x4*)(mbuf + 2048 + (bj * 128 + cown) * 4); bdv[bj][1] = *(const LAS f32x4*)(mbuf + 2048 + (bj * 128 + cown + 4) * 4); }
#pragma unroll
        for (int ai = 0; ai < 2; ++ai)
#pragma unroll
            for (int mp = 0; mp < 2; ++mp) {
                u32x2 w[2][2];
#pragma unroll
                for (int h = 0; h < 2; ++h) {
                    const int m = 2 * mp + h, rl = ai * 128 + wr * 64 + m * 16 + fr;
                    const float g = *(const LAS float*)(mbuf + 1024 + rl * 4), s1 = g * (Y8_SCALE / 64.0f), s2 = g * Y8_SCALE;
#pragma unroll
                    for (int bj = 0; bj < 2; ++bj) {
                        const f32x4 v0 = acc[ai][bj][m][0] * s1 + bdv[bj][0] * s2, v1 = acc[ai][bj][m][1] * s1 + bdv[bj][1] * s2;
                        w[h][bj].x = pk4_fp8(v0[0], v0[1], v0[2], v0[3]); w[h][bj].y = pk4_fp8(v1[0], v1[1], v1[2], v1[3]);
                    }
                }
                const int rls = ai * 128 + wr * 64 + (2 * mp + (fq & 1)) * 16 + fr;
                const unsigned sl = *(const LAS unsigned*)(mbuf + rls * 4);
                unsigned char* dst = y8 + (size_t)sl * D + cofs;
#pragma unroll
                for (int bj = 0; bj < 2; ++bj) { const u32x4 o = pair16(w[0][bj], w[1][bj]); if (rls < u.nvalid) *(u32x4*)(dst + bj * 128) = o; }
            }
    }
};

struct P0Item { const float* W; const float* scale; void* WT; int N, mode, off, k0, n0, fp8; };
__device__ __forceinline__ int p0_dest(const P0Item& d, int n) {
    if (d.mode == 1) { const int seg = n >> 9; if (seg == 2 || seg == 3) { const int w = n & 511, head = w >> 7, dd = w & 127; return (seg << 9) + (head << 7) + 2 * (dd & 63) + (dd >> 6); } return n; }
    if (d.mode == 2) return d.off + 256 * (n >> 7) + (n & 127);
    return d.off + n;
}
constexpr int P0_I_IN = 16 * (DIN / 64), P0_I_OUT = 16 * (D / 64), P0_I_E = 16 * (D / 64), P0_NITEMS_ALL = P0_I_IN + P0_I_OUT + 3 * NEXP * P0_I_E;
__device__ __forceinline__ void p0_load(const P0Item& d, int lane, f32x4 (&v)[16], float& sc) {
#pragma unroll
    for (int i = 0; i < 16; ++i) v[i] = __builtin_nontemporal_load((const f32x4*)(d.W + (size_t)(d.k0 + (lane >> 4) + 4 * i) * d.N + d.n0 + 4 * (lane & 15)));
    sc = d.scale ? d.scale[d.k0 + lane] : 1.0f;
    if (d.fp8) sc *= 64.0f;
}
__device__ __forceinline__ void p0_process(const P0Item& d, int lane, const f32x4 (&v)[16], float sc, LAS unsigned char* scr) {
    LAS float* ssc = (LAS float*)(scr + 64 * 136);
    ssc[lane] = sc;
    WAVE_SYNC();
#pragma unroll
    for (int i = 0; i < 16; ++i) { const int kk = (lane >> 4) + 4 * i; const float f = ssc[kk];
        u32x2 o; o.x = pk2(v[i].x * f, v[i].y * f); o.y = pk2(v[i].z * f, v[i].w * f);
        *(LAS u32x2*)(scr + kk * 136 + 8 * (lane & 15)) = o; }
    WAVE_SYNC();
    const int q = (lane & 15) >> 2, p = lane & 3;
    if (d.fp8) {
#pragma unroll
        for (int st = 0; st < 4; ++st) {
            const int n16 = 16 * st; unsigned o[4];
#pragma unroll
            for (int hf = 0; hf < 2; ++hf) {
                const int kb8 = 2 * (lane >> 4) + hf;
                const v4i16_t lo = __builtin_amdgcn_ds_read_tr16_b64_v4i16((LAS v4i16_t*)(scr + (8 * kb8 + q) * 136 + (n16 + 4 * p) * 2));
                const v4i16_t hi = __builtin_amdgcn_ds_read_tr16_b64_v4i16((LAS v4i16_t*)(scr + (8 * kb8 + 4 + q) * 136 + (n16 + 4 * p) * 2));
                o[2 * hf] = pk4_fp8(bf2f((unsigned short)lo[0]), bf2f((unsigned short)lo[1]), bf2f((unsigned short)lo[2]), bf2f((unsigned short)lo[3]));
                o[2 * hf + 1] = pk4_fp8(bf2f((unsigned short)hi[0]), bf2f((unsigned short)hi[1]), bf2f((unsigned short)hi[2]), bf2f((unsigned short)hi[3]));
            }
            __builtin_nontemporal_store((u32x4){o[0], o[1], o[2], o[3]}, (u32x4*)((unsigned char*)d.WT + (size_t)p0_dest(d, d.n0 + n16 + (lane & 15)) * D + d.k0 + 16 * (lane >> 4)));
        }
    } else {
#pragma unroll
    for (int st = 0; st < 8; ++st) {
        const int n16 = 16 * (st & 3), kb8 = (st >> 2) * 4 + (lane >> 4);
        const v4i16_t lo = __builtin_amdgcn_ds_read_tr16_b64_v4i16((LAS v4i16_t*)(scr + (8 * kb8 + q) * 136 + (n16 + 4 * p) * 2));
        const v4i16_t hi = __builtin_amdgcn_ds_read_tr16_b64_v4i16((LAS v4i16_t*)(scr + (8 * kb8 + 4 + q) * 136 + (n16 + 4 * p) * 2));
        u32x4 o; o.x = (unsigned)(unsigned short)lo[0] | ((unsigned)(unsigned short)lo[1] << 16); o.y = (unsigned)(unsigned short)lo[2] | ((unsigned)(unsigned short)lo[3] << 16);
        o.z = (unsigned)(unsigned short)hi[0] | ((unsigned)(unsigned short)hi[1] << 16); o.w = (unsigned)(unsigned short)hi[2] | ((unsigned)(unsigned short)hi[3] << 16);
        *(u32x4*)((bf16_t*)d.WT + (size_t)p0_dest(d, d.n0 + n16 + (lane & 15)) * D + d.k0 + 8 * kb8) = o;
    }
    }
    WAVE_SYNC();
}

#ifndef STREAM_FINAL
#define STREAM_FINAL 1
#endif
#define STREAM_IN_PASS(fin) ((fin) ? (STREAM_FINAL != 0) : true)
struct MoeConv { const float *wg, *wu, *wd, *ffn_g; unsigned char *wgu8, *wd8; };
constexpr int MOE_ITEMS = 3 * NEXP * P0_I_E, NLRU = BATCH * NCH;
constexpr int MOE_PER_WU = (MOE_ITEMS + NLRU * 8 - 1) / (NLRU * 8);
constexpr int MOE_K0 = MOE_PER_WU >= 12 ? 8 : (MOE_PER_WU * 2 + 2) / 3, MOE_K1_RAW = MOE_PER_WU - MOE_K0, MOE_K1 = MOE_K1_RAW < 0 ? 0 : (MOE_K1_RAW > 8 ? 8 : MOE_K1_RAW);
constexpr int MOE_PASS0_ITEMS = NLRU * 8 * MOE_K0, MOE_CAP = NLRU * 8 * (MOE_K0 + MOE_K1), MOE_STREAMED = MOE_ITEMS < MOE_CAP ? MOE_ITEMS : MOE_CAP;
constexpr int P0_NITEMS = P0_NITEMS_ALL - MOE_STREAMED;
__device__ __forceinline__ P0Item moe_item(const MoeConv& M, int it) {
    P0Item d; d.scale = nullptr; d.off = 0; d.mode = 0; d.fp8 = 1; d.N = D;
    const int e = it / (3 * P0_I_E), q = (it / P0_I_E) % 3, r = it % P0_I_E;
    if (q == 0) { d.W = M.wg + (size_t)e * D * D; d.scale = M.ffn_g; d.WT = M.wgu8; d.mode = 2; d.off = e * 2048; }
    else if (q == 1) { d.W = M.wu + (size_t)e * D * D; d.scale = M.ffn_g; d.WT = M.wgu8; d.mode = 2; d.off = e * 2048 + 128; }
    else { d.W = M.wd + (size_t)e * D * D; d.WT = M.wd8; d.off = e * D; }
    d.k0 = 64 * (r / (D / 64)); d.n0 = 64 * (r % (D / 64)); return d;
}

constexpr int RT_STRIDE = 272;
constexpr int LDS_VT = 0, LDS_KT = 128 * RT_STRIDE;
constexpr int XA_STRIDE = 144, XA_WAVE = 16 * XA_STRIDE;
constexpr int AG_STRIDE = 520, AG_WAVE = 16 * AG_STRIDE;
constexpr int LRU_WAVE = XA_WAVE + AG_WAVE;
constexpr int LDS_XA = 0, LDS_SS = 8 * LRU_WAVE, LDS_RSL = LDS_SS + 8 * 128 * 4;
static_assert(LRU_WAVE % 16 == 0 && LRU_WAVE >= 64 * 136 + 256, "LRU per-wave LDS block must hold one weight item");
static_assert(LDS_RSL + 512 <= RING_BYTES && LDS_KT + 128 * RT_STRIDE <= RING_BYTES, "LDS seq map");

__device__ __forceinline__ bf16x8 tr_frag(const LAS unsigned char* tile, int row0, int col0, int fr) {
    const int q = fr >> 2, p = fr & 3;
    const v4i16_t lo = __builtin_amdgcn_ds_read_tr16_b64_v4i16((LAS v4i16_t*)(tile + (row0 + q) * RT_STRIDE + (col0 + 4 * p) * 2));
    const v4i16_t hi = __builtin_amdgcn_ds_read_tr16_b64_v4i16((LAS v4i16_t*)(tile + (row0 + 4 + q) * RT_STRIDE + (col0 + 4 * p) * 2));
    bf16x8 r; r[0] = lo[0]; r[1] = lo[1]; r[2] = lo[2]; r[3] = lo[3]; r[4] = hi[0]; r[5] = hi[1]; r[6] = hi[2]; r[7] = hi[3]; return r;
}
__device__ __forceinline__ void stage_tile(LAS unsigned char* dst, const bf16_t* src, int tid) {
#pragma unroll
    for (int i = 0; i < 4; ++i) { const int p = tid + 512 * i, r = p >> 4, c = p & 15;
        const u32x4 v = *(const u32x4*)(src + (size_t)r * DIN + c * 8); *(LAS u32x4*)(dst + r * RT_STRIDE + c * 16) = v; }
}

template <bool FINAL>
__device__ __forceinline__ void lru_unit(LAS unsigned char* lds, int b, int n, const bf16_t* __restrict__ proj, const float* __restrict__ conv_w, const float* __restrict__ conv_b, const bf16_t* __restrict__ waf,
                                         const float* __restrict__ ba, const float* __restrict__ bx, const float* __restrict__ lam, const float* __restrict__ lru_ng,
                                         float* __restrict__ lap, float* __restrict__ lah, const float* __restrict__ carry, bf16_t* __restrict__ ycat, float* __restrict__ rsl_out, const MoeConv& MC, int item0, int wv) {
    int tid_ = wv * 64 + LANE_ID(); OPAQUE(tid_);
    const int tid = tid_, lane = tid & 63, w = __builtin_amdgcn_readfirstlane(tid >> 6), fr = lane & 15, fq = lane >> 4, c = tid;
    LAS unsigned char* xa = lds + LDS_XA + w * LRU_WAVE; LAS unsigned char* ag = xa + XA_WAVE;
    LAS float* ss = (LAS float*)(lds + LDS_SS);
    bf16x8 Ba[2][4], Bx[2][4];
#pragma unroll
    for (int ks = 0; ks < 2; ++ks)
#pragma unroll
        for (int nt = 0; nt < 4; ++nt) { const size_t fi = ((size_t)(w * 2 + ks) * 4 + nt) * 64 + lane; Ba[ks][nt] = *(const bf16x8*)(waf + fi * 8); Bx[ks][nt] = *(const bf16x8*)(waf + (fi + 4096) * 8); }
    float bav[4], bxv[4], spl[4];
#pragma unroll
    for (int nt = 0; nt < 4; ++nt) { const int co = w * 64 + 16 * nt + fr; bav[nt] = ba[co]; bxv[nt] = bx[co]; const float l = lam[co];
        spl[nt] = -8.0f * 1.4426950408889634f * (fmaxf(-l, 0.f) + log1pf(expf(-fabsf(l)))); }
    const float w0 = conv_w[c], w1 = conv_w[512 + c], w2 = conv_w[1024 + c], w3 = conv_w[1536 + c], cb = conv_b[c];
    const float gn = FINAL ? lru_ng[c] : 0.f;
    const size_t t0 = (size_t)b * SEQ + (size_t)n * 128;
    float xm3 = 0.f, xm2 = 0.f, xm1 = 0.f;
    if (n > 0) { xm3 = bf2f(proj[(t0 - 3) * DIN + c]); xm2 = bf2f(proj[(t0 - 2) * DIN + c]); xm1 = bf2f(proj[(t0 - 1) * DIN + c]); }
    float h = FINAL ? carry[((size_t)b * NCH + n) * 512 + c] : 0.f, P = 1.f;
    unsigned xr[16];
#pragma unroll
    for (int i = 0; i < 16; ++i) xr[i] = proj[(t0 + i) * DIN + c];
    for (int tt = 0; tt < 8; ++tt) {
        float xcv[16]; unsigned gr[16];
#pragma unroll
        for (int i = 0; i < 16; ++i) { xcv[i] = bf2f(xr[i]); gr[i] = FINAL ? (unsigned)proj[(t0 + tt * 16 + i) * DIN + 512 + c] : 0u; }
        if (tt < 7) {
#pragma unroll
            for (int i = 0; i < 16; ++i) xr[i] = proj[(t0 + (tt + 1) * 16 + i) * DIN + c];
        }
        constexpr int KP = FINAL ? MOE_K1 : MOE_K0;
        const int cit = item0 + (w * KP + tt);
        const bool chas = (tt < KP) && (cit < MOE_STREAMED);
        P0Item cd; f32x4 cv[16]; float csc = 1.f;
        if (chas) { cd = moe_item(MC, cit); p0_load(cd, lane, cv, csc); }
#pragma unroll
        for (int i = 0; i < 16; ++i) {
            const float x0 = xcv[i];
            const float xc = w0 * xm3 + w1 * xm2 + w2 * xm1 + w3 * x0 + cb;
            xm3 = xm2; xm2 = xm1; xm1 = x0; xcv[i] = xc;
            if (i & 1) { const unsigned pr = pk2(xcv[i - 1], xc);
                *(LAS bf16_t*)(xa + (i - 1) * XA_STRIDE + lane * 2) = (bf16_t)(pr & 0xffffu); *(LAS bf16_t*)(xa + i * XA_STRIDE + lane * 2) = (bf16_t)(pr >> 16); }
        }
        WAVE_SYNC();
        bf16x8 af[2];
#pragma unroll
        for (int ks = 0; ks < 2; ++ks) af[ks] = *(const LAS bf16x8*)(xa + fr * XA_STRIDE + (32 * ks + 8 * fq) * 2);
#pragma unroll
        for (int nt = 0; nt < 4; ++nt) {
            f32x4 ar = {0.f, 0.f, 0.f, 0.f}, ai = {0.f, 0.f, 0.f, 0.f};
#pragma unroll
            for (int ks = 0; ks < 2; ++ks) { ar = __builtin_amdgcn_mfma_f32_16x16x32_bf16(af[ks], Ba[ks][nt], ar, 0, 0, 0); ai = __builtin_amdgcn_mfma_f32_16x16x32_bf16(af[ks], Bx[ks][nt], ai, 0, 0, 0); }
#pragma unroll
            for (int r = 0; r < 4; ++r) {
                const float rr = sigmoid_f(ar[r] + bav[nt]), ii = sigmoid_f(ai[r] + bxv[nt]);
                const float a = fexp2(rr * spl[nt]);
                const float g = __builtin_amdgcn_sqrtf(fmaxf(1.0f - a * a, 0.f)) * ii;
                *(LAS f32x2*)(ag + (4 * fq + r) * AG_STRIDE + (16 * nt + fr) * 8) = (f32x2){a, g};
            }
        }
        WAVE_SYNC();
        float uprev = 0.f;
        unsigned upk[8];
#pragma unroll
        for (int i = 0; i < 16; ++i) {
            const f32x2 v = *(const LAS f32x2*)(ag + i * AG_STRIDE + lane * 8);
            h = v.x * h + v.y * xcv[i];
            if (!FINAL) P *= v.x;
            if (FINAL) {
                const float u = h * bf2f(gr[i]);
                if (i & 1) upk[i >> 1] = pk2(uprev * gn, u * gn); else uprev = u;
                *(LAS float*)(ag + i * AG_STRIDE + lane * 8) = u;
            }
        }
        if (FINAL) {
            WAVE_SYNC();
            const int tk = lane & 15, qd = lane >> 4; float s = 0.f;
#pragma unroll
            for (int i = 0; i < 16; ++i) { const float u = *(const LAS float*)(ag + tk * AG_STRIDE + (16 * qd + i) * 8); s += u * u; }
            s += SHFLX_F(s, 16, lane); s += SHFLX_F(s, 32, lane);
            if (qd == 0) ss[w * 128 + tt * 16 + tk] = s;
        }
        WAVE_SYNC();
        if (chas) p0_process(cd, lane, cv, csc, xa);
        if (FINAL) {
#pragma unroll
            for (int i = 0; i < 16; ++i) ycat[(t0 + tt * 16 + i) * D + c] = (bf16_t)((i & 1) ? (upk[i >> 1] >> 16) : (upk[i >> 1] & 0xffffu));
        }
    }
    if (!FINAL) { lap[((size_t)b * NCH + n) * 512 + c] = P; lah[((size_t)b * NCH + n) * 512 + c] = h; }
    else {
        __syncthreads();
        if (tid < 128) { float tot = 0.f;
#pragma unroll
            for (int q = 0; q < 8; ++q) tot += ss[q * 128 + tid];
            rsl_out[t0 + tid] = 1.0f / sqrtf(tot * (1.0f / 512.0f) + NORM_EPS); }
    }
    __syncthreads();
}

__device__ __forceinline__ void ret_kv_load(u32x4 (&tk)[4], u32x4 (&tv)[4], int unit, const bf16_t* __restrict__ proj, int tid) {
    const int bh = unit / NCH, n = unit % NCH, b = bh >> 2, hh = bh & 3;
    const size_t t0 = (size_t)b * SEQ + (size_t)n * 128;
#pragma unroll
    for (int i = 0; i < 4; ++i) { const int p = tid + 512 * i, r = p >> 4, c = p & 15;
        tk[i] = *(const u32x4*)(proj + (t0 + r) * DIN + 1536 + hh * 128 + c * 8); tv[i] = *(const u32x4*)(proj + (t0 + r) * DIN + 2048 + hh * 128 + c * 8); }
}
__device__ __forceinline__ void ret_kv_stage(LAS unsigned char* lds, const u32x4 (&tk)[4], const u32x4 (&tv)[4], int tid) {
#pragma unroll
    for (int i = 0; i < 4; ++i) { const int p = tid + 512 * i, r = p >> 4, c = p & 15;
        *(LAS u32x4*)(lds + LDS_KT + r * RT_STRIDE + c * 16) = tk[i]; *(LAS u32x4*)(lds + LDS_VT + r * RT_STRIDE + c * 16) = tv[i]; }
}
__device__ __forceinline__ void ret_kv_phase(LAS unsigned char* lds, const bf16_t* __restrict__ proj, bf16_t* __restrict__ kvt, int G, int bx, int wv) {
    int tid_ = wv * 64 + LANE_ID(); OPAQUE(tid_);
    const int tid = tid_, lane = tid & 63, w = wv, fr = lane & 15, fq = lane >> 4;
    u32x4 tk[4], tv[4];
    int unit = bx;
    if (unit < NBH * NCH) { ret_kv_load(tk, tv, unit, proj, tid); ret_kv_stage(lds, tk, tv, tid); __syncthreads(); if (unit + G < NBH * NCH) ret_kv_load(tk, tv, unit + G, proj, tid); }
    for (; unit < NBH * NCH; unit += G) {
        f32x4 acc[8];
#pragma unroll
        for (int et = 0; et < 8; ++et) acc[et] = (f32x4){0.f, 0.f, 0.f, 0.f};
#pragma unroll
        for (int ks = 0; ks < 4; ++ks) {
            const bf16x8 af = tr_frag(lds + LDS_KT, 32 * ks + 8 * fq, 16 * w, fr);
#pragma unroll
            for (int et = 0; et < 8; ++et) { const bf16x8 bfv = tr_frag(lds + LDS_VT, 32 * ks + 8 * fq, 16 * et, fr);
                acc[et] = __builtin_amdgcn_mfma_f32_16x16x32_bf16(af, bfv, acc[et], 0, 0, 0); }
        }
        u32x2 o[8];
#pragma unroll
        for (int et = 0; et < 8; ++et) { o[et].x = pk2v(acc[et][0], acc[et][1]); o[et].y = pk2v(acc[et][2], acc[et][3]); }
        __syncthreads();
        if (unit + G < NBH * NCH) ret_kv_stage(lds, tk, tv, tid);
        bf16_t* out = kvt + (size_t)unit * 16384;
#pragma unroll
        for (int ep = 0; ep < 4; ++ep) *(u32x4*)(out + (size_t)(16 * (2 * ep + (fq & 1)) + fr) * 128 + 16 * w + 4 * (fq & ~1)) = pair16(o[2 * ep], o[2 * ep + 1]);
        __syncthreads();
        if (unit + 2 * G < NBH * NCH) ret_kv_load(tk, tv, unit + 2 * G, proj, tid);
    }
}

__device__ __forceinline__ int swz_off(int row, int chunk) { return row * 256 + ((chunk ^ (row & 15)) << 4); }
constexpr int LDS_RV = 0, LDS_RK = 32768, LDS_RP = 65536, LDS_RPT = 98304;
__device__ __forceinline__ bf16x8 tr_frag_swz(const LAS unsigned char* tile, int row0, int col0, int fr) {
    const int q = fr >> 2, p = fr & 3, ch = (col0 >> 3) + (p >> 1), bo = (p & 1) * 8;
    const v4i16_t lo = __builtin_amdgcn_ds_read_tr16_b64_v4i16((LAS v4i16_t*)(tile + swz_off(row0 + q, ch) + bo));
    const v4i16_t hi = __builtin_amdgcn_ds_read_tr16_b64_v4i16((LAS v4i16_t*)(tile + swz_off(row0 + 4 + q, ch) + bo));
    bf16x8 r; r[0] = lo[0]; r[1] = lo[1]; r[2] = lo[2]; r[3] = lo[3]; r[4] = hi[0]; r[5] = hi[1]; r[6] = hi[2]; r[7] = hi[3]; return r;
}
struct RetRegs { u32x4 tv[4], tk[4], tp[4]; bf16x8 bq[4]; u32x2 sg[8]; };
__device__ __forceinline__ void ret_out_load(RetRegs& R, int unit, const bf16_t* __restrict__ proj, const bf16_t* __restrict__ prevt, int tid, int w, int fr, int fq) {
    const int bh = unit / NCH, n = unit % NCH, b = bh >> 2, hh = bh & 3;
    const size_t t0 = (size_t)b * SEQ + (size_t)n * 128;
#pragma unroll
    for (int i = 0; i < 4; ++i) { const int p = tid + 512 * i, r = p >> 4, c = p & 15;
        R.tv[i] = *(const u32x4*)(proj + (t0 + r) * DIN + 2048 + hh * 128 + c * 8);
        R.tk[i] = *(const u32x4*)(proj + (t0 + r) * DIN + 1536 + hh * 128 + c * 8);
        R.tp[i] = *(const u32x4*)(prevt + (size_t)unit * 16384 + r * 128 + c * 8); }
#pragma unroll
    for (int ks = 0; ks < 4; ++ks) R.bq[ks] = *(const bf16x8*)(proj + (t0 + 16 * w + fr) * DIN + 1024 + hh * 128 + 32 * ks + 8 * fq);
#pragma unroll
    for (int et = 0; et < 8; ++et) R.sg[et] = *(const u32x2*)(proj + (t0 + 16 * w + fr) * DIN + 2560 + hh * 128 + 16 * et + 4 * fq);
}
__device__ __forceinline__ void ret_out_phase(LAS unsigned char* lds, const bf16_t* __restrict__ proj, const bf16_t* __restrict__ prevt, const float* __restrict__ gng, const float* __restrict__ gnb, bf16_t* __restrict__ ycat, int G, int bx, int wv) {
    int tid_ = wv * 64 + LANE_ID(); OPAQUE(tid_);
    const int tid = tid_, lane = tid & 63, w = __builtin_amdgcn_readfirstlane(tid >> 6), fr = lane & 15, fq = lane >> 4;
    RetRegs R;
    int unit = bx;
    bf16x8 bq[4]; u32x2 sg[8];
    if (unit < NBH * NCH) {
        ret_out_load(R, unit, proj, prevt, tid, w, fr, fq);
#pragma unroll
        for (int i = 0; i < 4; ++i) { const int p = tid + 512 * i, r = p >> 4, c = p & 15, o = swz_off(r, c);
            *(LAS u32x4*)(lds + LDS_RV + o) = R.tv[i]; *(LAS u32x4*)(lds + LDS_RK + o) = R.tk[i]; *(LAS u32x4*)(lds + LDS_RP + o) = R.tp[i]; }
#pragma unroll
        for (int ks = 0; ks < 4; ++ks) bq[ks] = R.bq[ks];
#pragma unroll
        for (int et = 0; et < 8; ++et) sg[et] = R.sg[et];
        __syncthreads();
        if (unit + G < NBH * NCH) ret_out_load(R, unit + G, proj, prevt, tid, w, fr, fq);
    }
    for (; unit < NBH * NCH; unit += G) {
        const int bh = unit / NCH, n = unit % NCH, b = bh >> 2, hh = bh & 3;
        const size_t t0 = (size_t)b * SEQ + (size_t)n * 128;
        const int crow = 16 * w + fr;
#pragma unroll
        for (int mt = 0; mt < 8; ++mt) {
            if (mt <= w) {
                f32x4 sacc = {0.f, 0.f, 0.f, 0.f};
#pragma unroll
                for (int ks = 0; ks < 4; ++ks) { const bf16x8 ak = *(const LAS bf16x8*)(lds + LDS_RK + swz_off(16 * mt + fr, 4 * ks + fq));
                    sacc = __builtin_amdgcn_mfma_f32_16x16x32_bf16(ak, bq[ks], sacc, 0, 0, 0); }
                if (mt == w) {
#pragma unroll
                    for (int r = 0; r < 4; ++r) if (4 * fq + r > fr) sacc[r] = 0.f;
                }
                u32x2 o; o.x = pk2v(sacc[0], sacc[1]); o.y = pk2v(sacc[2], sacc[3]);
                *(LAS u32x2*)(lds + LDS_RPT + swz_off(crow, 2 * mt + (fq >> 1)) + (fq & 1) * 8) = o;
            } else if (mt == w + 1 && (mt & 1)) {
                *(LAS u32x2*)(lds + LDS_RPT + swz_off(crow, 2 * mt + (fq >> 1)) + (fq & 1) * 8) = (u32x2){0u, 0u};
            }
        }
        WAVE_SYNC();
        f32x4 acc[8];
#pragma unroll
        for (int et = 0; et < 8; ++et) acc[et] = (f32x4){0.f, 0.f, 0.f, 0.f};
        const int nks = (w + 2) >> 1;
#pragma unroll
        for (int ksm = 0; ksm < 4; ++ksm) {
            if (ksm < nks) {
                const bf16x8 bp = *(const LAS bf16x8*)(lds + LDS_RPT + swz_off(crow, 4 * ksm + fq));
#pragma unroll
                for (int et = 0; et < 8; ++et) { const bf16x8 av = tr_frag_swz(lds + LDS_RV, 32 * ksm + 8 * fq, 16 * et, fr);
                    acc[et] = __builtin_amdgcn_mfma_f32_16x16x32_bf16(av, bp, acc[et], 0, 0, 0); }
            }
        }
#pragma unroll
        for (int et = 0; et < 8; ++et)
#pragma unroll
            for (int ks = 0; ks < 4; ++ks) { const bf16x8 ap = *(const LAS bf16x8*)(lds + LDS_RP + swz_off(16 * et + fr, 4 * ks + fq));
                acc[et] = __builtin_amdgcn_mfma_f32_16x16x32_bf16(ap, bq[ks], acc[et], 0, 0, 0); }
        float s1 = 0.f;
#pragma unroll
        for (int et = 0; et < 8; ++et) s1 += (acc[et][0] + acc[et][1]) + (acc[et][2] + acc[et][3]);
        s1 += SHFLX_F(s1, 16, lane); s1 += SHFLX_F(s1, 32, lane);
        const float mu = s1 * (1.0f / 128.0f);
        float s2 = 0.f;
#pragma unroll
        for (int et = 0; et < 8; ++et)
#pragma unroll
            for (int r = 0; r < 4; ++r) { const float dlt = acc[et][r] - mu; s2 += dlt * dlt; }
        s2 += SHFLX_F(s2, 16, lane); s2 += SHFLX_F(s2, 32, lane);
        const float rstd = 1.0f / sqrtf(s2 * (1.0f / 128.0f) + NORM_EPS);
        const size_t t = t0 + 16 * w + fr;
        u32x2 yo[8];
#pragma unroll
        for (int et = 0; et < 8; ++et) {
            const int e0 = hh * 128 + 16 * et + 4 * fq;
            const f32x4 gv = *(const f32x4*)(gng + e0), bv = *(const f32x4*)(gnb + e0);
            const float y0 = ((acc[et][0] - mu) * rstd * gv[0] + bv[0]) * bflo(sg[et].x), y1 = ((acc[et][1] - mu) * rstd * gv[1] + bv[1]) * bfhi(sg[et].x);
            const float y2 = ((acc[et][2] - mu) * rstd * gv[2] + bv[2]) * bflo(sg[et].y), y3 = ((acc[et][3] - mu) * rstd * gv[3] + bv[3]) * bfhi(sg[et].y);
            yo[et].x = pk2v(y0, y1); yo[et].y = pk2v(y2, y3);
        }
        __syncthreads();
        const bool has_next = unit + G < NBH * NCH;
        if (has_next) {
#pragma unroll
            for (int i = 0; i < 4; ++i) { const int p = tid + 512 * i, r = p >> 4, c = p & 15, o = swz_off(r, c);
                *(LAS u32x4*)(lds + LDS_RV + o) = R.tv[i]; *(LAS u32x4*)(lds + LDS_RK + o) = R.tk[i]; *(LAS u32x4*)(lds + LDS_RP + o) = R.tp[i]; }
#pragma unroll
            for (int ks = 0; ks < 4; ++ks) bq[ks] = R.bq[ks];
#pragma unroll
            for (int et = 0; et < 8; ++et) sg[et] = R.sg[et];
        }
#pragma unroll
        for (int ep = 0; ep < 4; ++ep) *(u32x4*)(ycat + t * D + 512 + hh * 128 + 16 * (2 * ep + (fq & 1)) + 4 * (fq & ~1)) = pair16(yo[2 * ep], yo[2 * ep + 1]);
        __syncthreads();
        if (unit + 2 * G < NBH * NCH) ret_out_load(R, unit + 2 * G, proj, prevt, tid, w, fr, fq);
    }
}

struct Ptrs {
    const float *x, *attn_g, *w_in, *conv_w, *conv_b, *lru_wa, *lru_ba, *lru_wx, *lru_bx, *lru_lam, *lru_ng, *ret_ng, *ret_nb, *w_out, *ffn_g, *router_w, *router_b;
    const float *moe_wg, *moe_bg, *moe_wu, *moe_bu, *moe_wd, *moe_bd, *final_g; const int* positions;
    float *RS1, *RS2S, *SSQ, *GW, *LAP, *LAH, *CARRY, *out; unsigned *LIST, *ctl;
    bf16_t *WR_T, *WIN_T, *WOUT_T, *PROJ, *XB, *YCAT, *YB23, *KVT, *PREVT, *YB01, *WAF; float* RSL; unsigned char *WGU8, *WD8, *X8, *ACT; int wv;
};
__device__ __forceinline__ MoeConv moe_conv(const Ptrs& P) { MoeConv M; M.wg = P.moe_wg; M.wu = P.moe_wu; M.wd = P.moe_wd; M.ffn_g = P.ffn_g; M.wgu8 = P.WGU8; M.wd8 = P.WD8; return M; }
#define PHASE_IDS() int tid = P.wv * 64 + LANE_ID(); OPAQUE(tid); const int lane = tid & 63, wave = P.wv; const int gw = bx * NWAVES + wave, NGW = G * NWAVES; (void)lane; (void)gw; (void)NGW

__device__ __forceinline__ P0Item p0_decode(const Ptrs& P, int it) {
    P0Item d; d.scale = nullptr; d.off = 0; d.mode = 0; d.fp8 = 0; int r = it, nblk;
    if (r < P0_I_IN) { d.W = P.w_in; d.scale = P.attn_g; d.N = DIN; d.WT = P.WIN_T; d.mode = 1; }
    else if ((r -= P0_I_IN) < P0_I_OUT) { d.W = P.w_out; d.N = D; d.WT = P.WOUT_T; }
    else { r -= P0_I_OUT; r += MOE_STREAMED;
        const int e = r / (3 * P0_I_E), q = (r / P0_I_E) % 3; r = r % P0_I_E; d.N = D;
        d.fp8 = 1;
        if (q == 0) { d.W = P.moe_wg + (size_t)e * D * D; d.scale = P.ffn_g; d.WT = P.WGU8; d.mode = 2; d.off = e * 2048; }
        else if (q == 1) { d.W = P.moe_wu + (size_t)e * D * D; d.scale = P.ffn_g; d.WT = P.WGU8; d.mode = 2; d.off = e * 2048 + 128; }
        else { d.W = P.moe_wd + (size_t)e * D * D; d.WT = P.WD8; d.off = e * D; } }
    nblk = d.N / 64; d.k0 = 64 * (r / nblk); d.n0 = 64 * (r % nblk); return d;
}
__device__ __forceinline__ void p0_prologue(LAS unsigned char* lds, const Ptrs& P, int G, int bx) {
    PHASE_IDS();
    {
        f32x4 v[4], nv[4];
        int m = gw;
        if (m < T) {
#pragma unroll
            for (int j = 0; j < 4; ++j) v[j] = __builtin_nontemporal_load((const f32x4*)(P.x + (size_t)m * D) + lane + 64 * j);
        }
        for (; m < T; m += NGW) {
            const int mn = m + NGW;
            if (mn < T) {
#pragma unroll
                for (int j = 0; j < 4; ++j) nv[j] = __builtin_nontemporal_load((const f32x4*)(P.x + (size_t)mn * D) + lane + 64 * j);
            }
            float s = 0.f;
#pragma unroll
            for (int j = 0; j < 4; ++j) s += (v[j].x * v[j].x + v[j].y * v[j].y) + (v[j].z * v[j].z + v[j].w * v[j].w);
            s = wave_sum(s, lane);
            if (lane == 0) P.RS1[m] = 1.0f / sqrtf(s * (1.0f / D) + NORM_EPS);
            u32x2* o8 = (u32x2*)(P.XB + (size_t)m * D) + lane;
#pragma unroll
            for (int j = 0; j < 4; ++j) { u32x2 o; o.x = pk2(v[j].x, v[j].y); o.y = pk2(v[j].z, v[j].w); o8[64 * j] = o; }
#pragma unroll
            for (int j = 0; j < 4; ++j) v[j] = nv[j];
        }
    }
    {
        LAS unsigned char* scr = lds + wave * 16384;
        f32x4 v[16], nv[16]; float sc = 1.f, nsc = 1.f;
        int it = gw;
        P0Item d, nd;
        if (it < P0_NITEMS) { d = p0_decode(P, it); p0_load(d, lane, v, sc); }
        for (; it < P0_NITEMS; it += NGW) {
            const int nit = it + NGW;
            if (nit < P0_NITEMS) { nd = p0_decode(P, nit); p0_load(nd, lane, nv, nsc); }
            p0_process(d, lane, v, sc, scr);
            d = nd; sc = nsc;
#pragma unroll
            for (int i = 0; i < 16; ++i) v[i] = nv[i];
        }
    }
    for (int i = bx * NTHREADS + tid; i < 32 * D; i += G * NTHREADS) { const int e = i / D, k = i % D; P.WR_T[i] = (bf16_t)((e < NEXP) ? f2bf(P.router_w[(size_t)k * NEXP + e] * P.ffn_g[k]) : 0u); }
    for (int i = bx * NTHREADS + tid; i < 2 * 8 * 2 * 4 * 64; i += G * NTHREADS) {
        const int ln = i & 63, nt = (i >> 6) & 3, ks = (i >> 8) & 1, h = (i >> 9) & 7, mat = i >> 12, fr = ln & 15, fq = ln >> 4;
        const float* w = mat ? P.lru_wx : P.lru_wa; unsigned pk[4];
#pragma unroll
        for (int j = 0; j < 4; ++j) { const size_t i0 = ((size_t)h * 64 + 32 * ks + 8 * fq + 2 * j) * 64 + 16 * nt + fr; pk[j] = pk2(w[i0], w[i0 + 64]); }
        *(u32x4*)(P.WAF + (size_t)i * 8) = (u32x4){pk[0], pk[1], pk[2], pk[3]};
    }
}

__device__ __forceinline__ void p3_scans(const Ptrs& P, int G, int bx) {
    PHASE_IDS();
    if (wave == NWAVES - 1) {
        const int per = (BATCH * 512 + G - 1) / G;
        for (int i = bx * per + lane; lane < per && i < BATCH * 512 && i < (bx + 1) * per; i += 64) { const int b = i / 512, c = i % 512; float st = 0.f;
            for (int n0 = 0; n0 < NCH; n0 += 32) {
                float ap[32], ah[32];
#pragma unroll
                for (int j = 0; j < 32; ++j) { const size_t o = ((size_t)b * NCH + (n0 + j < NCH ? n0 + j : 0)) * 512 + c; ap[j] = P.LAP[o]; ah[j] = P.LAH[o]; }
#pragma unroll
                for (int j = 0; j < 32; ++j) { if (n0 + j < NCH) { P.CARRY[((size_t)b * NCH + n0 + j) * 512 + c] = st; st = ap[j] * st + ah[j]; } }
            }
        }
    }
    for (int i = bx * NTHREADS + tid; i < NBH * 8192; i += G * NTHREADS) {
        const int bh = i / 8192, rem = i % 8192, hh = bh & 3;
        const float lamb = exp2f(128.0f * log2_gamma(hh));
        float s0 = 0.f, s1 = 0.f;
        const unsigned* src = (const unsigned*)(P.KVT + (size_t)bh * NCH * 16384) + rem; unsigned* dst = (unsigned*)(P.PREVT + (size_t)bh * NCH * 16384) + rem;
        for (int n0 = 0; n0 < NCH; n0 += 64) {
            unsigned kv[64];
#pragma unroll
            for (int j = 0; j < 64; ++j) kv[j] = (n0 + j < NCH) ? src[(size_t)(n0 + j) * 8192] : 0u;
#pragma unroll
            for (int j = 0; j < 64; ++j) { if (n0 + j < NCH) { dst[(size_t)(n0 + j) * 8192] = pk2(s0, s1); s0 = lamb * (s0 + bflo(kv[j])); s1 = lamb * (s1 + bfhi(kv[j])); } }
        }
    }
}

constexpr int CW_HIST = 32768;
__device__ __forceinline__ void p6_router(LAS unsigned char* lds, const Ptrs& P, int G, int bx, const XcdBarrier& bar) {
    PHASE_IDS();
    LAS unsigned* hist = (LAS unsigned*)(lds + 0); LAS unsigned* base = (LAS unsigned*)(lds + 256); LAS unsigned* part = (LAS unsigned*)(lds + 512);
    const int fr = lane & 15, fq = lane >> 4;
    const bool act = bx < T / 128;
    if (tid < 64) hist[tid] = 0u;
    __syncthreads();
    const int tok = (act ? bx : 0) * 128 + wave * 16 + fr;
    constexpr int WR_LDS = 8192, WR_PITCH = 2064;
#pragma unroll
    for (int j = 0; j < 8; ++j) { const int r = wave * 4 + (j >> 1), h = j & 1;
        __builtin_amdgcn_global_load_lds((const unsigned*)((const char*)P.WR_T + (size_t)r * 2048 + h * 1024 + lane * 16), (LAS unsigned*)(lds + WR_LDS + r * WR_PITCH + h * 1024), 16, 0, 0); }
    bf16x8 bt[32];
#pragma unroll
    for (int ks = 0; ks < 32; ++ks) bt[ks] = *(const bf16x8*)(P.YB01 + (size_t)tok * 2048 + 32 * ks + 8 * fq);
    float sq[16];
#pragma unroll
    for (int p = 0; p < 16; ++p) sq[p] = P.SSQ[(size_t)p * T + tok];
    ASM_VMCNT(0);
    __syncthreads();
    f32x4 lg[2] = {{0.f, 0.f, 0.f, 0.f}, {0.f, 0.f, 0.f, 0.f}};
#pragma unroll
    for (int ks = 0; ks < 32; ++ks) {
#pragma unroll
        for (int tt = 0; tt < 2; ++tt) { const bf16x8 aw = *(const LAS bf16x8*)(lds + WR_LDS + (16 * tt + fr) * WR_PITCH + (32 * ks + 8 * fq) * 2);
            lg[tt] = __builtin_amdgcn_mfma_f32_16x16x32_bf16(aw, bt[ks], lg[tt], 0, 0, 0); }
    }
    float tot = 0.f;
#pragma unroll
    for (int p = 0; p < 16; ++p) tot += sq[p];
    const float rs = 1.0f / sqrtf(tot * (1.0f / D) + NORM_EPS);
    float val[8];
#pragma unroll
    for (int tt = 0; tt < 2; ++tt)
#pragma unroll
        for (int r = 0; r < 4; ++r) { const int e = 16 * tt + 4 * fq + r; val[4 * tt + r] = (e < NEXP) ? (lg[tt][r] * rs + P.router_b[e < NEXP ? e : 0]) : -3.0e38f; }
    float tv[4]; int ti[4];
#pragma unroll
    for (int k = 0; k < 4; ++k) {
        float bv = -3.4e38f; int bi = 1 << 20;
#pragma unroll
        for (int q = 0; q < 8; ++q) { const int e = 16 * (q >> 2) + 4 * fq + (q & 3); if (val[q] > bv || (val[q] == bv && e < bi)) { bv = val[q]; bi = e; } }
#pragma unroll
        for (int o = 16; o <= 32; o <<= 1) { const float ov = SHFLX_F(bv, o, lane); const int oi = SHFLX_I(bi, o, lane); if (ov > bv || (ov == bv && oi < bi)) { bv = ov; bi = oi; } }
        tv[k] = bv; ti[k] = bi;
#pragma unroll
        for (int q = 0; q < 8; ++q) { const int e = 16 * (q >> 2) + 4 * fq + (q & 3); if (e == bi) val[q] = -3.4e38f; }
    }
    float ex[4], den = 0.f;
#pragma unroll
    for (int k = 0; k < 4; ++k) { ex[k] = expf(tv[k] - tv[0]); den += ex[k]; }
    unsigned lp[4] = {0u, 0u, 0u, 0u};
    if (act && fq == 0) {
#pragma unroll
        for (int k = 0; k < 4; ++k) lp[k] = __hip_atomic_fetch_add(&hist[ti[k]], 1u, __ATOMIC_RELAXED, __HIP_MEMORY_SCOPE_WORKGROUP);
    }
    __syncthreads();
    if (tid < 32) P.ctl[CW_HIST + bx * 32 + tid] = hist[tid];
    xcd_barrier(bar, P.wv);
    {
        const int e = tid & 31, pt = tid >> 5; unsigned sum = 0u;
        unsigned all = 0u;
#pragma unroll
        for (int i = 0; i < 16; ++i) { const int w = pt * 16 + i; const unsigned c = P.ctl[CW_HIST + (w < G ? w : 0) * 32 + e]; sum += (w < bx) ? c : 0u; all += (w < G) ? c : 0u; }
        part[pt * 32 + e] = sum; part[512 + pt * 32 + e] = all;
    }
    __syncthreads();
    if (tid < 32) { unsigned sum = 0u;
#pragma unroll
        for (int i = 0; i < 16; ++i) sum += part[i * 32 + tid];
        base[tid] = sum;
        unsigned all = 0u;
#pragma unroll
        for (int i = 0; i < 16; ++i) all += part[512 + i * 32 + tid];
        if (tid < NEXP) ((LAS unsigned*)(lds + TAB_CNT))[tid] = all;
        if (bx == G - 1 && tid < NEXP) P.ctl[CW_CNT + 64 * tid] = all; }
    (void)moe_build_tabs(lds, nullptr, P.wv);
    if (act && fq == 0) {
#pragma unroll
        for (int k = 0; k < 4; ++k) { const size_t o = (size_t)ti[k] * T + base[ti[k]] + lp[k]; P.LIST[o] = (unsigned)tok * 4u + (unsigned)k; P.GW[o] = ex[k] / den; P.RS2S[o] = rs; }
    }
    __syncthreads();
}

__device__ __forceinline__ void p9_final(const Ptrs& P, int G, int bx) {
    PHASE_IDS();
    const unsigned char* Y8 = (const unsigned char*)P.YB23;
    u32x4 q[2], nq[2], nnq[2]; u32x2 e[8], ne[8], nne[8];
    int m = gw;
#define P9_LOAD(dq, de, row) do { _Pragma("unroll") for (int j = 0; j < 2; ++j) { const int col = (j * 64 + lane) * 8; \
        dq[j] = __builtin_nontemporal_load((const u32x4*)(P.YB01 + (size_t)(row) * 2048 + col)); \
        _Pragma("unroll") for (int k = 0; k < 4; ++k) de[4 * j + k] = __builtin_nontemporal_load((const u32x2*)(Y8 + (size_t)(row) * 4096 + k * 1024 + col)); } } while (0)
    if (m < T) P9_LOAD(q, e, m);
    if (m + NGW < T) P9_LOAD(nq, ne, m + NGW);
    f32x4 g0[2], g1[2];
#pragma unroll
    for (int j = 0; j < 2; ++j) { const int col = (j * 64 + lane) * 8; g0[j] = *(const f32x4*)(P.final_g + col); g1[j] = *(const f32x4*)(P.final_g + col + 4); }
    for (; m < T; m += NGW) {
        const int mn = m + 2 * NGW;
        if (mn < T) P9_LOAD(nnq, nne, mn);
        float v[2][8]; float s = 0.f;
#pragma unroll
        for (int j = 0; j < 2; ++j) {
            f32x2 t[4] = {{0.f, 0.f}, {0.f, 0.f}, {0.f, 0.f}, {0.f, 0.f}};
#pragma unroll
            for (int k = 0; k < 4; ++k) { const u32x2 w = e[4 * j + k]; t[0] += unpk2_fp8(w.x, false); t[1] += unpk2_fp8(w.x, true); t[2] += unpk2_fp8(w.y, false); t[3] += unpk2_fp8(w.y, true); }
            const u32x4 a = q[j];
            v[j][0] = bflo(a.x) + t[0].x * (1.0f / Y8_SCALE); v[j][1] = bfhi(a.x) + t[0].y * (1.0f / Y8_SCALE); v[j][2] = bflo(a.y) + t[1].x * (1.0f / Y8_SCALE); v[j][3] = bfhi(a.y) + t[1].y * (1.0f / Y8_SCALE);
            v[j][4] = bflo(a.z) + t[2].x * (1.0f / Y8_SCALE); v[j][5] = bfhi(a.z) + t[2].y * (1.0f / Y8_SCALE); v[j][6] = bflo(a.w) + t[3].x * (1.0f / Y8_SCALE); v[j][7] = bfhi(a.w) + t[3].y * (1.0f / Y8_SCALE);
#pragma unroll
            for (int k = 0; k < 8; ++k) s += v[j][k] * v[j][k];
        }
        s = wave_sum(s, lane);
        const float rs = 1.0f / sqrtf(s * (1.0f / D) + NORM_EPS);
#pragma unroll
        for (int j = 0; j < 2; ++j) {
            const int col = (j * 64 + lane) * 8;
            f32x4 o0, o1;
#pragma unroll
            for (int k = 0; k < 4; ++k) { o0[k] = v[j][k] * rs * g0[j][k]; o1[k] = v[j][4 + k] * rs * g1[j][k]; }
            __builtin_nontemporal_store(o0, (f32x4*)(P.out + (size_t)m * D + col)); __builtin_nontemporal_store(o1, (f32x4*)(P.out + (size_t)m * D + col + 4));
        }
#pragma unroll
        for (int k = 0; k < 2; ++k) { q[k] = nq[k]; nq[k] = nnq[k]; }
#pragma unroll
        for (int k = 0; k < 8; ++k) { e[k] = ne[k]; ne[k] = nne[k]; }
    }
#undef P9_LOAD
}

#ifndef REPEAT_PHASE
#define REPEAT_PHASE -1
#define REPEAT_N 0
#endif
#define RUN_PHASE(k, call) do { call; xcd_barrier(bar, P.wv); \
    if (REPEAT_PHASE == (k) && REPEAT_N >= 1) { call; xcd_barrier(bar, P.wv); } \
    if (REPEAT_PHASE == (k) && REPEAT_N >= 2) { call; xcd_barrier(bar, P.wv); } \
    if (REPEAT_PHASE == (k) && REPEAT_N >= 3) { call; xcd_barrier(bar, P.wv); } } while (0)

struct Args { const void* in[25]; float* out; unsigned char* ws; };

__device__ __forceinline__ void p1_gemm(LAS unsigned char* lds, const Ptrs& P, int G, int bx) { ProbIn pr; pr.xb = P.XB; pr.wt = P.WIN_T; pr.rs1 = P.RS1; pr.pos = P.positions; pr.proj = P.PROJ; pr.G = G; pr.c = bx; pg8::gemm_phase(lds, pr, P.wv); }
__device__ __forceinline__ void p2_seq(LAS unsigned char* lds, const Ptrs& P, int G, int bx) {
    for (int u = bx; u < BATCH * NCH; u += G) lru_unit<false>(lds, u / NCH, u % NCH, P.PROJ, P.conv_w, P.conv_b, P.WAF, P.lru_ba, P.lru_bx, P.lru_lam, P.lru_ng, P.LAP, P.LAH, nullptr, nullptr, nullptr, moe_conv(P), u * 8 * MOE_K0, P.wv);
    ret_kv_phase(lds, P.PROJ, P.KVT, G, bx, P.wv);
}
__device__ __forceinline__ void p4_lru(LAS unsigned char* lds, const Ptrs& P, int G, int bx) {
    for (int u = bx; u < BATCH * NCH; u += G) lru_unit<true>(lds, u / NCH, u % NCH, P.PROJ, P.conv_w, P.conv_b, P.WAF, P.lru_ba, P.lru_bx, P.lru_lam, P.lru_ng, nullptr, nullptr, P.CARRY, P.YCAT, P.RSL, moe_conv(P), MOE_PASS0_ITEMS + u * 8 * MOE_K1, P.wv);
}
__device__ __forceinline__ void p4_ret(LAS unsigned char* lds, const Ptrs& P, int G, int bx) {
    ret_out_phase(lds, P.PROJ, P.PREVT, P.ret_ng, P.ret_nb, P.YCAT, G, bx, P.wv);
}
__device__ __forceinline__ void p4_seq(LAS unsigned char* lds, const Ptrs& P, int G, int bx) {
    for (int u = bx; u < BATCH * NCH; u += G) lru_unit<true>(lds, u / NCH, u % NCH, P.PROJ, P.conv_w, P.conv_b, P.WAF, P.lru_ba, P.lru_bx, P.lru_lam, P.lru_ng, nullptr, nullptr, P.CARRY, P.YCAT, P.RSL, moe_conv(P), MOE_PASS0_ITEMS + u * 8 * MOE_K1, P.wv);
    ret_out_phase(lds, P.PROJ, P.PREVT, P.ret_ng, P.ret_nb, P.YCAT, G, bx, P.wv);
}
__device__ __forceinline__ void p5_gemm(LAS unsigned char* lds, const Ptrs& P, int G, int bx) { ProbOut pr; pr.ycat = P.YCAT; pr.wt = P.WOUT_T; pr.xb = P.XB; pr.rsl = P.RSL; pr.yb01 = P.YB01; pr.x8 = P.X8; pr.ssq = P.SSQ; pr.G = G; pr.c = bx; pg8::gemm_phase(lds, pr, P.wv); }
__device__ __forceinline__ void p7_gemm(LAS unsigned char* lds, const Ptrs& P, int G, int bx, int probe_mode = 0) {
    const MoeTabs tabs = moe_reuse_tabs(lds);
    ProbUp pr; pr.probe_mode = probe_mode; pr.tabs = tabs; pr.x8 = P.X8; pr.wgu = P.WGU8; pr.list = P.LIST; pr.rs2s = P.RS2S; pr.bg = P.moe_bg; pr.bu = P.moe_bu; pr.act = P.ACT; pr.G = G; pr.c = bx;
    pg8::gemm_phase(lds, pr, P.wv);
}
__device__ __forceinline__ void p8_gemm(LAS unsigned char* lds, const Ptrs& P, int G, int bx, int probe_mode = 0) {
    const MoeTabs tabs = moe_reuse_tabs(lds);
    ProbDown pr; pr.probe_mode = probe_mode; pr.tabs = tabs; pr.act = P.ACT; pr.wd = P.WD8; pr.list = P.LIST; pr.gw = P.GW; pr.bd = P.moe_bd; pr.y8 = (unsigned char*)P.YB23; pr.G = G; pr.c = bx;
    pg8::gemm_phase(lds, pr, P.wv);
}

__global__ void __launch_bounds__(NTHREADS, 2) mega_fwd(Args args) {
#ifdef CPU_EMU
    unsigned char* lds_raw = emu::cur->blk->lds;
#else
    extern __shared__ __attribute__((aligned(16))) unsigned char lds_raw[];
#endif
    LAS unsigned char* lds = (LAS unsigned char*)lds_raw;
    volatile LAS unsigned* MISC = (volatile LAS unsigned*)(lds + MISC_OFF);
    const int G = gridDim.x, bx = blockIdx.x;
    unsigned char* ws = args.ws;
    Ptrs P;
    P.wv = __builtin_amdgcn_readfirstlane((int)(threadIdx.x >> 6));
    P.x = (const float*)args.in[0]; P.positions = (const int*)args.in[1]; P.attn_g = (const float*)args.in[2];
    P.w_in = (const float*)args.in[3]; P.conv_w = (const float*)args.in[4]; P.conv_b = (const float*)args.in[5];
    P.lru_wa = (const float*)args.in[6]; P.lru_ba = (const float*)args.in[7]; P.lru_wx = (const float*)args.in[8]; P.lru_bx = (const float*)args.in[9];
    P.lru_lam = (const float*)args.in[10]; P.lru_ng = (const float*)args.in[11]; P.ret_ng = (const float*)args.in[12]; P.ret_nb = (const float*)args.in[13];
    P.w_out = (const float*)args.in[14]; P.ffn_g = (const float*)args.in[15]; P.router_w = (const float*)args.in[16]; P.router_b = (const float*)args.in[17];
    P.moe_wg = (const float*)args.in[18]; P.moe_bg = (const float*)args.in[19]; P.moe_wu = (const float*)args.in[20]; P.moe_bu = (const float*)args.in[21];
    P.moe_wd = (const float*)args.in[22]; P.moe_bd = (const float*)args.in[23]; P.final_g = (const float*)args.in[24];
    P.ctl = (unsigned*)(ws + WS_CTL);
    P.RS1 = (float*)(ws + WS_RS1); P.RS2S = (float*)(ws + WS_RS2S); P.SSQ = (float*)(ws + WS_SSQ); P.GW = (float*)(ws + WS_GW);
    P.LIST = (unsigned*)(ws + WS_LIST); P.LAP = (float*)(ws + WS_LAP); P.LAH = (float*)(ws + WS_LAH); P.CARRY = (float*)(ws + WS_CARRY);
    P.WAF = (bf16_t*)(ws + WS_WAF); P.RSL = (float*)(ws + WS_RSL);
    P.WR_T = (bf16_t*)(ws + WS_WR); P.WIN_T = (bf16_t*)(ws + WS_WIN); P.WOUT_T = (bf16_t*)(ws + WS_WOUT); P.WGU8 = ws + WS_WGU; P.WD8 = ws + WS_WD; P.X8 = ws + WS_X8;
    P.PROJ = (bf16_t*)(ws + WS_PROJ); P.XB = (bf16_t*)(ws + WS_XB); P.YCAT = (bf16_t*)(ws + WS_YCAT); P.ACT = ws + WS_ACT; P.YB23 = (bf16_t*)(ws + WS_YB23);
    P.KVT = (bf16_t*)((unsigned char*)args.out + DO_KVT); P.PREVT = (bf16_t*)((unsigned char*)args.out + DO_PREVT); P.YB01 = (bf16_t*)args.out; P.out = args.out;

    for (int u = (int)threadIdx.x; u < (LDS_BYTES - RING_BYTES) / 4; u += NTHREADS) ((LAS unsigned*)(lds + RING_BYTES))[u] = 0u;
    __syncthreads();
    const XcdBarrier bar = xcd_barrier_post(P.ctl + CW_BAR, MISC + 8, P.wv);

    if (REPEAT_PHASE == 100) { xcd_barrier(bar, P.wv); xcd_barrier(bar, P.wv); xcd_barrier(bar, P.wv); xcd_barrier(bar, P.wv); xcd_barrier(bar, P.wv); xcd_barrier(bar, P.wv); xcd_barrier(bar, P.wv); xcd_barrier(bar, P.wv); }
    RUN_PHASE(0, p0_prologue(lds, P, G, bx));
    RUN_PHASE(1, p1_gemm(lds, P, G, bx));
    RUN_PHASE(2, p2_seq(lds, P, G, bx));
    RUN_PHASE(3, p3_scans(P, G, bx));
    RUN_PHASE(4, p4_seq(lds, P, G, bx));
    if (REPEAT_PHASE == 41) { p4_lru(lds, P, G, bx); xcd_barrier(bar, P.wv); p4_lru(lds, P, G, bx); xcd_barrier(bar, P.wv); }
    if (REPEAT_PHASE == 42) { p4_ret(lds, P, G, bx); xcd_barrier(bar, P.wv); p4_ret(lds, P, G, bx); xcd_barrier(bar, P.wv); }
    RUN_PHASE(5, p5_gemm(lds, P, G, bx));
    RUN_PHASE(6, p6_router(lds, P, G, bx, bar));
    if (REPEAT_PHASE == 71) { p7_gemm(lds, P, G, bx, 1); xcd_barrier(bar, P.wv); p7_gemm(lds, P, G, bx, 1); xcd_barrier(bar, P.wv); }
    if (REPEAT_PHASE == 72) { p7_gemm(lds, P, G, bx, 2); xcd_barrier(bar, P.wv); }
#if REPEAT_PHASE >= 300 && REPEAT_PHASE < 316
    {   const MoeTabs tabs = moe_build_tabs(lds, P.ctl, P.wv);
        ProbUpDiag<REPEAT_PHASE - 300> pr; pr.probe_mode = 1; pr.tabs = tabs; pr.x8 = P.X8; pr.wgu = P.WGU8; pr.list = P.LIST; pr.rs2s = P.RS2S; pr.bg = P.moe_bg; pr.bu = P.moe_bu; pr.act = P.ACT; pr.G = G; pr.c = bx;
        pg8::gemm_phase(lds, pr, P.wv); xcd_barrier(bar, P.wv); pg8::gemm_phase(lds, pr, P.wv); xcd_barrier(bar, P.wv); }
#endif
#if REPEAT_PHASE == 200 || REPEAT_PHASE == 201
    {
        const unsigned long long t0 = __builtin_amdgcn_s_memtime(), r0 = __builtin_amdgcn_s_memrealtime();
        if (REPEAT_PHASE == 200) p7_gemm(lds, P, G, bx, 1); else p1_gemm(lds, P, G, bx);
        const unsigned long long t1 = __builtin_amdgcn_s_memtime(), r1 = __builtin_amdgcn_s_memrealtime();
        if (bx == 0) { const unsigned long long mhz = (t1 - t0) * 100ull / (r1 - r0); while (__builtin_amdgcn_s_memrealtime() - r1 < mhz * 10ull) __builtin_amdgcn_s_sleep(8); }
        xcd_barrier(bar, P.wv);
    }
#endif
    RUN_PHASE(7, p7_gemm(lds, P, G, bx));
    if (REPEAT_PHASE == 81) { p8_gemm(lds, P, G, bx, 1); xcd_barrier(bar, P.wv); p8_gemm(lds, P, G, bx, 1); xcd_barrier(bar, P.wv); }
    RUN_PHASE(8, p8_gemm(lds, P, G, bx));
    if (REPEAT_PHASE == 9) { Ptrs Q = P; Q.out = (float*)P.ACT; p9_final(Q, G, bx); xcd_barrier(bar, P.wv); }
    p9_final(P, G, bx);
}

extern "C" void kernel_launch(void* const* d_in, const int* in_sizes, int n_in, void* d_out, int out_size, void* d_ws, size_t ws_size, hipStream_t stream) {
    static int grid = 0;
    if (grid == 0) {
        if (n_in != 25 || out_size != T * D || ws_size < WS_END) { fprintf(stderr, "kernel_launch: unexpected shapes (n_in %d, out %d, ws %zu, need %zu)\n", n_in, out_size, ws_size, (size_t)WS_END); grid = -1; return; }
        int dev = 0, cus = 0;
        if (hipGetDevice(&dev) != hipSuccess || hipDeviceGetAttribute(&cus, hipDeviceAttributeMultiprocessorCount, dev) != hipSuccess) { fprintf(stderr, "kernel_launch: device query failed\n"); grid = -1; return; }
        if (hipFuncSetAttribute((const void*)mega_fwd, hipFuncAttributeMaxDynamicSharedMemorySize, LDS_BYTES) != hipSuccess) { fprintf(stderr, "kernel_launch: hipFuncSetAttribute failed\n"); grid = -1; return; }
        (void)hipGetLastError();
        if (cus < T / 128 || cus > 256) { fprintf(stderr, "kernel_launch: the router phase needs T/128 <= CUs <= 256 (have %d)\n", cus); grid = -1; return; }
        grid = cus;
    }
    if (grid < 0) return;
    (void)in_sizes;
    (void)hipMemsetAsync((char*)d_ws + WS_CTL, 0, CTL_ZERO_BYTES, stream);
    Args a{};
    for (int i = 0; i < 25; ++i) a.in[i] = d_in[i];
    a.out = (float*)d_out; a.ws = (unsigned char*)d_ws;
    hipLaunchKernelGGL(mega_fwd, dim3(grid), dim3(NTHREADS), LDS_BYTES, stream, a);
}
```
